# Optimizing an MI355X kernel written in HIP

```python
import numpy as np
import jax, jax.numpy as jnp
from jax import lax

D_MODEL = 1024
BATCH = 8
SEQ = 4096
DEPTH = 1

HEAD_DIM = 64
N_FOX_HEADS = 8
N_NSA_HEADS = 8
N_NSA_KV = 2
NSA_GROUP = N_NSA_HEADS // N_NSA_KV
FOX_WIDTH = N_FOX_HEADS * HEAD_DIM
NSA_WIDTH = N_NSA_HEADS * HEAD_DIM
MIX_WIDTH = FOX_WIDTH + NSA_WIDTH
KV_WIDTH = N_NSA_KV * HEAD_DIM
CMP_LEN = 32
CMP_STRIDE = 16
CMP_HIDDEN = 256
SEL_LEN = 64
SEL_TOPK = 16
WINDOW = 512
Q_BLOCK = 128
SEL_Q_BLOCK = 64
D_FF = 4 * D_MODEL
ROPE_THETA = 10000.0
EPS = 1e-6
NEG = -1e30
FORCE_BONUS = 1e4
IN_SIZES = [FOX_WIDTH, FOX_WIDTH, FOX_WIDTH, N_FOX_HEADS,
            NSA_WIDTH,
            KV_WIDTH, KV_WIDTH,
            KV_WIDTH, KV_WIDTH,
            KV_WIDTH, KV_WIDTH,
            3 * N_NSA_HEADS]
N_IN = sum(IN_SIZES)

kernel_name = "hymba_fox_nsa_hybrid_layer"


def rmsnorm(x, g):
    xf = x.astype(jnp.float32)
    y = xf * lax.rsqrt(jnp.mean(xf * xf, axis=-1, keepdims=True) + EPS)
    return (y * g.astype(jnp.float32)).astype(x.dtype)


def rope(x, pos):
    half = HEAD_DIM // 2
    inv = ROPE_THETA ** (-jnp.arange(half, dtype=jnp.float32) / half)
    ang = pos.astype(jnp.float32)[:, None] * inv[None, :]
    cos = jnp.cos(ang)[:, None, :]
    sin = jnp.sin(ang)[:, None, :]
    xf = x.astype(jnp.float32)
    x1, x2 = xf[..., :half], xf[..., half:]
    out = jnp.concatenate([x1 * cos - x2 * sin, x1 * sin + x2 * cos], axis=-1)
    return out.astype(x.dtype)


def forgetting_attention(q, k, v, f_logit):
    B, S, H, dh = q.shape
    c = jnp.cumsum(jax.nn.log_sigmoid(f_logit.astype(jnp.float32)), axis=1)
    nq = S // Q_BLOCK
    qb = q.reshape(B, nq, Q_BLOCK, H, dh).transpose(1, 0, 2, 3, 4)
    cb = c.reshape(B, nq, Q_BLOCK, H).transpose(1, 0, 2, 3)
    starts = jnp.arange(nq) * Q_BLOCK
    kpos = jnp.arange(S)
    c_k = c.transpose(0, 2, 1)
    scale = HEAD_DIM ** -0.5

    def block(args):
        q_blk, c_blk, start = args
        qpos = start + jnp.arange(Q_BLOCK)
        s = jnp.einsum('bqhd,bkhd->bhqk', q_blk, k).astype(jnp.float32) * scale
        s = s + c_blk.transpose(0, 2, 1)[..., None] - c_k[:, :, None, :]
        s = jnp.where(kpos[None, :] <= qpos[:, None], s, NEG)
        p = jax.nn.softmax(s, axis=-1)
        return jnp.einsum('bhqk,bkhd->bqhd', p.astype(v.dtype), v)

    o = lax.map(block, (qb, cb, starts))
    return o.transpose(1, 0, 2, 3, 4).reshape(B, S, H, dh)


def compress(x_raw, pe, w1, b1, w2, b2):
    B, S, G, dh = x_raw.shape
    nc = (S - CMP_LEN) // CMP_STRIDE + 1
    idx = jnp.arange(nc)[:, None] * CMP_STRIDE + jnp.arange(CMP_LEN)[None, :]
    blk = x_raw[:, idx] + pe[None, None, :, None, :]
    blk = blk.transpose(0, 1, 3, 2, 4).reshape(B, nc, G, CMP_LEN * dh)
    h = jax.nn.gelu(blk @ w1 + b1)
    return h @ w2 + b2


def nsa_compressed_selected(q, k_cmp, v_cmp, k_slc, v_slc):
    B, S, H, dh = q.shape
    G = N_NSA_KV
    nc = k_cmp.shape[1]
    nb = S // SEL_LEN
    topk = min(SEL_TOPK, nb)
    scale = HEAD_DIM ** -0.5
    cmp_start = jnp.arange(nc) * CMP_STRIDE
    cmp_end = cmp_start + CMP_LEN - 1
    sel_start = jnp.arange(nb) * SEL_LEN
    overlap = ((cmp_start[:, None] < sel_start[None, :] + SEL_LEN)
               & (cmp_start[:, None] + CMP_LEN > sel_start[None, :])).astype(jnp.float32)
    k_t = k_slc.transpose(0, 2, 1, 3)
    v_t = v_slc.transpose(0, 2, 1, 3)
    b_ix = jnp.arange(B)[:, None, None]
    g_ix = jnp.arange(G)[None, :, None]
    jb = jnp.arange(nb)
    nq = S // SEL_Q_BLOCK
    qb = q.reshape(B, nq, SEL_Q_BLOCK, G, NSA_GROUP, dh).transpose(1, 0, 2, 3, 4, 5)
    starts = jnp.arange(nq) * SEL_Q_BLOCK

    def block(args):
        q_blk, start = args
        qpos = start + jnp.arange(SEL_Q_BLOCK)
        s = jnp.einsum('bqgnd,bcgd->bgnqc', q_blk, k_cmp).astype(jnp.float32) * scale
        vis = cmp_end[None, :] <= qpos[:, None]
        p_cmp = jnp.where(vis, jax.nn.softmax(jnp.where(vis, s, NEG), axis=-1), 0.0)
        o_cmp = jnp.einsum('bgnqc,bcgd->bqgnd', p_cmp.astype(v_cmp.dtype), v_cmp)
        imp = jnp.einsum('bgnqc,cj->bgqj', p_cmp, overlap)
        cur = qpos // SEL_LEN
        valid = jb[None, :] <= cur[:, None]
        forced = (jb[None, :] == 0) | (jb[None, :] == cur[:, None]) | (jb[None, :] == cur[:, None] - 1)
        score = jnp.where(valid, imp + jnp.where(forced, FORCE_BONUS, 0.0), -1.0)
        _, sel = lax.top_k(score, topk)
        kpos = (sel[..., None] * SEL_LEN + jnp.arange(SEL_LEN)).reshape(B, G, SEL_Q_BLOCK * topk * SEL_LEN)
        ks = k_t[b_ix, g_ix, kpos].reshape(B, G, SEL_Q_BLOCK, topk * SEL_LEN, dh)
        vs = v_t[b_ix, g_ix, kpos].reshape(B, G, SEL_Q_BLOCK, topk * SEL_LEN, dh)
        kpos = kpos.reshape(B, G, SEL_Q_BLOCK, topk * SEL_LEN)
        s2 = jnp.einsum('bqgnd,bgqkd->bgnqk', q_blk, ks).astype(jnp.float32) * scale
        mask = (kpos <= qpos[None, None, :, None])[:, :, None]
        p2 = jax.nn.softmax(jnp.where(mask, s2, NEG), axis=-1)
        o_slc = jnp.einsum('bgnqk,bgqkd->bqgnd', p2.astype(vs.dtype), vs)
        return o_cmp, o_slc

    o_cmp, o_slc = lax.map(block, (qb, starts))
    o_cmp = o_cmp.transpose(1, 0, 2, 3, 4, 5).reshape(B, S, H, dh)
    o_slc = o_slc.transpose(1, 0, 2, 3, 4, 5).reshape(B, S, H, dh)
    return o_cmp, o_slc


def nsa_window(q, k, v):
    B, S, H, dh = q.shape
    G = N_NSA_KV
    scale = HEAD_DIM ** -0.5
    span = WINDOW + Q_BLOCK
    kp = jnp.pad(k, ((0, 0), (WINDOW, 0), (0, 0), (0, 0)))
    vp = jnp.pad(v, ((0, 0), (WINDOW, 0), (0, 0), (0, 0)))
    nq = S // Q_BLOCK
    qb = q.reshape(B, nq, Q_BLOCK, G, NSA_GROUP, dh).transpose(1, 0, 2, 3, 4, 5)
    starts = jnp.arange(nq) * Q_BLOCK

    def block(args):
        q_blk, start = args
        kb = lax.dynamic_slice_in_dim(kp, start, span, axis=1)
        vb = lax.dynamic_slice_in_dim(vp, start, span, axis=1)
        qpos = start + jnp.arange(Q_BLOCK)
        kpos = start - WINDOW + jnp.arange(span)
        s = jnp.einsum('bqgnd,bkgd->bgnqk', q_blk, kb).astype(jnp.float32) * scale
        diff = qpos[:, None] - kpos[None, :]
        mask = (kpos[None, :] >= 0) & (diff >= 0) & (diff < WINDOW)
        p = jax.nn.softmax(jnp.where(mask, s, NEG), axis=-1)
        return jnp.einsum('bgnqk,bkgd->bqgnd', p.astype(vb.dtype), vb)

    o = lax.map(block, (qb, starts))
    return o.transpose(1, 0, 2, 3, 4, 5).reshape(B, S, H, dh)


def hybrid_mixer(h, w_in, b_f, b_gate, cmpk_pe, cmpk_w1, cmpk_b1, cmpk_w2, cmpk_b2,
                 cmpv_pe, cmpv_w1, cmpv_b1, cmpv_w2, cmpv_b2, g_fox, g_nsa, w_out):
    B, S, _ = h.shape
    pos = jnp.arange(S)
    proj = h @ w_in
    offsets = np.cumsum(IN_SIZES)[:-1].tolist()
    (q_f, k_f, v_f, f_logit, q_n, kc, vc, ks, vs, kw, vw, gate) = jnp.split(proj, offsets, axis=-1)
    fh = lambda t: t.reshape(B, S, N_FOX_HEADS, HEAD_DIM)
    o_fox = forgetting_attention(fh(q_f), fh(k_f), fh(v_f), f_logit + b_f)
    kvh = lambda t: t.reshape(B, S, N_NSA_KV, HEAD_DIM)
    q_n = rope(q_n.reshape(B, S, N_NSA_HEADS, HEAD_DIM), pos)
    k_cmp = compress(kvh(kc), cmpk_pe, cmpk_w1, cmpk_b1, cmpk_w2, cmpk_b2)
    nc = k_cmp.shape[1]
    k_cmp = rope(k_cmp, jnp.arange(nc) * CMP_STRIDE + CMP_LEN - 1)
    v_cmp = compress(kvh(vc), cmpv_pe, cmpv_w1, cmpv_b1, cmpv_w2, cmpv_b2)
    o_cmp, o_slc = nsa_compressed_selected(q_n, k_cmp, v_cmp, rope(kvh(ks), pos), kvh(vs))
    o_win = nsa_window(q_n, rope(kvh(kw), pos), kvh(vw))
    g = jax.nn.sigmoid((gate + b_gate).astype(jnp.float32)).reshape(B, S, N_NSA_HEADS, 3).astype(h.dtype)
    o_nsa = g[..., 0:1] * o_cmp + g[..., 1:2] * o_slc + g[..., 2:3] * o_win
    y = jnp.concatenate([rmsnorm(o_fox.reshape(B, S, FOX_WIDTH), g_fox),
                         rmsnorm(o_nsa.reshape(B, S, NSA_WIDTH), g_nsa)], axis=-1)
    return y @ w_out


def squared_relu_mlp(h, w_up, w_down):
    return jnp.square(jax.nn.relu(h @ w_up)) @ w_down


def setup_inputs(seed: int = 0) -> dict:
    key = jax.random.key(seed)
    ks = jax.random.split(key, 24)
    nrm = lambda k, shape, fan: jax.random.normal(k, shape, jnp.float32) * (fan ** -0.5)
    gain = lambda k, shape: 1.0 + 0.02 * jax.random.normal(k, shape, jnp.float32)
    small = lambda k, shape: 0.01 * jax.random.normal(k, shape, jnp.float32)
    L = DEPTH
    return {
        "x": jax.random.normal(ks[0], (BATCH, SEQ, D_MODEL), jnp.float32),
        "g_attn": gain(ks[1], (L, D_MODEL)),
        "w_in": nrm(ks[2], (L, D_MODEL, N_IN), D_MODEL),
        "b_f": jax.random.uniform(ks[3], (L, N_FOX_HEADS), jnp.float32, 1.0, 5.0),
        "b_gate": small(ks[4], (L, 3 * N_NSA_HEADS)),
        "cmpk_pe": 0.1 * jax.random.normal(ks[5], (L, CMP_LEN, HEAD_DIM), jnp.float32),
        "cmpk_w1": nrm(ks[6], (L, CMP_LEN * HEAD_DIM, CMP_HIDDEN), CMP_LEN * HEAD_DIM),
        "cmpk_b1": small(ks[7], (L, CMP_HIDDEN)),
        "cmpk_w2": nrm(ks[8], (L, CMP_HIDDEN, HEAD_DIM), CMP_HIDDEN),
        "cmpk_b2": small(ks[9], (L, HEAD_DIM)),
        "cmpv_pe": 0.1 * jax.random.normal(ks[10], (L, CMP_LEN, HEAD_DIM), jnp.float32),
        "cmpv_w1": nrm(ks[11], (L, CMP_LEN * HEAD_DIM, CMP_HIDDEN), CMP_LEN * HEAD_DIM),
        "cmpv_b1": small(ks[12], (L, CMP_HIDDEN)),
        "cmpv_w2": nrm(ks[13], (L, CMP_HIDDEN, HEAD_DIM), CMP_HIDDEN),
        "cmpv_b2": small(ks[14], (L, HEAD_DIM)),
        "g_fox": gain(ks[15], (L, FOX_WIDTH)),
        "g_nsa": gain(ks[16], (L, NSA_WIDTH)),
        "w_out": nrm(ks[17], (L, MIX_WIDTH, D_MODEL), MIX_WIDTH),
        "g_mlp": gain(ks[18], (L, D_MODEL)),
        "w_up": nrm(ks[19], (L, D_MODEL, D_FF), D_MODEL),
        "w_down": nrm(ks[20], (L, D_FF, D_MODEL), D_FF),
        "g_final": gain(ks[21], (D_MODEL,)),
    }


def reference(x, g_attn, w_in, b_f, b_gate, cmpk_pe, cmpk_w1, cmpk_b1, cmpk_w2, cmpk_b2,
              cmpv_pe, cmpv_w1, cmpv_b1, cmpv_w2, cmpv_b2, g_fox, g_nsa, w_out,
              g_mlp, w_up, w_down, g_final):
    h = x
    for l in range(DEPTH):
        h = h + hybrid_mixer(rmsnorm(h, g_attn[l]), w_in[l], b_f[l], b_gate[l],
                             cmpk_pe[l], cmpk_w1[l], cmpk_b1[l], cmpk_w2[l], cmpk_b2[l],
                             cmpv_pe[l], cmpv_w1[l], cmpv_b1[l], cmpv_w2[l], cmpv_b2[l],
                             g_fox[l], g_nsa[l], w_out[l])
        h = h + squared_relu_mlp(rmsnorm(h, g_mlp[l]), w_up[l], w_down[l])
    return rmsnorm(h, g_final)
```

```cpp
#include <hip/hip_runtime.h>
#include <hip/hip_bf16.h>
#include <cstdio>
#include <cstdint>

#ifndef MK_N_LAUNCHES
#define MK_N_LAUNCHES 1
#endif

__device__ __forceinline__ int lane_id() { return (int)__builtin_amdgcn_mbcnt_hi(~0u, __builtin_amdgcn_mbcnt_lo(~0u, 0u)); }
namespace pg8 {
#define PG8_LAS __attribute__((address_space(3)))
typedef unsigned short bf16_t;
typedef short bf16x8 __attribute__((ext_vector_type(8)));
typedef float f32x4 __attribute__((ext_vector_type(4)));
typedef unsigned u32x4 __attribute__((ext_vector_type(4)));
constexpr int BM = 256, BK = 64, HALF = 128, HTB = HALF * BK * 2, STAGE_BYTES = 8 * HTB, NXCD = 8, WGM = 8;

__host__ __device__ __forceinline__ int lds_byte(int r, int c) { const int st = (r >> 4) * 2 + (c >> 5), rr = r & 15, cc = c & 31, ob = rr * 64 + cc * 2; return st * 1024 + (ob ^ (((ob >> 9) & 1) << 5)); }
__host__ __device__ __forceinline__ void stage_rc(int b, int& R, int& C) { const int st = b / 1024, sb = b % 1024, swz = sb ^ (((sb >> 9) & 1) << 5); R = (st >> 1) * 16 + swz / 64; C = (st & 1) * 32 + (swz % 64) / 2; }
__host__ __device__ __forceinline__ int perm32(int rho) { const int n = rho >> 4, i = rho & 15; return 8 * (i >> 2) + 4 * n + (i & 3); }

struct Unit { int pm, pn; };
struct Gemm { const bf16_t* A; const bf16_t* Bt; int M, N, K; };

struct StaticOrder {
    int nM, nN, nwg, G, c;
    __host__ __device__ void init(int M, int N, int G_, int c_) { nM = M / BM; nN = N / BM; nwg = nM * nN; G = G_; c = c_; }
    __host__ __device__ bool next(int i, Unit& u) const {
        const long L = (long)i * G + c; if (L >= nwg) return false;
        int wgid = (int)L; { const int q = nwg / NXCD, r = nwg % NXCD, xcd = wgid % NXCD, off = wgid / NXCD; wgid = (xcd < r ? xcd * (q + 1) : r * (q + 1) + (xcd - r) * q) + off; }
        const int nig = WGM * nN, gid = wgid / nig, fm = gid * WGM, gsz = (nM - fm) < WGM ? (nM - fm) : WGM;
        u.pm = fm + ((wgid % nig) % gsz); u.pn = (wgid % nig) / gsz; return true;
    }
    __device__ __forceinline__ void a_ready(const Unit&) const {}
    __device__ __forceinline__ void done(const Unit&) const {}
};

__device__ __forceinline__ unsigned cvt_pk_bf16(float lo, float hi) { unsigned r; asm volatile("v_cvt_pk_bf16_f32 %0, %1, %2" : "=v"(r) : "v"(lo), "v"(hi)); return r; }

template <class Epi, class Sched, bool ALIGN_EPI = false, bool SP2 = false>
__device__ __forceinline__ void gemm_phase(PG8_LAS unsigned char* lds, const Gemm g, const Sched& S, const Epi& E, int wave_id) {
    const int wid = wave_id, lane = lane_id(), tid = wid * 64 + lane, wr = wid >> 2, wc = wid & 3, fr = lane & 15, fq = lane >> 4;
    const int K = g.K, nt = K / BK;
    unsigned voffA[2], voffB[2];
#pragma unroll
    for (int i = 0; i < 2; ++i) { int R, C; stage_rc(tid * 16 + i * 8192, R, C); const int Rb = Epi::PERM ? ((R & ~31) + perm32(R & 31)) : R;
        voffA[i] = (unsigned)(R * K + C) * 2u; voffB[i] = (unsigned)(Rb * K + C) * 2u; }
    const size_t kstep = (size_t)(BK * 2);
    const size_t hstep = (size_t)HALF * K * 2;
    const size_t tstep = 2 * hstep;
    const unsigned ldsw = (unsigned)wid * 1024u;
    const int aoff = lds_byte(wr * 64 + fr, fq * 8), boff = lds_byte(wc * 32 + fr, fq * 8);
#define PG8_SA(b, h) (((b) * 2 + (h)) * HTB)
#define PG8_SB(b, h) ((4 + (b) * 2 + (h)) * HTB)
#define PG8_STAGE(bufoff, gbase, voff) do { _Pragma("unroll") for (int _i = 0; _i < 2; ++_i) \
        __builtin_amdgcn_global_load_lds((const unsigned*)((const char*)(gbase) + (voff)[_i]), (PG8_LAS unsigned*)(lds + (bufoff) + ldsw + _i * 8192), 16, 0, 0); } while (0)
#define PG8_LDA(dst, b, h) do { _Pragma("unroll") for (int m = 0; m < 4; ++m) _Pragma("unroll") for (int k = 0; k < 2; ++k) dst[m][k] = *(const PG8_LAS bf16x8*)(lds + PG8_SA(b, h) + aoff + m * 2048 + k * 1024); } while (0)
#define PG8_LDB(dst, b, h) do { _Pragma("unroll") for (int n = 0; n < 2; ++n) _Pragma("unroll") for (int k = 0; k < 2; ++k) dst[n][k] = *(const PG8_LAS bf16x8*)(lds + PG8_SB(b, h) + boff + n * 2048 + k * 1024); } while (0)
#define PG8_MMA(ai, bj, At, Bt) do { __builtin_amdgcn_s_setprio(1); _Pragma("unroll") for (int m = 0; m < 4; ++m) _Pragma("unroll") for (int n = 0; n < 2; ++n) _Pragma("unroll") for (int k = 0; k < 2; ++k) \
        acc[ai][bj][m][n] = __builtin_amdgcn_mfma_f32_16x16x32_bf16(Bt[n][k], At[m][k], acc[ai][bj][m][n], 0, 0, 0); __builtin_amdgcn_s_setprio(0); } while (0)
#define PG8_WAIT_V(n) asm volatile("s_waitcnt vmcnt(" #n ")" ::: "memory")
#define PG8_WAIT_L(n) asm volatile("s_waitcnt lgkmcnt(" #n ")" ::: "memory")
#define PG8_BAR __builtin_amdgcn_s_barrier()
#define PG8_SCHED __builtin_amdgcn_sched_barrier(0)
    Unit cur, nxt; int ui = 0;
    if (!S.next(0, cur)) return;
    f32x4 acc[2][2][4][2];
#pragma unroll
    for (int a = 0; a < 2; ++a)
#pragma unroll
        for (int b = 0; b < 2; ++b)
#pragma unroll
            for (int m = 0; m < 4; ++m)
#pragma unroll
                for (int n = 0; n < 2; ++n) acc[a][b][m][n] = (f32x4){0.f, 0.f, 0.f, 0.f};
    bf16x8 At[4][2], B0[2][2], B1[2][2];
    const char* cA = (const char*)g.A + (size_t)cur.pm * tstep; const char* cB = (const char*)g.Bt + (size_t)cur.pn * tstep;
    S.a_ready(cur);
    if constexpr (SP2) {
        PG8_STAGE(PG8_SB(0, 0), cB, voffB); PG8_STAGE(PG8_SB(0, 1), cB + hstep, voffB); PG8_STAGE(PG8_SA(0, 0), cA, voffA); PG8_STAGE(PG8_SA(0, 1), cA + hstep, voffA);
        if (wr == 1) PG8_BAR;
        PG8_WAIT_V(2); PG8_BAR;
        PG8_STAGE(PG8_SB(1, 0), cB + kstep, voffB); PG8_STAGE(PG8_SA(1, 0), cA + kstep, voffA); PG8_STAGE(PG8_SB(1, 1), cB + hstep + kstep, voffB);
        PG8_WAIT_V(6); PG8_BAR;
    } else {
        PG8_STAGE(PG8_SB(0, 0), cB, voffB); PG8_STAGE(PG8_SA(0, 0), cA, voffA); PG8_STAGE(PG8_SB(0, 1), cB + hstep, voffB); PG8_STAGE(PG8_SA(0, 1), cA + hstep, voffA);
        if (wr == 1) PG8_BAR;
        PG8_WAIT_V(4); PG8_BAR;
        PG8_STAGE(PG8_SB(1, 0), cB + kstep, voffB); PG8_STAGE(PG8_SA(1, 0), cA + kstep, voffA); PG8_STAGE(PG8_SB(1, 1), cB + hstep + kstep, voffB);
        PG8_WAIT_V(6); PG8_BAR;
    }
    for (;;) {
        const bool has_next = S.next(ui + 1, nxt);
        const char* nA = has_next ? (const char*)g.A + (size_t)nxt.pm * tstep : cA; const char* nB = has_next ? (const char*)g.Bt + (size_t)nxt.pn * tstep : cB;
        for (int t = 0; t < nt; t += 2) {
            const bool last = (t == nt - 2);
            const char* a1 = cA + (size_t)(t + 1) * kstep;
            const char* a2 = last ? nA : cA + (size_t)(t + 2) * kstep; const char* b2 = last ? nB : cB + (size_t)(t + 2) * kstep;
            const char* a3 = a2 + kstep; const char* b3 = b2 + kstep;
            if (last && has_next) S.a_ready(nxt);
            if constexpr (SP2) {
            PG8_LDB(B0, 0, 0); PG8_LDB(B1, 0, 1); PG8_SCHED; PG8_LDA(At, 0, 0); PG8_STAGE(PG8_SA(1, 1), a1 + hstep, voffA);
            PG8_WAIT_V(8); PG8_WAIT_L(0); PG8_BAR; PG8_MMA(0, 0, At, B0); PG8_MMA(0, 1, At, B1); PG8_BAR; PG8_SCHED;
            PG8_LDA(At, 0, 1); PG8_STAGE(PG8_SB(0, 0), b2, voffB); PG8_STAGE(PG8_SB(0, 1), b2 + hstep, voffB); PG8_STAGE(PG8_SA(0, 0), a2, voffA);
            PG8_WAIT_V(8); PG8_WAIT_L(0); PG8_BAR; PG8_MMA(1, 0, At, B0); PG8_MMA(1, 1, At, B1); PG8_BAR; PG8_SCHED;
            PG8_LDB(B0, 1, 0); PG8_LDB(B1, 1, 1); PG8_SCHED; PG8_LDA(At, 1, 0); PG8_STAGE(PG8_SA(0, 1), a2 + hstep, voffA);
            PG8_WAIT_V(8); PG8_WAIT_L(0); PG8_BAR; PG8_MMA(0, 0, At, B0); PG8_MMA(0, 1, At, B1); PG8_BAR; PG8_SCHED;
            PG8_LDA(At, 1, 1); PG8_STAGE(PG8_SB(1, 0), b3, voffB); PG8_STAGE(PG8_SB(1, 1), b3 + hstep, voffB); PG8_STAGE(PG8_SA(1, 0), a3, voffA);
            PG8_WAIT_V(8); PG8_WAIT_L(0); PG8_BAR; PG8_MMA(1, 0, At, B0); PG8_MMA(1, 1, At, B1); PG8_BAR; PG8_SCHED;
            } else {
            PG8_LDB(B0, 0, 0); PG8_SCHED; PG8_LDA(At, 0, 0); PG8_STAGE(PG8_SA(1, 1), a1 + hstep, voffA);
            PG8_WAIT_L(8); PG8_BAR; PG8_WAIT_L(0); PG8_MMA(0, 0, At, B0); PG8_BAR; PG8_SCHED;
            PG8_LDB(B1, 0, 1); PG8_STAGE(PG8_SB(0, 0), b2, voffB);
            PG8_BAR; PG8_WAIT_L(0); PG8_MMA(0, 1, At, B1); PG8_BAR;
            PG8_LDA(At, 0, 1); PG8_STAGE(PG8_SA(0, 0), a2, voffA);
            PG8_BAR; PG8_WAIT_L(0); PG8_MMA(1, 0, At, B0); PG8_BAR; PG8_SCHED;
            PG8_STAGE(PG8_SB(0, 1), b2 + hstep, voffB);
            PG8_WAIT_V(6); PG8_BAR; PG8_MMA(1, 1, At, B1); PG8_BAR;
            PG8_LDB(B0, 1, 0); PG8_SCHED; PG8_LDA(At, 1, 0); PG8_STAGE(PG8_SA(0, 1), a2 + hstep, voffA);
            PG8_WAIT_L(8); PG8_BAR; PG8_WAIT_L(0); PG8_MMA(0, 0, At, B0); PG8_BAR; PG8_SCHED;
            PG8_LDB(B1, 1, 1); PG8_STAGE(PG8_SB(1, 0), b3, voffB);
            PG8_BAR; PG8_WAIT_L(0); PG8_MMA(0, 1, At, B1); PG8_BAR;
            PG8_LDA(At, 1, 1); PG8_STAGE(PG8_SA(1, 0), a3, voffA);
            PG8_BAR; PG8_WAIT_L(0); PG8_MMA(1, 0, At, B0); PG8_BAR; PG8_SCHED;
            PG8_STAGE(PG8_SB(1, 1), b3 + hstep, voffB);
            PG8_WAIT_V(6); PG8_BAR; PG8_MMA(1, 1, At, B1); PG8_BAR;
            }
        }
        if constexpr (ALIGN_EPI) { if (wr == 0) PG8_BAR; }
        E(acc, cur, wr, wc, fr, fq); S.done(cur);
        if (!has_next) break;
#pragma unroll
        for (int a = 0; a < 2; ++a)
#pragma unroll
            for (int b = 0; b < 2; ++b)
#pragma unroll
                for (int m = 0; m < 4; ++m)
#pragma unroll
                    for (int n = 0; n < 2; ++n) acc[a][b][m][n] = (f32x4){0.f, 0.f, 0.f, 0.f};
        cur = nxt; cA = nA; cB = nB; ++ui;
        if constexpr (ALIGN_EPI) { if (wr == 1) PG8_BAR; }
    }
    PG8_WAIT_V(0);
    if constexpr (!ALIGN_EPI) { if (wr == 0) PG8_BAR; }
    PG8_BAR;
#undef PG8_SA
#undef PG8_SB
#undef PG8_STAGE
#undef PG8_LDA
#undef PG8_LDB
#undef PG8_MMA
#undef PG8_WAIT_V
#undef PG8_WAIT_L
#undef PG8_BAR
#undef PG8_SCHED
}
}

#define GAS __attribute__((address_space(1)))
#define LAS __attribute__((address_space(3)))
typedef unsigned short bf16;
typedef unsigned v4u __attribute__((ext_vector_type(4)));
typedef float f32x4 __attribute__((ext_vector_type(4)));
typedef float f32x16 __attribute__((ext_vector_type(16)));
typedef short bf16x8 __attribute__((ext_vector_type(8)));
typedef short s16x4 __attribute__((ext_vector_type(4)));
typedef short v4i16_t __attribute__((ext_vector_type(4)));
typedef LAS unsigned char LDSB;
typedef GAS unsigned gu32;

constexpr int NWAVES = 8, NTHR = 512;
constexpr int BATCH = 8, SEQ = 4096, DM = 1024, T = BATCH * SEQ;
constexpr int NPROJ = 3072;
constexpr int N_IN = 2848, FF = 4096;
constexpr float EPS = 1e-6f;
constexpr float C2 = 0.125f * 1.4426950408889634f;
constexpr float LOG2E = 1.4426950408889634f;
constexpr float NEGM = -1000.0f;

constexpr size_t MiB = 1u << 20;
constexpr size_t WS_CTL = 0, CTL_ZERO_BYTES = 1 * MiB;
constexpr size_t WS_WIN = 2 * MiB;
constexpr size_t WS_WOUT = 8 * MiB;
constexpr size_t WS_WUP = 10 * MiB;
constexpr size_t WS_WDN = 18 * MiB;
constexpr size_t WS_W1K = 26 * MiB;
constexpr size_t WS_W1V = 27 * MiB;
constexpr size_t WS_W2K = 28 * MiB;
constexpr size_t WS_W2V = 28 * MiB + 65536;
constexpr size_t WS_B1K = 28 * MiB + 131072;
constexpr size_t WS_B1V = 28 * MiB + 131072 + 65536;
constexpr size_t WS_ROPEC = 29 * MiB;
constexpr size_t WS_ROPES = 29 * MiB + 524288;
constexpr size_t WS_FL = 30 * MiB;
constexpr size_t WS_CB = 31 * MiB;
constexpr size_t WS_XN = 32 * MiB;
constexpr size_t WS_U = 96 * MiB;
constexpr size_t WS_QF = 96 * MiB;
constexpr size_t WS_KF = 128 * MiB;
constexpr size_t WS_VF = 160 * MiB;
constexpr size_t WS_QN = 192 * MiB;
constexpr size_t WS_KC = 224 * MiB;
constexpr size_t WS_VC = 233 * MiB;
constexpr size_t WS_KS = 242 * MiB;
constexpr size_t WS_VS = 250 * MiB;
constexpr size_t WS_KW = 258 * MiB;
constexpr size_t WS_VW = 266 * MiB;
constexpr size_t WS_GATE = 274 * MiB;
constexpr size_t WS_KCMP = 277 * MiB;
constexpr size_t WS_VCMP = 277 * MiB + 524288;
constexpr size_t WS_Y = 280 * MiB;
constexpr size_t WS_SSQ1 = 352 * MiB;
constexpr size_t WS_END = 356 * MiB;

constexpr int CW_Q_ATT = 64;
constexpr int CW_BAR = 4096;

constexpr int L_K = 0;
constexpr int L_V = 32768;
constexpr int L_ACC = 65536;
constexpr int L_IMP = 131072;
constexpr int L_WS = 131072 + 17408;
constexpr int L_SEL = L_WS + 8192;
constexpr int L_ORD = L_SEL + 512;
constexpr int L_MISC = L_ORD + 4096;
constexpr int L_TL = L_MISC + 256;
constexpr int LDS_BYTES = L_TL + 256;
constexpr int SLOTB = 8192;

#define RLX_AGENT __ATOMIC_RELAXED, __HIP_MEMORY_SCOPE_AGENT
#define LDS_WAIT() asm volatile("s_waitcnt lgkmcnt(0)" ::: "memory")
#define VM_WAIT() asm volatile("s_waitcnt vmcnt(0)" ::: "memory")
__device__ __forceinline__ unsigned f2bf(float f) { unsigned u = __builtin_bit_cast(unsigned, f); return (u + 0x7fffu + ((u >> 16) & 1u)) >> 16; }
__device__ __forceinline__ unsigned pk2(float lo, float hi) { return f2bf(lo) | (f2bf(hi) << 16); }
__device__ __forceinline__ float bf2f(unsigned short b) { return __builtin_bit_cast(float, (unsigned)b << 16); }

#define XB_TMO      128
#define XB_XCNT(j)  (256  + 64 * (j))
#define XB_XSUB(j)  (1280 + 64 * (j))
#define XB_XGEN(j)  (2304 + 64 * (j))
#define XB_TOP      3328
#define XB_TOPGEN   3392
#define XCD_BAR_WORDS 3456
#define XB_SPIN_CAP (1u << 22)
__device__ __forceinline__ unsigned xb_ld(unsigned* p)              { return __hip_atomic_load(p, __ATOMIC_RELAXED, __HIP_MEMORY_SCOPE_AGENT); }
__device__ __forceinline__ unsigned xb_add(unsigned* p, unsigned v) { return __hip_atomic_fetch_add(p, v, __ATOMIC_RELAXED, __HIP_MEMORY_SCOPE_AGENT); }
__device__ __forceinline__ unsigned xb_xcc_id() { return (unsigned)__builtin_amdgcn_s_getreg((3 << 11) | 20) & 0xFu; }
#define XB_SPIN(cond, bar) do { unsigned _sp = 0; while (cond) { __builtin_amdgcn_s_sleep(1); \
    if ((++_sp & 255u) == 0u) { if (xb_ld(&(bar)[XB_TMO])) break; if (_sp > XB_SPIN_CAP) { atomicAdd(&(bar)[XB_TMO], 1u); break; } } } } while (0)
struct XcdBarrier { unsigned* bar; unsigned x; volatile LAS unsigned* st; int wave; };
__device__ __forceinline__ XcdBarrier xcd_barrier_post(unsigned* bar, volatile LAS unsigned* st) {
    XcdBarrier b; b.bar = bar; b.x = xb_xcc_id(); b.st = st; b.wave = 0;
    if (threadIdx.x == 0) (void)xb_add(&bar[XB_XCNT(b.x)], 1u);
    return b;
}
__device__ __forceinline__ void xcd_barrier_complete(unsigned* bar, unsigned x, unsigned& nloc, unsigned& nx) {
    const unsigned G = gridDim.x * gridDim.y * gridDim.z;
    unsigned sum, cnt, mine, sp = 0u;
    for (;;) {
        sum = 0u; cnt = 0u; mine = 0u;
#pragma unroll
        for (unsigned j = 0; j < 16; ++j) { const unsigned c = xb_ld(&bar[XB_XCNT(j)]); sum += c; cnt += (c > 0u) ? 1u : 0u; mine = (j == x) ? c : mine; }
        if (sum == G) break;
        __builtin_amdgcn_s_sleep(1);
        if ((++sp & 255u) == 0u) { if (xb_ld(&bar[XB_TMO])) break; if (sp > XB_SPIN_CAP) { atomicAdd(&bar[XB_TMO], 1u); break; } }
    }
    nloc = mine > 0u ? mine : 1u; nx = cnt > 0u ? cnt : 1u;
}
__device__ __forceinline__ void xcd_barrier(const XcdBarrier& b) {
    asm volatile("s_waitcnt vmcnt(0)" ::: "memory");
    __syncthreads();
    if (b.wave == 0 && lane_id() == 0) {
        unsigned* bar = b.bar;
        __builtin_amdgcn_s_waitcnt(0);
        unsigned nloc = b.st[0], nx = b.st[1];
        if (nloc == 0u) { xcd_barrier_complete(bar, b.x, nloc, nx); b.st[0] = nloc; b.st[1] = nx; }
        const unsigned old = xb_add(&bar[XB_XSUB(b.x)], 1u);
        const unsigned gen = old / nloc;
        if (old + 1u == (gen + 1u) * nloc) {
            __builtin_amdgcn_fence(__ATOMIC_RELEASE, "agent");
            asm volatile("s_waitcnt vmcnt(0)" ::: "memory");
            const unsigned og = xb_add(&bar[XB_TOP], 1u);
            const unsigned tg = og / nx;
            if (og + 1u == (tg + 1u) * nx) xb_add(&bar[XB_TOPGEN], 1u);
            else XB_SPIN(xb_ld(&bar[XB_TOPGEN]) == tg, bar);
            __builtin_amdgcn_fence(__ATOMIC_ACQUIRE, "agent");
            xb_add(&bar[XB_XGEN(b.x)], 1u);
            asm volatile("s_waitcnt vmcnt(0)" ::: "memory");
        } else {
            XB_SPIN(xb_ld(&bar[XB_XGEN(b.x)]) == gen, bar);
            __builtin_amdgcn_fence(__ATOMIC_ACQUIRE, "agent");
            asm volatile("s_waitcnt vmcnt(0)" ::: "memory");
        }
    }
    __syncthreads();
}

struct Args { const float* in[22]; float* out; unsigned char* ws; int ph_lo, ph_hi; };

struct Frame {
    LDSB* lds;
    volatile LAS unsigned* MISC;
    gu32* ctl;
    int tid, lane, wave, vcu, G;
    unsigned char* ws;
};

__device__ __forceinline__ float wave_sum(float v) {
#pragma unroll
    for (int o = 1; o < 64; o <<= 1) v += __shfl_xor(v, o);
    return v;
}

__device__ __forceinline__ int win_src_col(int n) {
    const int pn = n >> 8, c = n & 255, half = c >> 7, slot = (c >> 5) & 3, d = c & 31;
    if (pn < 8) {
        const int tsr = pn >> 1, j = pn & 1;
        const int tb = (tsr == 0) ? 0 : (tsr == 1) ? 512 : (tsr == 2) ? 1024 : 1544;
        return tb + 64 * (4 * j + slot) + 32 * half + d;
    }
    if (pn < 11) {
        const int base = 2056 + (pn - 8) * 256;
        return base + (slot >> 1) * 128 + (slot & 1) * 64 + 32 * half + d;
    }
    if (c < 8) return 1536 + c;
    if (c < 32) return 2824 + (c - 8);
    return -1;
}

template <bool MAPPED>
__device__ __forceinline__ void p0_transpose_item(const float* W, int K, int N, bf16* WT, LAS float* scr, int item, int lane, const float* kscale, int nblk) {
    const int kb = item / nblk, nb = item % nblk, k0 = 64 * kb, n0 = 32 * nb;
    int src = n0 + (lane & 31);
    if (MAPPED) src = win_src_col(src);
#pragma unroll 8
    for (int i = 0; i < 32; ++i) { const int kk = 2 * i + (lane >> 5);
        float v = 0.f; if (src >= 0) v = W[(size_t)(k0 + kk) * N + src];
        if (kscale) v *= kscale[k0 + kk];
        scr[kk * 33 + (lane & 31)] = v; }
    LDS_WAIT(); asm volatile("" ::: "memory");
    const int c = lane & 7;
#pragma unroll
    for (int j = 0; j < 4; ++j) { const int n = (lane >> 3) + 8 * j; const LAS float* s = scr + (8 * c) * 33 + n;
        v4u o; o.x = pk2(s[0 * 33], s[1 * 33]); o.y = pk2(s[2 * 33], s[3 * 33]); o.z = pk2(s[4 * 33], s[5 * 33]); o.w = pk2(s[6 * 33], s[7 * 33]);
        *(GAS v4u*)(WT + (size_t)(n0 + n) * K + k0 + 8 * c) = o; }
    LDS_WAIT(); asm volatile("" ::: "memory");
}

__device__ __forceinline__ void rms_row_to_bf16(int lane, const float* xrow, bf16* orow) {
    const GAS f32x4* xr = (const GAS f32x4*)xrow + lane;
    f32x4 v[4]; float s = 0.f;
#pragma unroll
    for (int j = 0; j < 4; ++j) { v[j] = xr[64 * j]; s += (v[j].x * v[j].x + v[j].y * v[j].y) + (v[j].z * v[j].z + v[j].w * v[j].w); }
    const float r = 1.f / sqrtf(wave_sum(s) * (1.f / DM) + EPS);
    GAS unsigned long long* o8 = (GAS unsigned long long*)orow + lane;
#pragma unroll
    for (int j = 0; j < 4; ++j) o8[64 * j] = (unsigned long long)pk2(v[j].x * r, v[j].y * r) | ((unsigned long long)pk2(v[j].z * r, v[j].w * r) << 32);
}

typedef __attribute__((address_space(4))) const char* kptr_t;
#define AIN(kp_, i) (*(const float* const __attribute__((address_space(4)))*)((kp_) + 8 * (i)))
__device__ __forceinline__ void p0_prologue(Frame& F, kptr_t kp) {
    const float* x = AIN(kp, 0); const float* g_attn = AIN(kp, 1); const float* w_in = AIN(kp, 2);
    const float* cmpk_pe = AIN(kp, 5); const float* cmpk_w1 = AIN(kp, 6); const float* cmpk_w2 = AIN(kp, 8);
    const float* cmpv_pe = AIN(kp, 10); const float* cmpv_w1 = AIN(kp, 11); const float* cmpv_w2 = AIN(kp, 13);
    const float* g_fox = AIN(kp, 15); const float* g_nsa = AIN(kp, 16); const float* w_out = AIN(kp, 17);
    const float* g_mlp = AIN(kp, 18); const float* w_up = AIN(kp, 19); const float* w_down = AIN(kp, 20);
    LAS float* scr = (LAS float*)(F.lds + F.wave * 16384);
    const int gw = F.vcu * NWAVES + F.wave, NGW = F.G * NWAVES;
    for (int it = gw; it < 128; it += NGW) {
        const int kv = it >> 6, kc = it & 63;
        const float* pe = kv ? cmpv_pe : cmpk_pe; const float* w1 = kv ? cmpv_w1 : cmpk_w1;
        f32x4 a = (f32x4){0.f, 0.f, 0.f, 0.f};
#pragma unroll 8
        for (int k = 32 * kc; k < 32 * kc + 32; ++k) { const f32x4 wv = *((const f32x4*)(w1 + (size_t)k * 256) + F.lane); a = a + wv * pe[k]; }
        *((f32x4*)(F.ws + (kv ? WS_B1V : WS_B1K)) + kc * 64 + F.lane) = a;
    }
    constexpr int I_IN = (DM / 64) * (NPROJ / 32), I_OUT = (DM / 64) * (DM / 32), I_UP = (DM / 64) * (FF / 32), I_DN = (FF / 64) * (DM / 32);
    constexpr int I_W1 = (2048 / 64) * (256 / 32), I_W2 = (256 / 64) * (64 / 32);
    constexpr int NITEMS = I_IN + I_OUT + I_UP + I_DN + 2 * I_W1 + 2 * I_W2;
    for (int it = gw; it < NITEMS; it += NGW) {
        int r = it;
        if (r < I_IN) { p0_transpose_item<true>(w_in, DM, N_IN, (bf16*)(F.ws + WS_WIN), scr, r, F.lane, g_attn, NPROJ / 32); continue; } r -= I_IN;
        if (r < I_OUT) {
            const int kb = r / (DM / 32);
            const float* ks = (kb < 8) ? g_fox : (g_nsa - 512);
            p0_transpose_item<false>(w_out, DM, DM, (bf16*)(F.ws + WS_WOUT), scr, r, F.lane, ks, DM / 32); continue; } r -= I_OUT;
        if (r < I_UP) { p0_transpose_item<false>(w_up, DM, FF, (bf16*)(F.ws + WS_WUP), scr, r, F.lane, g_mlp, FF / 32); continue; } r -= I_UP;
        if (r < I_DN) { p0_transpose_item<false>(w_down, FF, DM, (bf16*)(F.ws + WS_WDN), scr, r, F.lane, nullptr, DM / 32); continue; } r -= I_DN;
        if (r < I_W1) { p0_transpose_item<false>(cmpk_w1, 2048, 256, (bf16*)(F.ws + WS_W1K), scr, r, F.lane, nullptr, 8); continue; } r -= I_W1;
        if (r < I_W1) { p0_transpose_item<false>(cmpv_w1, 2048, 256, (bf16*)(F.ws + WS_W1V), scr, r, F.lane, nullptr, 8); continue; } r -= I_W1;
        if (r < I_W2) { p0_transpose_item<false>(cmpk_w2, 256, 64, (bf16*)(F.ws + WS_W2K), scr, r, F.lane, nullptr, 2); continue; } r -= I_W2;
        p0_transpose_item<false>(cmpv_w2, 256, 64, (bf16*)(F.ws + WS_W2V), scr, r, F.lane, nullptr, 2);
    }
    {
        float* rc = (float*)(F.ws + WS_ROPEC); float* rs = (float*)(F.ws + WS_ROPES);
        for (int i = F.vcu * NTHR + F.tid; i < SEQ * 32; i += F.G * NTHR) {
            const int pos = i >> 5, d = i & 31;
            const float inv = exp2f(-(float)d * (13.287712379549449f / 32.0f));
            const float ang = (float)pos * inv;
            const double a = (double)ang;
            const double k = __builtin_rint(a * 0.15915494309189535);
            const float red = (float)(a - k * 6.283185307179586);
            rc[i] = cosf(red); rs[i] = sinf(red);
        }
    }
    for (int m = gw; m < T; m += NGW) rms_row_to_bf16(F.lane, x + (size_t)m * DM, (bf16*)(F.ws + WS_XN) + (size_t)m * DM);
}

typedef pg8::f32x4 pf4;
__device__ __forceinline__ float log_sigmoidf(float v) { return v >= 0.f ? -log1pf(expf(-v)) : v - log1pf(expf(v)); }

struct EpiProj {
    static constexpr bool PERM = true;
    unsigned char* ws; const float* b_f; const float* b_gate;
    __device__ __forceinline__ void operator()(const pf4 (&acc)[2][2][4][2], const pg8::Unit& u, int wr, int wc, int fr, int fq) const {
        const int pn = u.pn; const int rbase = u.pm * 256 + wr * 64 + fr;
        if (pn == 11) {
            if (wc != 0) return;
            float* FL = (float*)(ws + WS_FL); float* GT = (float*)(ws + WS_GATE);
#pragma unroll
            for (int ai = 0; ai < 2; ++ai)
#pragma unroll
                for (int m = 0; m < 4; ++m) { const int row = rbase + ai * 128 + m * 16; const int b = row >> 12, s = row & 4095;
#pragma unroll
                    for (int n = 0; n < 2; ++n) { const pf4 v = acc[ai][0][m][n];
                        if (fq == 0) {
#pragma unroll
                            for (int i = 0; i < 4; ++i) { const int h = 4 * n + i; FL[(size_t)(b * 8 + h) * SEQ + s] = log_sigmoidf(v[i] + b_f[h]); }
                        } else { const int j0 = 8 * fq - 8 + 4 * n; pf4 o;
#pragma unroll
                            for (int i = 0; i < 4; ++i) { const float z = v[i] + b_gate[j0 + i]; o[i] = 1.f / (1.f + expf(-z)); }
                            *(pf4*)(GT + (size_t)row * 24 + j0) = o; } } }
            return;
        }
        const bool rope = (pn == 6) || (pn == 7) || ((pn == 9 || pn == 10) && wc < 2);
        const float sc = (pn < 2 || pn == 6 || pn == 7) ? C2 : 1.f;
        const float* RC = (const float*)(ws + WS_ROPEC); const float* RS = (const float*)(ws + WS_ROPES);
        size_t tb;
        if (pn < 8) { const int tsr = pn >> 1; tb = (tsr == 0) ? WS_QF : (tsr == 1) ? WS_KF : (tsr == 2) ? WS_VF : WS_QN; }
        else { const int vt = wc >> 1; tb = (pn == 8) ? (vt ? WS_VC : WS_KC) : (pn == 9) ? (vt ? WS_VS : WS_KS) : (vt ? WS_VW : WS_KW); }
        bf16* TB = (bf16*)(ws + tb);
#pragma unroll
        for (int ai = 0; ai < 2; ++ai)
#pragma unroll
            for (int m = 0; m < 4; ++m) { const int row = rbase + ai * 128 + m * 16;
                pf4 a0 = acc[ai][0][m][0], a1 = acc[ai][0][m][1], b0 = acc[ai][1][m][0], b1 = acc[ai][1][m][1];
                if (rope) { const int pos = row & 4095;
                    const pf4 c0 = *(const pf4*)(RC + pos * 32 + 8 * fq), c1 = *(const pf4*)(RC + pos * 32 + 8 * fq + 4);
                    const pf4 s0 = *(const pf4*)(RS + pos * 32 + 8 * fq), s1 = *(const pf4*)(RS + pos * 32 + 8 * fq + 4);
                    const pf4 x0 = a0 * c0 - b0 * s0, x1 = a1 * c1 - b1 * s1, y0 = a0 * s0 + b0 * c0, y1 = a1 * s1 + b1 * c1;
                    a0 = x0; a1 = x1; b0 = y0; b1 = y1; }
                a0 = a0 * sc; a1 = a1 * sc; b0 = b0 * sc; b1 = b1 * sc;
                v4u w0, w1; w0.x = pk2(a0[0], a0[1]); w0.y = pk2(a0[2], a0[3]); w0.z = pk2(a1[0], a1[1]); w0.w = pk2(a1[2], a1[3]);
                w1.x = pk2(b0[0], b0[1]); w1.y = pk2(b0[2], b0[3]); w1.z = pk2(b1[0], b1[1]); w1.w = pk2(b1[2], b1[3]);
                bf16* p;
                if (pn < 8) p = TB + (size_t)row * 512 + 64 * (4 * (pn & 1) + wc) + 8 * fq;
                else { const int b = row >> 12, s = row & 4095, g = wc & 1; p = TB + ((size_t)(b * 2 + g) * SEQ + s) * 64 + 8 * fq; }
                *(v4u*)p = w0; *(v4u*)(p + 32) = w1; }
    }
};

struct EpiOutRes {
    static constexpr bool PERM = true;
    const float* x; float* out; bf16* xn; float* ssq; LDSB* lds;
    __device__ __forceinline__ void operator()(const pf4 (&acc)[2][2][4][2], const pg8::Unit& u, int wr, int wc, int fr, int fq) const {
        const int col0 = u.pn * 256 + wc * 32 + 8 * fq;
        LAS float* P = (LAS float*)(lds + L_IMP);
#pragma unroll
        for (int ai = 0; ai < 2; ++ai)
#pragma unroll
            for (int m = 0; m < 4; ++m) { const int rl = ai * 128 + wr * 64 + m * 16 + fr; const size_t off = (size_t)(u.pm * 256 + rl) * DM + col0; float sq = 0.f;
#pragma unroll
                for (int bj = 0; bj < 2; ++bj) {
                    const pf4 h0 = *(const pf4*)(x + off + bj * 128) + acc[ai][bj][m][0], h1 = *(const pf4*)(x + off + bj * 128 + 4) + acc[ai][bj][m][1];
                    *(pf4*)(out + off + bj * 128) = h0; *(pf4*)(out + off + bj * 128 + 4) = h1;
                    sq += ((h0[0] * h0[0] + h0[1] * h0[1]) + (h0[2] * h0[2] + h0[3] * h0[3])) + ((h1[0] * h1[0] + h1[1] * h1[1]) + (h1[2] * h1[2] + h1[3] * h1[3]));
                    v4u w; w.x = pk2(h0[0], h0[1]); w.y = pk2(h0[2], h0[3]); w.z = pk2(h1[0], h1[1]); w.w = pk2(h1[2], h1[3]);
                    *(v4u*)(xn + off + bj * 128) = w; }
                sq += __shfl_xor(sq, 16); sq += __shfl_xor(sq, 32);
                if (fq == 0) P[rl * 4 + wc] = sq; }
        asm volatile("s_waitcnt lgkmcnt(0)\n\ts_barrier" ::: "memory");
        const int t = (wr * 4 + wc) * 64 + (fq * 16 + fr);
        if (t < 256) { const f32x4 p = *(const LAS f32x4*)(P + t * 4); ssq[(size_t)(u.pm * 256 + t) * 4 + u.pn] = (p[0] + p[1]) + (p[2] + p[3]); }
    }
};

struct EpiUp {
    static constexpr bool PERM = true;
    bf16* O; const float* ssq;
    __device__ __forceinline__ void operator()(const pf4 (&acc)[2][2][4][2], const pg8::Unit& u, int wr, int wc, int fr, int fq) const {
        const int row0 = u.pm * 256 + wr * 64 + fr, col0 = u.pn * 256 + wc * 32 + 8 * fq;
#pragma unroll
        for (int ai = 0; ai < 2; ++ai)
#pragma unroll
            for (int m = 0; m < 4; ++m) { const int row = row0 + ai * 128 + m * 16; bf16* rowp = O + (size_t)row * FF + col0;
                const pf4 s0 = *(const pf4*)(ssq + (size_t)row * 4);
                const float tot = (s0[0] + s0[1]) + (s0[2] + s0[3]);
                const float r2 = 1.f / (tot * (1.f / DM) + EPS);
#pragma unroll
                for (int bj = 0; bj < 2; ++bj) { pf4 v0 = acc[ai][bj][m][0], v1 = acc[ai][bj][m][1];
#pragma unroll
                    for (int i = 0; i < 4; ++i) { const float a = fmaxf(v0[i], 0.f), b = fmaxf(v1[i], 0.f); v0[i] = a * a * r2; v1[i] = b * b * r2; }
                    v4u w; w.x = pk2(v0[0], v0[1]); w.y = pk2(v0[2], v0[3]); w.z = pk2(v1[0], v1[1]); w.w = pk2(v1[2], v1[3]);
                    *(v4u*)(rowp + bj * 128) = w; } }
    }
};

struct EpiDownRes {
    static constexpr bool PERM = true;
    float* out;
    __device__ __forceinline__ void operator()(const pf4 (&acc)[2][2][4][2], const pg8::Unit& u, int wr, int wc, int fr, int fq) const {
        const int col0 = u.pn * 256 + wc * 32 + 8 * fq;
#pragma unroll
        for (int ai = 0; ai < 2; ++ai)
#pragma unroll
            for (int m = 0; m < 4; ++m) { const size_t off = (size_t)(u.pm * 256 + ai * 128 + wr * 64 + m * 16 + fr) * DM + col0;
#pragma unroll
                for (int bj = 0; bj < 2; ++bj) { float* p = out + off + bj * 128; const pf4 b0 = *(const pf4*)p, b1 = *(const pf4*)(p + 4); *(pf4*)p = b0 + acc[ai][bj][m][0]; *(pf4*)(p + 4) = b1 + acc[ai][bj][m][1]; } }
    }
};

__device__ __forceinline__ void p2_cumsum_item(Frame& F, int item) {
    const float* fl = (const float*)(F.ws + WS_FL) + (size_t)item * SEQ; float* cb = (float*)(F.ws + WS_CB) + (size_t)item * SEQ;
    const int lane = F.lane;
    float v[64]; float run = 0.f;
#pragma unroll
    for (int i = 0; i < 16; ++i) { const f32x4 t = *(const f32x4*)(fl + lane * 64 + 4 * i); v[4 * i] = t[0]; v[4 * i + 1] = t[1]; v[4 * i + 2] = t[2]; v[4 * i + 3] = t[3]; }
#pragma unroll
    for (int i = 0; i < 64; ++i) { run += v[i]; v[i] = run; }
    float incl = run;
#pragma unroll
    for (int o = 1; o < 64; o <<= 1) { const float t = __shfl_up(incl, o); if (lane >= o) incl += t; }
    const float base = incl - run;
#pragma unroll
    for (int i = 0; i < 16; ++i) { f32x4 t; t[0] = -(v[4 * i] + base) * LOG2E; t[1] = -(v[4 * i + 1] + base) * LOG2E; t[2] = -(v[4 * i + 2] + base) * LOG2E; t[3] = -(v[4 * i + 3] + base) * LOG2E;
        *(f32x4*)(cb + lane * 64 + 4 * i) = t; }
}

__device__ __forceinline__ float gelu_tanh(float x) {
    const float u = 0.7978845608028654f * (x + 0.044715f * x * x * x);
    const float e = __expf(2.f * u);
    const float th = 1.f - 2.f / (e + 1.f);
    return 0.5f * x * (1.f + th);
}

__device__ __forceinline__ void p2_compress_item(Frame& F, kptr_t kp, int item) {
    typedef float f4 __attribute__((ext_vector_type(4)));
    const int kv = item >> 6, bg = (item >> 2) & 15, cblk = item & 3, c0 = 64 * cblk;
    const int lane = F.lane, w = F.wave, fr = lane & 15, fq = lane >> 4;
    const bf16* Ab = (const bf16*)(F.ws + (kv ? WS_VC : WS_KC)) + (size_t)bg * SEQ * 64 + (size_t)c0 * 1024;
    const bf16* W1 = (const bf16*)(F.ws + (kv ? WS_W1V : WS_W1K));
    const bf16* W2 = (const bf16*)(F.ws + (kv ? WS_W2V : WS_W2K));
    const float* B1 = (const float*)(F.ws + (kv ? WS_B1V : WS_B1K));
    const float* b1 = AIN(kp, kv ? 12 : 7);
    const float* b2 = AIN(kp, kv ? 14 : 9);
    LDSB* lds = F.lds;
    LAS bf16* Hs = (LAS bf16*)(lds + 92160);
    f4 acc[4][2];
#pragma unroll
    for (int m = 0; m < 4; ++m) { acc[m][0] = (f4){0.f, 0.f, 0.f, 0.f}; acc[m][1] = (f4){0.f, 0.f, 0.f, 0.f}; }
    const int tid = F.tid, lrow = tid >> 3, lch = tid & 7;
    const bf16* ag = Ab + (size_t)lrow * 1024 + lch * 8;
    const bf16* bg_ = W1 + (size_t)lrow * 2048 + lch * 8;
    const int sto = (lrow * 72 + lch * 8) * 2;
    v4u ra = *(const v4u*)ag, rb[4];
#pragma unroll
    for (int i = 0; i < 4; ++i) rb[i] = *(const v4u*)(bg_ + (size_t)i * 64 * 2048);
    *(LAS v4u*)(lds + sto) = ra;
#pragma unroll
    for (int i = 0; i < 4; ++i) *(LAS v4u*)(lds + 18432 + sto + i * 64 * 144) = rb[i];
    __syncthreads();
    for (int ks = 0; ks < 32; ++ks) {
        const int cb = ks & 1;
        if (ks + 1 < 32) { ra = *(const v4u*)(ag + (ks + 1) * 64);
#pragma unroll
            for (int i = 0; i < 4; ++i) rb[i] = *(const v4u*)(bg_ + (size_t)i * 64 * 2048 + (ks + 1) * 64); }
        const LDSB* As = lds + cb * 9216; const LDSB* Bs = lds + 18432 + cb * 36864;
#pragma unroll
        for (int kh = 0; kh < 2; ++kh) {
            bf16x8 a[4], b[2];
#pragma unroll
            for (int m = 0; m < 4; ++m) a[m] = *(const LAS bf16x8*)(As + ((16 * m + fr) * 72 + 32 * kh + 8 * fq) * 2);
#pragma unroll
            for (int n = 0; n < 2; ++n) b[n] = *(const LAS bf16x8*)(Bs + ((32 * w + 16 * n + fr) * 72 + 32 * kh + 8 * fq) * 2);
#pragma unroll
            for (int m = 0; m < 4; ++m)
#pragma unroll
                for (int n = 0; n < 2; ++n) acc[m][n] = __builtin_amdgcn_mfma_f32_16x16x32_bf16(a[m], b[n], acc[m][n], 0, 0, 0);
        }
        if (ks + 1 < 32) {
            *(LAS v4u*)(lds + (cb ^ 1) * 9216 + sto) = ra;
#pragma unroll
            for (int i = 0; i < 4; ++i) *(LAS v4u*)(lds + 18432 + (cb ^ 1) * 36864 + sto + i * 64 * 144) = rb[i];
        }
        __syncthreads();
    }
    float bbv[2];
#pragma unroll
    for (int n = 0; n < 2; ++n) { const int col = 32 * w + 16 * n + fr; float bb = b1[col];
#pragma unroll 8
        for (int kc = 0; kc < 64; ++kc) bb += B1[kc * 256 + col];
        bbv[n] = bb; }
#pragma unroll
    for (int m = 0; m < 4; ++m)
#pragma unroll
        for (int n = 0; n < 2; ++n) { const int col = 32 * w + 16 * n + fr;
#pragma unroll
            for (int r = 0; r < 4; ++r) Hs[(16 * m + 4 * fq + r) * 264 + col] = (bf16)f2bf(gelu_tanh(acc[m][n][r] + bbv[n])); }
    __syncthreads();
    const int mt = w >> 1, ntA = (w & 1), ntB = (w & 1) + 2;
    f4 oa = (f4){0.f, 0.f, 0.f, 0.f}, ob = (f4){0.f, 0.f, 0.f, 0.f};
#pragma unroll
    for (int k0 = 0; k0 < 256; k0 += 32) {
        const bf16x8 a = *(const LAS bf16x8*)(Hs + (16 * mt + fr) * 264 + k0 + 8 * fq);
        const bf16x8 bA = *(const bf16x8*)(W2 + (size_t)(16 * ntA + fr) * 256 + k0 + 8 * fq);
        const bf16x8 bB = *(const bf16x8*)(W2 + (size_t)(16 * ntB + fr) * 256 + k0 + 8 * fq);
        oa = __builtin_amdgcn_mfma_f32_16x16x32_bf16(a, bA, oa, 0, 0, 0);
        ob = __builtin_amdgcn_mfma_f32_16x16x32_bf16(a, bB, ob, 0, 0, 0);
    }
    const int d1 = 16 * (w & 1) + fr;
    const float bb1 = b2[d1], bb2 = b2[d1 + 32];
    const float* RC = (const float*)(F.ws + WS_ROPEC); const float* RS = (const float*)(F.ws + WS_ROPES);
    bf16* O = (bf16*)(F.ws + (kv ? WS_VCMP : WS_KCMP)) + (size_t)bg * 256 * 64;
#pragma unroll
    for (int r = 0; r < 4; ++r) { const int c = c0 + 16 * mt + 4 * fq + r;
        float x1 = oa[r] + bb1, x2 = ob[r] + bb2;
        if (kv == 0) { int pos = 16 * c + 31; pos = pos > 4095 ? 4095 : pos; const float cs = RC[pos * 32 + d1], sn = RS[pos * 32 + d1];
            const float y1 = x1 * cs - x2 * sn, y2 = x1 * sn + x2 * cs; x1 = y1; x2 = y2; }
        O[(size_t)c * 64 + d1] = (bf16)f2bf(x1); O[(size_t)c * 64 + d1 + 32] = (bf16)f2bf(x2); }
    __syncthreads();
}

__device__ __forceinline__ int crow(int r, int hi) { return (r & 3) + 8 * (r >> 2) + 4 * hi; }
__device__ __forceinline__ void glds16(const void* gsrc, unsigned lds_dst) { unsigned keep;
    asm volatile("s_mov_b32 %0, m0\n\ts_mov_b32 m0, %2\n\ts_nop 0\n\tglobal_load_lds_dwordx4 %1, off\n\ts_mov_b32 m0, %0" : "=&s"(keep) : "v"(gsrc), "s"(lds_dst) : "memory"); }
#define WAIT_BAR(N) asm volatile("s_waitcnt vmcnt(" #N ") lgkmcnt(0)\n\ts_barrier" ::: "memory")
__device__ __forceinline__ unsigned cvtpk_s(float lo, float hi) { typedef float f2 __attribute__((ext_vector_type(2))); typedef __bf16 b2 __attribute__((ext_vector_type(2)));
    f2 v = {lo, hi}; b2 b = __builtin_convertvector(v, b2); return __builtin_bit_cast(unsigned, b); }
__device__ __forceinline__ s16x4 vtr(const LDSB* p) { return __builtin_bit_cast(s16x4, __builtin_amdgcn_ds_read_tr16_b64_v4i16((LAS v4i16_t*)p)); }

__device__ __forceinline__ float xh_max(float a) { auto r = __builtin_amdgcn_permlane32_swap(__float_as_uint(a), __float_as_uint(a), false, false); return fmaxf(__uint_as_float(r[0]), __uint_as_float(r[1])); }
__device__ __forceinline__ float xh_sum(float a) { auto r = __builtin_amdgcn_permlane32_swap(__float_as_uint(a), __float_as_uint(a), false, false); return __uint_as_float(r[0]) + __uint_as_float(r[1]); }
__device__ __forceinline__ float xh_other(float a, int hi) { auto r = __builtin_amdgcn_permlane32_swap(__float_as_uint(a), __float_as_uint(a), false, false); return hi ? __uint_as_float(r[0]) : __uint_as_float(r[1]); }
__device__ __forceinline__ void qkt(f32x16& p0, f32x16& p1, const LDSB* kslot, const bf16x8 (&qr)[4], const f32x16& cinit, int r32, int hi) {
    const LDSB* kb = kslot + hi * 1024 + r32 * 16;
#pragma unroll
    for (int d0 = 0; d0 < 4; ++d0) {
        const bf16x8 b0 = *(const LAS bf16x8*)(kb + d0 * 2048);
        const bf16x8 b1 = *(const LAS bf16x8*)(kb + d0 * 2048 + 512);
        if (d0 == 0) { p0 = __builtin_amdgcn_mfma_f32_32x32x16_bf16(b0, qr[0], cinit, 0, 0, 0); p1 = __builtin_amdgcn_mfma_f32_32x32x16_bf16(b1, qr[0], cinit, 0, 0, 0); }
        else { p0 = __builtin_amdgcn_mfma_f32_32x32x16_bf16(b0, qr[d0], p0, 0, 0, 0); p1 = __builtin_amdgcn_mfma_f32_32x32x16_bf16(b1, qr[d0], p1, 0, 0, 0); }
    }
}
__device__ __forceinline__ void pv(f32x16 (&o)[2], const LDSB* vp, const f32x16& p0, const f32x16& p1) {
    v4u pw[4];
    pw[0] = (v4u){cvtpk_s(p0[0], p0[1]), cvtpk_s(p0[2], p0[3]), cvtpk_s(p0[4], p0[5]), cvtpk_s(p0[6], p0[7])};
    pw[1] = (v4u){cvtpk_s(p0[8], p0[9]), cvtpk_s(p0[10], p0[11]), cvtpk_s(p0[12], p0[13]), cvtpk_s(p0[14], p0[15])};
    pw[2] = (v4u){cvtpk_s(p1[0], p1[1]), cvtpk_s(p1[2], p1[3]), cvtpk_s(p1[4], p1[5]), cvtpk_s(p1[6], p1[7])};
    pw[3] = (v4u){cvtpk_s(p1[8], p1[9]), cvtpk_s(p1[10], p1[11]), cvtpk_s(p1[12], p1[13]), cvtpk_s(p1[14], p1[15])};
#pragma unroll
    for (int d0 = 0; d0 < 2; ++d0)
#pragma unroll
        for (int ks = 0; ks < 4; ++ks) {
            const s16x4 lo = vtr(vp + d0 * 4096 + ks * 1024), hi = vtr(vp + d0 * 4096 + ks * 1024 + 512);
            const bf16x8 vf = (bf16x8){lo[0], lo[1], lo[2], lo[3], hi[0], hi[1], hi[2], hi[3]};
            o[d0] = __builtin_amdgcn_mfma_f32_32x32x16_bf16(__builtin_bit_cast(bf16x8, pw[ks]), vf, o[d0], 0, 0, 0);
        }
}
__device__ __forceinline__ float rowmax32(const f32x16& p0, const f32x16& p1) {
    float a = fmaxf(p0[0], p1[0]);
#pragma unroll
    for (int r = 1; r < 16; ++r) a = fmaxf(a, fmaxf(p0[r], p1[r]));
    return xh_max(a);
}
__device__ __forceinline__ float rowsum32(const f32x16& p0, const f32x16& p1) {
    float a = 0.f, b = 0.f;
#pragma unroll
    for (int r = 0; r < 16; ++r) { a += p0[r]; b += p1[r]; }
    return a + b;
}

template <int PITCH>
__device__ __forceinline__ void dma_kv(const bf16* Kh, const bf16* Vh, int key0, unsigned kdst, unsigned vdst, int wid, int lane) {
    const bf16* ksrc = Kh + (size_t)(key0 + lane) * PITCH + wid * 8;
    const bf16* vsrc = Vh + (size_t)(key0 + 16 * (wid & 3) + (lane >> 2)) * PITCH + (wid >> 2) * 32 + (lane & 3) * 8;
    glds16(ksrc, (unsigned)__builtin_amdgcn_readfirstlane(kdst + wid * 1024));
    glds16(vsrc, (unsigned)__builtin_amdgcn_readfirstlane(vdst + wid * 1024));
}


#define SBAR() __builtin_amdgcn_sched_barrier(0)
__device__ __forceinline__ void kload8(bf16x8* kf, const LDSB* kp) {
    kf[0] = *(const LAS bf16x8*)(kp);        kf[1] = *(const LAS bf16x8*)(kp + 512);
    kf[2] = *(const LAS bf16x8*)(kp + 2048); kf[3] = *(const LAS bf16x8*)(kp + 2560);
    kf[4] = *(const LAS bf16x8*)(kp + 4096); kf[5] = *(const LAS bf16x8*)(kp + 4608);
    kf[6] = *(const LAS bf16x8*)(kp + 6144); kf[7] = *(const LAS bf16x8*)(kp + 6656);
}
__device__ __forceinline__ void kload2(bf16x8* kf, const LDSB* kp, int j) { kf[2 * j] = *(const LAS bf16x8*)(kp + j * 2048); kf[2 * j + 1] = *(const LAS bf16x8*)(kp + j * 2048 + 512); }

template <int MODE>
__device__ __forceinline__ void att_mod(f32x16& C0, f32x16& C1, int j, int qabs, int qw0, int cur, unsigned sel_lo, unsigned sel_hi, const LAS float* kbias, int hi) {
    if (MODE == 0) {
        const LAS float* kb = kbias + 64 * j + 4 * hi;
#pragma unroll
        for (int g4 = 0; g4 < 4; ++g4) { const f32x4 b0 = *(const LAS f32x4*)(kb + 8 * g4), b1 = *(const LAS f32x4*)(kb + 32 + 8 * g4);
#pragma unroll
            for (int i = 0; i < 4; ++i) { C0[4 * g4 + i] += b0[i]; C1[4 * g4 + i] += b1[i]; } }
        if (64 * j + 63 > qw0) {
#pragma unroll
            for (int r = 0; r < 16; ++r) { const int kv = 64 * j + crow(r, hi); if (kv > qabs) C0[r] = NEGM; if (kv + 32 > qabs) C1[r] = NEGM; }
        }
    } else if (MODE == 1) {
        const bool sel = ((j < 32 ? (sel_lo >> j) : (sel_hi >> (j - 32))) & 1u) != 0u;
        if (j == cur) {
#pragma unroll
            for (int r = 0; r < 16; ++r) { const int kv = 64 * j + crow(r, hi); if (kv > qabs || !sel) C0[r] = NEGM; if (kv + 32 > qabs || !sel) C1[r] = NEGM; }
        } else {
#pragma unroll
            for (int r = 0; r < 16; ++r) { if (!sel) { C0[r] = NEGM; C1[r] = NEGM; } }
        }
    } else {
        if (j == cur || j + 8 <= cur) {
#pragma unroll
            for (int r = 0; r < 16; ++r) { const int kv = 64 * j + crow(r, hi);
                if (kv > qabs || kv < qabs - 511) C0[r] = NEGM; if (kv + 32 > qabs || kv + 32 < qabs - 511) C1[r] = NEGM; }
        }
    }
}

template <int MODE, int PITCH, int THRL>
__device__ __forceinline__ void attn_fast(LDSB* lds, const bf16* Kh, const bf16* Vh, const LAS unsigned char* tl, int NT, const bf16x8 (&qr)[4], int qabs, int qw0, int cur,
                                          unsigned sel_lo, unsigned sel_hi, const LAS float* kbias, f32x16 (&o)[2], float& l_out, int wid, int lane) {
    const int r32 = lane & 31, hi = lane >> 5;
    const unsigned lds0 = (unsigned)(uintptr_t)lds;
    LAS float* wsf = (LAS float*)(lds + L_WS) + wid * 256;
    const bf16* ksrc = Kh + (size_t)lane * PITCH + wid * 8;
    const bf16* vsrc = Vh + (size_t)(16 * (wid & 3) + (lane >> 2)) * PITCH + (wid >> 2) * 32 + (lane & 3) * 8;
    const unsigned kdst = lds0 + L_K + wid * 1024, vdst = lds0 + L_V + wid * 1024;
#define TILE(t) __builtin_amdgcn_readfirstlane((int)tl[t])
#define DMA_K(t, slot) glds16(ksrc + (size_t)TILE(t) * (64 * PITCH), (unsigned)__builtin_amdgcn_readfirstlane(kdst + (slot)))
#define DMA_V(t, slot) glds16(vsrc + (size_t)TILE(t) * (64 * PITCH), (unsigned)__builtin_amdgcn_readfirstlane(vdst + (slot)))
    const LDSB* kp0 = lds + L_K + hi * 1024 + r32 * 16;
    const LDSB* vp0 = lds + L_V + ((lane >> 4) & 1) * 32 + (lane & 3) * 8 + (4 * hi + ((lane & 15) >> 2)) * 64;
    bf16x8 kf[8];
    float mhat = 0.f, l_reg = 0.f;
    f32x16 negm;
#pragma unroll
    for (int r = 0; r < 16; ++r) { negm[r] = 0.f; o[0][r] = 0.f; o[1][r] = 0.f; }
    asm volatile("" : "+v"(negm));
    bool resc = false;
    f32x16 pA0, pA1, pB0, pB1;
    int sl_prev = 0, sl_cur = 0, sl_next = SLOTB, sl_last = 0;
#define ROT() do { sl_prev = sl_cur; sl_cur = sl_next; sl_next = (sl_next == 2 * SLOTB) ? 0 : sl_next + SLOTB; } while (0)
#define RESC() do { if (resc) { LDS_WAIT(); \
        _Pragma("unroll") for (int d_ = 0; d_ < 2; ++d_) _Pragma("unroll") for (int r = 0; r < 16; ++r) o[d_][r] *= wsf[crow(r, hi)]; } } while (0)
#define ENDW(tt) do { if ((tt) + 3 < NT) { WAIT_BAR(2); } else if ((tt) + 2 < NT) { WAIT_BAR(1); } else { WAIT_BAR(0); } } while (0)
    DMA_K(0, 0); DMA_V(0, 0); if (NT > 1) DMA_K(1, SLOTB); if (NT > 2) DMA_K(2, 2 * SLOTB);
    if (NT > 2) { WAIT_BAR(3); } else if (NT > 1) { WAIT_BAR(2); } else { WAIT_BAR(1); }
    {
        const int j0 = TILE(0);
        qkt(pA0, pA1, lds + L_K, qr, negm, r32, hi);
        att_mod<MODE>(pA0, pA1, j0, qabs, qw0, cur, sel_lo, sel_hi, kbias, hi);
        const float rm = rowmax32(pA0, pA1);
        mhat += rm;
#pragma unroll
        for (int r = 0; r < 16; ++r) { pA0[r] -= rm; pA1[r] -= rm; negm[r] = -mhat; }
        asm volatile("" : "+v"(negm));
#pragma unroll
        for (int r = 0; r < 16; ++r) { pA0[r] = __builtin_amdgcn_exp2f(pA0[r]); pA1[r] = __builtin_amdgcn_exp2f(pA1[r]); }
    }
    WAIT_BAR(0);
    if (NT > 3) DMA_K(3, 0);
    if (NT > 1) DMA_V(1, SLOTB);
    ROT();
    if (NT > 1) kload8(kf, kp0 + sl_cur);
    ENDW(0);
    s16x4 vlo[8], vhi[8]; v4u pw0, pw1, pw2, pw3;
#define PKW(P, B) cvtpk_s(P[B], P[B + 1])
#define PAF(k) __builtin_bit_cast(bf16x8, pw##k)
#define VFR(i) (bf16x8){vlo[i][0], vlo[i][1], vlo[i][2], vlo[i][3], vhi[i][0], vhi[i][1], vhi[i][2], vhi[i][3]}
#define PIN(x) asm volatile("" : "+v"(x))
#define MX3(a, b, c) __builtin_fmaxf(__builtin_fmaxf((a), (b)), (c))
#define GAPA(MF, A0, A1, A2, A3, W0, W1, PW) do { MF; sacc += A0; sacc += A1; sacc += A2; sacc += A3; PIN(sacc); W0; W1; PIN(PW); SBAR(); } while (0)
#define EX(v) __builtin_amdgcn_exp2f(v)
#define GAPB(MF, X, B) do { MF; X[B] = EX(X[B]); X[B + 1] = EX(X[B + 1]); X[B + 2] = EX(X[B + 2]); X[B + 3] = EX(X[B + 3]); PIN(X); SBAR(); } while (0)
#define VRD(i) do { vlo[i] = vtr(vp_ + (((i) >> 2) * 4096 + ((i) & 3) * 1024)); vhi[i] = vtr(vp_ + (((i) >> 2) * 4096 + ((i) & 3) * 1024 + 512)); } while (0)
#define KRD(G, j) do { if (G) { kload2(kf, kp0 + sl_next, j); SBAR(); } } while (0)
#define MFMA32 __builtin_amdgcn_mfma_f32_32x32x16_bf16
#define STEP(C0, C1, P0, P1, t) do { const int jt_ = TILE(t); const bool GK_ = (t) + 3 < NT, GV_ = (t) + 1 < NT; sl_last = sl_cur; SBAR(); \
    const LDSB* vp_ = vp0 + sl_prev; \
    VRD(0); SBAR(); float sacc = (P0[0] + P0[1]); \
    GAPA(C0 = MFMA32(kf[0], qr[0], negm, 0, 0, 0), P0[2], P0[3], P0[4], P0[5],     pw0[0] = PKW(P0, 0), pw0[1] = PKW(P0, 2), pw0); \
    VRD(4); SBAR(); GAPA(C1 = MFMA32(kf[1], qr[0], negm, 0, 0, 0), P0[6], P0[7], P0[8], P0[9],     pw0[2] = PKW(P0, 4), pw0[3] = PKW(P0, 6), pw0); \
    VRD(1); SBAR(); GAPA(C0 = MFMA32(kf[2], qr[1], C0, 0, 0, 0),   P0[10], P0[11], P0[12], P0[13], pw1[0] = PKW(P0, 8), pw1[1] = PKW(P0, 10), pw1); \
    VRD(5); SBAR(); GAPA(C1 = MFMA32(kf[3], qr[1], C1, 0, 0, 0),   P0[14], P0[15], P1[0], P1[1],   pw1[2] = PKW(P0, 12), pw1[3] = PKW(P0, 14), pw1); \
    VRD(2); SBAR(); GAPA(C0 = MFMA32(kf[4], qr[2], C0, 0, 0, 0),   P1[2], P1[3], P1[4], P1[5],     pw2[0] = PKW(P1, 0), pw2[1] = PKW(P1, 2), pw2); \
    VRD(6); SBAR(); GAPA(C1 = MFMA32(kf[5], qr[2], C1, 0, 0, 0),   P1[6], P1[7], P1[8], P1[9],     pw2[2] = PKW(P1, 4), pw2[3] = PKW(P1, 6), pw2); \
    VRD(3); SBAR(); GAPA(C0 = MFMA32(kf[6], qr[3], C0, 0, 0, 0),   P1[10], P1[11], P1[12], P1[13], pw3[0] = PKW(P1, 8), pw3[1] = PKW(P1, 10), pw3); \
    VRD(7); SBAR(); GAPA(C1 = MFMA32(kf[7], qr[3], C1, 0, 0, 0),   P1[14], P1[15], 0.f, 0.f,       pw3[2] = PKW(P1, 12), pw3[3] = PKW(P1, 14), pw3); \
    l_reg += sacc; \
    if (GK_) { DMA_K((t) + 3, sl_cur); } if (GV_) { DMA_V((t) + 1, sl_next); } \
    att_mod<MODE>(C0, C1, jt_, qabs, qw0, cur, sel_lo, sel_hi, kbias, hi); \
    { float a = MX3(C0[0], C0[1], C1[0]), b = MX3(C0[2], C0[3], C1[1]); a = MX3(a, C1[2], C1[3]); \
      _Pragma("unroll") for (int r = 4; r < 16; r += 4) { a = MX3(a, C0[r], C0[r + 1]); b = MX3(b, C0[r + 2], C0[r + 3]); a = MX3(a, C1[r], C1[r + 1]); b = MX3(b, C1[r + 2], C1[r + 3]); } \
      float rm = xh_max(__builtin_fmaxf(a, b)); \
      resc = false; \
      if (__builtin_expect(__any(rm > (float)THRL), 0)) { const float dl = __builtin_fmaxf(rm, 0.f); mhat += dl; \
        _Pragma("unroll") for (int r = 0; r < 16; ++r) { C0[r] -= dl; C1[r] -= dl; } \
        _Pragma("unroll") for (int r = 0; r < 16; ++r) negm[r] = -mhat; asm volatile("" : "+v"(negm)); \
        const float f = __builtin_amdgcn_exp2f(-dl); l_reg *= f; if (hi == 0) wsf[r32] = f; resc = true; } } \
    SBAR(); \
    GAPB(o[0] = MFMA32(PAF(0), VFR(0), o[0], 0, 0, 0), C0, 0); \
    GAPB(o[1] = MFMA32(PAF(0), VFR(4), o[1], 0, 0, 0), C0, 4); \
    KRD(GV_, 0); GAPB(o[0] = MFMA32(PAF(1), VFR(1), o[0], 0, 0, 0), C0, 8); \
    KRD(GV_, 1); GAPB(o[1] = MFMA32(PAF(1), VFR(5), o[1], 0, 0, 0), C0, 12); \
    KRD(GV_, 2); GAPB(o[0] = MFMA32(PAF(2), VFR(2), o[0], 0, 0, 0), C1, 0); \
    KRD(GV_, 3); GAPB(o[1] = MFMA32(PAF(2), VFR(6), o[1], 0, 0, 0), C1, 4); \
    GAPB(o[0] = MFMA32(PAF(3), VFR(3), o[0], 0, 0, 0), C1, 8); \
    GAPB(o[1] = MFMA32(PAF(3), VFR(7), o[1], 0, 0, 0), C1, 12); \
    } while (0)
    int t = 1;
    for (; t + 1 < NT; t += 2) {
        STEP(pB0, pB1, pA0, pA1, t);     ENDW(t);     RESC(); ROT();
        STEP(pA0, pA1, pB0, pB1, t + 1); ENDW(t + 1); RESC(); ROT();
    }
    const LDSB* vlane_p = lds + L_V + ((lane >> 4) & 1) * 32 + (lane & 3) * 8 + (4 * hi + ((lane & 15) >> 2)) * 64;
    if (t < NT) {
        STEP(pB0, pB1, pA0, pA1, t); ENDW(t); RESC();
        l_reg += rowsum32(pB0, pB1);
        pv(o, vlane_p + sl_last, pB0, pB1);
    } else {
        l_reg += rowsum32(pA0, pA1);
        pv(o, vlane_p + sl_last, pA0, pA1);
    }
    l_out = xh_sum(l_reg);
    asm volatile("s_waitcnt lgkmcnt(0)\n\ts_barrier" ::: "memory");
#undef TILE
#undef DMA_K
#undef DMA_V
#undef ROT
#undef RESC
#undef ENDW
#undef PKW
#undef PAF
#undef VFR
#undef PIN
#undef MX3
#undef GAPA
#undef EX
#undef GAPB
#undef VRD
#undef KRD
#undef MFMA32
#undef STEP
}

__device__ __forceinline__ void load_rowvec(float (&fac)[16], const LAS float* tab, int hi) {
#pragma unroll
    for (int g4 = 0; g4 < 4; ++g4) { const f32x4 ff = *(const LAS f32x4*)(tab + 8 * g4 + 4 * hi);
#pragma unroll
        for (int i = 0; i < 4; ++i) fac[4 * g4 + i] = ff[i]; }
}

template <int PITCHO>
__device__ __forceinline__ void store_o_tile(LDSB* stage, const f32x16 (&o)[2], bf16* Ow, int lane) {
    const int r32 = lane & 31, hi = lane >> 5;
    LAS bf16* stg = (LAS bf16*)stage;
#pragma unroll
    for (int r = 0; r < 16; ++r) { const int orow = crow(r, hi);
#pragma unroll
        for (int d0 = 0; d0 < 2; ++d0) stg[orow * 64 + d0 * 32 + r32] = (bf16)f2bf(o[d0][r]); }
    LDS_WAIT();
#pragma unroll
    for (int i = 0; i < 4; ++i) { const int row = i * 8 + (lane >> 3), ch = lane & 7; const v4u v = *(const LAS v4u*)(stg + row * 64 + ch * 8); *(v4u*)(Ow + (size_t)row * PITCHO + ch * 8) = v; }
    LDS_WAIT();
}

__device__ __forceinline__ void fox_unit(Frame& F0, int b, int h, int qb) {
    struct { unsigned char* ws; LDSB* lds; int tid, wave; } F; F.ws = F0.ws; F.lds = F0.lds; F.tid = F0.tid; F.wave = F0.wave;
    asm volatile("" : "+s"(F.ws));
    LDSB* lds = F.lds; int tid_ = F.tid; asm volatile("" : "+v"(tid_));
    const int tid = tid_, lane = tid & 63, wid = F.wave, r32 = lane & 31, hi = lane >> 5;
    const int q0 = 256 * qb, NT = 4 * qb + 4;
    const float* cb = (const float*)(F.ws + WS_CB) + (size_t)(b * 8 + h) * SEQ;
    LAS float* kb = (LAS float*)(lds + L_ACC);
    for (int i = tid; i < q0 + 256; i += NTHR) kb[i] = cb[i];
    LAS unsigned char* tl = (LAS unsigned char*)(lds + L_TL);
    if (tid < NT) tl[tid] = (unsigned char)(NT - 1 - tid);
    const bf16* Qw = (const bf16*)(F.ws + WS_QF) + ((size_t)b * SEQ + q0 + 32 * wid) * 512 + h * 64;
    bf16x8 qr[4];
#pragma unroll
    for (int d0 = 0; d0 < 4; ++d0) qr[d0] = *(const bf16x8*)(Qw + (size_t)r32 * 512 + d0 * 16 + hi * 8);
    __syncthreads();
    const bf16* Kh = (const bf16*)(F.ws + WS_KF) + (size_t)b * SEQ * 512 + h * 64;
    const bf16* Vh = (const bf16*)(F.ws + WS_VF) + (size_t)b * SEQ * 512 + h * 64;
    f32x16 o[2]; float l;
    attn_fast<0, 512, 8>(lds, Kh, Vh, tl, NT, qr, q0 + 32 * wid + r32, q0 + 32 * wid, 0, 0u, 0u, kb, o, l, wid, lane);
    LAS float* wsf = (LAS float*)(lds + L_WS) + wid * 256;
    if (hi == 0) wsf[32 + r32] = 1.f / l;
    LDS_WAIT();
    float fac[16]; load_rowvec(fac, wsf + 32, hi);
#pragma unroll
    for (int r = 0; r < 16; ++r) { o[0][r] *= fac[r]; o[1][r] *= fac[r]; }
    bf16* Ow = (bf16*)(F.ws + WS_Y) + ((size_t)b * SEQ + q0 + 32 * wid) * 1024 + h * 64;
    store_o_tile<1024>(lds + L_ACC + 16384 + wid * 4096, o, Ow, lane);
    __syncthreads();
}

__device__ __forceinline__ void nsa_unit(Frame& F0, int b, int g, int cur) {
    struct { unsigned char* ws; LDSB* lds; int tid, wave; } F; F.ws = F0.ws; F.lds = F0.lds; F.tid = F0.tid; F.wave = F0.wave;
    asm volatile("" : "+s"(F.ws));
    LDSB* lds = F.lds; int tid_ = F.tid; asm volatile("" : "+v"(tid_));
    const int tid = tid_, lane = tid & 63, wid = F.wave, r32 = lane & 31, hi = lane >> 5;
    const int bg = b * 2 + g, hh = wid >> 1, head = 4 * g + hh, qh = wid & 1, qq = 32 * qh + r32, qpos = 64 * cur + qq;
    const unsigned lds0 = (unsigned)(uintptr_t)lds;
    LAS float* wsf = (LAS float*)(lds + L_WS) + wid * 256;
    LAS float* accw = (LAS float*)(lds + L_ACC) + wid * 2048;
    const size_t row0 = (size_t)b * SEQ + 64 * cur + 32 * qh;
    const bf16* Qw = (const bf16*)(F.ws + WS_QN) + row0 * 512 + head * 64;
    bf16x8 qr[4];
#pragma unroll
    for (int d0 = 0; d0 < 4; ++d0) qr[d0] = *(const bf16x8*)(Qw + (size_t)r32 * 512 + d0 * 16 + hi * 8);
    if (tid < 2) ((LAS unsigned*)(lds + L_TL + 128))[tid] = 0u;
    if (lane < 32) { const float* gp = (const float*)(F.ws + WS_GATE) + (row0 + lane) * 24 + head * 3;
        wsf[64 + lane] = gp[0]; wsf[96 + lane] = gp[1]; wsf[128 + lane] = gp[2]; }
    LDS_WAIT();
    {
        const bf16* Kc = (const bf16*)(F.ws + WS_KCMP) + (size_t)bg * 256 * 64;
        const bf16* Vc = (const bf16*)(F.ws + WS_VCMP) + (size_t)bg * 256 * 64;
#pragma unroll
        for (int tl = 0; tl < 4; ++tl) dma_kv<64>(Kc, Vc, 64 * tl, lds0 + L_K + tl * SLOTB, lds0 + L_V + tl * SLOTB, wid, lane);
        WAIT_BAR(0);
        f32x16 zero;
#pragma unroll
        for (int r = 0; r < 16; ++r) zero[r] = 0.f;
        float mrun = -1e30f, lrun = 0.f;
#pragma unroll 1
        for (int tl = 0; tl < 4; ++tl) {
            f32x16 p0, p1;
            qkt(p0, p1, lds + L_K + tl * SLOTB, qr, zero, r32, hi);
#pragma unroll
            for (int r = 0; r < 16; ++r) { const int c = 64 * tl + crow(r, hi); if (16 * c + 31 > qpos) p0[r] = NEGM; if (16 * (c + 32) + 31 > qpos) p1[r] = NEGM; }
            const float rm = rowmax32(p0, p1), mn = fmaxf(mrun, rm);
            float s = 0.f;
#pragma unroll
            for (int r = 0; r < 16; ++r) s += __builtin_amdgcn_exp2f(p0[r] - mn) + __builtin_amdgcn_exp2f(p1[r] - mn);
            lrun = lrun * __builtin_amdgcn_exp2f(mrun - mn) + s; mrun = mn;
            asm volatile("" ::: "memory");
        }
        lrun = xh_sum(lrun);
        const float invl = 1.f / lrun;
        f32x16 o[2];
#pragma unroll
        for (int r = 0; r < 16; ++r) { o[0][r] = 0.f; o[1][r] = 0.f; }
        float impv[4][8]; float prevY3 = 0.f;
        const int vlane = ((lane >> 4) & 1) * 32 + (lane & 3) * 8 + (4 * hi + ((lane & 15) >> 2)) * 64;
#pragma unroll
        for (int tl = 0; tl < 4; ++tl) {
            f32x16 p0, p1;
            qkt(p0, p1, lds + L_K + tl * SLOTB, qr, zero, r32, hi);
#pragma unroll
            for (int r = 0; r < 16; ++r) { const int c = 64 * tl + crow(r, hi);
                p0[r] = (16 * c + 31 > qpos) ? 0.f : __builtin_amdgcn_exp2f(p0[r] - mrun) * invl;
                p1[r] = (16 * (c + 32) + 31 > qpos) ? 0.f : __builtin_amdgcn_exp2f(p1[r] - mrun) * invl; }
            float rX[4], rY[4];
#pragma unroll
            for (int g4 = 0; g4 < 4; ++g4) { rX[g4] = xh_other(p0[4 * g4 + 3], hi); rY[g4] = xh_other(p1[4 * g4 + 3], hi); }
#pragma unroll
            for (int g4 = 0; g4 < 4; ++g4) {
                const float qs0 = (p0[4 * g4] + p0[4 * g4 + 1]) + (p0[4 * g4 + 2] + p0[4 * g4 + 3]);
                const float qs1 = (p1[4 * g4] + p1[4 * g4 + 1]) + (p1[4 * g4 + 2] + p1[4 * g4 + 3]);
                const float lo0 = (g4 > 0) ? rX[g4 > 0 ? g4 - 1 : 0] : prevY3;
                const float lo1 = (g4 > 0) ? rY[g4 > 0 ? g4 - 1 : 0] : rX[3];
                impv[tl][g4] = qs0 + (hi ? rX[g4] : lo0);
                impv[tl][4 + g4] = qs1 + (hi ? rY[g4] : lo1);
            }
            prevY3 = rY[3];
            pv(o, lds + L_V + tl * SLOTB + vlane, p0, p1);
            asm volatile("" ::: "memory");
        }
        LAS float* imp = (LAS float*)(lds + L_IMP);
#pragma unroll
        for (int hd = 0; hd < 4; ++hd) {
            if (hh == hd) {
#pragma unroll
                for (int tl = 0; tl < 4; ++tl)
#pragma unroll
                    for (int e = 0; e < 8; ++e) { const int jj = 16 * tl + 8 * (e >> 2) + 2 * (e & 3) + hi; LAS float* p = imp + qq * 65 + jj;
                        if (hd == 0) *p = impv[tl][e]; else *p += impv[tl][e]; }
            }
            LDS_WAIT(); __syncthreads();
        }
        float gc[16]; load_rowvec(gc, wsf + 64, hi);
#pragma unroll
        for (int d0 = 0; d0 < 2; ++d0)
#pragma unroll
            for (int r = 0; r < 16; ++r) accw[(d0 * 16 + r) * 64 + lane] = o[d0][r] * gc[r];
    }
    {
        const LAS float* imp = (const LAS float*)(lds + L_IMP);
        const int q = tid >> 3, part = tid & 7;
        float sc[8];
#pragma unroll
        for (int i = 0; i < 8; ++i) { const int jj = part * 8 + i; const float v = imp[q * 65 + jj];
            sc[i] = (jj <= cur) ? v + ((jj == 0 || jj == cur || jj == cur - 1) ? 1e4f : 0.f) : -1.f; }
        int rank[8];
#pragma unroll
        for (int i = 0; i < 8; ++i) rank[i] = 0;
        for (int jp = 0; jp < 64; ++jp) { const float v = imp[q * 65 + jp];
            const float s = (jp <= cur) ? v + ((jp == 0 || jp == cur || jp == cur - 1) ? 1e4f : 0.f) : -1.f;
#pragma unroll
            for (int i = 0; i < 8; ++i) { const int jj = part * 8 + i; rank[i] += (s > sc[i] || (s == sc[i] && jp < jj)) ? 1 : 0; } }
        unsigned bits = 0;
#pragma unroll
        for (int i = 0; i < 8; ++i) bits |= (rank[i] < 16 ? 1u : 0u) << i;
        ((LAS unsigned char*)(lds + L_SEL))[q * 8 + part] = (unsigned char)bits;
        __hip_atomic_fetch_or((LAS unsigned*)(lds + L_TL + 128) + (part >> 2), bits << (8 * (part & 3)), __ATOMIC_RELAXED, __HIP_MEMORY_SCOPE_WORKGROUP);
        LDS_WAIT(); __syncthreads();
    }
    const LAS unsigned* selw = (const LAS unsigned*)(lds + L_SEL);
    const unsigned sel_lo = selw[qq * 2], sel_hi = selw[qq * 2 + 1];
    const unsigned ulo = ((const LAS unsigned*)(lds + L_TL + 128))[0], uhi = ((const LAS unsigned*)(lds + L_TL + 128))[1];
    unsigned long long umask = ((unsigned long long)uhi << 32) | ulo;
    umask &= (cur >= 63) ? ~0ull : ((1ull << (cur + 1)) - 1ull);
    const int jlo = cur >= 8 ? cur - 8 : 0;
    LAS unsigned char* tls = (LAS unsigned char*)(lds + L_TL);
    LAS unsigned char* tlw = tls + 64;
    if (tid < 64) {
        if ((umask >> tid) & 1ull) tls[__builtin_popcountll(umask & ((1ull << tid) - 1ull))] = (unsigned char)tid;
        if (tid <= cur - jlo) tlw[tid] = (unsigned char)(jlo + tid);
    }
    LDS_WAIT(); __syncthreads();
    const int NTs = __builtin_amdgcn_readfirstlane(__builtin_popcountll(umask)), NTw = cur - jlo + 1;
    {
        const bf16* Kh = (const bf16*)(F.ws + WS_KS) + (size_t)bg * SEQ * 64;
        const bf16* Vh = (const bf16*)(F.ws + WS_VS) + (size_t)bg * SEQ * 64;
        f32x16 o[2]; float l;
        attn_fast<1, 64, 8>(lds, Kh, Vh, tls, NTs, qr, qpos, 0, cur, sel_lo, sel_hi, nullptr, o, l, wid, lane);
        if (hi == 0) wsf[32 + r32] = 1.f / l;
        LDS_WAIT();
        float fl[16], gs[16]; load_rowvec(fl, wsf + 32, hi); load_rowvec(gs, wsf + 96, hi);
#pragma unroll
        for (int d0 = 0; d0 < 2; ++d0)
#pragma unroll
            for (int r = 0; r < 16; ++r) accw[(d0 * 16 + r) * 64 + lane] += o[d0][r] * (fl[r] * gs[r]);
        LDS_WAIT();
    }
    {
        const bf16* Kh = (const bf16*)(F.ws + WS_KW) + (size_t)bg * SEQ * 64;
        const bf16* Vh = (const bf16*)(F.ws + WS_VW) + (size_t)bg * SEQ * 64;
        f32x16 o[2]; float l;
        attn_fast<2, 64, 8>(lds, Kh, Vh, tlw, NTw, qr, qpos, 0, cur, 0u, 0u, nullptr, o, l, wid, lane);
        if (hi == 0) wsf[32 + r32] = 1.f / l;
        LDS_WAIT();
        float fl[16], gate_win[16]; load_rowvec(fl, wsf + 32, hi); load_rowvec(gate_win, wsf + 128, hi);
#pragma unroll
        for (int d0 = 0; d0 < 2; ++d0)
#pragma unroll
            for (int r = 0; r < 16; ++r) o[d0][r] = accw[(d0 * 16 + r) * 64 + lane] + o[d0][r] * (fl[r] * gate_win[r]);
        LDS_WAIT();
        bf16* Ow = (bf16*)(F.ws + WS_Y) + row0 * 1024 + 512 + head * 64;
        store_o_tile<1024>((LDSB*)accw, o, Ow, lane);
    }
    __syncthreads();
}

__device__ __forceinline__ int att_unit_cost(int id) { return id < 1024 ? (63 - (id >> 4)) + 30 : 4 * (15 - ((id - 1024) >> 6)) + 4; }
__device__ __forceinline__ void p3_attention(Frame& F) {
    LAS unsigned short* order = (LAS unsigned short*)(F.lds + L_ORD);
    for (int id = F.tid; id < 2048; id += NTHR) {
        const int c = att_unit_cost(id); int pos = 0;
        { int lo = c - 30 + 1; if (lo < 0) lo = 0; int cnt = 64 - lo; if (cnt < 0) cnt = 0; pos += 16 * cnt; }
        { int cnt = 0; for (int qb = 0; qb < 16; ++qb) cnt += (4 * qb + 4 > c) ? 1 : 0; pos += 64 * cnt; }
        if (id < 1024) pos += (id & 15);
        else { const int cn = c - 30; if (cn >= 0 && cn <= 63) pos += 16; pos += (id & 63); }
        order[pos] = (unsigned short)id;
    }
    LDS_WAIT(); __syncthreads();
    gu32* qhead = F.ctl + CW_Q_ATT;
    for (;;) {
        if (F.tid == 0) F.MISC[0] = __hip_atomic_fetch_add(qhead, 1u, RLX_AGENT);
        LDS_WAIT(); __syncthreads();
        const unsigned k = F.MISC[0];
        if (k >= 2048u) break;
        const int id = order[k];
        __syncthreads();
#ifndef NO_NSA
        if (id < 1024) nsa_unit(F, (id & 15) >> 1, id & 1, 63 - (id >> 4));
#endif
#ifndef NO_FOX
        if (id >= 1024) fox_unit(F, (id & 63) >> 3, id & 7, 15 - ((id - 1024) >> 6));
#endif
    }
}

__device__ __forceinline__ void p4_ynorm(Frame& F) {
    const int gw = F.vcu * NWAVES + F.wave, NGW = F.G * NWAVES;
    for (int m = gw; m < T; m += NGW) {
        bf16* row = (bf16*)(F.ws + WS_Y) + (size_t)m * 1024 + F.lane * 16;
        v4u a = *(const v4u*)row, b = *(const v4u*)(row + 8);
        float v[16];
        const unsigned w[8] = {a.x, a.y, a.z, a.w, b.x, b.y, b.z, b.w};
#pragma unroll
        for (int i = 0; i < 8; ++i) { v[2 * i] = __builtin_bit_cast(float, w[i] << 16); v[2 * i + 1] = __builtin_bit_cast(float, w[i] & 0xffff0000u); }
        float s = 0.f;
#pragma unroll
        for (int i = 0; i < 16; ++i) s += v[i] * v[i];
#pragma unroll
        for (int o = 1; o < 32; o <<= 1) s += __shfl_xor(s, o);
        const float r = 1.f / sqrtf(s * (1.f / 512.f) + EPS);
        v4u oa, ob;
        oa.x = pk2(v[0] * r, v[1] * r); oa.y = pk2(v[2] * r, v[3] * r); oa.z = pk2(v[4] * r, v[5] * r); oa.w = pk2(v[6] * r, v[7] * r);
        ob.x = pk2(v[8] * r, v[9] * r); ob.y = pk2(v[10] * r, v[11] * r); ob.z = pk2(v[12] * r, v[13] * r); ob.w = pk2(v[14] * r, v[15] * r);
        *(v4u*)row = oa; *(v4u*)(row + 8) = ob;
    }
}
__device__ __forceinline__ void p6_hnorm(Frame& F, const float* h1) {
    const int gw = F.vcu * NWAVES + F.wave, NGW = F.G * NWAVES;
    for (int m = gw; m < T; m += NGW) rms_row_to_bf16(F.lane, h1 + (size_t)m * DM, (bf16*)(F.ws + WS_XN) + (size_t)m * DM);
}
__device__ __forceinline__ void p9_final(Frame& F, float* out, const float* g_final) {
    const int gw = F.vcu * NWAVES + F.wave, NGW = F.G * NWAVES;
    for (int m = gw; m < T; m += NGW) {
        GAS f32x4* xr = (GAS f32x4*)(out + (size_t)m * DM) + F.lane;
        f32x4 v[4]; float s = 0.f;
#pragma unroll
        for (int j = 0; j < 4; ++j) { v[j] = xr[64 * j]; s += (v[j].x * v[j].x + v[j].y * v[j].y) + (v[j].z * v[j].z + v[j].w * v[j].w); }
        const float r = 1.f / sqrtf(wave_sum(s) * (1.f / DM) + EPS);
#pragma unroll
        for (int j = 0; j < 4; ++j) { const f32x4 gg = *((const f32x4*)g_final + F.lane + 64 * j); xr[64 * j] = v[j] * r * gg; }
    }
}

constexpr int N_PHASES = 10;
__global__ void __launch_bounds__(NTHR, 2) hymba_fwd(Args args) {
    extern __shared__ __attribute__((aligned(16))) unsigned char lds_raw[];
    Frame F;
    F.lds = (LDSB*)lds_raw;
    F.MISC = (volatile LAS unsigned*)(F.lds + L_MISC);
    F.tid = threadIdx.x; F.lane = F.tid & 63; F.wave = __builtin_amdgcn_readfirstlane(F.tid >> 6);
    F.G = gridDim.x; { const int bx = blockIdx.x; F.vcu = (F.G % 8 == 0) ? (bx % 8) * (F.G / 8) + bx / 8 : bx; }
    kptr_t kp0 = (kptr_t)__builtin_amdgcn_kernarg_segment_ptr();
#define KP() ({ kptr_t k_ = kp0; asm volatile("" : "+s"(k_)); k_; })
    { kptr_t kp = KP(); F.ws = *(unsigned char* const __attribute__((address_space(4)))*)(kp + 8 * 23); }
    F.ctl = (gu32*)(F.ws + WS_CTL);
    if (F.tid < 64) F.MISC[F.tid] = 0u;
    __syncthreads();
    int lo, hi; { kptr_t kp = KP(); lo = *(const int __attribute__((address_space(4)))*)(kp + 192); hi = *(const int __attribute__((address_space(4)))*)(kp + 196); }
    const bool one_launch = (hi - lo) > 1;
    XcdBarrier bar; bar.bar = (unsigned*)(F.ctl + CW_BAR); bar.x = 0; bar.st = nullptr; bar.wave = F.wave;
    if (one_launch) { bar = xcd_barrier_post((unsigned*)(F.ctl + CW_BAR), F.MISC + 8); bar.wave = F.wave; }
#ifdef PHASE_MASK
#define IN(k) (((PHASE_MASK >> (k)) & 1) && lo <= (k) && (k) < hi)
#else
#define IN(k) (lo <= (k) && (k) < hi)
#endif
#define SEAM(k) do { if (IN(k) && IN((k) + 1)) xcd_barrier(bar); } while (0)
#define RELANE() do { int l_ = lane_id(); asm volatile("" : "+v"(l_)); F.lane = l_; F.tid = F.wave * 64 + l_; } while (0)

    if (IN(0)) { RELANE(); p0_prologue(F, KP()); SEAM(0); }

    if (IN(1)) { RELANE();
        pg8::Gemm g{(const bf16*)(F.ws + WS_XN), (const bf16*)(F.ws + WS_WIN), T, NPROJ, DM}; pg8::StaticOrder S; S.init(T, NPROJ, F.G, (int)blockIdx.x);
        kptr_t kp = KP(); EpiProj E{F.ws, AIN(kp, 3), AIN(kp, 4)};
        pg8::gemm_phase<EpiProj, pg8::StaticOrder, true, true>(F.lds, g, S, E, F.wave);
        SEAM(1);
    }

    if (IN(2)) { RELANE();
        const int gw = F.vcu * NWAVES + F.wave;
        if (gw < 64) p2_cumsum_item(F, gw);
        { kptr_t kp = KP(); for (int it = (int)blockIdx.x; it < 128; it += F.G) p2_compress_item(F, kp, it); }
        SEAM(2);
    }

    if (IN(3)) { RELANE(); p3_attention(F); SEAM(3); }

    if (IN(4)) { RELANE(); p4_ynorm(F); SEAM(4); }

    if (IN(5)) { RELANE();
        pg8::Gemm g{(const bf16*)(F.ws + WS_Y), (const bf16*)(F.ws + WS_WOUT), T, DM, DM}; pg8::StaticOrder S; S.init(T, DM, F.G, (int)blockIdx.x);
        kptr_t kp = KP(); EpiOutRes E{AIN(kp, 0), *(float* const __attribute__((address_space(4)))*)(kp + 8 * 22), (bf16*)(F.ws + WS_XN), (float*)(F.ws + WS_SSQ1), F.lds};
        pg8::gemm_phase<EpiOutRes, pg8::StaticOrder, true, true>(F.lds, g, S, E, F.wave);
        if (IN(5) && IN(7)) xcd_barrier(bar);
    }


    if (IN(7)) { RELANE();
        pg8::Gemm g{(const bf16*)(F.ws + WS_XN), (const bf16*)(F.ws + WS_WUP), T, FF, DM}; pg8::StaticOrder S; S.init(T, FF, F.G, (int)blockIdx.x);
        EpiUp E{(bf16*)(F.ws + WS_U), (const float*)(F.ws + WS_SSQ1)};
        pg8::gemm_phase<EpiUp, pg8::StaticOrder, true, true>(F.lds, g, S, E, F.wave);
        SEAM(7);
    }

    if (IN(8)) { RELANE();
        pg8::Gemm g{(const bf16*)(F.ws + WS_U), (const bf16*)(F.ws + WS_WDN), T, DM, FF}; pg8::StaticOrder S; S.init(T, DM, F.G, (int)blockIdx.x);
        kptr_t kp = KP(); EpiDownRes E{*(float* const __attribute__((address_space(4)))*)(kp + 8 * 22)};
        pg8::gemm_phase<EpiDownRes, pg8::StaticOrder, true, true>(F.lds, g, S, E, F.wave);
        SEAM(8);
    }

    if (IN(9)) { RELANE(); { kptr_t kp = KP(); p9_final(F, *(float* const __attribute__((address_space(4)))*)(kp + 8 * 22), AIN(kp, 21)); } }
#undef IN
#undef SEAM
}

extern "C" void kernel_launch(void* const* d_in, const int* in_sizes, int n_in, void* d_out, int out_size, void* d_ws, size_t ws_size, hipStream_t stream) {
    static int grid = 0;
    if (grid == 0) {
        if (n_in != 22 || out_size != T * DM || ws_size < WS_END) { fprintf(stderr, "kernel_launch: unexpected shapes (n_in %d out %d ws %zu)\n", n_in, out_size, ws_size); grid = -1; return; }
        int dev = 0, cus = 0, per_cu = 0;
        if (hipGetDevice(&dev) != hipSuccess || hipDeviceGetAttribute(&cus, hipDeviceAttributeMultiprocessorCount, dev) != hipSuccess) { grid = -1; return; }
        if (hipFuncSetAttribute((const void*)hymba_fwd, hipFuncAttributeMaxDynamicSharedMemorySize, LDS_BYTES) != hipSuccess) { fprintf(stderr, "kernel_launch: hipFuncSetAttribute failed\n"); grid = -1; return; }
        if (hipOccupancyMaxActiveBlocksPerMultiprocessor(&per_cu, (const void*)hymba_fwd, NTHR, LDS_BYTES) != hipSuccess || per_cu < 1) { fprintf(stderr, "kernel_launch: occupancy query says %d\n", per_cu); per_cu = 1; }
        (void)hipGetLastError();
        grid = cus;
    }
    if (grid < 0) return;
    (void)hipMemsetAsync((char*)d_ws + WS_CTL, 0, CTL_ZERO_BYTES, stream);
    Args a{};
    for (int i = 0; i < 22; ++i) a.in[i] = (const float*)d_in[i];
    a.out = (float*)d_out; a.ws = (unsigned char*)d_ws;
#if MK_N_LAUNCHES == 1
    a.ph_lo = 0; a.ph_hi = N_PHASES;
    void* kargs[] = {&a};
    hipError_t e = hipLaunchCooperativeKernel((const void*)hymba_fwd, dim3(grid), dim3(NTHR), kargs, LDS_BYTES, stream);
    if (e != hipSuccess) fprintf(stderr, "kernel_launch: cooperative launch failed: %s (grid %d)\n", hipGetErrorString(e), grid);
#else
    for (int p = 0; p < N_PHASES; ++p) { a.ph_lo = p; a.ph_hi = p + 1; hipLaunchKernelGGL(hymba_fwd, dim3(grid), dim3(NTHR), LDS_BYTES, stream, a); }
#endif
}
```

```cpp
#include <hip/hip_runtime.h>
#include <hip/hip_bf16.h>
#include <cstdio>
#include <cstdint>

#ifndef MK_N_LAUNCHES
#define MK_N_LAUNCHES 1
#endif

__device__ __forceinline__ int lane_id() { return (int)__builtin_amdgcn_mbcnt_hi(~0u, __builtin_amdgcn_mbcnt_lo(~0u, 0u)); }
namespace pg8 {
#define PG8_LAS __attribute__((address_space(3)))
typedef unsigned short bf16_t;
typedef short bf16x8 __attribute__((ext_vector_type(8)));
typedef float f32x4 __attribute__((ext_vector_type(4)));
typedef unsigned u32x4 __attribute__((ext_vector_type(4)));
constexpr int BM = 256, BK = 64, HALF = 128, HTB = HALF * BK * 2, STAGE_BYTES = 8 * HTB, NXCD = 8, WGM = 8;

__host__ __device__ __forceinline__ int lds_byte(int r, int c) { const int st = (r >> 4) * 2 + (c >> 5), rr = r & 15, cc = c & 31, ob = rr * 64 + cc * 2; return st * 1024 + (ob ^ (((ob >> 9) & 1) << 5)); }
__host__ __device__ __forceinline__ void stage_rc(int b, int& R, int& C) { const int st = b / 1024, sb = b % 1024, swz = sb ^ (((sb >> 9) & 1) << 5); R = (st >> 1) * 16 + swz / 64; C = (st & 1) * 32 + (swz % 64) / 2; }
__host__ __device__ __forceinline__ int perm32(int rho) { const int n = rho >> 4, i = rho & 15; return 8 * (i >> 2) + 4 * n + (i & 3); }

struct Unit { int pm, pn; };
struct Gemm { const bf16_t* A; const bf16_t* Bt; int M, N, K; };

struct StaticOrder {
    int nM, nN, nwg, G, c;
    __host__ __device__ void init(int M, int N, int G_, int c_) { nM = M / BM; nN = N / BM; nwg = nM * nN; G = G_; c = c_; }
    __host__ __device__ bool next(int i, Unit& u) const {
        const long L = (long)i * G + c; if (L >= nwg) return false;
        int wgid = (int)L; { const int q = nwg / NXCD, r = nwg % NXCD, xcd = wgid % NXCD, off = wgid / NXCD; wgid = (xcd < r ? xcd * (q + 1) : r * (q + 1) + (xcd - r) * q) + off; }
        const int nig = WGM * nN, gid = wgid / nig, fm = gid * WGM, gsz = (nM - fm) < WGM ? (nM - fm) : WGM;
        u.pm = fm + ((wgid % nig) % gsz); u.pn = (wgid % nig) / gsz; return true;
    }
    __device__ __forceinline__ void a_ready(const Unit&) const {}
    __device__ __forceinline__ void done(const Unit&) const {}
};

__device__ __forceinline__ unsigned cvt_pk_bf16(float lo, float hi) { unsigned r; asm volatile("v_cvt_pk_bf16_f32 %0, %1, %2" : "=v"(r) : "v"(lo), "v"(hi)); return r; }

template <class Epi, class Sched, bool ALIGN_EPI = false, bool SP2 = false>
__device__ __forceinline__ void gemm_phase(PG8_LAS unsigned char* lds, const Gemm g, const Sched& S, const Epi& E, int wave_id) {
    const int wid = wave_id, lane = lane_id(), tid = wid * 64 + lane, wr = wid >> 2, wc = wid & 3, fr = lane & 15, fq = lane >> 4;
    const int K = g.K, nt = K / BK;
    unsigned voffA[2], voffB[2];
#pragma unroll
    for (int i = 0; i < 2; ++i) { int R, C; stage_rc(tid * 16 + i * 8192, R, C); const int Rb = Epi::PERM ? ((R & ~31) + perm32(R & 31)) : R;
        voffA[i] = (unsigned)(R * K + C) * 2u; voffB[i] = (unsigned)(Rb * K + C) * 2u; }
    const size_t kstep = (size_t)(BK * 2);
    const size_t hstep = (size_t)HALF * K * 2;
    const size_t tstep = 2 * hstep;
    const unsigned ldsw = (unsigned)wid * 1024u;
    const int aoff = lds_byte(wr * 64 + fr, fq * 8), boff = lds_byte(wc * 32 + fr, fq * 8);
#define PG8_SA(b, h) (((b) * 2 + (h)) * HTB)
#define PG8_SB(b, h) ((4 + (b) * 2 + (h)) * HTB)
#define PG8_STAGE(bufoff, gbase, voff) do { _Pragma("unroll") for (int _i = 0; _i < 2; ++_i) \
        __builtin_amdgcn_global_load_lds((const unsigned*)((const char*)(gbase) + (voff)[_i]), (PG8_LAS unsigned*)(lds + (bufoff) + ldsw + _i * 8192), 16, 0, 0); } while (0)
#define PG8_LDA(dst, b, h) do { _Pragma("unroll") for (int m = 0; m < 4; ++m) _Pragma("unroll") for (int k = 0; k < 2; ++k) dst[m][k] = *(const PG8_LAS bf16x8*)(lds + PG8_SA(b, h) + aoff + m * 2048 + k * 1024); } while (0)
#define PG8_LDB(dst, b, h) do { _Pragma("unroll") for (int n = 0; n < 2; ++n) _Pragma("unroll") for (int k = 0; k < 2; ++k) dst[n][k] = *(const PG8_LAS bf16x8*)(lds + PG8_SB(b, h) + boff + n * 2048 + k * 1024); } while (0)
#define PG8_MMA(ai, bj, At, Bt) do { __builtin_amdgcn_s_setprio(1); _Pragma("unroll") for (int m = 0; m < 4; ++m) _Pragma("unroll") for (int n = 0; n < 2; ++n) _Pragma("unroll") for (int k = 0; k < 2; ++k) \
        acc[ai][bj][m][n] = __builtin_amdgcn_mfma_f32_16x16x32_bf16(Bt[n][k], At[m][k], acc[ai][bj][m][n], 0, 0, 0); __builtin_amdgcn_s_setprio(0); } while (0)
#define PG8_WAIT_V(n) asm volatile("s_waitcnt vmcnt(" #n ")" ::: "memory")
#define PG8_WAIT_L(n) asm volatile("s_waitcnt lgkmcnt(" #n ")" ::: "memory")
#define PG8_BAR __builtin_amdgcn_s_barrier()
#define PG8_SCHED __builtin_amdgcn_sched_barrier(0)
    Unit cur, nxt; int ui = 0;
    if (!S.next(0, cur)) return;
    f32x4 acc[2][2][4][2];
#pragma unroll
    for (int a = 0; a < 2; ++a)
#pragma unroll
        for (int b = 0; b < 2; ++b)
#pragma unroll
            for (int m = 0; m < 4; ++m)
#pragma unroll
                for (int n = 0; n < 2; ++n) acc[a][b][m][n] = (f32x4){0.f, 0.f, 0.f, 0.f};
    bf16x8 At[4][2], B0[2][2], B1[2][2];
    const char* cA = (const char*)g.A + (size_t)cur.pm * tstep; const char* cB = (const char*)g.Bt + (size_t)cur.pn * tstep;
    S.a_ready(cur);
    if constexpr (SP2) {
        PG8_STAGE(PG8_SB(0, 0), cB, voffB); PG8_STAGE(PG8_SB(0, 1), cB + hstep, voffB); PG8_STAGE(PG8_SA(0, 0), cA, voffA); PG8_STAGE(PG8_SA(0, 1), cA + hstep, voffA);
        if (wr == 1) PG8_BAR;
        PG8_WAIT_V(2); PG8_BAR;
        PG8_STAGE(PG8_SB(1, 0), cB + kstep, voffB); PG8_STAGE(PG8_SA(1, 0), cA + kstep, voffA); PG8_STAGE(PG8_SB(1, 1), cB + hstep + kstep, voffB);
        PG8_WAIT_V(6); PG8_BAR;
    } else {
        PG8_STAGE(PG8_SB(0, 0), cB, voffB); PG8_STAGE(PG8_SA(0, 0), cA, voffA); PG8_STAGE(PG8_SB(0, 1), cB + hstep, voffB); PG8_STAGE(PG8_SA(0, 1), cA + hstep, voffA);
        if (wr == 1) PG8_BAR;
        PG8_WAIT_V(4); PG8_BAR;
        PG8_STAGE(PG8_SB(1, 0), cB + kstep, voffB); PG8_STAGE(PG8_SA(1, 0), cA + kstep, voffA); PG8_STAGE(PG8_SB(1, 1), cB + hstep + kstep, voffB);
        PG8_WAIT_V(6); PG8_BAR;
    }
    for (;;) {
        const bool has_next = S.next(ui + 1, nxt);
        const char* nA = has_next ? (const char*)g.A + (size_t)nxt.pm * tstep : cA; const char* nB = has_next ? (const char*)g.Bt + (size_t)nxt.pn * tstep : cB;
        for (int t = 0; t < nt; t += 2) {
            const bool last = (t == nt - 2);
            const char* a1 = cA + (size_t)(t + 1) * kstep;
            const char* a2 = last ? nA : cA + (size_t)(t + 2) * kstep; const char* b2 = last ? nB : cB + (size_t)(t + 2) * kstep;
            const char* a3 = a2 + kstep; const char* b3 = b2 + kstep;
            if (last && has_next) S.a_ready(nxt);
            if constexpr (SP2) {
            PG8_LDB(B0, 0, 0); PG8_LDB(B1, 0, 1); PG8_SCHED; PG8_LDA(At, 0, 0); PG8_STAGE(PG8_SA(1, 1), a1 + hstep, voffA);
            PG8_WAIT_V(8); PG8_WAIT_L(0); PG8_BAR; PG8_MMA(0, 0, At, B0); PG8_MMA(0, 1, At, B1); PG8_BAR; PG8_SCHED;
            PG8_LDA(At, 0, 1); PG8_STAGE(PG8_SB(0, 0), b2, voffB); PG8_STAGE(PG8_SB(0, 1), b2 + hstep, voffB); PG8_STAGE(PG8_SA(0, 0), a2, voffA);
            PG8_WAIT_V(8); PG8_WAIT_L(0); PG8_BAR; PG8_MMA(1, 0, At, B0); PG8_MMA(1, 1, At, B1); PG8_BAR; PG8_SCHED;
            PG8_LDB(B0, 1, 0); PG8_LDB(B1, 1, 1); PG8_SCHED; PG8_LDA(At, 1, 0); PG8_STAGE(PG8_SA(0, 1), a2 + hstep, voffA);
            PG8_WAIT_V(8); PG8_WAIT_L(0); PG8_BAR; PG8_MMA(0, 0, At, B0); PG8_MMA(0, 1, At, B1); PG8_BAR; PG8_SCHED;
            PG8_LDA(At, 1, 1); PG8_STAGE(PG8_SB(1, 0), b3, voffB); PG8_STAGE(PG8_SB(1, 1), b3 + hstep, voffB); PG8_STAGE(PG8_SA(1, 0), a3, voffA);
            PG8_WAIT_V(8); PG8_WAIT_L(0); PG8_BAR; PG8_MMA(1, 0, At, B0); PG8_MMA(1, 1, At, B1); PG8_BAR; PG8_SCHED;
            } else {
            PG8_LDB(B0, 0, 0); PG8_SCHED; PG8_LDA(At, 0, 0); PG8_STAGE(PG8_SA(1, 1), a1 + hstep, voffA);
            PG8_WAIT_L(8); PG8_BAR; PG8_WAIT_L(0); PG8_MMA(0, 0, At, B0); PG8_BAR; PG8_SCHED;
            PG8_LDB(B1, 0, 1); PG8_STAGE(PG8_SB(0, 0), b2, voffB);
            PG8_BAR; PG8_WAIT_L(0); PG8_MMA(0, 1, At, B1); PG8_BAR;
            PG8_LDA(At, 0, 1); PG8_STAGE(PG8_SA(0, 0), a2, voffA);
            PG8_BAR; PG8_WAIT_L(0); PG8_MMA(1, 0, At, B0); PG8_BAR; PG8_SCHED;
            PG8_STAGE(PG8_SB(0, 1), b2 + hstep, voffB);
            PG8_WAIT_V(6); PG8_BAR; PG8_MMA(1, 1, At, B1); PG8_BAR;
            PG8_LDB(B0, 1, 0); PG8_SCHED; PG8_LDA(At, 1, 0); PG8_STAGE(PG8_SA(0, 1), a2 + hstep, voffA);
            PG8_WAIT_L(8); PG8_BAR; PG8_WAIT_L(0); PG8_MMA(0, 0, At, B0); PG8_BAR; PG8_SCHED;
            PG8_LDB(B1, 1, 1); PG8_STAGE(PG8_SB(1, 0), b3, voffB);
            PG8_BAR; PG8_WAIT_L(0); PG8_MMA(0, 1, At, B1); PG8_BAR;
            PG8_LDA(At, 1, 1); PG8_STAGE(PG8_SA(1, 0), a3, voffA);
            PG8_BAR; PG8_WAIT_L(0); PG8_MMA(1, 0, At, B0); PG8_BAR; PG8_SCHED;
            PG8_STAGE(PG8_SB(1, 1), b3 + hstep, voffB);
            PG8_WAIT_V(6); PG8_BAR; PG8_MMA(1, 1, At, B1); PG8_BAR;
            }
        }
        if constexpr (ALIGN_EPI) { if (wr == 0) PG8_BAR; }
        E(acc, cur, wr, wc, fr, fq); S.done(cur);
        if (!has_next) break;
#pragma unroll
        for (int a = 0; a < 2; ++a)
#pragma unroll
            for (int b = 0; b < 2; ++b)
#pragma unroll
                for (int m = 0; m < 4; ++m)
#pragma unroll
                    for (int n = 0; n < 2; ++n) acc[a][b][m][n] = (f32x4){0.f, 0.f, 0.f, 0.f};
        cur = nxt; cA = nA; cB = nB; ++ui;
        if constexpr (ALIGN_EPI) { if (wr == 1) PG8_BAR; }
    }
    PG8_WAIT_V(0);
    if constexpr (!ALIGN_EPI) { if (wr == 0) PG8_BAR; }
    PG8_BAR;
#undef PG8_SA
#undef PG8_SB
#undef PG8_STAGE
#undef PG8_LDA
#undef PG8_LDB
#undef PG8_MMA
#undef PG8_WAIT_V
#undef PG8_WAIT_L
#undef PG8_BAR
#undef PG8_SCHED
}
}

#define GAS __attribute__((address_space(1)))
#define LAS __attribute__((address_space(3)))
typedef unsigned short bf16;
typedef unsigned v4u __attribute__((ext_vector_type(4)));
typedef float f32x4 __attribute__((ext_vector_type(4)));
typedef float f32x16 __attribute__((ext_vector_type(16)));
typedef short bf16x8 __attribute__((ext_vector_type(8)));
typedef short s16x4 __attribute__((ext_vector_type(4)));
typedef short v4i16_t __attribute__((ext_vector_type(4)));
typedef LAS unsigned char LDSB;
typedef GAS unsigned gu32;

constexpr int NWAVES = 8, NTHR = 512;
constexpr int BATCH = 8, SEQ = 4096, DM = 1024, T = BATCH * SEQ;
constexpr int NPROJ = 3072;
constexpr int N_IN = 2848, FF = 4096;
constexpr float EPS = 1e-6f;
constexpr float C2 = 0.125f * 1.4426950408889634f;
constexpr float LOG2E = 1.4426950408889634f;
constexpr float NEGM = -1000.0f;

constexpr size_t MiB = 1u << 20;
constexpr size_t WS_CTL = 0, CTL_ZERO_BYTES = 1 * MiB;
constexpr size_t WS_WIN = 2 * MiB;
constexpr size_t WS_WOUT = 8 * MiB;
constexpr size_t WS_WUP = 10 * MiB;
constexpr size_t WS_WDN = 18 * MiB;
constexpr size_t WS_W1K = 26 * MiB;
constexpr size_t WS_W1V = 27 * MiB;
constexpr size_t WS_W2K = 28 * MiB;
constexpr size_t WS_W2V = 28 * MiB + 65536;
constexpr size_t WS_B1K = 28 * MiB + 131072;
constexpr size_t WS_B1V = 28 * MiB + 131072 + 65536;
constexpr size_t WS_ROPEC = 29 * MiB;
constexpr size_t WS_ROPES = 29 * MiB + 524288;
constexpr size_t WS_FL = 30 * MiB;
constexpr size_t WS_CB = 31 * MiB;
constexpr size_t WS_XN = 32 * MiB;
constexpr size_t WS_U = 96 * MiB;
constexpr size_t WS_QF = 96 * MiB;
constexpr size_t WS_KF = 128 * MiB;
constexpr size_t WS_VF = 160 * MiB;
constexpr size_t WS_QN = 192 * MiB;
constexpr size_t WS_KC = 224 * MiB;
constexpr size_t WS_VC = 233 * MiB;
constexpr size_t WS_KS = 242 * MiB;
constexpr size_t WS_VS = 250 * MiB;
constexpr size_t WS_KW = 258 * MiB;
constexpr size_t WS_VW = 266 * MiB;
constexpr size_t WS_GATE = 274 * MiB;
constexpr size_t WS_KCMP = 277 * MiB;
constexpr size_t WS_VCMP = 277 * MiB + 524288;
constexpr size_t WS_Y = 280 * MiB;
constexpr size_t WS_SSQ1 = 352 * MiB;
constexpr size_t WS_END = 356 * MiB;

constexpr int CW_Q_ATT = 64;
constexpr int CW_BAR = 4096;

constexpr int L_K = 0;
constexpr int L_V = 32768;
constexpr int L_ACC = 65536;
constexpr int L_IMP = 131072;
constexpr int L_WS = 131072 + 17408;
constexpr int L_SEL = L_WS + 8192;
constexpr int L_ORD = L_SEL + 512;
constexpr int L_MISC = L_ORD + 4096;
constexpr int L_TL = L_MISC + 256;
constexpr int LDS_BYTES = L_TL + 256;
constexpr int SLOTB = 8192;

#define RLX_AGENT __ATOMIC_RELAXED, __HIP_MEMORY_SCOPE_AGENT
#define LDS_WAIT() asm volatile("s_waitcnt lgkmcnt(0)" ::: "memory")
#define VM_WAIT() asm volatile("s_waitcnt vmcnt(0)" ::: "memory")
__device__ __forceinline__ unsigned f2bf(float f) { unsigned u = __builtin_bit_cast(unsigned, f); return (u + 0x7fffu + ((u >> 16) & 1u)) >> 16; }
__device__ __forceinline__ unsigned pk2(float lo, float hi) { return f2bf(lo) | (f2bf(hi) << 16); }
__device__ __forceinline__ float bf2f(unsigned short b) { return __builtin_bit_cast(float, (unsigned)b << 16); }

#define XB_TMO      128
#define XB_XCNT(j)  (256  + 64 * (j))
#define XB_XSUB(j)  (1280 + 64 * (j))
#define XB_XGEN(j)  (2304 + 64 * (j))
#define XB_TOP      3328
#define XB_TOPGEN   3392
#define XCD_BAR_WORDS 3456
#define XB_SPIN_CAP (1u << 22)
__device__ __forceinline__ unsigned xb_ld(unsigned* p)              { return __hip_atomic_load(p, __ATOMIC_RELAXED, __HIP_MEMORY_SCOPE_AGENT); }
__device__ __forceinline__ unsigned xb_add(unsigned* p, unsigned v) { return __hip_atomic_fetch_add(p, v, __ATOMIC_RELAXED, __HIP_MEMORY_SCOPE_AGENT); }
__device__ __forceinline__ unsigned xb_xcc_id() { return (unsigned)__builtin_amdgcn_s_getreg((3 << 11) | 20) & 0xFu; }
#define XB_SPIN(cond, bar) do { unsigned _sp = 0; while (cond) { __builtin_amdgcn_s_sleep(1); \
    if ((++_sp & 255u) == 0u) { if (xb_ld(&(bar)[XB_TMO])) break; if (_sp > XB_SPIN_CAP) { atomicAdd(&(bar)[XB_TMO], 1u); break; } } } } while (0)
struct XcdBarrier { unsigned* bar; unsigned x; volatile LAS unsigned* st; int wave; };
__device__ __forceinline__ XcdBarrier xcd_barrier_post(unsigned* bar, volatile LAS unsigned* st) {
    XcdBarrier b; b.bar = bar; b.x = xb_xcc_id(); b.st = st; b.wave = 0;
    if (threadIdx.x == 0) (void)xb_add(&bar[XB_XCNT(b.x)], 1u);
    return b;
}
__device__ __forceinline__ void xcd_barrier_complete(unsigned* bar, unsigned x, unsigned& nloc, unsigned& nx) {
    const unsigned G = gridDim.x * gridDim.y * gridDim.z;
    unsigned sum, cnt, mine, sp = 0u;
    for (;;) {
        sum = 0u; cnt = 0u; mine = 0u;
#pragma unroll
        for (unsigned j = 0; j < 16; ++j) { const unsigned c = xb_ld(&bar[XB_XCNT(j)]); sum += c; cnt += (c > 0u) ? 1u : 0u; mine = (j == x) ? c : mine; }
        if (sum == G) break;
        __builtin_amdgcn_s_sleep(1);
        if ((++sp & 255u) == 0u) { if (xb_ld(&bar[XB_TMO])) break; if (sp > XB_SPIN_CAP) { atomicAdd(&bar[XB_TMO], 1u); break; } }
    }
    nloc = mine > 0u ? mine : 1u; nx = cnt > 0u ? cnt : 1u;
}
__device__ __forceinline__ void xcd_barrier(const XcdBarrier& b) {
    asm volatile("s_waitcnt vmcnt(0)" ::: "memory");
    __syncthreads();
    if (b.wave == 0 && lane_id() == 0) {
        unsigned* bar = b.bar;
        __builtin_amdgcn_s_waitcnt(0);
        unsigned nloc = b.st[0], nx = b.st[1];
        if (nloc == 0u) { xcd_barrier_complete(bar, b.x, nloc, nx); b.st[0] = nloc; b.st[1] = nx; }
        const unsigned old = xb_add(&bar[XB_XSUB(b.x)], 1u);
        const unsigned gen = old / nloc;
        if (old + 1u == (gen + 1u) * nloc) {
            __builtin_amdgcn_fence(__ATOMIC_RELEASE, "agent");
            asm volatile("s_waitcnt vmcnt(0)" ::: "memory");
            const unsigned og = xb_add(&bar[XB_TOP], 1u);
            const unsigned tg = og / nx;
            if (og + 1u == (tg + 1u) * nx) xb_add(&bar[XB_TOPGEN], 1u);
            else XB_SPIN(xb_ld(&bar[XB_TOPGEN]) == tg, bar);
            __builtin_amdgcn_fence(__ATOMIC_ACQUIRE, "agent");
            xb_add(&bar[XB_XGEN(b.x)], 1u);
            asm volatile("s_waitcnt vmcnt(0)" ::: "memory");
        } else {
            XB_SPIN(xb_ld(&bar[XB_XGEN(b.x)]) == gen, bar);
            __builtin_amdgcn_fence(__ATOMIC_ACQUIRE, "agent");
            asm volatile("s_waitcnt vmcnt(0)" ::: "memory");
        }
    }
    __syncthreads();
}

struct Args { const float* in[22]; float* out; unsigned char* ws; int ph_lo, ph_hi; };

struct Frame {
    LDSB* lds;
    volatile LAS unsigned* MISC;
    gu32* ctl;
    int tid, lane, wave, vcu, G;
    unsigned char* ws;
};

__device__ __forceinline__ float wave_sum(float v) {
#pragma unroll
    for (int o = 1; o < 64; o <<= 1) v += __shfl_xor(v, o);
    return v;
}

__device__ __forceinline__ int win_src_col(int n) {
    const int pn = n >> 8, c = n & 255, half = c >> 7, slot = (c >> 5) & 3, d = c & 31;
    if (pn < 8) {
        const int tsr = pn >> 1, j = pn & 1;
        const int tb = (tsr == 0) ? 0 : (tsr == 1) ? 512 : (tsr == 2) ? 1024 : 1544;
        return tb + 64 * (4 * j + slot) + 32 * half + d;
    }
    if (pn < 11) {
        const int base = 2056 + (pn - 8) * 256;
        return base + (slot >> 1) * 128 + (slot & 1) * 64 + 32 * half + d;
    }
    if (c < 8) return 1536 + c;
    if (c < 32) return 2824 + (c - 8);
    return -1;
}

template <bool MAPPED>
__device__ __forceinline__ void p0_transpose_item(const float* W, int K, int N, bf16* WT, LAS float* scr, int item, int lane, const float* kscale, int nblk) {
    const int kb = item / nblk, nb = item % nblk, k0 = 64 * kb, n0 = 32 * nb;
    int src = n0 + (lane & 31);
    if (MAPPED) src = win_src_col(src);
#pragma unroll 8
    for (int i = 0; i < 32; ++i) { const int kk = 2 * i + (lane >> 5);
        float v = 0.f; if (src >= 0) v = W[(size_t)(k0 + kk) * N + src];
        if (kscale) v *= kscale[k0 + kk];
        scr[kk * 33 + (lane & 31)] = v; }
    LDS_WAIT(); asm volatile("" ::: "memory");
    const int c = lane & 7;
#pragma unroll
    for (int j = 0; j < 4; ++j) { const int n = (lane >> 3) + 8 * j; const LAS float* s = scr + (8 * c) * 33 + n;
        v4u o; o.x = pk2(s[0 * 33], s[1 * 33]); o.y = pk2(s[2 * 33], s[3 * 33]); o.z = pk2(s[4 * 33], s[5 * 33]); o.w = pk2(s[6 * 33], s[7 * 33]);
        *(GAS v4u*)(WT + (size_t)(n0 + n) * K + k0 + 8 * c) = o; }
    LDS_WAIT(); asm volatile("" ::: "memory");
}

__device__ __forceinline__ void rms_row_to_bf16(int lane, const float* xrow, bf16* orow) {
    const GAS f32x4* xr = (const GAS f32x4*)xrow + lane;
    f32x4 v[4]; float s = 0.f;
#pragma unroll
    for (int j = 0; j < 4; ++j) { v[j] = xr[64 * j]; s += (v[j].x * v[j].x + v[j].y * v[j].y) + (v[j].z * v[j].z + v[j].w * v[j].w); }
    const float r = 1.f / sqrtf(wave_sum(s) * (1.f / DM) + EPS);
    GAS unsigned long long* o8 = (GAS unsigned long long*)orow + lane;
#pragma unroll
    for (int j = 0; j < 4; ++j) o8[64 * j] = (unsigned long long)pk2(v[j].x * r, v[j].y * r) | ((unsigned long long)pk2(v[j].z * r, v[j].w * r) << 32);
}

typedef __attribute__((address_space(4))) const char* kptr_t;
#define AIN(kp_, i) (*(const float* const __attribute__((address_space(4)))*)((kp_) + 8 * (i)))
__device__ __forceinline__ void p0_prologue(Frame& F, kptr_t kp) {
    const float* x = AIN(kp, 0); const float* g_attn = AIN(kp, 1); const float* w_in = AIN(kp, 2);
    const float* cmpk_pe = AIN(kp, 5); const float* cmpk_w1 = AIN(kp, 6); const float* cmpk_w2 = AIN(kp, 8);
    const float* cmpv_pe = AIN(kp, 10); const float* cmpv_w1 = AIN(kp, 11); const float* cmpv_w2 = AIN(kp, 13);
    const float* g_fox = AIN(kp, 15); const float* g_nsa = AIN(kp, 16); const float* w_out = AIN(kp, 17);
    const float* g_mlp = AIN(kp, 18); const float* w_up = AIN(kp, 19); const float* w_down = AIN(kp, 20);
    LAS float* scr = (LAS float*)(F.lds + F.wave * 16384);
    const int gw = F.vcu * NWAVES + F.wave, NGW = F.G * NWAVES;
    for (int it = gw; it < 128; it += NGW) {
        const int kv = it >> 6, kc = it & 63;
        const float* pe = kv ? cmpv_pe : cmpk_pe; const float* w1 = kv ? cmpv_w1 : cmpk_w1;
        f32x4 a = (f32x4){0.f, 0.f, 0.f, 0.f};
#pragma unroll 8
        for (int k = 32 * kc; k < 32 * kc + 32; ++k) { const f32x4 wv = *((const f32x4*)(w1 + (size_t)k * 256) + F.lane); a = a + wv * pe[k]; }
        *((f32x4*)(F.ws + (kv ? WS_B1V : WS_B1K)) + kc * 64 + F.lane) = a;
    }
    constexpr int I_IN = (DM / 64) * (NPROJ / 32), I_OUT = (DM / 64) * (DM / 32), I_UP = (DM / 64) * (FF / 32), I_DN = (FF / 64) * (DM / 32);
    constexpr int I_W1 = (2048 / 64) * (256 / 32), I_W2 = (256 / 64) * (64 / 32);
    constexpr int NITEMS = I_IN + I_OUT + I_UP + I_DN + 2 * I_W1 + 2 * I_W2;
    for (int it = gw; it < NITEMS; it += NGW) {
        int r = it;
        if (r < I_IN) { p0_transpose_item<true>(w_in, DM, N_IN, (bf16*)(F.ws + WS_WIN), scr, r, F.lane, g_attn, NPROJ / 32); continue; } r -= I_IN;
        if (r < I_OUT) {
            const int kb = r / (DM / 32);
            const float* ks = (kb < 8) ? g_fox : (g_nsa - 512);
            p0_transpose_item<false>(w_out, DM, DM, (bf16*)(F.ws + WS_WOUT), scr, r, F.lane, ks, DM / 32); continue; } r -= I_OUT;
        if (r < I_UP) { p0_transpose_item<false>(w_up, DM, FF, (bf16*)(F.ws + WS_WUP), scr, r, F.lane, g_mlp, FF / 32); continue; } r -= I_UP;
        if (r < I_DN) { p0_transpose_item<false>(w_down, FF, DM, (bf16*)(F.ws + WS_WDN), scr, r, F.lane, nullptr, DM / 32); continue; } r -= I_DN;
        if (r < I_W1) { p0_transpose_item<false>(cmpk_w1, 2048, 256, (bf16*)(F.ws + WS_W1K), scr, r, F.lane, nullptr, 8); continue; } r -= I_W1;
        if (r < I_W1) { p0_transpose_item<false>(cmpv_w1, 2048, 256, (bf16*)(F.ws + WS_W1V), scr, r, F.lane, nullptr, 8); continue; } r -= I_W1;
        if (r < I_W2) { p0_transpose_item<false>(cmpk_w2, 256, 64, (bf16*)(F.ws + WS_W2K), scr, r, F.lane, nullptr, 2); continue; } r -= I_W2;
        p0_transpose_item<false>(cmpv_w2, 256, 64, (bf16*)(F.ws + WS_W2V), scr, r, F.lane, nullptr, 2);
    }
    {
        float* rc = (float*)(F.ws + WS_ROPEC); float* rs = (float*)(F.ws + WS_ROPES);
        for (int i = F.vcu * NTHR + F.tid; i < SEQ * 32; i += F.G * NTHR) {
            const int pos = i >> 5, d = i & 31;
            const float inv = exp2f(-(float)d * (13.287712379549449f / 32.0f));
            const float ang = (float)pos * inv;
            const double a = (double)ang;
            const double k = __builtin_rint(a * 0.15915494309189535);
            const float red = (float)(a - k * 6.283185307179586);
            rc[i] = cosf(red); rs[i] = sinf(red);
        }
    }
    for (int m = gw; m < T; m += NGW) rms_row_to_bf16(F.lane, x + (size_t)m * DM, (bf16*)(F.ws + WS_XN) + (size_t)m * DM);
}

typedef pg8::f32x4 pf4;
__device__ __forceinline__ float log_sigmoidf(float v) { return v >= 0.f ? -log1pf(expf(-v)) : v - log1pf(expf(v)); }

struct EpiProj {
    static constexpr bool PERM = true;
    unsigned char* ws; const float* b_f; const float* b_gate;
    __device__ __forceinline__ void operator()(const pf4 (&acc)[2][2][4][2], const pg8::Unit& u, int wr, int wc, int fr, int fq) const {
        const int pn = u.pn; const int rbase = u.pm * 256 + wr * 64 + fr;
        if (pn == 11) {
            if (wc != 0) return;
            float* FL = (float*)(ws + WS_FL); float* GT = (float*)(ws + WS_GATE);
#pragma unroll
            for (int ai = 0; ai < 2; ++ai)
#pragma unroll
                for (int m = 0; m < 4; ++m) { const int row = rbase + ai * 128 + m * 16; const int b = row >> 12, s = row & 4095;
#pragma unroll
                    for (int n = 0; n < 2; ++n) { const pf4 v = acc[ai][0][m][n];
                        if (fq == 0) {
#pragma unroll
                            for (int i = 0; i < 4; ++i) { const int h = 4 * n + i; FL[(size_t)(b * 8 + h) * SEQ + s] = log_sigmoidf(v[i] + b_f[h]); }
                        } else { const int j0 = 8 * fq - 8 + 4 * n; pf4 o;
#pragma unroll
                            for (int i = 0; i < 4; ++i) { const float z = v[i] + b_gate[j0 + i]; o[i] = 1.f / (1.f + expf(-z)); }
                            *(pf4*)(GT + (size_t)row * 24 + j0) = o; } } }
            return;
        }
        const bool rope = (pn == 6) || (pn == 7) || ((pn == 9 || pn == 10) && wc < 2);
        const float sc = (pn < 2 || pn == 6 || pn == 7) ? C2 : 1.f;
        const float* RC = (const float*)(ws + WS_ROPEC); const float* RS = (const float*)(ws + WS_ROPES);
        size_t tb;
        if (pn < 8) { const int tsr = pn >> 1; tb = (tsr == 0) ? WS_QF : (tsr == 1) ? WS_KF : (tsr == 2) ? WS_VF : WS_QN; }
        else { const int vt = wc >> 1; tb = (pn == 8) ? (vt ? WS_VC : WS_KC) : (pn == 9) ? (vt ? WS_VS : WS_KS) : (vt ? WS_VW : WS_KW); }
        bf16* TB = (bf16*)(ws + tb);
#pragma unroll
        for (int ai = 0; ai < 2; ++ai)
#pragma unroll
            for (int m = 0; m < 4; ++m) { const int row = rbase + ai * 128 + m * 16;
                pf4 a0 = acc[ai][0][m][0], a1 = acc[ai][0][m][1], b0 = acc[ai][1][m][0], b1 = acc[ai][1][m][1];
                if (rope) { const int pos = row & 4095;
                    const pf4 c0 = *(const pf4*)(RC + pos * 32 + 8 * fq), c1 = *(const pf4*)(RC + pos * 32 + 8 * fq + 4);
                    const pf4 s0 = *(const pf4*)(RS + pos * 32 + 8 * fq), s1 = *(const pf4*)(RS + pos * 32 + 8 * fq + 4);
                    const pf4 x0 = a0 * c0 - b0 * s0, x1 = a1 * c1 - b1 * s1, y0 = a0 * s0 + b0 * c0, y1 = a1 * s1 + b1 * c1;
                    a0 = x0; a1 = x1; b0 = y0; b1 = y1; }
                a0 = a0 * sc; a1 = a1 * sc; b0 = b0 * sc; b1 = b1 * sc;
                v4u w0, w1; w0.x = pk2(a0[0], a0[1]); w0.y = pk2(a0[2], a0[3]); w0.z = pk2(a1[0], a1[1]); w0.w = pk2(a1[2], a1[3]);
                w1.x = pk2(b0[0], b0[1]); w1.y = pk2(b0[2], b0[3]); w1.z = pk2(b1[0], b1[1]); w1.w = pk2(b1[2], b1[3]);
                bf16* p;
                if (pn < 8) p = TB + (size_t)row * 512 + 64 * (4 * (pn & 1) + wc) + 8 * fq;
                else { const int b = row >> 12, s = row & 4095, g = wc & 1; p = TB + ((size_t)(b * 2 + g) * SEQ + s) * 64 + 8 * fq; }
                *(v4u*)p = w0; *(v4u*)(p + 32) = w1; }
    }
};

struct EpiOutRes {
    static constexpr bool PERM = true;
    const float* x; float* out; bf16* xn; float* ssq; LDSB* lds;
    __device__ __forceinline__ void operator()(const pf4 (&acc)[2][2][4][2], const pg8::Unit& u, int wr, int wc, int fr, int fq) const {
        const int col0 = u.pn * 256 + wc * 32 + 8 * fq;
        LAS float* P = (LAS float*)(lds + L_IMP);
#pragma unroll
        for (int ai = 0; ai < 2; ++ai)
#pragma unroll
            for (int m = 0; m < 4; ++m) { const int rl = ai * 128 + wr * 64 + m * 16 + fr; const size_t off = (size_t)(u.pm * 256 + rl) * DM + col0; float sq = 0.f;
#pragma unroll
                for (int bj = 0; bj < 2; ++bj) {
                    const pf4 h0 = *(const pf4*)(x + off + bj * 128) + acc[ai][bj][m][0], h1 = *(const pf4*)(x + off + bj * 128 + 4) + acc[ai][bj][m][1];
                    *(pf4*)(out + off + bj * 128) = h0; *(pf4*)(out + off + bj * 128 + 4) = h1;
                    sq += ((h0[0] * h0[0] + h0[1] * h0[1]) + (h0[2] * h0[2] + h0[3] * h0[3])) + ((h1[0] * h1[0] + h1[1] * h1[1]) + (h1[2] * h1[2] + h1[3] * h1[3]));
                    v4u w; w.x = pk2(h0[0], h0[1]); w.y = pk2(h0[2], h0[3]); w.z = pk2(h1[0], h1[1]); w.w = pk2(h1[2], h1[3]);
                    *(v4u*)(xn + off + bj * 128) = w; }
                sq += __shfl_xor(sq, 16); sq += __shfl_xor(sq, 32);
                if (fq == 0) P[rl * 4 + wc] = sq; }
        asm volatile("s_waitcnt lgkmcnt(0)\n\ts_barrier" ::: "memory");
        const int t = (wr * 4 + wc) * 64 + (fq * 16 + fr);
        if (t < 256) { const f32x4 p = *(const LAS f32x4*)(P + t * 4); ssq[(size_t)(u.pm * 256 + t) * 4 + u.pn] = (p[0] + p[1]) + (p[2] + p[3]); }
    }
};

struct EpiUp {
    static constexpr bool PERM = true;
    bf16* O; const float* ssq;
    __device__ __forceinline__ void operator()(const pf4 (&acc)[2][2][4][2], const pg8::Unit& u, int wr, int wc, int fr, int fq) const {
        const int row0 = u.pm * 256 + wr * 64 + fr, col0 = u.pn * 256 + wc * 32 + 8 * fq;
#pragma unroll
        for (int ai = 0; ai < 2; ++ai)
#pragma unroll
            for (int m = 0; m < 4; ++m) { const int row = row0 + ai * 128 + m * 16; bf16* rowp = O + (size_t)row * FF + col0;
                const pf4 s0 = *(const pf4*)(ssq + (size_t)row * 4);
                const float tot = (s0[0] + s0[1]) + (s0[2] + s0[3]);
                const float r2 = 1.f / (tot * (1.f / DM) + EPS);
#pragma unroll
                for (int bj = 0; bj < 2; ++bj) { pf4 v0 = acc[ai][bj][m][0], v1 = acc[ai][bj][m][1];
#pragma unroll
                    for (int i = 0; i < 4; ++i) { const float a = fmaxf(v0[i], 0.f), b = fmaxf(v1[i], 0.f); v0[i] = a * a * r2; v1[i] = b * b * r2; }
                    v4u w; w.x = pk2(v0[0], v0[1]); w.y = pk2(v0[2], v0[3]); w.z = pk2(v1[0], v1[1]); w.w = pk2(v1[2], v1[3]);
                    *(v4u*)(rowp + bj * 128) = w; } }
    }
};

struct EpiDownRes {
    static constexpr bool PERM = true;
    float* out;
    __device__ __forceinline__ void operator()(const pf4 (&acc)[2][2][4][2], const pg8::Unit& u, int wr, int wc, int fr, int fq) const {
        const int col0 = u.pn * 256 + wc * 32 + 8 * fq;
#pragma unroll
        for (int ai = 0; ai < 2; ++ai)
#pragma unroll
            for (int m = 0; m < 4; ++m) { const size_t off = (size_t)(u.pm * 256 + ai * 128 + wr * 64 + m * 16 + fr) * DM + col0;
#pragma unroll
                for (int bj = 0; bj < 2; ++bj) { float* p = out + off + bj * 128; const pf4 b0 = *(const pf4*)p, b1 = *(const pf4*)(p + 4); *(pf4*)p = b0 + acc[ai][bj][m][0]; *(pf4*)(p + 4) = b1 + acc[ai][bj][m][1]; } }
    }
};

__device__ __forceinline__ void p2_cumsum_item(Frame& F, int item) {
    const float* fl = (const float*)(F.ws + WS_FL) + (size_t)item * SEQ; float* cb = (float*)(F.ws + WS_CB) + (size_t)item * SEQ;
    const int lane = F.lane;
    float v[64]; float run = 0.f;
#pragma unroll
    for (int i = 0; i < 16; ++i) { const f32x4 t = *(const f32x4*)(fl + lane * 64 + 4 * i); v[4 * i] = t[0]; v[4 * i + 1] = t[1]; v[4 * i + 2] = t[2]; v[4 * i + 3] = t[3]; }
#pragma unroll
    for (int i = 0; i < 64; ++i) { run += v[i]; v[i] = run; }
    float incl = run;
#pragma unroll
    for (int o = 1; o < 64; o <<= 1) { const float t = __shfl_up(incl, o); if (lane >= o) incl += t; }
    const float base = incl - run;
#pragma unroll
    for (int i = 0; i < 16; ++i) { f32x4 t; t[0] = -(v[4 * i] + base) * LOG2E; t[1] = -(v[4 * i + 1] + base) * LOG2E; t[2] = -(v[4 * i + 2] + base) * LOG2E; t[3] = -(v[4 * i + 3] + base) * LOG2E;
        *(f32x4*)(cb + lane * 64 + 4 * i) = t; }
}

__device__ __forceinline__ float gelu_tanh(float x) {
    const float u = 0.7978845608028654f * (x + 0.044715f * x * x * x);
    const float e = __expf(2.f * u);
    const float th = 1.f - 2.f / (e + 1.f);
    return 0.5f * x * (1.f + th);
}

__device__ __forceinline__ void p2_compress_item(Frame& F, kptr_t kp, int item) {
    typedef float f4 __attribute__((ext_vector_type(4)));
    const int kv = item >> 6, bg = (item >> 2) & 15, cblk = item & 3, c0 = 64 * cblk;
    const int lane = F.lane, w = F.wave, fr = lane & 15, fq = lane >> 4;
    const bf16* Ab = (const bf16*)(F.ws + (kv ? WS_VC : WS_KC)) + (size_t)bg * SEQ * 64 + (size_t)c0 * 1024;
    const bf16* W1 = (const bf16*)(F.ws + (kv ? WS_W1V : WS_W1K));
    const bf16* W2 = (const bf16*)(F.ws + (kv ? WS_W2V : WS_W2K));
    const float* B1 = (const float*)(F.ws + (kv ? WS_B1V : WS_B1K));
    const float* b1 = AIN(kp, kv ? 12 : 7);
    const float* b2 = AIN(kp, kv ? 14 : 9);
    LDSB* lds = F.lds;
    LAS bf16* Hs = (LAS bf16*)(lds + 92160);
    f4 acc[4][2];
#pragma unroll
    for (int m = 0; m < 4; ++m) { acc[m][0] = (f4){0.f, 0.f, 0.f, 0.f}; acc[m][1] = (f4){0.f, 0.f, 0.f, 0.f}; }
    const int tid = F.tid, lrow = tid >> 3, lch = tid & 7;
    const bf16* ag = Ab + (size_t)lrow * 1024 + lch * 8;
    const bf16* bg_ = W1 + (size_t)lrow * 2048 + lch * 8;
    const int sto = (lrow * 72 + lch * 8) * 2;
    v4u ra = *(const v4u*)ag, rb[4];
#pragma unroll
    for (int i = 0; i < 4; ++i) rb[i] = *(const v4u*)(bg_ + (size_t)i * 64 * 2048);
    *(LAS v4u*)(lds + sto) = ra;
#pragma unroll
    for (int i = 0; i < 4; ++i) *(LAS v4u*)(lds + 18432 + sto + i * 64 * 144) = rb[i];
    __syncthreads();
    for (int ks = 0; ks < 32; ++ks) {
        const int cb = ks & 1;
        if (ks + 1 < 32) { ra = *(const v4u*)(ag + (ks + 1) * 64);
#pragma unroll
            for (int i = 0; i < 4; ++i) rb[i] = *(const v4u*)(bg_ + (size_t)i * 64 * 2048 + (ks + 1) * 64); }
        const LDSB* As = lds + cb * 9216; const LDSB* Bs = lds + 18432 + cb * 36864;
#pragma unroll
        for (int kh = 0; kh < 2; ++kh) {
            bf16x8 a[4], b[2];
#pragma unroll
            for (int m = 0; m < 4; ++m) a[m] = *(const LAS bf16x8*)(As + ((16 * m + fr) * 72 + 32 * kh + 8 * fq) * 2);
#pragma unroll
            for (int n = 0; n < 2; ++n) b[n] = *(const LAS bf16x8*)(Bs + ((32 * w + 16 * n + fr) * 72 + 32 * kh + 8 * fq) * 2);
#pragma unroll
            for (int m = 0; m < 4; ++m)
#pragma unroll
                for (int n = 0; n < 2; ++n) acc[m][n] = __builtin_amdgcn_mfma_f32_16x16x32_bf16(a[m], b[n], acc[m][n], 0, 0, 0);
        }
        if (ks + 1 < 32) {
            *(LAS v4u*)(lds + (cb ^ 1) * 9216 + sto) = ra;
#pragma unroll
            for (int i = 0; i < 4; ++i) *(LAS v4u*)(lds + 18432 + (cb ^ 1) * 36864 + sto + i * 64 * 144) = rb[i];
        }
        __syncthreads();
    }
    float bbv[2];
#pragma unroll
    for (int n = 0; n < 2; ++n) { const int col = 32 * w + 16 * n + fr; float bb = b1[col];
#pragma unroll 8
        for (int kc = 0; kc < 64; ++kc) bb += B1[kc * 256 + col];
        bbv[n] = bb; }
#pragma unroll
    for (int m = 0; m < 4; ++m)
#pragma unroll
        for (int n = 0; n < 2; ++n) { const int col = 32 * w + 16 * n + fr;
#pragma unroll
            for (int r = 0; r < 4; ++r) Hs[(16 * m + 4 * fq + r) * 264 + col] = (bf16)f2bf(gelu_tanh(acc[m][n][r] + bbv[n])); }
    __syncthreads();
    const int mt = w >> 1, ntA = (w & 1), ntB = (w & 1) + 2;
    f4 oa = (f4){0.f, 0.f, 0.f, 0.f}, ob = (f4){0.f, 0.f, 0.f, 0.f};
#pragma unroll
    for (int k0 = 0; k0 < 256; k0 += 32) {
        const bf16x8 a = *(const LAS bf16x8*)(Hs + (16 * mt + fr) * 264 + k0 + 8 * fq);
        const bf16x8 bA = *(const bf16x8*)(W2 + (size_t)(16 * ntA + fr) * 256 + k0 + 8 * fq);
        const bf16x8 bB = *(const bf16x8*)(W2 + (size_t)(16 * ntB + fr) * 256 + k0 + 8 * fq);
        oa = __builtin_amdgcn_mfma_f32_16x16x32_bf16(a, bA, oa, 0, 0, 0);
        ob = __builtin_amdgcn_mfma_f32_16x16x32_bf16(a, bB, ob, 0, 0, 0);
    }
    const int d1 = 16 * (w & 1) + fr;
    const float bb1 = b2[d1], bb2 = b2[d1 + 32];
    const float* RC = (const float*)(F.ws + WS_ROPEC); const float* RS = (const float*)(F.ws + WS_ROPES);
    bf16* O = (bf16*)(F.ws + (kv ? WS_VCMP : WS_KCMP)) + (size_t)bg * 256 * 64;
#pragma unroll
    for (int r = 0; r < 4; ++r) { const int c = c0 + 16 * mt + 4 * fq + r;
        float x1 = oa[r] + bb1, x2 = ob[r] + bb2;
        if (kv == 0) { int pos = 16 * c + 31; pos = pos > 4095 ? 4095 : pos; const float cs = RC[pos * 32 + d1], sn = RS[pos * 32 + d1];
            const float y1 = x1 * cs - x2 * sn, y2 = x1 * sn + x2 * cs; x1 = y1; x2 = y2; }
        O[(size_t)c * 64 + d1] = (bf16)f2bf(x1); O[(size_t)c * 64 + d1 + 32] = (bf16)f2bf(x2); }
    __syncthreads();
}

__device__ __forceinline__ int crow(int r, int hi) { return (r & 3) + 8 * (r >> 2) + 4 * hi; }
__device__ __forceinline__ void glds16(const void* gsrc, unsigned lds_dst) { unsigned keep;
    asm volatile("s_mov_b32 %0, m0\n\ts_mov_b32 m0, %2\n\ts_nop 0\n\tglobal_load_lds_dwordx4 %1, off\n\ts_mov_b32 m0, %0" : "=&s"(keep) : "v"(gsrc), "s"(lds_dst) : "memory"); }
#define WAIT_BAR(N) asm volatile("s_waitcnt vmcnt(" #N ") lgkmcnt(0)\n\ts_barrier" ::: "memory")
__device__ __forceinline__ unsigned cvtpk_s(float lo, float hi) { typedef float f2 __attribute__((ext_vector_type(2))); typedef __bf16 b2 __attribute__((ext_vector_type(2)));
    f2 v = {lo, hi}; b2 b = __builtin_convertvector(v, b2); return __builtin_bit_cast(unsigned, b); }
__device__ __forceinline__ s16x4 vtr(const LDSB* p) { return __builtin_bit_cast(s16x4, __builtin_amdgcn_ds_read_tr16_b64_v4i16((LAS v4i16_t*)p)); }

__device__ __forceinline__ float xh_max(float a) { auto r = __builtin_amdgcn_permlane32_swap(__float_as_uint(a), __float_as_uint(a), false, false); return fmaxf(__uint_as_float(r[0]), __uint_as_float(r[1])); }
__device__ __forceinline__ float xh_sum(float a) { auto r = __builtin_amdgcn_permlane32_swap(__float_as_uint(a), __float_as_uint(a), false, false); return __uint_as_float(r[0]) + __uint_as_float(r[1]); }
__device__ __forceinline__ float xh_other(float a, int hi) { auto r = __builtin_amdgcn_permlane32_swap(__float_as_uint(a), __float_as_uint(a), false, false); return hi ? __uint_as_float(r[0]) : __uint_as_float(r[1]); }
__device__ __forceinline__ void qkt(f32x16& p0, f32x16& p1, const LDSB* kslot, const bf16x8 (&qr)[4], const f32x16& cinit, int r32, int hi) {
    const LDSB* kb = kslot + hi * 1024 + r32 * 16;
#pragma unroll
    for (int d0 = 0; d0 < 4; ++d0) {
        const bf16x8 b0 = *(const LAS bf16x8*)(kb + d0 * 2048);
        const bf16x8 b1 = *(const LAS bf16x8*)(kb + d0 * 2048 + 512);
        if (d0 == 0) { p0 = __builtin_amdgcn_mfma_f32_32x32x16_bf16(b0, qr[0], cinit, 0, 0, 0); p1 = __builtin_amdgcn_mfma_f32_32x32x16_bf16(b1, qr[0], cinit, 0, 0, 0); }
        else { p0 = __builtin_amdgcn_mfma_f32_32x32x16_bf16(b0, qr[d0], p0, 0, 0, 0); p1 = __builtin_amdgcn_mfma_f32_32x32x16_bf16(b1, qr[d0], p1, 0, 0, 0); }
    }
}
__device__ __forceinline__ void pv(f32x16 (&o)[2], const LDSB* vp, const f32x16& p0, const f32x16& p1) {
    v4u pw[4];
    pw[0] = (v4u){cvtpk_s(p0[0], p0[1]), cvtpk_s(p0[2], p0[3]), cvtpk_s(p0[4], p0[5]), cvtpk_s(p0[6], p0[7])};
    pw[1] = (v4u){cvtpk_s(p0[8], p0[9]), cvtpk_s(p0[10], p0[11]), cvtpk_s(p0[12], p0[13]), cvtpk_s(p0[14], p0[15])};
    pw[2] = (v4u){cvtpk_s(p1[0], p1[1]), cvtpk_s(p1[2], p1[3]), cvtpk_s(p1[4], p1[5]), cvtpk_s(p1[6], p1[7])};
    pw[3] = (v4u){cvtpk_s(p1[8], p1[9]), cvtpk_s(p1[10], p1[11]), cvtpk_s(p1[12], p1[13]), cvtpk_s(p1[14], p1[15])};
#pragma unroll
    for (int d0 = 0; d0 < 2; ++d0)
#pragma unroll
        for (int ks = 0; ks < 4; ++ks) {
            const s16x4 lo = vtr(vp + d0 * 4096 + ks * 1024), hi = vtr(vp + d0 * 4096 + ks * 1024 + 512);
            const bf16x8 vf = (bf16x8){lo[0], lo[1], lo[2], lo[3], hi[0], hi[1], hi[2], hi[3]};
            o[d0] = __builtin_amdgcn_mfma_f32_32x32x16_bf16(__builtin_bit_cast(bf16x8, pw[ks]), vf, o[d0], 0, 0, 0);
        }
}
__device__ __forceinline__ float rowmax32(const f32x16& p0, const f32x16& p1) {
    float a = fmaxf(p0[0], p1[0]);
#pragma unroll
    for (int r = 1; r < 16; ++r) a = fmaxf(a, fmaxf(p0[r], p1[r]));
    return xh_max(a);
}
__device__ __forceinline__ float rowsum32(const f32x16& p0, const f32x16& p1) {
    float a = 0.f, b = 0.f;
#pragma unroll
    for (int r = 0; r < 16; ++r) { a += p0[r]; b += p1[r]; }
    return a + b;
}

template <int PITCH>
__device__ __forceinline__ void dma_kv(const bf16* Kh, const bf16* Vh, int key0, unsigned kdst, unsigned vdst, int wid, int lane) {
    const bf16* ksrc = Kh + (size_t)(key0 + lane) * PITCH + wid * 8;
    const bf16* vsrc = Vh + (size_t)(key0 + 16 * (wid & 3) + (lane >> 2)) * PITCH + (wid >> 2) * 32 + (lane & 3) * 8;
    glds16(ksrc, (unsigned)__builtin_amdgcn_readfirstlane(kdst + wid * 1024));
    glds16(vsrc, (unsigned)__builtin_amdgcn_readfirstlane(vdst + wid * 1024));
}


#define SBAR() __builtin_amdgcn_sched_barrier(0)
__device__ __forceinline__ void kload8(bf16x8* kf, const LDSB* kp) {
    kf[0] = *(const LAS bf16x8*)(kp);        kf[1] = *(const LAS bf16x8*)(kp + 512);
    kf[2] = *(const LAS bf16x8*)(kp + 2048); kf[3] = *(const LAS bf16x8*)(kp + 2560);
    kf[4] = *(const LAS bf16x8*)(kp + 4096); kf[5] = *(const LAS bf16x8*)(kp + 4608);
    kf[6] = *(const LAS bf16x8*)(kp + 6144); kf[7] = *(const LAS bf16x8*)(kp + 6656);
}
__device__ __forceinline__ void kload2(bf16x8* kf, const LDSB* kp, int j) { kf[2 * j] = *(const LAS bf16x8*)(kp + j * 2048); kf[2 * j + 1] = *(const LAS bf16x8*)(kp + j * 2048 + 512); }

template <int MODE>
__device__ __forceinline__ void att_mod(f32x16& C0, f32x16& C1, int j, int qabs, int qw0, int cur, unsigned sel_lo, unsigned sel_hi, const LAS float* kbias, int hi) {
    if (MODE == 0) {
        const LAS float* kb = kbias + 64 * j + 4 * hi;
#pragma unroll
        for (int g4 = 0; g4 < 4; ++g4) { const f32x4 b0 = *(const LAS f32x4*)(kb + 8 * g4), b1 = *(const LAS f32x4*)(kb + 32 + 8 * g4);
#pragma unroll
            for (int i = 0; i < 4; ++i) { C0[4 * g4 + i] += b0[i]; C1[4 * g4 + i] += b1[i]; } }
        if (64 * j + 63 > qw0) {
#pragma unroll
            for (int r = 0; r < 16; ++r) { const int kv = 64 * j + crow(r, hi); if (kv > qabs) C0[r] = NEGM; if (kv + 32 > qabs) C1[r] = NEGM; }
        }
    } else if (MODE == 1) {
        const bool sel = ((j < 32 ? (sel_lo >> j) : (sel_hi >> (j - 32))) & 1u) != 0u;
        if (j == cur) {
#pragma unroll
            for (int r = 0; r < 16; ++r) { const int kv = 64 * j + crow(r, hi); if (kv > qabs || !sel) C0[r] = NEGM; if (kv + 32 > qabs || !sel) C1[r] = NEGM; }
        } else {
#pragma unroll
            for (int r = 0; r < 16; ++r) { if (!sel) { C0[r] = NEGM; C1[r] = NEGM; } }
        }
    } else {
        if (j == cur || j + 8 <= cur) {
#pragma unroll
            for (int r = 0; r < 16; ++r) { const int kv = 64 * j + crow(r, hi);
                if (kv > qabs || kv < qabs - 511) C0[r] = NEGM; if (kv + 32 > qabs || kv + 32 < qabs - 511) C1[r] = NEGM; }
        }
    }
}

template <int MODE, int PITCH, int THRL>
__device__ __forceinline__ void attn_fast(LDSB* lds, const bf16* Kh, const bf16* Vh, const LAS unsigned char* tl, int NT, const bf16x8 (&qr)[4], int qabs, int qw0, int cur,
                                          unsigned sel_lo, unsigned sel_hi, const LAS float* kbias, f32x16 (&o)[2], float& l_out, int wid, int lane) {
    const int r32 = lane & 31, hi = lane >> 5;
    const unsigned lds0 = (unsigned)(uintptr_t)lds;
    LAS float* wsf = (LAS float*)(lds + L_WS) + wid * 256;
    const bf16* ksrc = Kh + (size_t)lane * PITCH + wid * 8;
    const bf16* vsrc = Vh + (size_t)(16 * (wid & 3) + (lane >> 2)) * PITCH + (wid >> 2) * 32 + (lane & 3) * 8;
    const unsigned kdst = lds0 + L_K + wid * 1024, vdst = lds0 + L_V + wid * 1024;
#define TILE(t) __builtin_amdgcn_readfirstlane((int)tl[t])
#define DMA_K(t, slot) glds16(ksrc + (size_t)TILE(t) * (64 * PITCH), (unsigned)__builtin_amdgcn_readfirstlane(kdst + (slot)))
#define DMA_V(t, slot) glds16(vsrc + (size_t)TILE(t) * (64 * PITCH), (unsigned)__builtin_amdgcn_readfirstlane(vdst + (slot)))
    const LDSB* kp0 = lds + L_K + hi * 1024 + r32 * 16;
    const LDSB* vp0 = lds + L_V + ((lane >> 4) & 1) * 32 + (lane & 3) * 8 + (4 * hi + ((lane & 15) >> 2)) * 64;
    bf16x8 kf[8];
    float mhat = 0.f, l_reg = 0.f;
    f32x16 negm;
#pragma unroll
    for (int r = 0; r < 16; ++r) { negm[r] = 0.f; o[0][r] = 0.f; o[1][r] = 0.f; }
    asm volatile("" : "+v"(negm));
    bool resc = false;
    f32x16 pA0, pA1, pB0, pB1;
    int sl_prev = 0, sl_cur = 0, sl_next = SLOTB, sl_last = 0;
#define ROT() do { sl_prev = sl_cur; sl_cur = sl_next; sl_next = (sl_next == 2 * SLOTB) ? 0 : sl_next + SLOTB; } while (0)
#define RESC() do { if (resc) { LDS_WAIT(); \
        _Pragma("unroll") for (int d_ = 0; d_ < 2; ++d_) _Pragma("unroll") for (int r = 0; r < 16; ++r) o[d_][r] *= wsf[crow(r, hi)]; } } while (0)
#define ENDW(tt) do { if ((tt) + 3 < NT) { WAIT_BAR(2); } else if ((tt) + 2 < NT) { WAIT_BAR(1); } else { WAIT_BAR(0); } } while (0)
    DMA_K(0, 0); DMA_V(0, 0); if (NT > 1) DMA_K(1, SLOTB); if (NT > 2) DMA_K(2, 2 * SLOTB);
    if (NT > 2) { WAIT_BAR(3); } else if (NT > 1) { WAIT_BAR(2); } else { WAIT_BAR(1); }
    {
        const int j0 = TILE(0);
        qkt(pA0, pA1, lds + L_K, qr, negm, r32, hi);
        att_mod<MODE>(pA0, pA1, j0, qabs, qw0, cur, sel_lo, sel_hi, kbias, hi);
        const float rm = rowmax32(pA0, pA1);
        mhat += rm;
#pragma unroll
        for (int r = 0; r < 16; ++r) { pA0[r] -= rm; pA1[r] -= rm; negm[r] = -mhat; }
        asm volatile("" : "+v"(negm));
#pragma unroll
        for (int r = 0; r < 16; ++r) { pA0[r] = __builtin_amdgcn_exp2f(pA0[r]); pA1[r] = __builtin_amdgcn_exp2f(pA1[r]); }
    }
    WAIT_BAR(0);
    if (NT > 3) DMA_K(3, 0);
    if (NT > 1) DMA_V(1, SLOTB);
    ROT();
    if (NT > 1) kload8(kf, kp0 + sl_cur);
    ENDW(0);
    s16x4 vlo[8], vhi[8]; v4u pw0, pw1, pw2, pw3;
#define PKW(P, B) cvtpk_s(P[B], P[B + 1])
#define PAF(k) __builtin_bit_cast(bf16x8, pw##k)
#define VFR(i) (bf16x8){vlo[i][0], vlo[i][1], vlo[i][2], vlo[i][3], vhi[i][0], vhi[i][1], vhi[i][2], vhi[i][3]}
#define PIN(x) asm volatile("" : "+v"(x))
#define MX3(a, b, c) __builtin_fmaxf(__builtin_fmaxf((a), (b)), (c))
#define GAPA(MF, A0, A1, A2, A3, W0, W1, PW) do { MF; sacc += A0; sacc += A1; sacc += A2; sacc += A3; PIN(sacc); W0; W1; PIN(PW); SBAR(); } while (0)
#define EX(v) __builtin_amdgcn_exp2f(v)
#define GAPB(MF, X, B) do { MF; X[B] = EX(X[B]); X[B + 1] = EX(X[B + 1]); X[B + 2] = EX(X[B + 2]); X[B + 3] = EX(X[B + 3]); PIN(X); SBAR(); } while (0)
#define VRD(i) do { vlo[i] = vtr(vp_ + (((i) >> 2) * 4096 + ((i) & 3) * 1024)); vhi[i] = vtr(vp_ + (((i) >> 2) * 4096 + ((i) & 3) * 1024 + 512)); } while (0)
#define KRD(G, j) do { if (G) { kload2(kf, kp0 + sl_next, j); SBAR(); } } while (0)
#define MFMA32 __builtin_amdgcn_mfma_f32_32x32x16_bf16
#define STEP(C0, C1, P0, P1, t) do { const int jt_ = TILE(t); const bool GK_ = (t) + 3 < NT, GV_ = (t) + 1 < NT; sl_last = sl_cur; SBAR(); \
    const LDSB* vp_ = vp0 + sl_prev; \
    VRD(0); SBAR(); float sacc = (P0[0] + P0[1]); \
    GAPA(C0 = MFMA32(kf[0], qr[0], negm, 0, 0, 0), P0[2], P0[3], P0[4], P0[5],     pw0[0] = PKW(P0, 0), pw0[1] = PKW(P0, 2), pw0); \
    VRD(4); SBAR(); GAPA(C1 = MFMA32(kf[1], qr[0], negm, 0, 0, 0), P0[6], P0[7], P0[8], P0[9],     pw0[2] = PKW(P0, 4), pw0[3] = PKW(P0, 6), pw0); \
    VRD(1); SBAR(); GAPA(C0 = MFMA32(kf[2], qr[1], C0, 0, 0, 0),   P0[10], P0[11], P0[12], P0[13], pw1[0] = PKW(P0, 8), pw1[1] = PKW(P0, 10), pw1); \
    VRD(5); SBAR(); GAPA(C1 = MFMA32(kf[3], qr[1], C1, 0, 0, 0),   P0[14], P0[15], P1[0], P1[1],   pw1[2] = PKW(P0, 12), pw1[3] = PKW(P0, 14), pw1); \
    VRD(2); SBAR(); GAPA(C0 = MFMA32(kf[4], qr[2], C0, 0, 0, 0),   P1[2], P1[3], P1[4], P1[5],     pw2[0] = PKW(P1, 0), pw2[1] = PKW(P1, 2), pw2); \
    VRD(6); SBAR(); GAPA(C1 = MFMA32(kf[5], qr[2], C1, 0, 0, 0),   P1[6], P1[7], P1[8], P1[9],     pw2[2] = PKW(P1, 4), pw2[3] = PKW(P1, 6), pw2); \
    VRD(3); SBAR(); GAPA(C0 = MFMA32(kf[6], qr[3], C0, 0, 0, 0),   P1[10], P1[11], P1[12], P1[13], pw3[0] = PKW(P1, 8), pw3[1] = PKW(P1, 10), pw3); \
    VRD(7); SBAR(); GAPA(C1 = MFMA32(kf[7], qr[3], C1, 0, 0, 0),   P1[14], P1[15], 0.f, 0.f,       pw3[2] = PKW(P1, 12), pw3[3] = PKW(P1, 14), pw3); \
    l_reg += sacc; \
    if (GK_) { DMA_K((t) + 3, sl_cur); } if (GV_) { DMA_V((t) + 1, sl_next); } \
    att_mod<MODE>(C0, C1, jt_, qabs, qw0, cur, sel_lo, sel_hi, kbias, hi); \
    { float a = MX3(C0[0], C0[1], C1[0]), b = MX3(C0[2], C0[3], C1[1]); a = MX3(a, C1[2], C1[3]); \
      _Pragma("unroll") for (int r = 4; r < 16; r += 4) { a = MX3(a, C0[r], C0[r + 1]); b = MX3(b, C0[r + 2], C0[r + 3]); a = MX3(a, C1[r], C1[r + 1]); b = MX3(b, C1[r + 2], C1[r + 3]); } \
      float rm = xh_max(__builtin_fmaxf(a, b)); \
      resc = false; \
      if (__builtin_expect(__any(rm > (float)THRL), 0)) { const float dl = __builtin_fmaxf(rm, 0.f); mhat += dl; \
        _Pragma("unroll") for (int r = 0; r < 16; ++r) { C0[r] -= dl; C1[r] -= dl; } \
        _Pragma("unroll") for (int r = 0; r < 16; ++r) negm[r] = -mhat; asm volatile("" : "+v"(negm)); \
        const float f = __builtin_amdgcn_exp2f(-dl); l_reg *= f; if (hi == 0) wsf[r32] = f; resc = true; } } \
    SBAR(); \
    GAPB(o[0] = MFMA32(PAF(0), VFR(0), o[0], 0, 0, 0), C0, 0); \
    GAPB(o[1] = MFMA32(PAF(0), VFR(4), o[1], 0, 0, 0), C0, 4); \
    KRD(GV_, 0); GAPB(o[0] = MFMA32(PAF(1), VFR(1), o[0], 0, 0, 0), C0, 8); \
    KRD(GV_, 1); GAPB(o[1] = MFMA32(PAF(1), VFR(5), o[1], 0, 0, 0), C0, 12); \
    KRD(GV_, 2); GAPB(o[0] = MFMA32(PAF(2), VFR(2), o[0], 0, 0, 0), C1, 0); \
    KRD(GV_, 3); GAPB(o[1] = MFMA32(PAF(2), VFR(6), o[1], 0, 0, 0), C1, 4); \
    GAPB(o[0] = MFMA32(PAF(3), VFR(3), o[0], 0, 0, 0), C1, 8); \
    GAPB(o[1] = MFMA32(PAF(3), VFR(7), o[1], 0, 0, 0), C1, 12); \
    } while (0)
    int t = 1;
    for (; t + 1 < NT; t += 2) {
        STEP(pB0, pB1, pA0, pA1, t);     ENDW(t);     RESC(); ROT();
        STEP(pA0, pA1, pB0, pB1, t + 1); ENDW(t + 1); RESC(); ROT();
    }
    const LDSB* vlane_p = lds + L_V + ((lane >> 4) & 1) * 32 + (lane & 3) * 8 + (4 * hi + ((lane & 15) >> 2)) * 64;
    if (t < NT) {
        STEP(pB0, pB1, pA0, pA1, t); ENDW(t); RESC();
        l_reg += rowsum32(pB0, pB1);
        pv(o, vlane_p + sl_last, pB0, pB1);
    } else {
        l_reg += rowsum32(pA0, pA1);
        pv(o, vlane_p + sl_last, pA0, pA1);
    }
    l_out = xh_sum(l_reg);
    asm volatile("s_waitcnt lgkmcnt(0)\n\ts_barrier" ::: "memory");
#undef TILE
#undef DMA_K
#undef DMA_V
#undef ROT
#undef RESC
#undef ENDW
#undef PKW
#undef PAF
#undef VFR
#undef PIN
#undef MX3
#undef GAPA
#undef EX
#undef GAPB
#undef VRD
#undef KRD
#undef MFMA32
#undef STEP
}

__device__ __forceinline__ void load_rowvec(float (&fac)[16], const LAS float* tab, int hi) {
#pragma unroll
    for (int g4 = 0; g4 < 4; ++g4) { const f32x4 ff = *(const LAS f32x4*)(tab + 8 * g4 + 4 * hi);
#pragma unroll
        for (int i = 0; i < 4; ++i) fac[4 * g4 + i] = ff[i]; }
}

template <int PITCHO>
__device__ __forceinline__ void store_o_tile(LDSB* stage, const f32x16 (&o)[2], bf16* Ow, int lane) {
    const int r32 = lane & 31, hi = lane >> 5;
    LAS bf16* stg = (LAS bf16*)stage;
#pragma unroll
    for (int r = 0; r < 16; ++r) { const int orow = crow(r, hi);
#pragma unroll
        for (int d0 = 0; d0 < 2; ++d0) stg[orow * 64 + d0 * 32 + r32] = (bf16)f2bf(o[d0][r]); }
    LDS_WAIT();
#pragma unroll
    for (int i = 0; i < 4; ++i) { const int row = i * 8 + (lane >> 3), ch = lane & 7; const v4u v = *(const LAS v4u*)(stg + row * 64 + ch * 8); *(v4u*)(Ow + (size_t)row * PITCHO + ch * 8) = v; }
    LDS_WAIT();
}

__device__ __forceinline__ void fox_unit(Frame& F0, int b, int h, int qb) {
    struct { unsigned char* ws; LDSB* lds; int tid, wave; } F; F.ws = F0.ws; F.lds = F0.lds; F.tid = F0.tid; F.wave = F0.wave;
    asm volatile("" : "+s"(F.ws));
    LDSB* lds = F.lds; int tid_ = F.tid; asm volatile("" : "+v"(tid_));
    const int tid = tid_, lane = tid & 63, wid = F.wave, r32 = lane & 31, hi = lane >> 5;
    const int q0 = 256 * qb, NT = 4 * qb + 4;
    const float* cb = (const float*)(F.ws + WS_CB) + (size_t)(b * 8 + h) * SEQ;
    LAS float* kb = (LAS float*)(lds + L_ACC);
    for (int i = tid; i < q0 + 256; i += NTHR) kb[i] = cb[i];
    LAS unsigned char* tl = (LAS unsigned char*)(lds + L_TL);
    if (tid < NT) tl[tid] = (unsigned char)(NT - 1 - tid);
    const bf16* Qw = (const bf16*)(F.ws + WS_QF) + ((size_t)b * SEQ + q0 + 32 * wid) * 512 + h * 64;
    bf16x8 qr[4];
#pragma unroll
    for (int d0 = 0; d0 < 4; ++d0) qr[d0] = *(const bf16x8*)(Qw + (size_t)r32 * 512 + d0 * 16 + hi * 8);
    __syncthreads();
    const bf16* Kh = (const bf16*)(F.ws + WS_KF) + (size_t)b * SEQ * 512 + h * 64;
    const bf16* Vh = (const bf16*)(F.ws + WS_VF) + (size_t)b * SEQ * 512 + h * 64;
    f32x16 o[2]; float l;
    attn_fast<0, 512, 8>(lds, Kh, Vh, tl, NT, qr, q0 + 32 * wid + r32, q0 + 32 * wid, 0, 0u, 0u, kb, o, l, wid, lane);
    LAS float* wsf = (LAS float*)(lds + L_WS) + wid * 256;
    if (hi == 0) wsf[32 + r32] = 1.f / l;
    LDS_WAIT();
    float fac[16]; load_rowvec(fac, wsf + 32, hi);
#pragma unroll
    for (int r = 0; r < 16; ++r) { o[0][r] *= fac[r]; o[1][r] *= fac[r]; }
    bf16* Ow = (bf16*)(F.ws + WS_Y) + ((size_t)b * SEQ + q0 + 32 * wid) * 1024 + h * 64;
    store_o_tile<1024>(lds + L_ACC + 16384 + wid * 4096, o, Ow, lane);
    __syncthreads();
}

__device__ __forceinline__ void nsa_unit(Frame& F0, int b, int g, int cur) {
    struct { unsigned char* ws; LDSB* lds; int tid, wave; } F; F.ws = F0.ws; F.lds = F0.lds; F.tid = F0.tid; F.wave = F0.wave;
    asm volatile("" : "+s"(F.ws));
    LDSB* lds = F.lds; int tid_ = F.tid; asm volatile("" : "+v"(tid_));
    const int tid = tid_, lane = tid & 63, wid = F.wave, r32 = lane & 31, hi = lane >> 5;
    const int bg = b * 2 + g, hh = wid >> 1, head = 4 * g + hh, qh = wid & 1, qq = 32 * qh + r32, qpos = 64 * cur + qq;
    const unsigned lds0 = (unsigned)(uintptr_t)lds;
    LAS float* wsf = (LAS float*)(lds + L_WS) + wid * 256;
    LAS float* accw = (LAS float*)(lds + L_ACC) + wid * 2048;
    const size_t row0 = (size_t)b * SEQ + 64 * cur + 32 * qh;
    const bf16* Qw = (const bf16*)(F.ws + WS_QN) + row0 * 512 + head * 64;
    bf16x8 qr[4];
#pragma unroll
    for (int d0 = 0; d0 < 4; ++d0) qr[d0] = *(const bf16x8*)(Qw + (size_t)r32 * 512 + d0 * 16 + hi * 8);
    if (tid < 2) ((LAS unsigned*)(lds + L_TL + 128))[tid] = 0u;
    if (lane < 32) { const float* gp = (const float*)(F.ws + WS_GATE) + (row0 + lane) * 24 + head * 3;
        wsf[64 + lane] = gp[0]; wsf[96 + lane] = gp[1]; wsf[128 + lane] = gp[2]; }
    LDS_WAIT();
    {
        const bf16* Kc = (const bf16*)(F.ws + WS_KCMP) + (size_t)bg * 256 * 64;
        const bf16* Vc = (const bf16*)(F.ws + WS_VCMP) + (size_t)bg * 256 * 64;
        const int ntl = (4 * cur + 66) >> 6;
#pragma unroll
        for (int tl = 0; tl < 4; ++tl) if (tl < ntl) dma_kv<64>(Kc, Vc, 64 * tl, lds0 + L_K + tl * SLOTB, lds0 + L_V + tl * SLOTB, wid, lane);
        WAIT_BAR(0);
        f32x16 zero;
#pragma unroll
        for (int r = 0; r < 16; ++r) zero[r] = 0.f;
        float mrun = -1e30f;
#pragma unroll 1
        for (int tl = 0; tl < ntl; ++tl) {
            f32x16 p0, p1;
            qkt(p0, p1, lds + L_K + tl * SLOTB, qr, zero, r32, hi);
#pragma unroll
            for (int r = 0; r < 16; ++r) { const int c = 64 * tl + crow(r, hi); if (16 * c + 31 > qpos) p0[r] = NEGM; if (16 * (c + 32) + 31 > qpos) p1[r] = NEGM; }
            mrun = fmaxf(mrun, rowmax32(p0, p1));
            asm volatile("" ::: "memory");
        }
        f32x16 o[2];
#pragma unroll
        for (int r = 0; r < 16; ++r) { o[0][r] = 0.f; o[1][r] = 0.f; }
        float impv[4][8]; float prevY3 = 0.f, lsum = 0.f;
        const int vlane = ((lane >> 4) & 1) * 32 + (lane & 3) * 8 + (4 * hi + ((lane & 15) >> 2)) * 64;
#pragma unroll
        for (int tl = 0; tl < 4; ++tl) {
            if (tl < ntl) {
                f32x16 p0, p1;
                qkt(p0, p1, lds + L_K + tl * SLOTB, qr, zero, r32, hi);
#pragma unroll
                for (int r = 0; r < 16; ++r) { const int c = 64 * tl + crow(r, hi);
                    p0[r] = (16 * c + 31 > qpos) ? 0.f : __builtin_amdgcn_exp2f(p0[r] - mrun);
                    p1[r] = (16 * (c + 32) + 31 > qpos) ? 0.f : __builtin_amdgcn_exp2f(p1[r] - mrun); }
                lsum += rowsum32(p0, p1);
                float rX[4], rY[4];
#pragma unroll
                for (int g4 = 0; g4 < 4; ++g4) { rX[g4] = xh_other(p0[4 * g4 + 3], hi); rY[g4] = xh_other(p1[4 * g4 + 3], hi); }
#pragma unroll
                for (int g4 = 0; g4 < 4; ++g4) {
                    const float qs0 = (p0[4 * g4] + p0[4 * g4 + 1]) + (p0[4 * g4 + 2] + p0[4 * g4 + 3]);
                    const float qs1 = (p1[4 * g4] + p1[4 * g4 + 1]) + (p1[4 * g4 + 2] + p1[4 * g4 + 3]);
                    const float lo0 = (g4 > 0) ? rX[g4 > 0 ? g4 - 1 : 0] : prevY3;
                    const float lo1 = (g4 > 0) ? rY[g4 > 0 ? g4 - 1 : 0] : rX[3];
                    impv[tl][g4] = qs0 + (hi ? rX[g4] : lo0);
                    impv[tl][4 + g4] = qs1 + (hi ? rY[g4] : lo1);
                }
                prevY3 = rY[3];
                pv(o, lds + L_V + tl * SLOTB + vlane, p0, p1);
                asm volatile("" ::: "memory");
            } else {
#pragma unroll
                for (int e = 0; e < 8; ++e) impv[tl][e] = 0.f;
            }
        }
        const float ltot = xh_sum(lsum);
        const float invl = ltot > 0.f ? 1.f / ltot : 0.f;
        LAS float* imp = (LAS float*)(lds + L_IMP);
#pragma unroll
        for (int hd = 0; hd < 4; ++hd) {
            if (hh == hd) {
#pragma unroll
                for (int tl = 0; tl < 4; ++tl)
#pragma unroll
                    for (int e = 0; e < 8; ++e) { const int jj = 16 * tl + 8 * (e >> 2) + 2 * (e & 3) + hi; LAS float* p = imp + qq * 65 + jj;
                        if (hd == 0) *p = impv[tl][e] * invl; else *p += impv[tl][e] * invl; }
            }
            LDS_WAIT(); __syncthreads();
        }
        if (hi == 0) wsf[32 + r32] = invl;
        LDS_WAIT();
        float gc[16], il[16]; load_rowvec(gc, wsf + 64, hi); load_rowvec(il, wsf + 32, hi);
#pragma unroll
        for (int d0 = 0; d0 < 2; ++d0)
#pragma unroll
            for (int r = 0; r < 16; ++r) accw[(d0 * 16 + r) * 64 + lane] = o[d0][r] * (gc[r] * il[r]);
        LDS_WAIT();
    }
    if (cur >= 16) {
        LAS float* imp = (LAS float*)(lds + L_IMP);
        const int q = tid >> 3, part = tid & 7;
        if (part == 0) { imp[q * 65] += 1e4f; imp[q * 65 + cur] += 1e4f; imp[q * 65 + cur - 1] += 1e4f; }
        LDS_WAIT(); __syncthreads();
        const LAS float* irow = imp + q * 65;
        float sc[8];
#pragma unroll
        for (int i = 0; i < 8; ++i) { const int jj = part * 8 + i; sc[i] = (jj <= cur) ? irow[jj] : -1.f; }
        int rank[8];
#pragma unroll
        for (int i = 0; i < 8; ++i) rank[i] = 0;
        const int nv = cur + 1, e0 = (8 * part < nv) ? 8 * part : nv, e1 = (8 * part + 8 < nv) ? 8 * part + 8 : nv;
        for (int jp = 0; jp < e0; ++jp) { const float v = irow[jp];
#pragma unroll
            for (int i = 0; i < 8; ++i) rank[i] += (v >= sc[i]) ? 1 : 0; }
        for (int jp = e0; jp < e1; ++jp) { const float v = irow[jp];
#pragma unroll
            for (int i = 0; i < 8; ++i) { const int jj = part * 8 + i; rank[i] += (v > sc[i] || (v == sc[i] && jp < jj)) ? 1 : 0; } }
        for (int jp = e1; jp < nv; ++jp) { const float v = irow[jp];
#pragma unroll
            for (int i = 0; i < 8; ++i) rank[i] += (v > sc[i]) ? 1 : 0; }
        unsigned bits = 0;
#pragma unroll
        for (int i = 0; i < 8; ++i) bits |= (rank[i] < 16 ? 1u : 0u) << i;
        ((LAS unsigned char*)(lds + L_SEL))[q * 8 + part] = (unsigned char)bits;
        __hip_atomic_fetch_or((LAS unsigned*)(lds + L_TL + 128) + (part >> 2), bits << (8 * (part & 3)), __ATOMIC_RELAXED, __HIP_MEMORY_SCOPE_WORKGROUP);
        LDS_WAIT(); __syncthreads();
    } else {
        if (tid < 128) ((LAS unsigned*)(lds + L_SEL))[tid] = (tid & 1) ? 0u : ((1u << (cur + 1)) - 1u);
        if (tid == 0) ((LAS unsigned*)(lds + L_TL + 128))[0] = (1u << (cur + 1)) - 1u;
        LDS_WAIT(); __syncthreads();
    }
    const LAS unsigned* selw = (const LAS unsigned*)(lds + L_SEL);
    const unsigned sel_lo = selw[qq * 2], sel_hi = selw[qq * 2 + 1];
    const unsigned ulo = ((const LAS unsigned*)(lds + L_TL + 128))[0], uhi = ((const LAS unsigned*)(lds + L_TL + 128))[1];
    unsigned long long umask = ((unsigned long long)uhi << 32) | ulo;
    umask &= (cur >= 63) ? ~0ull : ((1ull << (cur + 1)) - 1ull);
    const int jlo = cur >= 8 ? cur - 8 : 0;
    LAS unsigned char* tls = (LAS unsigned char*)(lds + L_TL);
    LAS unsigned char* tlw = tls + 64;
    if (tid < 64) {
        if ((umask >> tid) & 1ull) tls[__builtin_popcountll(umask & ((1ull << tid) - 1ull))] = (unsigned char)tid;
        if (tid <= cur - jlo) tlw[tid] = (unsigned char)(jlo + tid);
    }
    LDS_WAIT(); __syncthreads();
    const int NTs = __builtin_amdgcn_readfirstlane(__builtin_popcountll(umask)), NTw = cur - jlo + 1;
    {
        const bf16* Kh = (const bf16*)(F.ws + WS_KS) + (size_t)bg * SEQ * 64;
        const bf16* Vh = (const bf16*)(F.ws + WS_VS) + (size_t)bg * SEQ * 64;
        f32x16 o[2]; float l;
        attn_fast<1, 64, 8>(lds, Kh, Vh, tls, NTs, qr, qpos, 0, cur, sel_lo, sel_hi, nullptr, o, l, wid, lane);
        if (hi == 0) wsf[32 + r32] = 1.f / l;
        LDS_WAIT();
        float fl[16], gs[16]; load_rowvec(fl, wsf + 32, hi); load_rowvec(gs, wsf + 96, hi);
#pragma unroll
        for (int d0 = 0; d0 < 2; ++d0)
#pragma unroll
            for (int r = 0; r < 16; ++r) accw[(d0 * 16 + r) * 64 + lane] += o[d0][r] * (fl[r] * gs[r]);
        LDS_WAIT();
    }
    {
        const bf16* Kh = (const bf16*)(F.ws + WS_KW) + (size_t)bg * SEQ * 64;
        const bf16* Vh = (const bf16*)(F.ws + WS_VW) + (size_t)bg * SEQ * 64;
        f32x16 o[2]; float l;
        attn_fast<2, 64, 8>(lds, Kh, Vh, tlw, NTw, qr, qpos, 0, cur, 0u, 0u, nullptr, o, l, wid, lane);
        if (hi == 0) wsf[32 + r32] = 1.f / l;
        LDS_WAIT();
        float fl[16], gate_win[16]; load_rowvec(fl, wsf + 32, hi); load_rowvec(gate_win, wsf + 128, hi);
#pragma unroll
        for (int d0 = 0; d0 < 2; ++d0)
#pragma unroll
            for (int r = 0; r < 16; ++r) o[d0][r] = accw[(d0 * 16 + r) * 64 + lane] + o[d0][r] * (fl[r] * gate_win[r]);
        LDS_WAIT();
        bf16* Ow = (bf16*)(F.ws + WS_Y) + row0 * 1024 + 512 + head * 64;
        store_o_tile<1024>((LDSB*)accw, o, Ow, lane);
    }
    __syncthreads();
}

__device__ __forceinline__ int att_unit_cost(int id) { return id < 1024 ? (63 - (id >> 4)) + 30 : 4 * (15 - ((id - 1024) >> 6)) + 4; }
__device__ __forceinline__ void p3_attention(Frame& F) {
    LAS unsigned short* order = (LAS unsigned short*)(F.lds + L_ORD);
    for (int id = F.tid; id < 2048; id += NTHR) {
        const int c = att_unit_cost(id); int pos = 0;
        { int lo = c - 30 + 1; if (lo < 0) lo = 0; int cnt = 64 - lo; if (cnt < 0) cnt = 0; pos += 16 * cnt; }
        { int cnt = 0; for (int qb = 0; qb < 16; ++qb) cnt += (4 * qb + 4 > c) ? 1 : 0; pos += 64 * cnt; }
        if (id < 1024) pos += (id & 15);
        else { const int cn = c - 30; if (cn >= 0 && cn <= 63) pos += 16; pos += (id & 63); }
        order[pos] = (unsigned short)id;
    }
    LDS_WAIT(); __syncthreads();
    gu32* qhead = F.ctl + CW_Q_ATT;
    for (;;) {
        if (F.tid == 0) F.MISC[0] = __hip_atomic_fetch_add(qhead, 1u, RLX_AGENT);
        LDS_WAIT(); __syncthreads();
        const unsigned k = F.MISC[0];
        if (k >= 2048u) break;
        const int id = order[k];
        __syncthreads();
#ifndef NO_NSA
        if (id < 1024) nsa_unit(F, (id & 15) >> 1, id & 1, 63 - (id >> 4));
#endif
#ifndef NO_FOX
        if (id >= 1024) fox_unit(F, (id & 63) >> 3, id & 7, 15 - ((id - 1024) >> 6));
#endif
    }
}

__device__ __forceinline__ void p4_ynorm(Frame& F) {
    const int gw = F.vcu * NWAVES + F.wave, NGW = F.G * NWAVES;
    for (int m = gw; m < T; m += NGW) {
        bf16* row = (bf16*)(F.ws + WS_Y) + (size_t)m * 1024 + F.lane * 16;
        v4u a = *(const v4u*)row, b = *(const v4u*)(row + 8);
        float v[16];
        const unsigned w[8] = {a.x, a.y, a.z, a.w, b.x, b.y, b.z, b.w};
#pragma unroll
        for (int i = 0; i < 8; ++i) { v[2 * i] = __builtin_bit_cast(float, w[i] << 16); v[2 * i + 1] = __builtin_bit_cast(float, w[i] & 0xffff0000u); }
        float s = 0.f;
#pragma unroll
        for (int i = 0; i < 16; ++i) s += v[i] * v[i];
#pragma unroll
        for (int o = 1; o < 32; o <<= 1) s += __shfl_xor(s, o);
        const float r = 1.f / sqrtf(s * (1.f / 512.f) + EPS);
        v4u oa, ob;
        oa.x = pk2(v[0] * r, v[1] * r); oa.y = pk2(v[2] * r, v[3] * r); oa.z = pk2(v[4] * r, v[5] * r); oa.w = pk2(v[6] * r, v[7] * r);
        ob.x = pk2(v[8] * r, v[9] * r); ob.y = pk2(v[10] * r, v[11] * r); ob.z = pk2(v[12] * r, v[13] * r); ob.w = pk2(v[14] * r, v[15] * r);
        *(v4u*)row = oa; *(v4u*)(row + 8) = ob;
    }
}
__device__ __forceinline__ void p6_hnorm(Frame& F, const float* h1) {
    const int gw = F.vcu * NWAVES + F.wave, NGW = F.G * NWAVES;
    for (int m = gw; m < T; m += NGW) rms_row_to_bf16(F.lane, h1 + (size_t)m * DM, (bf16*)(F.ws + WS_XN) + (size_t)m * DM);
}
__device__ __forceinline__ void p9_final(Frame& F, float* out, const float* g_final) {
    const int gw = F.vcu * NWAVES + F.wave, NGW = F.G * NWAVES;
    for (int m = gw; m < T; m += NGW) {
        GAS f32x4* xr = (GAS f32x4*)(out + (size_t)m * DM) + F.lane;
        f32x4 v[4]; float s = 0.f;
#pragma unroll
        for (int j = 0; j < 4; ++j) { v[j] = xr[64 * j]; s += (v[j].x * v[j].x + v[j].y * v[j].y) + (v[j].z * v[j].z + v[j].w * v[j].w); }
        const float r = 1.f / sqrtf(wave_sum(s) * (1.f / DM) + EPS);
#pragma unroll
        for (int j = 0; j < 4; ++j) { const f32x4 gg = *((const f32x4*)g_final + F.lane + 64 * j); xr[64 * j] = v[j] * r * gg; }
    }
}

constexpr int N_PHASES = 10;
__global__ void __launch_bounds__(NTHR, 2) hymba_fwd(Args args) {
    extern __shared__ __attribute__((aligned(16))) unsigned char lds_raw[];
    Frame F;
    F.lds = (LDSB*)lds_raw;
    F.MISC = (volatile LAS unsigned*)(F.lds + L_MISC);
    F.tid = threadIdx.x; F.lane = F.tid & 63; F.wave = __builtin_amdgcn_readfirstlane(F.tid >> 6);
    F.G = gridDim.x; { const int bx = blockIdx.x; F.vcu = (F.G % 8 == 0) ? (bx % 8) * (F.G / 8) + bx / 8 : bx; }
    kptr_t kp0 = (kptr_t)__builtin_amdgcn_kernarg_segment_ptr();
#define KP() ({ kptr_t k_ = kp0; asm volatile("" : "+s"(k_)); k_; })
    { kptr_t kp = KP(); F.ws = *(unsigned char* const __attribute__((address_space(4)))*)(kp + 8 * 23); }
    F.ctl = (gu32*)(F.ws + WS_CTL);
    if (F.tid < 64) F.MISC[F.tid] = 0u;
    __syncthreads();
    int lo, hi; { kptr_t kp = KP(); lo = *(const int __attribute__((address_space(4)))*)(kp + 192); hi = *(const int __attribute__((address_space(4)))*)(kp + 196); }
    const bool one_launch = (hi - lo) > 1;
    XcdBarrier bar; bar.bar = (unsigned*)(F.ctl + CW_BAR); bar.x = 0; bar.st = nullptr; bar.wave = F.wave;
    if (one_launch) { bar = xcd_barrier_post((unsigned*)(F.ctl + CW_BAR), F.MISC + 8); bar.wave = F.wave; }
#ifdef PHASE_MASK
#define IN(k) (((PHASE_MASK >> (k)) & 1) && lo <= (k) && (k) < hi)
#else
#define IN(k) (lo <= (k) && (k) < hi)
#endif
#define SEAM(k) do { if (IN(k) && IN((k) + 1)) xcd_barrier(bar); } while (0)
#define RELANE() do { int l_ = lane_id(); asm volatile("" : "+v"(l_)); F.lane = l_; F.tid = F.wave * 64 + l_; } while (0)

    if (IN(0)) { RELANE(); p0_prologue(F, KP()); SEAM(0); }

    if (IN(1)) { RELANE();
        pg8::Gemm g{(const bf16*)(F.ws + WS_XN), (const bf16*)(F.ws + WS_WIN), T, NPROJ, DM}; pg8::StaticOrder S; S.init(T, NPROJ, F.G, (int)blockIdx.x);
        kptr_t kp = KP(); EpiProj E{F.ws, AIN(kp, 3), AIN(kp, 4)};
        pg8::gemm_phase<EpiProj, pg8::StaticOrder, true, true>(F.lds, g, S, E, F.wave);
        SEAM(1);
    }

    if (IN(2)) { RELANE();
        const int gw = F.vcu * NWAVES + F.wave;
        if (gw < 64) p2_cumsum_item(F, gw);
        { kptr_t kp = KP(); for (int it = (int)blockIdx.x; it < 128; it += F.G) p2_compress_item(F, kp, it); }
        SEAM(2);
    }

    if (IN(3)) { RELANE(); p3_attention(F); SEAM(3); }

    if (IN(4)) { RELANE(); p4_ynorm(F); SEAM(4); }

    if (IN(5)) { RELANE();
        pg8::Gemm g{(const bf16*)(F.ws + WS_Y), (const bf16*)(F.ws + WS_WOUT), T, DM, DM}; pg8::StaticOrder S; S.init(T, DM, F.G, (int)blockIdx.x);
        kptr_t kp = KP(); EpiOutRes E{AIN(kp, 0), *(float* const __attribute__((address_space(4)))*)(kp + 8 * 22), (bf16*)(F.ws + WS_XN), (float*)(F.ws + WS_SSQ1), F.lds};
        pg8::gemm_phase<EpiOutRes, pg8::StaticOrder, true, true>(F.lds, g, S, E, F.wave);
        if (IN(5) && IN(7)) xcd_barrier(bar);
    }


    if (IN(7)) { RELANE();
        pg8::Gemm g{(const bf16*)(F.ws + WS_XN), (const bf16*)(F.ws + WS_WUP), T, FF, DM}; pg8::StaticOrder S; S.init(T, FF, F.G, (int)blockIdx.x);
        EpiUp E{(bf16*)(F.ws + WS_U), (const float*)(F.ws + WS_SSQ1)};
        pg8::gemm_phase<EpiUp, pg8::StaticOrder, true, true>(F.lds, g, S, E, F.wave);
        SEAM(7);
    }

    if (IN(8)) { RELANE();
        pg8::Gemm g{(const bf16*)(F.ws + WS_U), (const bf16*)(F.ws + WS_WDN), T, DM, FF}; pg8::StaticOrder S; S.init(T, DM, F.G, (int)blockIdx.x);
        kptr_t kp = KP(); EpiDownRes E{*(float* const __attribute__((address_space(4)))*)(kp + 8 * 22)};
        pg8::gemm_phase<EpiDownRes, pg8::StaticOrder, true, true>(F.lds, g, S, E, F.wave);
        SEAM(8);
    }

    if (IN(9)) { RELANE(); { kptr_t kp = KP(); p9_final(F, *(float* const __attribute__((address_space(4)))*)(kp + 8 * 22), AIN(kp, 21)); } }
#undef IN
#undef SEAM
}

extern "C" void kernel_launch(void* const* d_in, const int* in_sizes, int n_in, void* d_out, int out_size, void* d_ws, size_t ws_size, hipStream_t stream) {
    static int grid = 0;
    if (grid == 0) {
        if (n_in != 22 || out_size != T * DM || ws_size < WS_END) { fprintf(stderr, "kernel_launch: unexpected shapes (n_in %d out %d ws %zu)\n", n_in, out_size, ws_size); grid = -1; return; }
        int dev = 0, cus = 0, per_cu = 0;
        if (hipGetDevice(&dev) != hipSuccess || hipDeviceGetAttribute(&cus, hipDeviceAttributeMultiprocessorCount, dev) != hipSuccess) { grid = -1; return; }
        if (hipFuncSetAttribute((const void*)hymba_fwd, hipFuncAttributeMaxDynamicSharedMemorySize, LDS_BYTES) != hipSuccess) { fprintf(stderr, "kernel_launch: hipFuncSetAttribute failed\n"); grid = -1; return; }
        if (hipOccupancyMaxActiveBlocksPerMultiprocessor(&per_cu, (const void*)hymba_fwd, NTHR, LDS_BYTES) != hipSuccess || per_cu < 1) { fprintf(stderr, "kernel_launch: occupancy query says %d\n", per_cu); per_cu = 1; }
        (void)hipGetLastError();
        grid = cus;
    }
    if (grid < 0) return;
    (void)hipMemsetAsync((char*)d_ws + WS_CTL, 0, CTL_ZERO_BYTES, stream);
    Args a{};
    for (int i = 0; i < 22; ++i) a.in[i] = (const float*)d_in[i];
    a.out = (float*)d_out; a.ws = (unsigned char*)d_ws;
#if MK_N_LAUNCHES == 1
    a.ph_lo = 0; a.ph_hi = N_PHASES;
    void* kargs[] = {&a};
    hipError_t e = hipLaunchCooperativeKernel((const void*)hymba_fwd, dim3(grid), dim3(NTHR), kargs, LDS_BYTES, stream);
    if (e != hipSuccess) fprintf(stderr, "kernel_launch: cooperative launch failed: %s (grid %d)\n", hipGetErrorString(e), grid);
#else
    for (int p = 0; p < N_PHASES; ++p) { a.ph_lo = p; a.ph_hi = p + 1; hipLaunchKernelGGL(hymba_fwd, dim3(grid), dim3(NTHR), LDS_BYTES, stream, a); }
#endif
}
```

```cpp
#include <hip/hip_runtime.h>
#include <hip/hip_bf16.h>
#include <cstdio>
#include <cstdint>

#ifndef MK_N_LAUNCHES
#define MK_N_LAUNCHES 1
#endif

__device__ __forceinline__ int lane_id() { return (int)__builtin_amdgcn_mbcnt_hi(~0u, __builtin_amdgcn_mbcnt_lo(~0u, 0u)); }
namespace pg8 {
#define PG8_LAS __attribute__((address_space(3)))
typedef unsigned short bf16_t;
typedef short bf16x8 __attribute__((ext_vector_type(8)));
typedef float f32x4 __attribute__((ext_vector_type(4)));
typedef unsigned u32x4 __attribute__((ext_vector_type(4)));
constexpr int BM = 256, BK = 64, HALF = 128, HTB = HALF * BK * 2, STAGE_BYTES = 8 * HTB, NXCD = 8, WGM = 8;

__host__ __device__ __forceinline__ int lds_byte(int r, int c) { const int st = (r >> 4) * 2 + (c >> 5), rr = r & 15, cc = c & 31, ob = rr * 64 + cc * 2; return st * 1024 + (ob ^ (((ob >> 9) & 1) << 5)); }
__host__ __device__ __forceinline__ void stage_rc(int b, int& R, int& C) { const int st = b / 1024, sb = b % 1024, swz = sb ^ (((sb >> 9) & 1) << 5); R = (st >> 1) * 16 + swz / 64; C = (st & 1) * 32 + (swz % 64) / 2; }
__host__ __device__ __forceinline__ int perm32(int rho) { const int n = rho >> 4, i = rho & 15; return 8 * (i >> 2) + 4 * n + (i & 3); }

struct Unit { int pm, pn; };
struct Gemm { const bf16_t* A; const bf16_t* Bt; int M, N, K; };

struct StaticOrder {
    int nM, nN, nwg, G, c;
    __host__ __device__ void init(int M, int N, int G_, int c_) { nM = M / BM; nN = N / BM; nwg = nM * nN; G = G_; c = c_; }
    __host__ __device__ bool next(int i, Unit& u) const {
        const long L = (long)i * G + c; if (L >= nwg) return false;
        int wgid = (int)L; { const int q = nwg / NXCD, r = nwg % NXCD, xcd = wgid % NXCD, off = wgid / NXCD; wgid = (xcd < r ? xcd * (q + 1) : r * (q + 1) + (xcd - r) * q) + off; }
        const int nig = WGM * nN, gid = wgid / nig, fm = gid * WGM, gsz = (nM - fm) < WGM ? (nM - fm) : WGM;
        u.pm = fm + ((wgid % nig) % gsz); u.pn = (wgid % nig) / gsz; return true;
    }
    __device__ __forceinline__ void a_ready(const Unit&) const {}
    __device__ __forceinline__ void done(const Unit&) const {}
};

__device__ __forceinline__ unsigned cvt_pk_bf16(float lo, float hi) { unsigned r; asm volatile("v_cvt_pk_bf16_f32 %0, %1, %2" : "=v"(r) : "v"(lo), "v"(hi)); return r; }

template <class Epi, class Sched, bool ALIGN_EPI = false, bool SP2 = false>
__device__ __forceinline__ void gemm_phase(PG8_LAS unsigned char* lds, const Gemm g, const Sched& S, const Epi& E, int wave_id) {
    const int wid = wave_id, lane = lane_id(), tid = wid * 64 + lane, wr = wid >> 2, wc = wid & 3, fr = lane & 15, fq = lane >> 4;
    const int K = g.K, nt = K / BK;
    unsigned voffA[2], voffB[2];
#pragma unroll
    for (int i = 0; i < 2; ++i) { int R, C; stage_rc(tid * 16 + i * 8192, R, C); const int Rb = Epi::PERM ? ((R & ~31) + perm32(R & 31)) : R;
        voffA[i] = (unsigned)(R * K + C) * 2u; voffB[i] = (unsigned)(Rb * K + C) * 2u; }
    const size_t kstep = (size_t)(BK * 2);
    const size_t hstep = (size_t)HALF * K * 2;
    const size_t tstep = 2 * hstep;
    const unsigned ldsw = (unsigned)wid * 1024u;
    const int aoff = lds_byte(wr * 64 + fr, fq * 8), boff = lds_byte(wc * 32 + fr, fq * 8);
#define PG8_SA(b, h) (((b) * 2 + (h)) * HTB)
#define PG8_SB(b, h) ((4 + (b) * 2 + (h)) * HTB)
#define PG8_STAGE(bufoff, gbase, voff) do { _Pragma("unroll") for (int _i = 0; _i < 2; ++_i) \
        __builtin_amdgcn_global_load_lds((const unsigned*)((const char*)(gbase) + (voff)[_i]), (PG8_LAS unsigned*)(lds + (bufoff) + ldsw + _i * 8192), 16, 0, 0); } while (0)
#define PG8_LDA(dst, b, h) do { _Pragma("unroll") for (int m = 0; m < 4; ++m) _Pragma("unroll") for (int k = 0; k < 2; ++k) dst[m][k] = *(const PG8_LAS bf16x8*)(lds + PG8_SA(b, h) + aoff + m * 2048 + k * 1024); } while (0)
#define PG8_LDB(dst, b, h) do { _Pragma("unroll") for (int n = 0; n < 2; ++n) _Pragma("unroll") for (int k = 0; k < 2; ++k) dst[n][k] = *(const PG8_LAS bf16x8*)(lds + PG8_SB(b, h) + boff + n * 2048 + k * 1024); } while (0)
#define PG8_MMA(ai, bj, At, Bt) do { __builtin_amdgcn_s_setprio(1); _Pragma("unroll") for (int m = 0; m < 4; ++m) _Pragma("unroll") for (int n = 0; n < 2; ++n) _Pragma("unroll") for (int k = 0; k < 2; ++k) \
        acc[ai][bj][m][n] = __builtin_amdgcn_mfma_f32_16x16x32_bf16(Bt[n][k], At[m][k], acc[ai][bj][m][n], 0, 0, 0); __builtin_amdgcn_s_setprio(0); } while (0)
#define PG8_WAIT_V(n) asm volatile("s_waitcnt vmcnt(" #n ")" ::: "memory")
#define PG8_WAIT_L(n) asm volatile("s_waitcnt lgkmcnt(" #n ")" ::: "memory")
#define PG8_BAR __builtin_amdgcn_s_barrier()
#define PG8_SCHED __builtin_amdgcn_sched_barrier(0)
    Unit cur, nxt; int ui = 0;
    if (!S.next(0, cur)) return;
    f32x4 acc[2][2][4][2];
#pragma unroll
    for (int a = 0; a < 2; ++a)
#pragma unroll
        for (int b = 0; b < 2; ++b)
#pragma unroll
            for (int m = 0; m < 4; ++m)
#pragma unroll
                for (int n = 0; n < 2; ++n) acc[a][b][m][n] = (f32x4){0.f, 0.f, 0.f, 0.f};
    bf16x8 At[4][2], B0[2][2], B1[2][2];
    const char* cA = (const char*)g.A + (size_t)cur.pm * tstep; const char* cB = (const char*)g.Bt + (size_t)cur.pn * tstep;
    S.a_ready(cur);
    if constexpr (SP2) {
        PG8_STAGE(PG8_SB(0, 0), cB, voffB); PG8_STAGE(PG8_SB(0, 1), cB + hstep, voffB); PG8_STAGE(PG8_SA(0, 0), cA, voffA); PG8_STAGE(PG8_SA(0, 1), cA + hstep, voffA);
        if (wr == 1) PG8_BAR;
        PG8_WAIT_V(2); PG8_BAR;
        PG8_STAGE(PG8_SB(1, 0), cB + kstep, voffB); PG8_STAGE(PG8_SA(1, 0), cA + kstep, voffA); PG8_STAGE(PG8_SB(1, 1), cB + hstep + kstep, voffB);
        PG8_WAIT_V(6); PG8_BAR;
    } else {
        PG8_STAGE(PG8_SB(0, 0), cB, voffB); PG8_STAGE(PG8_SA(0, 0), cA, voffA); PG8_STAGE(PG8_SB(0, 1), cB + hstep, voffB); PG8_STAGE(PG8_SA(0, 1), cA + hstep, voffA);
        if (wr == 1) PG8_BAR;
        PG8_WAIT_V(4); PG8_BAR;
        PG8_STAGE(PG8_SB(1, 0), cB + kstep, voffB); PG8_STAGE(PG8_SA(1, 0), cA + kstep, voffA); PG8_STAGE(PG8_SB(1, 1), cB + hstep + kstep, voffB);
        PG8_WAIT_V(6); PG8_BAR;
    }
    for (;;) {
        const bool has_next = S.next(ui + 1, nxt);
        const char* nA = has_next ? (const char*)g.A + (size_t)nxt.pm * tstep : cA; const char* nB = has_next ? (const char*)g.Bt + (size_t)nxt.pn * tstep : cB;
        for (int t = 0; t < nt; t += 2) {
            const bool last = (t == nt - 2);
            const char* a1 = cA + (size_t)(t + 1) * kstep;
            const char* a2 = last ? nA : cA + (size_t)(t + 2) * kstep; const char* b2 = last ? nB : cB + (size_t)(t + 2) * kstep;
            const char* a3 = a2 + kstep; const char* b3 = b2 + kstep;
            if (last && has_next) S.a_ready(nxt);
            if constexpr (SP2) {
            PG8_LDB(B0, 0, 0); PG8_LDB(B1, 0, 1); PG8_SCHED; PG8_LDA(At, 0, 0); PG8_STAGE(PG8_SA(1, 1), a1 + hstep, voffA);
            PG8_WAIT_V(8); PG8_WAIT_L(0); PG8_BAR; PG8_MMA(0, 0, At, B0); PG8_MMA(0, 1, At, B1); PG8_BAR; PG8_SCHED;
            PG8_LDA(At, 0, 1); PG8_STAGE(PG8_SB(0, 0), b2, voffB); PG8_STAGE(PG8_SB(0, 1), b2 + hstep, voffB); PG8_STAGE(PG8_SA(0, 0), a2, voffA);
            PG8_WAIT_V(8); PG8_WAIT_L(0); PG8_BAR; PG8_MMA(1, 0, At, B0); PG8_MMA(1, 1, At, B1); PG8_BAR; PG8_SCHED;
            PG8_LDB(B0, 1, 0); PG8_LDB(B1, 1, 1); PG8_SCHED; PG8_LDA(At, 1, 0); PG8_STAGE(PG8_SA(0, 1), a2 + hstep, voffA);
            PG8_WAIT_V(8); PG8_WAIT_L(0); PG8_BAR; PG8_MMA(0, 0, At, B0); PG8_MMA(0, 1, At, B1); PG8_BAR; PG8_SCHED;
            PG8_LDA(At, 1, 1); PG8_STAGE(PG8_SB(1, 0), b3, voffB); PG8_STAGE(PG8_SB(1, 1), b3 + hstep, voffB); PG8_STAGE(PG8_SA(1, 0), a3, voffA);
            PG8_WAIT_V(8); PG8_WAIT_L(0); PG8_BAR; PG8_MMA(1, 0, At, B0); PG8_MMA(1, 1, At, B1); PG8_BAR; PG8_SCHED;
            } else {
            PG8_LDB(B0, 0, 0); PG8_SCHED; PG8_LDA(At, 0, 0); PG8_STAGE(PG8_SA(1, 1), a1 + hstep, voffA);
            PG8_WAIT_L(8); PG8_BAR; PG8_WAIT_L(0); PG8_MMA(0, 0, At, B0); PG8_BAR; PG8_SCHED;
            PG8_LDB(B1, 0, 1); PG8_STAGE(PG8_SB(0, 0), b2, voffB);
            PG8_BAR; PG8_WAIT_L(0); PG8_MMA(0, 1, At, B1); PG8_BAR;
            PG8_LDA(At, 0, 1); PG8_STAGE(PG8_SA(0, 0), a2, voffA);
            PG8_BAR; PG8_WAIT_L(0); PG8_MMA(1, 0, At, B0); PG8_BAR; PG8_SCHED;
            PG8_STAGE(PG8_SB(0, 1), b2 + hstep, voffB);
            PG8_WAIT_V(6); PG8_BAR; PG8_MMA(1, 1, At, B1); PG8_BAR;
            PG8_LDB(B0, 1, 0); PG8_SCHED; PG8_LDA(At, 1, 0); PG8_STAGE(PG8_SA(0, 1), a2 + hstep, voffA);
            PG8_WAIT_L(8); PG8_BAR; PG8_WAIT_L(0); PG8_MMA(0, 0, At, B0); PG8_BAR; PG8_SCHED;
            PG8_LDB(B1, 1, 1); PG8_STAGE(PG8_SB(1, 0), b3, voffB);
            PG8_BAR; PG8_WAIT_L(0); PG8_MMA(0, 1, At, B1); PG8_BAR;
            PG8_LDA(At, 1, 1); PG8_STAGE(PG8_SA(1, 0), a3, voffA);
            PG8_BAR; PG8_WAIT_L(0); PG8_MMA(1, 0, At, B0); PG8_BAR; PG8_SCHED;
            PG8_STAGE(PG8_SB(1, 1), b3 + hstep, voffB);
            PG8_WAIT_V(6); PG8_BAR; PG8_MMA(1, 1, At, B1); PG8_BAR;
            }
        }
        if constexpr (ALIGN_EPI) { if (wr == 0) PG8_BAR; }
        E(acc, cur, wr, wc, fr, fq); S.done(cur);
        if (!has_next) break;
#pragma unroll
        for (int a = 0; a < 2; ++a)
#pragma unroll
            for (int b = 0; b < 2; ++b)
#pragma unroll
                for (int m = 0; m < 4; ++m)
#pragma unroll
                    for (int n = 0; n < 2; ++n) acc[a][b][m][n] = (f32x4){0.f, 0.f, 0.f, 0.f};
        cur = nxt; cA = nA; cB = nB; ++ui;
        if constexpr (ALIGN_EPI) { if (wr == 1) PG8_BAR; }
    }
    PG8_WAIT_V(0);
    if constexpr (!ALIGN_EPI) { if (wr == 0) PG8_BAR; }
    PG8_BAR;
#undef PG8_SA
#undef PG8_SB
#undef PG8_STAGE
#undef PG8_LDA
#undef PG8_LDB
#undef PG8_MMA
#undef PG8_WAIT_V
#undef PG8_WAIT_L
#undef PG8_BAR
#undef PG8_SCHED
}
}

#define GAS __attribute__((address_space(1)))
#define LAS __attribute__((address_space(3)))
typedef unsigned short bf16;
typedef unsigned v4u __attribute__((ext_vector_type(4)));
typedef float f32x4 __attribute__((ext_vector_type(4)));
typedef float f32x16 __attribute__((ext_vector_type(16)));
typedef short bf16x8 __attribute__((ext_vector_type(8)));
typedef short s16x4 __attribute__((ext_vector_type(4)));
typedef short v4i16_t __attribute__((ext_vector_type(4)));
typedef LAS unsigned char LDSB;
typedef GAS unsigned gu32;

constexpr int NWAVES = 8, NTHR = 512;
constexpr int BATCH = 8, SEQ = 4096, DM = 1024, T = BATCH * SEQ;
constexpr int NPROJ = 3072;
constexpr int N_IN = 2848, FF = 4096;
constexpr float EPS = 1e-6f;
constexpr float C2 = 0.125f * 1.4426950408889634f;
constexpr float LOG2E = 1.4426950408889634f;
constexpr float NEGM = -1000.0f;

constexpr size_t MiB = 1u << 20;
constexpr size_t WS_CTL = 0, CTL_ZERO_BYTES = 1 * MiB;
constexpr size_t WS_WIN = 2 * MiB;
constexpr size_t WS_WOUT = 8 * MiB;
constexpr size_t WS_WUP = 10 * MiB;
constexpr size_t WS_WDN = 18 * MiB;
constexpr size_t WS_W1K = 26 * MiB;
constexpr size_t WS_W1V = 27 * MiB;
constexpr size_t WS_W2K = 28 * MiB;
constexpr size_t WS_W2V = 28 * MiB + 65536;
constexpr size_t WS_B1K = 28 * MiB + 131072;
constexpr size_t WS_B1V = 28 * MiB + 131072 + 65536;
constexpr size_t WS_ROPEC = 29 * MiB;
constexpr size_t WS_ROPES = 29 * MiB + 524288;
constexpr size_t WS_FL = 30 * MiB;
constexpr size_t WS_CB = 31 * MiB;
constexpr size_t WS_XN = 32 * MiB;
constexpr size_t WS_U = 96 * MiB;
constexpr size_t WS_QF = 96 * MiB;
constexpr size_t WS_KF = 128 * MiB;
constexpr size_t WS_VF = 160 * MiB;
constexpr size_t WS_QN = 192 * MiB;
constexpr size_t WS_KC = 224 * MiB;
constexpr size_t WS_VC = 233 * MiB;
constexpr size_t WS_KS = 242 * MiB;
constexpr size_t WS_VS = 250 * MiB;
constexpr size_t WS_KW = 258 * MiB;
constexpr size_t WS_VW = 266 * MiB;
constexpr size_t WS_GATE = 274 * MiB;
constexpr size_t WS_KCMP = 277 * MiB;
constexpr size_t WS_VCMP = 277 * MiB + 524288;
constexpr size_t WS_Y = 280 * MiB;
constexpr size_t WS_SSQ1 = 352 * MiB;
constexpr size_t WS_END = 356 * MiB;

constexpr int CW_Q_ATT = 64;
constexpr int CW_CS = 128;
constexpr int CW_CMPT = 192;
constexpr int CW_CMP = 256;
constexpr int CW_BAR = 4096;

constexpr int L_K = 0;
constexpr int L_V = 32768;
constexpr int L_ACC = 65536;
constexpr int L_IMP = 131072;
constexpr int L_WS = 131072 + 17408;
constexpr int L_SEL = L_WS + 8192;
constexpr int L_ORD = L_SEL + 512;
constexpr int L_MISC = L_ORD + 4096;
constexpr int L_TL = L_MISC + 256;
constexpr int LDS_BYTES = L_TL + 256;
constexpr int SLOTB = 8192;

#define RLX_AGENT __ATOMIC_RELAXED, __HIP_MEMORY_SCOPE_AGENT
#define LDS_WAIT() asm volatile("s_waitcnt lgkmcnt(0)" ::: "memory")
#define VM_WAIT() asm volatile("s_waitcnt vmcnt(0)" ::: "memory")
__device__ __forceinline__ unsigned f2bf(float f) { unsigned u = __builtin_bit_cast(unsigned, f); return (u + 0x7fffu + ((u >> 16) & 1u)) >> 16; }
__device__ __forceinline__ unsigned pk2(float lo, float hi) { return f2bf(lo) | (f2bf(hi) << 16); }
__device__ __forceinline__ float bf2f(unsigned short b) { return __builtin_bit_cast(float, (unsigned)b << 16); }

#define XB_TMO      128
#define XB_XCNT(j)  (256  + 64 * (j))
#define XB_XSUB(j)  (1280 + 64 * (j))
#define XB_XGEN(j)  (2304 + 64 * (j))
#define XB_TOP      3328
#define XB_TOPGEN   3392
#define XCD_BAR_WORDS 3456
#define XB_SPIN_CAP (1u << 22)
__device__ __forceinline__ unsigned xb_ld(unsigned* p)              { return __hip_atomic_load(p, __ATOMIC_RELAXED, __HIP_MEMORY_SCOPE_AGENT); }
__device__ __forceinline__ unsigned xb_add(unsigned* p, unsigned v) { return __hip_atomic_fetch_add(p, v, __ATOMIC_RELAXED, __HIP_MEMORY_SCOPE_AGENT); }
__device__ __forceinline__ unsigned xb_xcc_id() { return (unsigned)__builtin_amdgcn_s_getreg((3 << 11) | 20) & 0xFu; }
#define XB_SPIN(cond, bar) do { unsigned _sp = 0; while (cond) { __builtin_amdgcn_s_sleep(1); \
    if ((++_sp & 255u) == 0u) { if (xb_ld(&(bar)[XB_TMO])) break; if (_sp > XB_SPIN_CAP) { atomicAdd(&(bar)[XB_TMO], 1u); break; } } } } while (0)
struct XcdBarrier { unsigned* bar; unsigned x; volatile LAS unsigned* st; int wave; };
__device__ __forceinline__ XcdBarrier xcd_barrier_post(unsigned* bar, volatile LAS unsigned* st) {
    XcdBarrier b; b.bar = bar; b.x = xb_xcc_id(); b.st = st; b.wave = 0;
    if (threadIdx.x == 0) (void)xb_add(&bar[XB_XCNT(b.x)], 1u);
    return b;
}
__device__ __forceinline__ void xcd_barrier_complete(unsigned* bar, unsigned x, unsigned& nloc, unsigned& nx) {
    const unsigned G = gridDim.x * gridDim.y * gridDim.z;
    unsigned sum, cnt, mine, sp = 0u;
    for (;;) {
        sum = 0u; cnt = 0u; mine = 0u;
#pragma unroll
        for (unsigned j = 0; j < 16; ++j) { const unsigned c = xb_ld(&bar[XB_XCNT(j)]); sum += c; cnt += (c > 0u) ? 1u : 0u; mine = (j == x) ? c : mine; }
        if (sum == G) break;
        __builtin_amdgcn_s_sleep(1);
        if ((++sp & 255u) == 0u) { if (xb_ld(&bar[XB_TMO])) break; if (sp > XB_SPIN_CAP) { atomicAdd(&bar[XB_TMO], 1u); break; } }
    }
    nloc = mine > 0u ? mine : 1u; nx = cnt > 0u ? cnt : 1u;
}
__device__ __forceinline__ void xcd_barrier(const XcdBarrier& b) {
    asm volatile("s_waitcnt vmcnt(0)" ::: "memory");
    __syncthreads();
    if (b.wave == 0 && lane_id() == 0) {
        unsigned* bar = b.bar;
        __builtin_amdgcn_s_waitcnt(0);
        unsigned nloc = b.st[0], nx = b.st[1];
        if (nloc == 0u) { xcd_barrier_complete(bar, b.x, nloc, nx); b.st[0] = nloc; b.st[1] = nx; }
        const unsigned old = xb_add(&bar[XB_XSUB(b.x)], 1u);
        const unsigned gen = old / nloc;
        if (old + 1u == (gen + 1u) * nloc) {
            __builtin_amdgcn_fence(__ATOMIC_RELEASE, "agent");
            asm volatile("s_waitcnt vmcnt(0)" ::: "memory");
            const unsigned og = xb_add(&bar[XB_TOP], 1u);
            const unsigned tg = og / nx;
            if (og + 1u == (tg + 1u) * nx) xb_add(&bar[XB_TOPGEN], 1u);
            else XB_SPIN(xb_ld(&bar[XB_TOPGEN]) == tg, bar);
            __builtin_amdgcn_fence(__ATOMIC_ACQUIRE, "agent");
            xb_add(&bar[XB_XGEN(b.x)], 1u);
            asm volatile("s_waitcnt vmcnt(0)" ::: "memory");
        } else {
            XB_SPIN(xb_ld(&bar[XB_XGEN(b.x)]) == gen, bar);
            __builtin_amdgcn_fence(__ATOMIC_ACQUIRE, "agent");
            asm volatile("s_waitcnt vmcnt(0)" ::: "memory");
        }
    }
    __syncthreads();
}

struct Args { const float* in[22]; float* out; unsigned char* ws; int ph_lo, ph_hi; };

struct Frame {
    LDSB* lds;
    volatile LAS unsigned* MISC;
    gu32* ctl;
    int tid, lane, wave, vcu, G;
    unsigned char* ws;
};

__device__ __forceinline__ float wave_sum(float v) {
#pragma unroll
    for (int o = 1; o < 64; o <<= 1) v += __shfl_xor(v, o);
    return v;
}

__device__ __forceinline__ int win_src_col(int n) {
    const int pn = n >> 8, c = n & 255, half = c >> 7, slot = (c >> 5) & 3, d = c & 31;
    if (pn < 8) {
        const int tsr = pn >> 1, j = pn & 1;
        const int tb = (tsr == 0) ? 0 : (tsr == 1) ? 512 : (tsr == 2) ? 1024 : 1544;
        return tb + 64 * (4 * j + slot) + 32 * half + d;
    }
    if (pn < 11) {
        const int base = 2056 + (pn - 8) * 256;
        return base + (slot >> 1) * 128 + (slot & 1) * 64 + 32 * half + d;
    }
    if (c < 8) return 1536 + c;
    if (c < 32) return 2824 + (c - 8);
    return -1;
}

template <bool MAPPED>
__device__ __forceinline__ void p0_transpose_item(const float* W, int K, int N, bf16* WT, LAS float* scr, int item, int lane, const float* kscale, int nblk) {
    const int kb = item / nblk, nb = item % nblk, k0 = 64 * kb, n0 = 32 * nb;
    int src = n0 + (lane & 31);
    if (MAPPED) src = win_src_col(src);
#pragma unroll 8
    for (int i = 0; i < 32; ++i) { const int kk = 2 * i + (lane >> 5);
        float v = 0.f; if (src >= 0) v = W[(size_t)(k0 + kk) * N + src];
        if (kscale) v *= kscale[k0 + kk];
        scr[kk * 33 + (lane & 31)] = v; }
    LDS_WAIT(); asm volatile("" ::: "memory");
    const int c = lane & 7;
#pragma unroll
    for (int j = 0; j < 4; ++j) { const int n = (lane >> 3) + 8 * j; const LAS float* s = scr + (8 * c) * 33 + n;
        v4u o; o.x = pk2(s[0 * 33], s[1 * 33]); o.y = pk2(s[2 * 33], s[3 * 33]); o.z = pk2(s[4 * 33], s[5 * 33]); o.w = pk2(s[6 * 33], s[7 * 33]);
        *(GAS v4u*)(WT + (size_t)(n0 + n) * K + k0 + 8 * c) = o; }
    LDS_WAIT(); asm volatile("" ::: "memory");
}

__device__ __forceinline__ void rms_row_to_bf16(int lane, const float* xrow, bf16* orow) {
    const GAS f32x4* xr = (const GAS f32x4*)xrow + lane;
    f32x4 v[4]; float s = 0.f;
#pragma unroll
    for (int j = 0; j < 4; ++j) { v[j] = xr[64 * j]; s += (v[j].x * v[j].x + v[j].y * v[j].y) + (v[j].z * v[j].z + v[j].w * v[j].w); }
    const float r = 1.f / sqrtf(wave_sum(s) * (1.f / DM) + EPS);
    GAS unsigned long long* o8 = (GAS unsigned long long*)orow + lane;
#pragma unroll
    for (int j = 0; j < 4; ++j) o8[64 * j] = (unsigned long long)pk2(v[j].x * r, v[j].y * r) | ((unsigned long long)pk2(v[j].z * r, v[j].w * r) << 32);
}

typedef __attribute__((address_space(4))) const char* kptr_t;
#define AIN(kp_, i) (*(const float* const __attribute__((address_space(4)))*)((kp_) + 8 * (i)))
__device__ __forceinline__ void p0_prologue(Frame& F, kptr_t kp) {
    const float* x = AIN(kp, 0); const float* g_attn = AIN(kp, 1); const float* w_in = AIN(kp, 2);
    const float* cmpk_pe = AIN(kp, 5); const float* cmpk_w1 = AIN(kp, 6); const float* cmpk_w2 = AIN(kp, 8);
    const float* cmpv_pe = AIN(kp, 10); const float* cmpv_w1 = AIN(kp, 11); const float* cmpv_w2 = AIN(kp, 13);
    const float* g_fox = AIN(kp, 15); const float* g_nsa = AIN(kp, 16); const float* w_out = AIN(kp, 17);
    const float* g_mlp = AIN(kp, 18); const float* w_up = AIN(kp, 19); const float* w_down = AIN(kp, 20);
    LAS float* scr = (LAS float*)(F.lds + F.wave * 16384);
    const int gw = F.vcu * NWAVES + F.wave, NGW = F.G * NWAVES;
    for (int it = gw; it < 128; it += NGW) {
        const int kv = it >> 6, kc = it & 63;
        const float* pe = kv ? cmpv_pe : cmpk_pe; const float* w1 = kv ? cmpv_w1 : cmpk_w1;
        f32x4 a = (f32x4){0.f, 0.f, 0.f, 0.f};
#pragma unroll 8
        for (int k = 32 * kc; k < 32 * kc + 32; ++k) { const f32x4 wv = *((const f32x4*)(w1 + (size_t)k * 256) + F.lane); a = a + wv * pe[k]; }
        *((f32x4*)(F.ws + (kv ? WS_B1V : WS_B1K)) + kc * 64 + F.lane) = a;
    }
    constexpr int I_IN = (DM / 64) * (NPROJ / 32), I_OUT = (DM / 64) * (DM / 32), I_UP = (DM / 64) * (FF / 32), I_DN = (FF / 64) * (DM / 32);
    constexpr int I_W1 = (2048 / 64) * (256 / 32), I_W2 = (256 / 64) * (64 / 32);
    constexpr int NITEMS = I_IN + I_OUT + I_UP + I_DN + 2 * I_W1 + 2 * I_W2;
    for (int it = gw; it < NITEMS; it += NGW) {
        int r = it;
        if (r < I_IN) { p0_transpose_item<true>(w_in, DM, N_IN, (bf16*)(F.ws + WS_WIN), scr, r, F.lane, g_attn, NPROJ / 32); continue; } r -= I_IN;
        if (r < I_OUT) {
            const int kb = r / (DM / 32);
            const float* ks = (kb < 8) ? g_fox : (g_nsa - 512);
            p0_transpose_item<false>(w_out, DM, DM, (bf16*)(F.ws + WS_WOUT), scr, r, F.lane, ks, DM / 32); continue; } r -= I_OUT;
        if (r < I_UP) { p0_transpose_item<false>(w_up, DM, FF, (bf16*)(F.ws + WS_WUP), scr, r, F.lane, g_mlp, FF / 32); continue; } r -= I_UP;
        if (r < I_DN) { p0_transpose_item<false>(w_down, FF, DM, (bf16*)(F.ws + WS_WDN), scr, r, F.lane, nullptr, DM / 32); continue; } r -= I_DN;
        if (r < I_W1) { p0_transpose_item<false>(cmpk_w1, 2048, 256, (bf16*)(F.ws + WS_W1K), scr, r, F.lane, nullptr, 8); continue; } r -= I_W1;
        if (r < I_W1) { p0_transpose_item<false>(cmpv_w1, 2048, 256, (bf16*)(F.ws + WS_W1V), scr, r, F.lane, nullptr, 8); continue; } r -= I_W1;
        if (r < I_W2) { p0_transpose_item<false>(cmpk_w2, 256, 64, (bf16*)(F.ws + WS_W2K), scr, r, F.lane, nullptr, 2); continue; } r -= I_W2;
        p0_transpose_item<false>(cmpv_w2, 256, 64, (bf16*)(F.ws + WS_W2V), scr, r, F.lane, nullptr, 2);
    }
    {
        float* rc = (float*)(F.ws + WS_ROPEC); float* rs = (float*)(F.ws + WS_ROPES);
        for (int i = F.vcu * NTHR + F.tid; i < SEQ * 32; i += F.G * NTHR) {
            const int pos = i >> 5, d = i & 31;
            const float inv = exp2f(-(float)d * (13.287712379549449f / 32.0f));
            const float ang = (float)pos * inv;
            const double a = (double)ang;
            const double k = __builtin_rint(a * 0.15915494309189535);
            const float red = (float)(a - k * 6.283185307179586);
            rc[i] = cosf(red); rs[i] = sinf(red);
        }
    }
    for (int m = gw; m < T; m += NGW) rms_row_to_bf16(F.lane, x + (size_t)m * DM, (bf16*)(F.ws + WS_XN) + (size_t)m * DM);
}

typedef pg8::f32x4 pf4;
__device__ __forceinline__ float log_sigmoidf(float v) { return v >= 0.f ? -log1pf(expf(-v)) : v - log1pf(expf(v)); }

struct EpiProj {
    static constexpr bool PERM = true;
    unsigned char* ws; const float* b_f; const float* b_gate;
    __device__ __forceinline__ void operator()(const pf4 (&acc)[2][2][4][2], const pg8::Unit& u, int wr, int wc, int fr, int fq) const {
        const int pn = u.pn; const int rbase = u.pm * 256 + wr * 64 + fr;
        if (pn == 11) {
            if (wc != 0) return;
            float* FL = (float*)(ws + WS_FL); float* GT = (float*)(ws + WS_GATE);
#pragma unroll
            for (int ai = 0; ai < 2; ++ai)
#pragma unroll
                for (int m = 0; m < 4; ++m) { const int row = rbase + ai * 128 + m * 16; const int b = row >> 12, s = row & 4095;
#pragma unroll
                    for (int n = 0; n < 2; ++n) { const pf4 v = acc[ai][0][m][n];
                        if (fq == 0) {
#pragma unroll
                            for (int i = 0; i < 4; ++i) { const int h = 4 * n + i; FL[(size_t)(b * 8 + h) * SEQ + s] = log_sigmoidf(v[i] + b_f[h]); }
                        } else { const int j0 = 8 * fq - 8 + 4 * n; pf4 o;
#pragma unroll
                            for (int i = 0; i < 4; ++i) { const float z = v[i] + b_gate[j0 + i]; o[i] = 1.f / (1.f + expf(-z)); }
                            *(pf4*)(GT + (size_t)row * 24 + j0) = o; } } }
            return;
        }
        const bool rope = (pn == 6) || (pn == 7) || ((pn == 9 || pn == 10) && wc < 2);
        const float sc = (pn < 2 || pn == 6 || pn == 7) ? C2 : 1.f;
        const float* RC = (const float*)(ws + WS_ROPEC); const float* RS = (const float*)(ws + WS_ROPES);
        size_t tb;
        if (pn < 8) { const int tsr = pn >> 1; tb = (tsr == 0) ? WS_QF : (tsr == 1) ? WS_KF : (tsr == 2) ? WS_VF : WS_QN; }
        else { const int vt = wc >> 1; tb = (pn == 8) ? (vt ? WS_VC : WS_KC) : (pn == 9) ? (vt ? WS_VS : WS_KS) : (vt ? WS_VW : WS_KW); }
        bf16* TB = (bf16*)(ws + tb);
#pragma unroll
        for (int ai = 0; ai < 2; ++ai)
#pragma unroll
            for (int m = 0; m < 4; ++m) { const int row = rbase + ai * 128 + m * 16;
                pf4 a0 = acc[ai][0][m][0], a1 = acc[ai][0][m][1], b0 = acc[ai][1][m][0], b1 = acc[ai][1][m][1];
                if (rope) { const int pos = row & 4095;
                    const pf4 c0 = *(const pf4*)(RC + pos * 32 + 8 * fq), c1 = *(const pf4*)(RC + pos * 32 + 8 * fq + 4);
                    const pf4 s0 = *(const pf4*)(RS + pos * 32 + 8 * fq), s1 = *(const pf4*)(RS + pos * 32 + 8 * fq + 4);
                    const pf4 x0 = a0 * c0 - b0 * s0, x1 = a1 * c1 - b1 * s1, y0 = a0 * s0 + b0 * c0, y1 = a1 * s1 + b1 * c1;
                    a0 = x0; a1 = x1; b0 = y0; b1 = y1; }
                a0 = a0 * sc; a1 = a1 * sc; b0 = b0 * sc; b1 = b1 * sc;
                v4u w0, w1; w0.x = pk2(a0[0], a0[1]); w0.y = pk2(a0[2], a0[3]); w0.z = pk2(a1[0], a1[1]); w0.w = pk2(a1[2], a1[3]);
                w1.x = pk2(b0[0], b0[1]); w1.y = pk2(b0[2], b0[3]); w1.z = pk2(b1[0], b1[1]); w1.w = pk2(b1[2], b1[3]);
                bf16* p;
                if (pn < 8) p = TB + (size_t)row * 512 + 64 * (4 * (pn & 1) + wc) + 8 * fq;
                else { const int b = row >> 12, s = row & 4095, g = wc & 1; p = TB + ((size_t)(b * 2 + g) * SEQ + s) * 64 + 8 * fq; }
                *(v4u*)p = w0; *(v4u*)(p + 32) = w1; }
    }
};

struct EpiOutRes {
    static constexpr bool PERM = true;
    const float* x; float* out; bf16* xn; float* ssq; LDSB* lds;
    __device__ __forceinline__ void operator()(const pf4 (&acc)[2][2][4][2], const pg8::Unit& u, int wr, int wc, int fr, int fq) const {
        const int col0 = u.pn * 256 + wc * 32 + 8 * fq;
        LAS float* P = (LAS float*)(lds + L_IMP);
#pragma unroll
        for (int ai = 0; ai < 2; ++ai)
#pragma unroll
            for (int m = 0; m < 4; ++m) { const int rl = ai * 128 + wr * 64 + m * 16 + fr; const size_t off = (size_t)(u.pm * 256 + rl) * DM + col0; float sq = 0.f;
#pragma unroll
                for (int bj = 0; bj < 2; ++bj) {
                    const pf4 h0 = *(const pf4*)(x + off + bj * 128) + acc[ai][bj][m][0], h1 = *(const pf4*)(x + off + bj * 128 + 4) + acc[ai][bj][m][1];
                    *(pf4*)(out + off + bj * 128) = h0; *(pf4*)(out + off + bj * 128 + 4) = h1;
                    sq += ((h0[0] * h0[0] + h0[1] * h0[1]) + (h0[2] * h0[2] + h0[3] * h0[3])) + ((h1[0] * h1[0] + h1[1] * h1[1]) + (h1[2] * h1[2] + h1[3] * h1[3]));
                    v4u w; w.x = pk2(h0[0], h0[1]); w.y = pk2(h0[2], h0[3]); w.z = pk2(h1[0], h1[1]); w.w = pk2(h1[2], h1[3]);
                    *(v4u*)(xn + off + bj * 128) = w; }
                sq += __shfl_xor(sq, 16); sq += __shfl_xor(sq, 32);
                if (fq == 0) P[rl * 4 + wc] = sq; }
        asm volatile("s_waitcnt lgkmcnt(0)\n\ts_barrier" ::: "memory");
        const int t = (wr * 4 + wc) * 64 + (fq * 16 + fr);
        if (t < 256) { const f32x4 p = *(const LAS f32x4*)(P + t * 4); ssq[(size_t)(u.pm * 256 + t) * 4 + u.pn] = (p[0] + p[1]) + (p[2] + p[3]); }
    }
};

struct EpiUp {
    static constexpr bool PERM = true;
    bf16* O; const float* ssq;
    __device__ __forceinline__ void operator()(const pf4 (&acc)[2][2][4][2], const pg8::Unit& u, int wr, int wc, int fr, int fq) const {
        const int row0 = u.pm * 256 + wr * 64 + fr, col0 = u.pn * 256 + wc * 32 + 8 * fq;
#pragma unroll
        for (int ai = 0; ai < 2; ++ai)
#pragma unroll
            for (int m = 0; m < 4; ++m) { const int row = row0 + ai * 128 + m * 16; bf16* rowp = O + (size_t)row * FF + col0;
                const pf4 s0 = *(const pf4*)(ssq + (size_t)row * 4);
                const float tot = (s0[0] + s0[1]) + (s0[2] + s0[3]);
                const float r2 = 1.f / (tot * (1.f / DM) + EPS);
#pragma unroll
                for (int bj = 0; bj < 2; ++bj) { pf4 v0 = acc[ai][bj][m][0], v1 = acc[ai][bj][m][1];
#pragma unroll
                    for (int i = 0; i < 4; ++i) { const float a = fmaxf(v0[i], 0.f), b = fmaxf(v1[i], 0.f); v0[i] = a * a * r2; v1[i] = b * b * r2; }
                    v4u w; w.x = pk2(v0[0], v0[1]); w.y = pk2(v0[2], v0[3]); w.z = pk2(v1[0], v1[1]); w.w = pk2(v1[2], v1[3]);
                    *(v4u*)(rowp + bj * 128) = w; } }
    }
};

struct EpiDownRes {
    static constexpr bool PERM = true;
    float* out;
    __device__ __forceinline__ void operator()(const pf4 (&acc)[2][2][4][2], const pg8::Unit& u, int wr, int wc, int fr, int fq) const {
        const int col0 = u.pn * 256 + wc * 32 + 8 * fq;
#pragma unroll
        for (int ai = 0; ai < 2; ++ai)
#pragma unroll
            for (int m = 0; m < 4; ++m) { const size_t off = (size_t)(u.pm * 256 + ai * 128 + wr * 64 + m * 16 + fr) * DM + col0;
#pragma unroll
                for (int bj = 0; bj < 2; ++bj) { float* p = out + off + bj * 128; const pf4 b0 = *(const pf4*)p, b1 = *(const pf4*)(p + 4); *(pf4*)p = b0 + acc[ai][bj][m][0]; *(pf4*)(p + 4) = b1 + acc[ai][bj][m][1]; } }
    }
};

__device__ __forceinline__ void p2_cumsum_item(Frame& F, int item) {
    const float* fl = (const float*)(F.ws + WS_FL) + (size_t)item * SEQ; float* cb = (float*)(F.ws + WS_CB) + (size_t)item * SEQ;
    const int lane = F.lane;
    float v[64]; float run = 0.f;
#pragma unroll
    for (int i = 0; i < 16; ++i) { const f32x4 t = *(const f32x4*)(fl + lane * 64 + 4 * i); v[4 * i] = t[0]; v[4 * i + 1] = t[1]; v[4 * i + 2] = t[2]; v[4 * i + 3] = t[3]; }
#pragma unroll
    for (int i = 0; i < 64; ++i) { run += v[i]; v[i] = run; }
    float incl = run;
#pragma unroll
    for (int o = 1; o < 64; o <<= 1) { const float t = __shfl_up(incl, o); if (lane >= o) incl += t; }
    const float base = incl - run;
#pragma unroll
    for (int i = 0; i < 16; ++i) { f32x4 t; t[0] = -(v[4 * i] + base) * LOG2E; t[1] = -(v[4 * i + 1] + base) * LOG2E; t[2] = -(v[4 * i + 2] + base) * LOG2E; t[3] = -(v[4 * i + 3] + base) * LOG2E;
        *(f32x4*)(cb + lane * 64 + 4 * i) = t; }
}

__device__ __forceinline__ float gelu_tanh(float x) {
    const float u = 0.7978845608028654f * (x + 0.044715f * x * x * x);
    const float e = __expf(2.f * u);
    const float th = 1.f - 2.f / (e + 1.f);
    return 0.5f * x * (1.f + th);
}

__device__ __forceinline__ void p2_compress_item(Frame& F0, kptr_t kp, int item) {
    typedef float f4 __attribute__((ext_vector_type(4)));
    struct { unsigned char* ws; LDSB* lds; int tid, lane, wave; } F; F.ws = F0.ws; F.lds = F0.lds; F.wave = F0.wave;
    { int t_ = F0.tid; asm volatile("" : "+v"(t_)); F.tid = t_; F.lane = t_ & 63; }
    asm volatile("" : "+s"(F.ws));
    const int kv = item >> 6, bg = (item >> 2) & 15, cblk = item & 3, c0 = 64 * cblk;
    const int lane = F.lane, w = F.wave, fr = lane & 15, fq = lane >> 4;
    const bf16* Ab = (const bf16*)(F.ws + (kv ? WS_VC : WS_KC)) + (size_t)bg * SEQ * 64 + (size_t)c0 * 1024;
    const bf16* W1 = (const bf16*)(F.ws + (kv ? WS_W1V : WS_W1K));
    const bf16* W2 = (const bf16*)(F.ws + (kv ? WS_W2V : WS_W2K));
    const float* B1 = (const float*)(F.ws + (kv ? WS_B1V : WS_B1K));
    const float* b1 = AIN(kp, kv ? 12 : 7);
    const float* b2 = AIN(kp, kv ? 14 : 9);
    LDSB* lds = F.lds;
    LAS bf16* Hs = (LAS bf16*)(lds + 92160);
    f4 acc[4][2];
#pragma unroll
    for (int m = 0; m < 4; ++m) { acc[m][0] = (f4){0.f, 0.f, 0.f, 0.f}; acc[m][1] = (f4){0.f, 0.f, 0.f, 0.f}; }
    const int tid = F.tid, lrow = tid >> 3, lch = tid & 7;
    const bf16* ag = Ab + (size_t)lrow * 1024 + lch * 8;
    const bf16* bg_ = W1 + (size_t)lrow * 2048 + lch * 8;
    const int sto = (lrow * 72 + lch * 8) * 2;
    v4u ra = *(const v4u*)ag, rb[4];
#pragma unroll
    for (int i = 0; i < 4; ++i) rb[i] = *(const v4u*)(bg_ + (size_t)i * 64 * 2048);
    *(LAS v4u*)(lds + sto) = ra;
#pragma unroll
    for (int i = 0; i < 4; ++i) *(LAS v4u*)(lds + 18432 + sto + i * 64 * 144) = rb[i];
    __syncthreads();
    for (int ks = 0; ks < 32; ++ks) {
        const int cb = ks & 1;
        if (ks + 1 < 32) { ra = *(const v4u*)(ag + (ks + 1) * 64);
#pragma unroll
            for (int i = 0; i < 4; ++i) rb[i] = *(const v4u*)(bg_ + (size_t)i * 64 * 2048 + (ks + 1) * 64); }
        const LDSB* As = lds + cb * 9216; const LDSB* Bs = lds + 18432 + cb * 36864;
#pragma unroll
        for (int kh = 0; kh < 2; ++kh) {
            bf16x8 a[4], b[2];
#pragma unroll
            for (int m = 0; m < 4; ++m) a[m] = *(const LAS bf16x8*)(As + ((16 * m + fr) * 72 + 32 * kh + 8 * fq) * 2);
#pragma unroll
            for (int n = 0; n < 2; ++n) b[n] = *(const LAS bf16x8*)(Bs + ((32 * w + 16 * n + fr) * 72 + 32 * kh + 8 * fq) * 2);
#pragma unroll
            for (int m = 0; m < 4; ++m)
#pragma unroll
                for (int n = 0; n < 2; ++n) acc[m][n] = __builtin_amdgcn_mfma_f32_16x16x32_bf16(a[m], b[n], acc[m][n], 0, 0, 0);
        }
        if (ks + 1 < 32) {
            *(LAS v4u*)(lds + (cb ^ 1) * 9216 + sto) = ra;
#pragma unroll
            for (int i = 0; i < 4; ++i) *(LAS v4u*)(lds + 18432 + (cb ^ 1) * 36864 + sto + i * 64 * 144) = rb[i];
        }
        __syncthreads();
    }
    float bbv[2];
#pragma unroll
    for (int n = 0; n < 2; ++n) { const int col = 32 * w + 16 * n + fr; float bb = b1[col];
#pragma unroll 8
        for (int kc = 0; kc < 64; ++kc) bb += B1[kc * 256 + col];
        bbv[n] = bb; }
#pragma unroll
    for (int m = 0; m < 4; ++m)
#pragma unroll
        for (int n = 0; n < 2; ++n) { const int col = 32 * w + 16 * n + fr;
#pragma unroll
            for (int r = 0; r < 4; ++r) Hs[(16 * m + 4 * fq + r) * 264 + col] = (bf16)f2bf(gelu_tanh(acc[m][n][r] + bbv[n])); }
    __syncthreads();
    const int mt = w >> 1, ntA = (w & 1), ntB = (w & 1) + 2;
    f4 oa = (f4){0.f, 0.f, 0.f, 0.f}, ob = (f4){0.f, 0.f, 0.f, 0.f};
#pragma unroll
    for (int k0 = 0; k0 < 256; k0 += 32) {
        const bf16x8 a = *(const LAS bf16x8*)(Hs + (16 * mt + fr) * 264 + k0 + 8 * fq);
        const bf16x8 bA = *(const bf16x8*)(W2 + (size_t)(16 * ntA + fr) * 256 + k0 + 8 * fq);
        const bf16x8 bB = *(const bf16x8*)(W2 + (size_t)(16 * ntB + fr) * 256 + k0 + 8 * fq);
        oa = __builtin_amdgcn_mfma_f32_16x16x32_bf16(a, bA, oa, 0, 0, 0);
        ob = __builtin_amdgcn_mfma_f32_16x16x32_bf16(a, bB, ob, 0, 0, 0);
    }
    const int d1 = 16 * (w & 1) + fr;
    const float bb1 = b2[d1], bb2 = b2[d1 + 32];
    const float* RC = (const float*)(F.ws + WS_ROPEC); const float* RS = (const float*)(F.ws + WS_ROPES);
    bf16* O = (bf16*)(F.ws + (kv ? WS_VCMP : WS_KCMP)) + (size_t)bg * 256 * 64;
#pragma unroll
    for (int r = 0; r < 4; ++r) { const int c = c0 + 16 * mt + 4 * fq + r;
        float x1 = oa[r] + bb1, x2 = ob[r] + bb2;
        if (kv == 0) { int pos = 16 * c + 31; pos = pos > 4095 ? 4095 : pos; const float cs = RC[pos * 32 + d1], sn = RS[pos * 32 + d1];
            const float y1 = x1 * cs - x2 * sn, y2 = x1 * sn + x2 * cs; x1 = y1; x2 = y2; }
        O[(size_t)c * 64 + d1] = (bf16)f2bf(x1); O[(size_t)c * 64 + d1 + 32] = (bf16)f2bf(x2); }
    __syncthreads();
}

__device__ __forceinline__ int crow(int r, int hi) { return (r & 3) + 8 * (r >> 2) + 4 * hi; }
__device__ __forceinline__ void glds16(const void* gsrc, unsigned lds_dst) { unsigned keep;
    asm volatile("s_mov_b32 %0, m0\n\ts_mov_b32 m0, %2\n\ts_nop 0\n\tglobal_load_lds_dwordx4 %1, off\n\ts_mov_b32 m0, %0" : "=&s"(keep) : "v"(gsrc), "s"(lds_dst) : "memory"); }
#define WAIT_BAR(N) asm volatile("s_waitcnt vmcnt(" #N ") lgkmcnt(0)\n\ts_barrier" ::: "memory")
__device__ __forceinline__ unsigned cvtpk_s(float lo, float hi) { typedef float f2 __attribute__((ext_vector_type(2))); typedef __bf16 b2 __attribute__((ext_vector_type(2)));
    f2 v = {lo, hi}; b2 b = __builtin_convertvector(v, b2); return __builtin_bit_cast(unsigned, b); }
__device__ __forceinline__ s16x4 vtr(const LDSB* p) { return __builtin_bit_cast(s16x4, __builtin_amdgcn_ds_read_tr16_b64_v4i16((LAS v4i16_t*)p)); }

__device__ __forceinline__ float xh_max(float a) { auto r = __builtin_amdgcn_permlane32_swap(__float_as_uint(a), __float_as_uint(a), false, false); return fmaxf(__uint_as_float(r[0]), __uint_as_float(r[1])); }
__device__ __forceinline__ float xh_sum(float a) { auto r = __builtin_amdgcn_permlane32_swap(__float_as_uint(a), __float_as_uint(a), false, false); return __uint_as_float(r[0]) + __uint_as_float(r[1]); }
__device__ __forceinline__ float xh_other(float a, int hi) { auto r = __builtin_amdgcn_permlane32_swap(__float_as_uint(a), __float_as_uint(a), false, false); return hi ? __uint_as_float(r[0]) : __uint_as_float(r[1]); }
__device__ __forceinline__ void qkt(f32x16& p0, f32x16& p1, const LDSB* kslot, const bf16x8 (&qr)[4], const f32x16& cinit, int r32, int hi) {
    const LDSB* kb = kslot + hi * 1024 + r32 * 16;
#pragma unroll
    for (int d0 = 0; d0 < 4; ++d0) {
        const bf16x8 b0 = *(const LAS bf16x8*)(kb + d0 * 2048);
        const bf16x8 b1 = *(const LAS bf16x8*)(kb + d0 * 2048 + 512);
        if (d0 == 0) { p0 = __builtin_amdgcn_mfma_f32_32x32x16_bf16(b0, qr[0], cinit, 0, 0, 0); p1 = __builtin_amdgcn_mfma_f32_32x32x16_bf16(b1, qr[0], cinit, 0, 0, 0); }
        else { p0 = __builtin_amdgcn_mfma_f32_32x32x16_bf16(b0, qr[d0], p0, 0, 0, 0); p1 = __builtin_amdgcn_mfma_f32_32x32x16_bf16(b1, qr[d0], p1, 0, 0, 0); }
    }
}
__device__ __forceinline__ void pv(f32x16 (&o)[2], const LDSB* vp, const f32x16& p0, const f32x16& p1) {
    v4u pw[4];
    pw[0] = (v4u){cvtpk_s(p0[0], p0[1]), cvtpk_s(p0[2], p0[3]), cvtpk_s(p0[4], p0[5]), cvtpk_s(p0[6], p0[7])};
    pw[1] = (v4u){cvtpk_s(p0[8], p0[9]), cvtpk_s(p0[10], p0[11]), cvtpk_s(p0[12], p0[13]), cvtpk_s(p0[14], p0[15])};
    pw[2] = (v4u){cvtpk_s(p1[0], p1[1]), cvtpk_s(p1[2], p1[3]), cvtpk_s(p1[4], p1[5]), cvtpk_s(p1[6], p1[7])};
    pw[3] = (v4u){cvtpk_s(p1[8], p1[9]), cvtpk_s(p1[10], p1[11]), cvtpk_s(p1[12], p1[13]), cvtpk_s(p1[14], p1[15])};
#pragma unroll
    for (int d0 = 0; d0 < 2; ++d0)
#pragma unroll
        for (int ks = 0; ks < 4; ++ks) {
            const s16x4 lo = vtr(vp + d0 * 4096 + ks * 1024), hi = vtr(vp + d0 * 4096 + ks * 1024 + 512);
            const bf16x8 vf = (bf16x8){lo[0], lo[1], lo[2], lo[3], hi[0], hi[1], hi[2], hi[3]};
            o[d0] = __builtin_amdgcn_mfma_f32_32x32x16_bf16(__builtin_bit_cast(bf16x8, pw[ks]), vf, o[d0], 0, 0, 0);
        }
}
__device__ __forceinline__ float rowmax32(const f32x16& p0, const f32x16& p1) {
    float a = fmaxf(p0[0], p1[0]);
#pragma unroll
    for (int r = 1; r < 16; ++r) a = fmaxf(a, fmaxf(p0[r], p1[r]));
    return xh_max(a);
}
__device__ __forceinline__ float rowsum32(const f32x16& p0, const f32x16& p1) {
    float a = 0.f, b = 0.f;
#pragma unroll
    for (int r = 0; r < 16; ++r) { a += p0[r]; b += p1[r]; }
    return a + b;
}

template <int PITCH>
__device__ __forceinline__ void dma_kv(const bf16* Kh, const bf16* Vh, int key0, unsigned kdst, unsigned vdst, int wid, int lane) {
    const bf16* ksrc = Kh + (size_t)(key0 + lane) * PITCH + wid * 8;
    const bf16* vsrc = Vh + (size_t)(key0 + 16 * (wid & 3) + (lane >> 2)) * PITCH + (wid >> 2) * 32 + (lane & 3) * 8;
    glds16(ksrc, (unsigned)__builtin_amdgcn_readfirstlane(kdst + wid * 1024));
    glds16(vsrc, (unsigned)__builtin_amdgcn_readfirstlane(vdst + wid * 1024));
}


#define SBAR() __builtin_amdgcn_sched_barrier(0)
__device__ __forceinline__ void kload8(bf16x8* kf, const LDSB* kp) {
    kf[0] = *(const LAS bf16x8*)(kp);        kf[1] = *(const LAS bf16x8*)(kp + 512);
    kf[2] = *(const LAS bf16x8*)(kp + 2048); kf[3] = *(const LAS bf16x8*)(kp + 2560);
    kf[4] = *(const LAS bf16x8*)(kp + 4096); kf[5] = *(const LAS bf16x8*)(kp + 4608);
    kf[6] = *(const LAS bf16x8*)(kp + 6144); kf[7] = *(const LAS bf16x8*)(kp + 6656);
}
__device__ __forceinline__ void kload2(bf16x8* kf, const LDSB* kp, int j) { kf[2 * j] = *(const LAS bf16x8*)(kp + j * 2048); kf[2 * j + 1] = *(const LAS bf16x8*)(kp + j * 2048 + 512); }

template <int MODE>
__device__ __forceinline__ void att_mod(f32x16& C0, f32x16& C1, int j, int qabs, int qw0, int cur, unsigned sel_lo, unsigned sel_hi, const LAS float* kbias, int hi) {
    if (MODE == 0) {
        const LAS float* kb = kbias + 64 * j + 4 * hi;
#pragma unroll
        for (int g4 = 0; g4 < 4; ++g4) { const f32x4 b0 = *(const LAS f32x4*)(kb + 8 * g4), b1 = *(const LAS f32x4*)(kb + 32 + 8 * g4);
#pragma unroll
            for (int i = 0; i < 4; ++i) { C0[4 * g4 + i] += b0[i]; C1[4 * g4 + i] += b1[i]; } }
        if (64 * j + 63 > qw0) {
#pragma unroll
            for (int r = 0; r < 16; ++r) { const int kv = 64 * j + crow(r, hi); if (kv > qabs) C0[r] = NEGM; if (kv + 32 > qabs) C1[r] = NEGM; }
        }
    } else if (MODE == 1) {
        const bool sel = ((j < 32 ? (sel_lo >> j) : (sel_hi >> (j - 32))) & 1u) != 0u;
        if (j == cur) {
#pragma unroll
            for (int r = 0; r < 16; ++r) { const int kv = 64 * j + crow(r, hi); if (kv > qabs || !sel) C0[r] = NEGM; if (kv + 32 > qabs || !sel) C1[r] = NEGM; }
        } else {
#pragma unroll
            for (int r = 0; r < 16; ++r) { if (!sel) { C0[r] = NEGM; C1[r] = NEGM; } }
        }
    } else {
        if (j == cur || j + 8 <= cur) {
#pragma unroll
            for (int r = 0; r < 16; ++r) { const int kv = 64 * j + crow(r, hi);
                if (kv > qabs || kv < qabs - 511) C0[r] = NEGM; if (kv + 32 > qabs || kv + 32 < qabs - 511) C1[r] = NEGM; }
        }
    }
}

template <int MODE, int PITCH, int THRL>
__device__ __forceinline__ void attn_fast(LDSB* lds, const bf16* Kh, const bf16* Vh, const LAS unsigned char* tl, int NT, const bf16x8 (&qr)[4], int qabs, int qw0, int cur,
                                          unsigned sel_lo, unsigned sel_hi, const LAS float* kbias, f32x16 (&o)[2], float& l_out, int wid, int lane) {
    const int r32 = lane & 31, hi = lane >> 5;
    const unsigned lds0 = (unsigned)(uintptr_t)lds;
    LAS float* wsf = (LAS float*)(lds + L_WS) + wid * 256;
    const bf16* ksrc = Kh + (size_t)lane * PITCH + wid * 8;
    const bf16* vsrc = Vh + (size_t)(16 * (wid & 3) + (lane >> 2)) * PITCH + (wid >> 2) * 32 + (lane & 3) * 8;
    const unsigned kdst = lds0 + L_K + wid * 1024, vdst = lds0 + L_V + wid * 1024;
#define TILE(t) __builtin_amdgcn_readfirstlane((int)tl[t])
#define DMA_K(t, slot) glds16(ksrc + (size_t)TILE(t) * (64 * PITCH), (unsigned)__builtin_amdgcn_readfirstlane(kdst + (slot)))
#define DMA_V(t, slot) glds16(vsrc + (size_t)TILE(t) * (64 * PITCH), (unsigned)__builtin_amdgcn_readfirstlane(vdst + (slot)))
    const LDSB* kp0 = lds + L_K + hi * 1024 + r32 * 16;
    const LDSB* vp0 = lds + L_V + ((lane >> 4) & 1) * 32 + (lane & 3) * 8 + (4 * hi + ((lane & 15) >> 2)) * 64;
    bf16x8 kf[8];
    float mhat = 0.f, l_reg = 0.f;
    f32x16 negm;
#pragma unroll
    for (int r = 0; r < 16; ++r) { negm[r] = 0.f; o[0][r] = 0.f; o[1][r] = 0.f; }
    asm volatile("" : "+v"(negm));
    bool resc = false;
    f32x16 pA0, pA1, pB0, pB1;
    int sl_prev = 0, sl_cur = 0, sl_next = SLOTB, sl_last = 0;
#define ROT() do { sl_prev = sl_cur; sl_cur = sl_next; sl_next = (sl_next == 2 * SLOTB) ? 0 : sl_next + SLOTB; } while (0)
#define RESC() do { if (resc) { LDS_WAIT(); \
        _Pragma("unroll") for (int d_ = 0; d_ < 2; ++d_) _Pragma("unroll") for (int r = 0; r < 16; ++r) o[d_][r] *= wsf[crow(r, hi)]; } } while (0)
#define ENDW(tt) do { if ((tt) + 3 < NT) { WAIT_BAR(2); } else if ((tt) + 2 < NT) { WAIT_BAR(1); } else { WAIT_BAR(0); } } while (0)
    DMA_K(0, 0); DMA_V(0, 0); if (NT > 1) DMA_K(1, SLOTB); if (NT > 2) DMA_K(2, 2 * SLOTB);
    if (NT > 2) { WAIT_BAR(3); } else if (NT > 1) { WAIT_BAR(2); } else { WAIT_BAR(1); }
    {
        const int j0 = TILE(0);
        qkt(pA0, pA1, lds + L_K, qr, negm, r32, hi);
        att_mod<MODE>(pA0, pA1, j0, qabs, qw0, cur, sel_lo, sel_hi, kbias, hi);
        const float rm = rowmax32(pA0, pA1);
        mhat += rm;
#pragma unroll
        for (int r = 0; r < 16; ++r) { pA0[r] -= rm; pA1[r] -= rm; negm[r] = -mhat; }
        asm volatile("" : "+v"(negm));
#pragma unroll
        for (int r = 0; r < 16; ++r) { pA0[r] = __builtin_amdgcn_exp2f(pA0[r]); pA1[r] = __builtin_amdgcn_exp2f(pA1[r]); }
    }
    WAIT_BAR(0);
    if (NT > 3) DMA_K(3, 0);
    if (NT > 1) DMA_V(1, SLOTB);
    ROT();
    if (NT > 1) kload8(kf, kp0 + sl_cur);
    ENDW(0);
    s16x4 vlo[8], vhi[8]; v4u pw0, pw1, pw2, pw3;
#define PKW(P, B) cvtpk_s(P[B], P[B + 1])
#define PAF(k) __builtin_bit_cast(bf16x8, pw##k)
#define VFR(i) (bf16x8){vlo[i][0], vlo[i][1], vlo[i][2], vlo[i][3], vhi[i][0], vhi[i][1], vhi[i][2], vhi[i][3]}
#define PIN(x) asm volatile("" : "+v"(x))
#define MX3(a, b, c) __builtin_fmaxf(__builtin_fmaxf((a), (b)), (c))
#define GAPA(MF, A0, A1, A2, A3, W0, W1, PW) do { MF; sacc += A0; sacc += A1; sacc += A2; sacc += A3; PIN(sacc); W0; W1; PIN(PW); SBAR(); } while (0)
#define EX(v) __builtin_amdgcn_exp2f(v)
#define GAPB(MF, X, B) do { MF; X[B] = EX(X[B]); X[B + 1] = EX(X[B + 1]); X[B + 2] = EX(X[B + 2]); X[B + 3] = EX(X[B + 3]); PIN(X); SBAR(); } while (0)
#define VRD(i) do { vlo[i] = vtr(vp_ + (((i) >> 2) * 4096 + ((i) & 3) * 1024)); vhi[i] = vtr(vp_ + (((i) >> 2) * 4096 + ((i) & 3) * 1024 + 512)); } while (0)
#define KRD(G, j) do { if (G) { kload2(kf, kp0 + sl_next, j); SBAR(); } } while (0)
#define MFMA32 __builtin_amdgcn_mfma_f32_32x32x16_bf16
#define STEP(C0, C1, P0, P1, t) do { const int jt_ = TILE(t); const bool GK_ = (t) + 3 < NT, GV_ = (t) + 1 < NT; sl_last = sl_cur; SBAR(); \
    const LDSB* vp_ = vp0 + sl_prev; \
    VRD(0); SBAR(); float sacc = (P0[0] + P0[1]); \
    GAPA(C0 = MFMA32(kf[0], qr[0], negm, 0, 0, 0), P0[2], P0[3], P0[4], P0[5],     pw0[0] = PKW(P0, 0), pw0[1] = PKW(P0, 2), pw0); \
    VRD(4); SBAR(); GAPA(C1 = MFMA32(kf[1], qr[0], negm, 0, 0, 0), P0[6], P0[7], P0[8], P0[9],     pw0[2] = PKW(P0, 4), pw0[3] = PKW(P0, 6), pw0); \
    VRD(1); SBAR(); GAPA(C0 = MFMA32(kf[2], qr[1], C0, 0, 0, 0),   P0[10], P0[11], P0[12], P0[13], pw1[0] = PKW(P0, 8), pw1[1] = PKW(P0, 10), pw1); \
    VRD(5); SBAR(); GAPA(C1 = MFMA32(kf[3], qr[1], C1, 0, 0, 0),   P0[14], P0[15], P1[0], P1[1],   pw1[2] = PKW(P0, 12), pw1[3] = PKW(P0, 14), pw1); \
    VRD(2); SBAR(); GAPA(C0 = MFMA32(kf[4], qr[2], C0, 0, 0, 0),   P1[2], P1[3], P1[4], P1[5],     pw2[0] = PKW(P1, 0), pw2[1] = PKW(P1, 2), pw2); \
    VRD(6); SBAR(); GAPA(C1 = MFMA32(kf[5], qr[2], C1, 0, 0, 0),   P1[6], P1[7], P1[8], P1[9],     pw2[2] = PKW(P1, 4), pw2[3] = PKW(P1, 6), pw2); \
    VRD(3); SBAR(); GAPA(C0 = MFMA32(kf[6], qr[3], C0, 0, 0, 0),   P1[10], P1[11], P1[12], P1[13], pw3[0] = PKW(P1, 8), pw3[1] = PKW(P1, 10), pw3); \
    VRD(7); SBAR(); GAPA(C1 = MFMA32(kf[7], qr[3], C1, 0, 0, 0),   P1[14], P1[15], 0.f, 0.f,       pw3[2] = PKW(P1, 12), pw3[3] = PKW(P1, 14), pw3); \
    l_reg += sacc; \
    if (GK_) { DMA_K((t) + 3, sl_cur); } if (GV_) { DMA_V((t) + 1, sl_next); } \
    att_mod<MODE>(C0, C1, jt_, qabs, qw0, cur, sel_lo, sel_hi, kbias, hi); \
    { float a = MX3(C0[0], C0[1], C1[0]), b = MX3(C0[2], C0[3], C1[1]); a = MX3(a, C1[2], C1[3]); \
      _Pragma("unroll") for (int r = 4; r < 16; r += 4) { a = MX3(a, C0[r], C0[r + 1]); b = MX3(b, C0[r + 2], C0[r + 3]); a = MX3(a, C1[r], C1[r + 1]); b = MX3(b, C1[r + 2], C1[r + 3]); } \
      float rm = xh_max(__builtin_fmaxf(a, b)); \
      resc = false; \
      if (__builtin_expect(__any(rm > (float)THRL), 0)) { const float dl = __builtin_fmaxf(rm, 0.f); mhat += dl; \
        _Pragma("unroll") for (int r = 0; r < 16; ++r) { C0[r] -= dl; C1[r] -= dl; } \
        _Pragma("unroll") for (int r = 0; r < 16; ++r) negm[r] = -mhat; asm volatile("" : "+v"(negm)); \
        const float f = __builtin_amdgcn_exp2f(-dl); l_reg *= f; if (hi == 0) wsf[r32] = f; resc = true; } } \
    SBAR(); \
    GAPB(o[0] = MFMA32(PAF(0), VFR(0), o[0], 0, 0, 0), C0, 0); \
    GAPB(o[1] = MFMA32(PAF(0), VFR(4), o[1], 0, 0, 0), C0, 4); \
    KRD(GV_, 0); GAPB(o[0] = MFMA32(PAF(1), VFR(1), o[0], 0, 0, 0), C0, 8); \
    KRD(GV_, 1); GAPB(o[1] = MFMA32(PAF(1), VFR(5), o[1], 0, 0, 0), C0, 12); \
    KRD(GV_, 2); GAPB(o[0] = MFMA32(PAF(2), VFR(2), o[0], 0, 0, 0), C1, 0); \
    KRD(GV_, 3); GAPB(o[1] = MFMA32(PAF(2), VFR(6), o[1], 0, 0, 0), C1, 4); \
    GAPB(o[0] = MFMA32(PAF(3), VFR(3), o[0], 0, 0, 0), C1, 8); \
    GAPB(o[1] = MFMA32(PAF(3), VFR(7), o[1], 0, 0, 0), C1, 12); \
    } while (0)
    int t = 1;
    for (; t + 1 < NT; t += 2) {
        STEP(pB0, pB1, pA0, pA1, t);     ENDW(t);     RESC(); ROT();
        STEP(pA0, pA1, pB0, pB1, t + 1); ENDW(t + 1); RESC(); ROT();
    }
    const LDSB* vlane_p = lds + L_V + ((lane >> 4) & 1) * 32 + (lane & 3) * 8 + (4 * hi + ((lane & 15) >> 2)) * 64;
    if (t < NT) {
        STEP(pB0, pB1, pA0, pA1, t); ENDW(t); RESC();
        l_reg += rowsum32(pB0, pB1);
        pv(o, vlane_p + sl_last, pB0, pB1);
    } else {
        l_reg += rowsum32(pA0, pA1);
        pv(o, vlane_p + sl_last, pA0, pA1);
    }
    l_out = xh_sum(l_reg);
    asm volatile("s_waitcnt lgkmcnt(0)\n\ts_barrier" ::: "memory");
#undef TILE
#undef DMA_K
#undef DMA_V
#undef ROT
#undef RESC
#undef ENDW
#undef PKW
#undef PAF
#undef VFR
#undef PIN
#undef MX3
#undef GAPA
#undef EX
#undef GAPB
#undef VRD
#undef KRD
#undef MFMA32
#undef STEP
}

__device__ __forceinline__ void load_rowvec(float (&fac)[16], const LAS float* tab, int hi) {
#pragma unroll
    for (int g4 = 0; g4 < 4; ++g4) { const f32x4 ff = *(const LAS f32x4*)(tab + 8 * g4 + 4 * hi);
#pragma unroll
        for (int i = 0; i < 4; ++i) fac[4 * g4 + i] = ff[i]; }
}

template <int PITCHO>
__device__ __forceinline__ void store_o_tile(LDSB* stage, const f32x16 (&o)[2], bf16* Ow, int lane) {
    const int r32 = lane & 31, hi = lane >> 5;
    LAS bf16* stg = (LAS bf16*)stage;
#pragma unroll
    for (int r = 0; r < 16; ++r) { const int orow = crow(r, hi);
#pragma unroll
        for (int d0 = 0; d0 < 2; ++d0) stg[orow * 64 + d0 * 32 + r32] = (bf16)f2bf(o[d0][r]); }
    LDS_WAIT();
#pragma unroll
    for (int i = 0; i < 4; ++i) { const int row = i * 8 + (lane >> 3), ch = lane & 7; const v4u v = *(const LAS v4u*)(stg + row * 64 + ch * 8); *(v4u*)(Ow + (size_t)row * PITCHO + ch * 8) = v; }
    LDS_WAIT();
}

__device__ __forceinline__ void fox_unit(Frame& F0, int b, int h, int qb) {
    struct { unsigned char* ws; LDSB* lds; int tid, wave; } F; F.ws = F0.ws; F.lds = F0.lds; F.tid = F0.tid; F.wave = F0.wave;
    asm volatile("" : "+s"(F.ws));
    LDSB* lds = F.lds; int tid_ = F.tid; asm volatile("" : "+v"(tid_));
    const int tid = tid_, lane = tid & 63, wid = F.wave, r32 = lane & 31, hi = lane >> 5;
    const int q0 = 256 * qb, NT = 4 * qb + 4;
    const float* cb = (const float*)(F.ws + WS_CB) + (size_t)(b * 8 + h) * SEQ;
    LAS float* kb = (LAS float*)(lds + L_ACC);
    for (int i = tid; i < q0 + 256; i += NTHR) kb[i] = cb[i];
    LAS unsigned char* tl = (LAS unsigned char*)(lds + L_TL);
    if (tid < NT) tl[tid] = (unsigned char)(NT - 1 - tid);
    const bf16* Qw = (const bf16*)(F.ws + WS_QF) + ((size_t)b * SEQ + q0 + 32 * wid) * 512 + h * 64;
    bf16x8 qr[4];
#pragma unroll
    for (int d0 = 0; d0 < 4; ++d0) qr[d0] = *(const bf16x8*)(Qw + (size_t)r32 * 512 + d0 * 16 + hi * 8);
    __syncthreads();
    const bf16* Kh = (const bf16*)(F.ws + WS_KF) + (size_t)b * SEQ * 512 + h * 64;
    const bf16* Vh = (const bf16*)(F.ws + WS_VF) + (size_t)b * SEQ * 512 + h * 64;
    f32x16 o[2]; float l;
    attn_fast<0, 512, 8>(lds, Kh, Vh, tl, NT, qr, q0 + 32 * wid + r32, q0 + 32 * wid, 0, 0u, 0u, kb, o, l, wid, lane);
    LAS float* wsf = (LAS float*)(lds + L_WS) + wid * 256;
    if (hi == 0) wsf[32 + r32] = 1.f / l;
    LDS_WAIT();
    float fac[16]; load_rowvec(fac, wsf + 32, hi);
#pragma unroll
    for (int r = 0; r < 16; ++r) { o[0][r] *= fac[r]; o[1][r] *= fac[r]; }
    bf16* Ow = (bf16*)(F.ws + WS_Y) + ((size_t)b * SEQ + q0 + 32 * wid) * 1024 + h * 64;
    store_o_tile<1024>(lds + L_ACC + 16384 + wid * 4096, o, Ow, lane);
    __syncthreads();
}

__device__ __forceinline__ void nsa_unit(Frame& F0, int b, int g, int cur) {
    struct { unsigned char* ws; LDSB* lds; int tid, wave; } F; F.ws = F0.ws; F.lds = F0.lds; F.tid = F0.tid; F.wave = F0.wave;
    asm volatile("" : "+s"(F.ws));
    LDSB* lds = F.lds; int tid_ = F.tid; asm volatile("" : "+v"(tid_));
    const int tid = tid_, lane = tid & 63, wid = F.wave, r32 = lane & 31, hi = lane >> 5;
    const int bg = b * 2 + g, hh = wid >> 1, head = 4 * g + hh, qh = wid & 1, qq = 32 * qh + r32, qpos = 64 * cur + qq;
    const unsigned lds0 = (unsigned)(uintptr_t)lds;
    LAS float* wsf = (LAS float*)(lds + L_WS) + wid * 256;
    LAS float* accw = (LAS float*)(lds + L_ACC) + wid * 2048;
    const size_t row0 = (size_t)b * SEQ + 64 * cur + 32 * qh;
    const bf16* Qw = (const bf16*)(F.ws + WS_QN) + row0 * 512 + head * 64;
    bf16x8 qr[4];
#pragma unroll
    for (int d0 = 0; d0 < 4; ++d0) qr[d0] = *(const bf16x8*)(Qw + (size_t)r32 * 512 + d0 * 16 + hi * 8);
    if (tid < 2) ((LAS unsigned*)(lds + L_TL + 128))[tid] = 0u;
    if (lane < 32) { const float* gp = (const float*)(F.ws + WS_GATE) + (row0 + lane) * 24 + head * 3;
        wsf[64 + lane] = gp[0]; wsf[96 + lane] = gp[1]; wsf[128 + lane] = gp[2]; }
    LDS_WAIT();
    {
        const bf16* Kc = (const bf16*)(F.ws + WS_KCMP) + (size_t)bg * 256 * 64;
        const bf16* Vc = (const bf16*)(F.ws + WS_VCMP) + (size_t)bg * 256 * 64;
        const int ntl = (4 * cur + 66) >> 6;
#pragma unroll
        for (int tl = 0; tl < 4; ++tl) if (tl < ntl) dma_kv<64>(Kc, Vc, 64 * tl, lds0 + L_K + tl * SLOTB, lds0 + L_V + tl * SLOTB, wid, lane);
        WAIT_BAR(0);
        f32x16 zero;
#pragma unroll
        for (int r = 0; r < 16; ++r) zero[r] = 0.f;
        float mrun = -1e30f;
#pragma unroll 1
        for (int tl = 0; tl < ntl; ++tl) {
            f32x16 p0, p1;
            qkt(p0, p1, lds + L_K + tl * SLOTB, qr, zero, r32, hi);
#pragma unroll
            for (int r = 0; r < 16; ++r) { const int c = 64 * tl + crow(r, hi); if (16 * c + 31 > qpos) p0[r] = NEGM; if (16 * (c + 32) + 31 > qpos) p1[r] = NEGM; }
            mrun = fmaxf(mrun, rowmax32(p0, p1));
            asm volatile("" ::: "memory");
        }
        f32x16 o[2];
#pragma unroll
        for (int r = 0; r < 16; ++r) { o[0][r] = 0.f; o[1][r] = 0.f; }
        float impv[4][8]; float prevY3 = 0.f, lsum = 0.f;
        const int vlane = ((lane >> 4) & 1) * 32 + (lane & 3) * 8 + (4 * hi + ((lane & 15) >> 2)) * 64;
#pragma unroll
        for (int tl = 0; tl < 4; ++tl) {
            if (tl < ntl) {
                f32x16 p0, p1;
                qkt(p0, p1, lds + L_K + tl * SLOTB, qr, zero, r32, hi);
#pragma unroll
                for (int r = 0; r < 16; ++r) { const int c = 64 * tl + crow(r, hi);
                    p0[r] = (16 * c + 31 > qpos) ? 0.f : __builtin_amdgcn_exp2f(p0[r] - mrun);
                    p1[r] = (16 * (c + 32) + 31 > qpos) ? 0.f : __builtin_amdgcn_exp2f(p1[r] - mrun); }
                lsum += rowsum32(p0, p1);
                float rX[4], rY[4];
#pragma unroll
                for (int g4 = 0; g4 < 4; ++g4) { rX[g4] = xh_other(p0[4 * g4 + 3], hi); rY[g4] = xh_other(p1[4 * g4 + 3], hi); }
#pragma unroll
                for (int g4 = 0; g4 < 4; ++g4) {
                    const float qs0 = (p0[4 * g4] + p0[4 * g4 + 1]) + (p0[4 * g4 + 2] + p0[4 * g4 + 3]);
                    const float qs1 = (p1[4 * g4] + p1[4 * g4 + 1]) + (p1[4 * g4 + 2] + p1[4 * g4 + 3]);
                    const float lo0 = (g4 > 0) ? rX[g4 > 0 ? g4 - 1 : 0] : prevY3;
                    const float lo1 = (g4 > 0) ? rY[g4 > 0 ? g4 - 1 : 0] : rX[3];
                    impv[tl][g4] = qs0 + (hi ? rX[g4] : lo0);
                    impv[tl][4 + g4] = qs1 + (hi ? rY[g4] : lo1);
                }
                prevY3 = rY[3];
                pv(o, lds + L_V + tl * SLOTB + vlane, p0, p1);
                asm volatile("" ::: "memory");
            } else {
#pragma unroll
                for (int e = 0; e < 8; ++e) impv[tl][e] = 0.f;
            }
        }
        const float ltot = xh_sum(lsum);
        const float invl = ltot > 0.f ? 1.f / ltot : 0.f;
        LAS float* imp = (LAS float*)(lds + L_IMP);
#pragma unroll
        for (int hd = 0; hd < 4; ++hd) {
            if (hh == hd) {
#pragma unroll
                for (int tl = 0; tl < 4; ++tl)
#pragma unroll
                    for (int e = 0; e < 8; ++e) { const int jj = 16 * tl + 8 * (e >> 2) + 2 * (e & 3) + hi; LAS float* p = imp + qq * 65 + jj;
                        if (hd == 0) *p = impv[tl][e] * invl; else *p += impv[tl][e] * invl; }
            }
            LDS_WAIT(); __syncthreads();
        }
        if (hi == 0) wsf[32 + r32] = invl;
        LDS_WAIT();
        float gc[16], il[16]; load_rowvec(gc, wsf + 64, hi); load_rowvec(il, wsf + 32, hi);
#pragma unroll
        for (int d0 = 0; d0 < 2; ++d0)
#pragma unroll
            for (int r = 0; r < 16; ++r) accw[(d0 * 16 + r) * 64 + lane] = o[d0][r] * (gc[r] * il[r]);
        LDS_WAIT();
    }
    if (cur >= 16) {
        LAS float* imp = (LAS float*)(lds + L_IMP);
        const int q = tid >> 3, part = tid & 7;
        if (part == 0) { imp[q * 65] += 1e4f; imp[q * 65 + cur] += 1e4f; imp[q * 65 + cur - 1] += 1e4f; }
        LDS_WAIT(); __syncthreads();
        const LAS float* irow = imp + q * 65;
        float sc[8];
#pragma unroll
        for (int i = 0; i < 8; ++i) { const int jj = part * 8 + i; sc[i] = (jj <= cur) ? irow[jj] : -1.f; }
        int rank[8];
#pragma unroll
        for (int i = 0; i < 8; ++i) rank[i] = 0;
        const int nv = cur + 1, e0 = (8 * part < nv) ? 8 * part : nv, e1 = (8 * part + 8 < nv) ? 8 * part + 8 : nv;
        for (int jp = 0; jp < e0; ++jp) { const float v = irow[jp];
#pragma unroll
            for (int i = 0; i < 8; ++i) rank[i] += (v >= sc[i]) ? 1 : 0; }
        for (int jp = e0; jp < e1; ++jp) { const float v = irow[jp];
#pragma unroll
            for (int i = 0; i < 8; ++i) { const int jj = part * 8 + i; rank[i] += (v > sc[i] || (v == sc[i] && jp < jj)) ? 1 : 0; } }
        for (int jp = e1; jp < nv; ++jp) { const float v = irow[jp];
#pragma unroll
            for (int i = 0; i < 8; ++i) rank[i] += (v > sc[i]) ? 1 : 0; }
        unsigned bits = 0;
#pragma unroll
        for (int i = 0; i < 8; ++i) bits |= (rank[i] < 16 ? 1u : 0u) << i;
        ((LAS unsigned char*)(lds + L_SEL))[q * 8 + part] = (unsigned char)bits;
        __hip_atomic_fetch_or((LAS unsigned*)(lds + L_TL + 128) + (part >> 2), bits << (8 * (part & 3)), __ATOMIC_RELAXED, __HIP_MEMORY_SCOPE_WORKGROUP);
        LDS_WAIT(); __syncthreads();
    } else {
        if (tid < 128) ((LAS unsigned*)(lds + L_SEL))[tid] = (tid & 1) ? 0u : ((1u << (cur + 1)) - 1u);
        if (tid == 0) ((LAS unsigned*)(lds + L_TL + 128))[0] = (1u << (cur + 1)) - 1u;
        LDS_WAIT(); __syncthreads();
    }
    const LAS unsigned* selw = (const LAS unsigned*)(lds + L_SEL);
    const unsigned sel_lo = selw[qq * 2], sel_hi = selw[qq * 2 + 1];
    const unsigned ulo = ((const LAS unsigned*)(lds + L_TL + 128))[0], uhi = ((const LAS unsigned*)(lds + L_TL + 128))[1];
    unsigned long long umask = ((unsigned long long)uhi << 32) | ulo;
    umask &= (cur >= 63) ? ~0ull : ((1ull << (cur + 1)) - 1ull);
    const int jlo = cur >= 8 ? cur - 8 : 0;
    LAS unsigned char* tls = (LAS unsigned char*)(lds + L_TL);
    LAS unsigned char* tlw = tls + 64;
    if (tid < 64) {
        if ((umask >> tid) & 1ull) tls[__builtin_popcountll(umask & ((1ull << tid) - 1ull))] = (unsigned char)tid;
        if (tid <= cur - jlo) tlw[tid] = (unsigned char)(jlo + tid);
    }
    LDS_WAIT(); __syncthreads();
    const int NTs = __builtin_amdgcn_readfirstlane(__builtin_popcountll(umask)), NTw = cur - jlo + 1;
    {
        const bf16* Kh = (const bf16*)(F.ws + WS_KS) + (size_t)bg * SEQ * 64;
        const bf16* Vh = (const bf16*)(F.ws + WS_VS) + (size_t)bg * SEQ * 64;
        f32x16 o[2]; float l;
        attn_fast<1, 64, 8>(lds, Kh, Vh, tls, NTs, qr, qpos, 0, cur, sel_lo, sel_hi, nullptr, o, l, wid, lane);
        if (hi == 0) wsf[32 + r32] = 1.f / l;
        LDS_WAIT();
        float fl[16], gs[16]; load_rowvec(fl, wsf + 32, hi); load_rowvec(gs, wsf + 96, hi);
#pragma unroll
        for (int d0 = 0; d0 < 2; ++d0)
#pragma unroll
            for (int r = 0; r < 16; ++r) accw[(d0 * 16 + r) * 64 + lane] += o[d0][r] * (fl[r] * gs[r]);
        LDS_WAIT();
    }
    {
        const bf16* Kh = (const bf16*)(F.ws + WS_KW) + (size_t)bg * SEQ * 64;
        const bf16* Vh = (const bf16*)(F.ws + WS_VW) + (size_t)bg * SEQ * 64;
        f32x16 o[2]; float l;
        attn_fast<2, 64, 8>(lds, Kh, Vh, tlw, NTw, qr, qpos, 0, cur, 0u, 0u, nullptr, o, l, wid, lane);
        if (hi == 0) wsf[32 + r32] = 1.f / l;
        LDS_WAIT();
        float fl[16], gate_win[16]; load_rowvec(fl, wsf + 32, hi); load_rowvec(gate_win, wsf + 128, hi);
#pragma unroll
        for (int d0 = 0; d0 < 2; ++d0)
#pragma unroll
            for (int r = 0; r < 16; ++r) o[d0][r] = accw[(d0 * 16 + r) * 64 + lane] + o[d0][r] * (fl[r] * gate_win[r]);
        LDS_WAIT();
        bf16* Ow = (bf16*)(F.ws + WS_Y) + row0 * 1024 + 512 + head * 64;
        store_o_tile<1024>((LDSB*)accw, o, Ow, lane);
    }
    __syncthreads();
}

__device__ __forceinline__ void dep_publish(Frame& F, gu32* w0, gu32* w1) {
    asm volatile("s_waitcnt vmcnt(0)" ::: "memory"); __syncthreads();
    if (F.tid == 0) { __builtin_amdgcn_fence(__ATOMIC_RELEASE, "agent"); asm volatile("s_waitcnt vmcnt(0)" ::: "memory");
        __hip_atomic_fetch_add(w0, 1u, RLX_AGENT); if (w1) __hip_atomic_fetch_add(w1, 1u, RLX_AGENT); }
}
__device__ __forceinline__ void dep_wait(Frame& F, gu32* w, unsigned need, gu32* wall, unsigned needall, int flagword) {
    if (F.wave == 0) {
        unsigned sp = 0;
        while ((unsigned)__builtin_amdgcn_readfirstlane((int)__hip_atomic_load(w, RLX_AGENT)) < need) { __builtin_amdgcn_s_sleep(4); if (++sp > (1u << 22)) break; }
        const unsigned tot = wall ? (unsigned)__builtin_amdgcn_readfirstlane((int)__hip_atomic_load(wall, RLX_AGENT)) : 0u;
        __builtin_amdgcn_fence(__ATOMIC_ACQUIRE, "agent");
        asm volatile("s_waitcnt vmcnt(0)" ::: "memory");
        if (F.lane == 0 && (!wall || tot >= needall)) F.MISC[flagword] = 1u;
    }
    LDS_WAIT(); __syncthreads();
}

constexpr int NSA_COST0 = 24;
__device__ __forceinline__ void p3_attention(Frame& F, kptr_t kp) {
    LAS unsigned short* order = (LAS unsigned short*)(F.lds + L_ORD);
    for (int id = F.tid; id < 2048; id += NTHR) {
        int pos;
        if (id >= 1024 && ((id - 1024) >> 6) < 2) pos = id - 1024;
        else {
            const int c = id < 1024 ? (63 - (id >> 4)) + NSA_COST0 : 4 * (15 - ((id - 1024) >> 6)) + 4;
            pos = 128;
            { int lo = c - NSA_COST0 + 1; if (lo < 0) lo = 0; int cnt = 64 - lo; if (cnt < 0) cnt = 0; pos += 16 * cnt; }
            { int cnt = 0; for (int qb = 0; qb < 14; ++qb) cnt += (4 * qb + 4 > c) ? 1 : 0; pos += 64 * cnt; }
            if (id < 1024) pos += (id & 15);
            else { const int cn = c - NSA_COST0; if (cn >= 0 && cn <= 63) pos += 16; pos += (id & 63); }
        }
        order[pos] = (unsigned short)id;
    }
    if (F.vcu < 8) { p2_cumsum_item(F, F.vcu * NWAVES + F.wave); dep_publish(F, F.ctl + CW_CS, nullptr); }
    LDS_WAIT(); __syncthreads();
    if (F.vcu >= F.G - 128 || F.G < 136) {
        for (int it = (F.G < 136) ? F.vcu : F.vcu - (F.G - 128); it < 128; it += (F.G < 136) ? F.G : 128) {
            p2_compress_item(F, kp, it);
            dep_publish(F, F.ctl + CW_CMP + 64 * ((it >> 2) & 15), F.ctl + CW_CMPT);
        }
    }
    gu32* qhead = F.ctl + CW_Q_ATT;
    for (;;) {
        if (F.tid == 0) F.MISC[0] = __hip_atomic_fetch_add(qhead, 1u, RLX_AGENT);
        LDS_WAIT(); __syncthreads();
        const unsigned k = F.MISC[0];
        if (k >= 2048u) break;
        const int id = (int)order[k];
        __syncthreads();
        if (id < 1024) {
            if (F.MISC[17] == 0u) dep_wait(F, F.ctl + CW_CMP + 64 * (id & 15), 8u, F.ctl + CW_CMPT, 128u, 17);
            nsa_unit(F, (id & 15) >> 1, id & 1, 63 - (id >> 4));
        } else {
            if (F.MISC[16] == 0u) dep_wait(F, F.ctl + CW_CS, 8u, nullptr, 0u, 16);
            fox_unit(F, (id & 63) >> 3, id & 7, 15 - ((id - 1024) >> 6));
        }
    }
}

__device__ __forceinline__ void p4_ynorm(Frame& F) {
    const int gw = F.vcu * NWAVES + F.wave, NGW = F.G * NWAVES;
    for (int m = gw; m < T; m += NGW) {
        bf16* row = (bf16*)(F.ws + WS_Y) + (size_t)m * 1024 + F.lane * 16;
        v4u a = *(const v4u*)row, b = *(const v4u*)(row + 8);
        float v[16];
        const unsigned w[8] = {a.x, a.y, a.z, a.w, b.x, b.y, b.z, b.w};
#pragma unroll
        for (int i = 0; i < 8; ++i) { v[2 * i] = __builtin_bit_cast(float, w[i] << 16); v[2 * i + 1] = __builtin_bit_cast(float, w[i] & 0xffff0000u); }
        float s = 0.f;
#pragma unroll
        for (int i = 0; i < 16; ++i) s += v[i] * v[i];
#pragma unroll
        for (int o = 1; o < 32; o <<= 1) s += __shfl_xor(s, o);
        const float r = 1.f / sqrtf(s * (1.f / 512.f) + EPS);
        v4u oa, ob;
        oa.x = pk2(v[0] * r, v[1] * r); oa.y = pk2(v[2] * r, v[3] * r); oa.z = pk2(v[4] * r, v[5] * r); oa.w = pk2(v[6] * r, v[7] * r);
        ob.x = pk2(v[8] * r, v[9] * r); ob.y = pk2(v[10] * r, v[11] * r); ob.z = pk2(v[12] * r, v[13] * r); ob.w = pk2(v[14] * r, v[15] * r);
        *(v4u*)row = oa; *(v4u*)(row + 8) = ob;
    }
}
__device__ __forceinline__ void p6_hnorm(Frame& F, const float* h1) {
    const int gw = F.vcu * NWAVES + F.wave, NGW = F.G * NWAVES;
    for (int m = gw; m < T; m += NGW) rms_row_to_bf16(F.lane, h1 + (size_t)m * DM, (bf16*)(F.ws + WS_XN) + (size_t)m * DM);
}
__device__ __forceinline__ void p9_final(Frame& F, float* out, const float* g_final) {
    const int gw = F.vcu * NWAVES + F.wave, NGW = F.G * NWAVES;
    for (int m = gw; m < T; m += NGW) {
        GAS f32x4* xr = (GAS f32x4*)(out + (size_t)m * DM) + F.lane;
        f32x4 v[4]; float s = 0.f;
#pragma unroll
        for (int j = 0; j < 4; ++j) { v[j] = xr[64 * j]; s += (v[j].x * v[j].x + v[j].y * v[j].y) + (v[j].z * v[j].z + v[j].w * v[j].w); }
        const float r = 1.f / sqrtf(wave_sum(s) * (1.f / DM) + EPS);
#pragma unroll
        for (int j = 0; j < 4; ++j) { const f32x4 gg = *((const f32x4*)g_final + F.lane + 64 * j); xr[64 * j] = v[j] * r * gg; }
    }
}

constexpr int N_PHASES = 10;
__global__ void __launch_bounds__(NTHR, 2) hymba_fwd(Args args) {
    extern __shared__ __attribute__((aligned(16))) unsigned char lds_raw[];
    Frame F;
    F.lds = (LDSB*)lds_raw;
    F.MISC = (volatile LAS unsigned*)(F.lds + L_MISC);
    F.tid = threadIdx.x; F.lane = F.tid & 63; F.wave = __builtin_amdgcn_readfirstlane(F.tid >> 6);
    F.G = gridDim.x; { const int bx = blockIdx.x; F.vcu = (F.G % 8 == 0) ? (bx % 8) * (F.G / 8) + bx / 8 : bx; }
    kptr_t kp0 = (kptr_t)__builtin_amdgcn_kernarg_segment_ptr();
#define KP() ({ kptr_t k_ = kp0; asm volatile("" : "+s"(k_)); k_; })
    { kptr_t kp = KP(); F.ws = *(unsigned char* const __attribute__((address_space(4)))*)(kp + 8 * 23); }
    F.ctl = (gu32*)(F.ws + WS_CTL);
    if (F.tid < 64) F.MISC[F.tid] = 0u;
    __syncthreads();
    int lo, hi; { kptr_t kp = KP(); lo = *(const int __attribute__((address_space(4)))*)(kp + 192); hi = *(const int __attribute__((address_space(4)))*)(kp + 196); }
    const bool one_launch = (hi - lo) > 1;
    XcdBarrier bar; bar.bar = (unsigned*)(F.ctl + CW_BAR); bar.x = 0; bar.st = nullptr; bar.wave = F.wave;
    if (one_launch) { bar = xcd_barrier_post((unsigned*)(F.ctl + CW_BAR), F.MISC + 8); bar.wave = F.wave; }
#ifdef PHASE_MASK
#define IN(k) (((PHASE_MASK >> (k)) & 1) && lo <= (k) && (k) < hi)
#else
#define IN(k) (lo <= (k) && (k) < hi)
#endif
#define SEAM(k) do { if (IN(k) && IN((k) + 1)) xcd_barrier(bar); } while (0)
#define RELANE() do { F.lane = lane_id(); F.tid = F.wave * 64 + F.lane; } while (0)

    if (IN(0)) { RELANE(); p0_prologue(F, KP()); SEAM(0); }

    if (IN(1)) { RELANE();
        pg8::Gemm g{(const bf16*)(F.ws + WS_XN), (const bf16*)(F.ws + WS_WIN), T, NPROJ, DM}; pg8::StaticOrder S; S.init(T, NPROJ, F.G, (int)blockIdx.x);
        kptr_t kp = KP(); EpiProj E{F.ws, AIN(kp, 3), AIN(kp, 4)};
        pg8::gemm_phase<EpiProj, pg8::StaticOrder, true, true>(F.lds, g, S, E, F.wave);
        if (IN(1) && IN(3)) xcd_barrier(bar);
    }

    if (IN(3)) { RELANE(); p3_attention(F, KP()); SEAM(3); }

    if (IN(4)) { RELANE(); p4_ynorm(F); SEAM(4); }

    if (IN(5)) { RELANE();
        pg8::Gemm g{(const bf16*)(F.ws + WS_Y), (const bf16*)(F.ws + WS_WOUT), T, DM, DM}; pg8::StaticOrder S; S.init(T, DM, F.G, (int)blockIdx.x);
        kptr_t kp = KP(); EpiOutRes E{AIN(kp, 0), *(float* const __attribute__((address_space(4)))*)(kp + 8 * 22), (bf16*)(F.ws + WS_XN), (float*)(F.ws + WS_SSQ1), F.lds};
        pg8::gemm_phase<EpiOutRes, pg8::StaticOrder, true, true>(F.lds, g, S, E, F.wave);
        if (IN(5) && IN(7)) xcd_barrier(bar);
    }


    if (IN(7)) { RELANE();
        pg8::Gemm g{(const bf16*)(F.ws + WS_XN), (const bf16*)(F.ws + WS_WUP), T, FF, DM}; pg8::StaticOrder S; S.init(T, FF, F.G, (int)blockIdx.x);
        EpiUp E{(bf16*)(F.ws + WS_U), (const float*)(F.ws + WS_SSQ1)};
        pg8::gemm_phase<EpiUp, pg8::StaticOrder, true, true>(F.lds, g, S, E, F.wave);
        SEAM(7);
    }

    if (IN(8)) { RELANE();
        pg8::Gemm g{(const bf16*)(F.ws + WS_U), (const bf16*)(F.ws + WS_WDN), T, DM, FF}; pg8::StaticOrder S; S.init(T, DM, F.G, (int)blockIdx.x);
        kptr_t kp = KP(); EpiDownRes E{*(float* const __attribute__((address_space(4)))*)(kp + 8 * 22)};
        pg8::gemm_phase<EpiDownRes, pg8::StaticOrder, true, true>(F.lds, g, S, E, F.wave);
        SEAM(8);
    }

    if (IN(9)) { RELANE(); { kptr_t kp = KP(); p9_final(F, *(float* const __attribute__((address_space(4)))*)(kp + 8 * 22), AIN(kp, 21)); } }
#undef IN
#undef SEAM
}

extern "C" void kernel_launch(void* const* d_in, const int* in_sizes, int n_in, void* d_out, int out_size, void* d_ws, size_t ws_size, hipStream_t stream) {
    static int grid = 0;
    if (grid == 0) {
        if (n_in != 22 || out_size != T * DM || ws_size < WS_END) { fprintf(stderr, "kernel_launch: unexpected shapes (n_in %d out %d ws %zu)\n", n_in, out_size, ws_size); grid = -1; return; }
        int dev = 0, cus = 0, per_cu = 0;
        if (hipGetDevice(&dev) != hipSuccess || hipDeviceGetAttribute(&cus, hipDeviceAttributeMultiprocessorCount, dev) != hipSuccess) { grid = -1; return; }
        if (hipFuncSetAttribute((const void*)hymba_fwd, hipFuncAttributeMaxDynamicSharedMemorySize, LDS_BYTES) != hipSuccess) { fprintf(stderr, "kernel_launch: hipFuncSetAttribute failed\n"); grid = -1; return; }
        if (hipOccupancyMaxActiveBlocksPerMultiprocessor(&per_cu, (const void*)hymba_fwd, NTHR, LDS_BYTES) != hipSuccess || per_cu < 1) { fprintf(stderr, "kernel_launch: occupancy query says %d\n", per_cu); per_cu = 1; }
        (void)hipGetLastError();
        grid = cus;
    }
    if (grid < 0) return;
    (void)hipMemsetAsync((char*)d_ws + WS_CTL, 0, CTL_ZERO_BYTES, stream);
    Args a{};
    for (int i = 0; i < 22; ++i) a.in[i] = (const float*)d_in[i];
    a.out = (float*)d_out; a.ws = (unsigned char*)d_ws;
#if MK_N_LAUNCHES == 1
    a.ph_lo = 0; a.ph_hi = N_PHASES;
    void* kargs[] = {&a};
    hipError_t e = hipLaunchCooperativeKernel((const void*)hymba_fwd, dim3(grid), dim3(NTHR), kargs, LDS_BYTES, stream);
    if (e != hipSuccess) fprintf(stderr, "kernel_launch: cooperative launch failed: %s (grid %d)\n", hipGetErrorString(e), grid);
#else
    for (int p = 0; p < N_PHASES; ++p) { a.ph_lo = p; a.ph_hi = p + 1; hipLaunchKernelGGL(hymba_fwd, dim3(grid), dim3(NTHR), LDS_BYTES, stream, a); }
#endif
}
```

```cpp
#include <hip/hip_runtime.h>
#include <hip/hip_bf16.h>
#include <cstdio>
#include <cstdint>

#ifndef MK_N_LAUNCHES
#define MK_N_LAUNCHES 1
#endif

__device__ __forceinline__ int lane_id() { return (int)__builtin_amdgcn_mbcnt_hi(~0u, __builtin_amdgcn_mbcnt_lo(~0u, 0u)); }
namespace pg8 {
#define PG8_LAS __attribute__((address_space(3)))
typedef unsigned short bf16_t;
typedef short bf16x8 __attribute__((ext_vector_type(8)));
typedef float f32x4 __attribute__((ext_vector_type(4)));
typedef unsigned u32x4 __attribute__((ext_vector_type(4)));
constexpr int BM = 256, BK = 64, HALF = 128, HTB = HALF * BK * 2, STAGE_BYTES = 8 * HTB, NXCD = 8, WGM = 8;

__host__ __device__ __forceinline__ int lds_byte(int r, int c) { const int st = (r >> 4) * 2 + (c >> 5), rr = r & 15, cc = c & 31, ob = rr * 64 + cc * 2; return st * 1024 + (ob ^ (((ob >> 9) & 1) << 5)); }
__host__ __device__ __forceinline__ void stage_rc(int b, int& R, int& C) { const int st = b / 1024, sb = b % 1024, swz = sb ^ (((sb >> 9) & 1) << 5); R = (st >> 1) * 16 + swz / 64; C = (st & 1) * 32 + (swz % 64) / 2; }
__host__ __device__ __forceinline__ int perm32(int rho) { const int n = rho >> 4, i = rho & 15; return 8 * (i >> 2) + 4 * n + (i & 3); }

struct Unit { int pm, pn; };
struct Gemm { const bf16_t* A; const bf16_t* Bt; int M, N, K; };

struct StaticOrder {
    int nM, nN, nwg, G, c;
    __host__ __device__ void init(int M, int N, int G_, int c_) { nM = M / BM; nN = N / BM; nwg = nM * nN; G = G_; c = c_; }
    __host__ __device__ bool next(int i, Unit& u) const {
        const long L = (long)i * G + c; if (L >= nwg) return false;
        int wgid = (int)L; { const int q = nwg / NXCD, r = nwg % NXCD, xcd = wgid % NXCD, off = wgid / NXCD; wgid = (xcd < r ? xcd * (q + 1) : r * (q + 1) + (xcd - r) * q) + off; }
        const int nig = WGM * nN, gid = wgid / nig, fm = gid * WGM, gsz = (nM - fm) < WGM ? (nM - fm) : WGM;
        u.pm = fm + ((wgid % nig) % gsz); u.pn = (wgid % nig) / gsz; return true;
    }
    __device__ __forceinline__ void a_ready(const Unit&) const {}
    __device__ __forceinline__ void done(const Unit&) const {}
};

__device__ __forceinline__ unsigned cvt_pk_bf16(float lo, float hi) { unsigned r; asm volatile("v_cvt_pk_bf16_f32 %0, %1, %2" : "=v"(r) : "v"(lo), "v"(hi)); return r; }

template <class Epi, class Sched, bool ALIGN_EPI = false, bool SP2 = false>
__device__ __forceinline__ void gemm_phase(PG8_LAS unsigned char* lds, const Gemm g, const Sched& S, const Epi& E, int wave_id) {
    const int wid = wave_id, lane = lane_id(), tid = wid * 64 + lane, wr = wid >> 2, wc = wid & 3, fr = lane & 15, fq = lane >> 4;
    const int K = g.K, nt = K / BK;
    unsigned voffA[2], voffB[2];
#pragma unroll
    for (int i = 0; i < 2; ++i) { int R, C; stage_rc(tid * 16 + i * 8192, R, C); const int Rb = Epi::PERM ? ((R & ~31) + perm32(R & 31)) : R;
        voffA[i] = (unsigned)(R * K + C) * 2u; voffB[i] = (unsigned)(Rb * K + C) * 2u; }
    const size_t kstep = (size_t)(BK * 2);
    const size_t hstep = (size_t)HALF * K * 2;
    const size_t tstep = 2 * hstep;
    const unsigned ldsw = (unsigned)wid * 1024u;
    const int aoff = lds_byte(wr * 64 + fr, fq * 8), boff = lds_byte(wc * 32 + fr, fq * 8);
#define PG8_SA(b, h) (((b) * 2 + (h)) * HTB)
#define PG8_SB(b, h) ((4 + (b) * 2 + (h)) * HTB)
#define PG8_STAGE(bufoff, gbase, voff) do { _Pragma("unroll") for (int _i = 0; _i < 2; ++_i) \
        __builtin_amdgcn_global_load_lds((const unsigned*)((const char*)(gbase) + (voff)[_i]), (PG8_LAS unsigned*)(lds + (bufoff) + ldsw + _i * 8192), 16, 0, 0); } while (0)
#define PG8_LDA(dst, b, h) do { _Pragma("unroll") for (int m = 0; m < 4; ++m) _Pragma("unroll") for (int k = 0; k < 2; ++k) dst[m][k] = *(const PG8_LAS bf16x8*)(lds + PG8_SA(b, h) + aoff + m * 2048 + k * 1024); } while (0)
#define PG8_LDB(dst, b, h) do { _Pragma("unroll") for (int n = 0; n < 2; ++n) _Pragma("unroll") for (int k = 0; k < 2; ++k) dst[n][k] = *(const PG8_LAS bf16x8*)(lds + PG8_SB(b, h) + boff + n * 2048 + k * 1024); } while (0)
#define PG8_MMA(ai, bj, At, Bt) do { __builtin_amdgcn_s_setprio(1); _Pragma("unroll") for (int m = 0; m < 4; ++m) _Pragma("unroll") for (int n = 0; n < 2; ++n) _Pragma("unroll") for (int k = 0; k < 2; ++k) \
        acc[ai][bj][m][n] = __builtin_amdgcn_mfma_f32_16x16x32_bf16(Bt[n][k], At[m][k], acc[ai][bj][m][n], 0, 0, 0); __builtin_amdgcn_s_setprio(0); } while (0)
#define PG8_WAIT_V(n) asm volatile("s_waitcnt vmcnt(" #n ")" ::: "memory")
#define PG8_WAIT_L(n) asm volatile("s_waitcnt lgkmcnt(" #n ")" ::: "memory")
#define PG8_BAR __builtin_amdgcn_s_barrier()
#define PG8_SCHED __builtin_amdgcn_sched_barrier(0)
    Unit cur, nxt; int ui = 0;
    if (!S.next(0, cur)) return;
    f32x4 acc[2][2][4][2];
#pragma unroll
    for (int a = 0; a < 2; ++a)
#pragma unroll
        for (int b = 0; b < 2; ++b)
#pragma unroll
            for (int m = 0; m < 4; ++m)
#pragma unroll
                for (int n = 0; n < 2; ++n) acc[a][b][m][n] = (f32x4){0.f, 0.f, 0.f, 0.f};
    bf16x8 At[4][2], B0[2][2], B1[2][2];
    const char* cA = (const char*)g.A + (size_t)cur.pm * tstep; const char* cB = (const char*)g.Bt + (size_t)cur.pn * tstep;
    S.a_ready(cur);
    if constexpr (SP2) {
        PG8_STAGE(PG8_SB(0, 0), cB, voffB); PG8_STAGE(PG8_SB(0, 1), cB + hstep, voffB); PG8_STAGE(PG8_SA(0, 0), cA, voffA); PG8_STAGE(PG8_SA(0, 1), cA + hstep, voffA);
        if (wr == 1) PG8_BAR;
        PG8_WAIT_V(2); PG8_BAR;
        PG8_STAGE(PG8_SB(1, 0), cB + kstep, voffB); PG8_STAGE(PG8_SA(1, 0), cA + kstep, voffA); PG8_STAGE(PG8_SB(1, 1), cB + hstep + kstep, voffB);
        PG8_WAIT_V(6); PG8_BAR;
    } else {
        PG8_STAGE(PG8_SB(0, 0), cB, voffB); PG8_STAGE(PG8_SA(0, 0), cA, voffA); PG8_STAGE(PG8_SB(0, 1), cB + hstep, voffB); PG8_STAGE(PG8_SA(0, 1), cA + hstep, voffA);
        if (wr == 1) PG8_BAR;
        PG8_WAIT_V(4); PG8_BAR;
        PG8_STAGE(PG8_SB(1, 0), cB + kstep, voffB); PG8_STAGE(PG8_SA(1, 0), cA + kstep, voffA); PG8_STAGE(PG8_SB(1, 1), cB + hstep + kstep, voffB);
        PG8_WAIT_V(6); PG8_BAR;
    }
    for (;;) {
        const bool has_next = S.next(ui + 1, nxt);
        const char* nA = has_next ? (const char*)g.A + (size_t)nxt.pm * tstep : cA; const char* nB = has_next ? (const char*)g.Bt + (size_t)nxt.pn * tstep : cB;
        for (int t = 0; t < nt; t += 2) {
            const bool last = (t == nt - 2);
            const char* a1 = cA + (size_t)(t + 1) * kstep;
            const char* a2 = last ? nA : cA + (size_t)(t + 2) * kstep; const char* b2 = last ? nB : cB + (size_t)(t + 2) * kstep;
            const char* a3 = a2 + kstep; const char* b3 = b2 + kstep;
            if (last && has_next) S.a_ready(nxt);
            if constexpr (SP2) {
            PG8_LDB(B0, 0, 0); PG8_LDB(B1, 0, 1); PG8_SCHED; PG8_LDA(At, 0, 0); PG8_STAGE(PG8_SA(1, 1), a1 + hstep, voffA);
            PG8_WAIT_V(8); PG8_WAIT_L(0); PG8_BAR; PG8_MMA(0, 0, At, B0); PG8_MMA(0, 1, At, B1); PG8_BAR; PG8_SCHED;
            PG8_LDA(At, 0, 1); PG8_STAGE(PG8_SB(0, 0), b2, voffB); PG8_STAGE(PG8_SB(0, 1), b2 + hstep, voffB); PG8_STAGE(PG8_SA(0, 0), a2, voffA);
            PG8_WAIT_V(8); PG8_WAIT_L(0); PG8_BAR; PG8_MMA(1, 0, At, B0); PG8_MMA(1, 1, At, B1); PG8_BAR; PG8_SCHED;
            PG8_LDB(B0, 1, 0); PG8_LDB(B1, 1, 1); PG8_SCHED; PG8_LDA(At, 1, 0); PG8_STAGE(PG8_SA(0, 1), a2 + hstep, voffA);
            PG8_WAIT_V(8); PG8_WAIT_L(0); PG8_BAR; PG8_MMA(0, 0, At, B0); PG8_MMA(0, 1, At, B1); PG8_BAR; PG8_SCHED;
            PG8_LDA(At, 1, 1); PG8_STAGE(PG8_SB(1, 0), b3, voffB); PG8_STAGE(PG8_SB(1, 1), b3 + hstep, voffB); PG8_STAGE(PG8_SA(1, 0), a3, voffA);
            PG8_WAIT_V(8); PG8_WAIT_L(0); PG8_BAR; PG8_MMA(1, 0, At, B0); PG8_MMA(1, 1, At, B1); PG8_BAR; PG8_SCHED;
            } else {
            PG8_LDB(B0, 0, 0); PG8_SCHED; PG8_LDA(At, 0, 0); PG8_STAGE(PG8_SA(1, 1), a1 + hstep, voffA);
            PG8_WAIT_L(8); PG8_BAR; PG8_WAIT_L(0); PG8_MMA(0, 0, At, B0); PG8_BAR; PG8_SCHED;
            PG8_LDB(B1, 0, 1); PG8_STAGE(PG8_SB(0, 0), b2, voffB);
            PG8_BAR; PG8_WAIT_L(0); PG8_MMA(0, 1, At, B1); PG8_BAR;
            PG8_LDA(At, 0, 1); PG8_STAGE(PG8_SA(0, 0), a2, voffA);
            PG8_BAR; PG8_WAIT_L(0); PG8_MMA(1, 0, At, B0); PG8_BAR; PG8_SCHED;
            PG8_STAGE(PG8_SB(0, 1), b2 + hstep, voffB);
            PG8_WAIT_V(6); PG8_BAR; PG8_MMA(1, 1, At, B1); PG8_BAR;
            PG8_LDB(B0, 1, 0); PG8_SCHED; PG8_LDA(At, 1, 0); PG8_STAGE(PG8_SA(0, 1), a2 + hstep, voffA);
            PG8_WAIT_L(8); PG8_BAR; PG8_WAIT_L(0); PG8_MMA(0, 0, At, B0); PG8_BAR; PG8_SCHED;
            PG8_LDB(B1, 1, 1); PG8_STAGE(PG8_SB(1, 0), b3, voffB);
            PG8_BAR; PG8_WAIT_L(0); PG8_MMA(0, 1, At, B1); PG8_BAR;
            PG8_LDA(At, 1, 1); PG8_STAGE(PG8_SA(1, 0), a3, voffA);
            PG8_BAR; PG8_WAIT_L(0); PG8_MMA(1, 0, At, B0); PG8_BAR; PG8_SCHED;
            PG8_STAGE(PG8_SB(1, 1), b3 + hstep, voffB);
            PG8_WAIT_V(6); PG8_BAR; PG8_MMA(1, 1, At, B1); PG8_BAR;
            }
        }
        if constexpr (ALIGN_EPI) { if (wr == 0) PG8_BAR; }
        E(acc, cur, wr, wc, fr, fq); S.done(cur);
        if (!has_next) break;
#pragma unroll
        for (int a = 0; a < 2; ++a)
#pragma unroll
            for (int b = 0; b < 2; ++b)
#pragma unroll
                for (int m = 0; m < 4; ++m)
#pragma unroll
                    for (int n = 0; n < 2; ++n) acc[a][b][m][n] = (f32x4){0.f, 0.f, 0.f, 0.f};
        cur = nxt; cA = nA; cB = nB; ++ui;
        if constexpr (ALIGN_EPI) { if (wr == 1) PG8_BAR; }
    }
    PG8_WAIT_V(0);
    if constexpr (!ALIGN_EPI) { if (wr == 0) PG8_BAR; }
    PG8_BAR;
#undef PG8_SA
#undef PG8_SB
#undef PG8_STAGE
#undef PG8_LDA
#undef PG8_LDB
#undef PG8_MMA
#undef PG8_WAIT_V
#undef PG8_WAIT_L
#undef PG8_BAR
#undef PG8_SCHED
}
}

#define GAS __attribute__((address_space(1)))
#define LAS __attribute__((address_space(3)))
typedef unsigned short bf16;
typedef unsigned v4u __attribute__((ext_vector_type(4)));
typedef float f32x4 __attribute__((ext_vector_type(4)));
typedef float f32x16 __attribute__((ext_vector_type(16)));
typedef short bf16x8 __attribute__((ext_vector_type(8)));
typedef short s16x4 __attribute__((ext_vector_type(4)));
typedef short v4i16_t __attribute__((ext_vector_type(4)));
typedef LAS unsigned char LDSB;
typedef GAS unsigned gu32;

constexpr int NWAVES = 8, NTHR = 512;
constexpr int BATCH = 8, SEQ = 4096, DM = 1024, T = BATCH * SEQ;
constexpr int NPROJ = 3072;
constexpr int N_IN = 2848, FF = 4096;
constexpr float EPS = 1e-6f;
constexpr float C2 = 0.125f * 1.4426950408889634f;
constexpr float LOG2E = 1.4426950408889634f;
constexpr float NEGM = -1000.0f;

constexpr size_t MiB = 1u << 20;
constexpr size_t WS_CTL = 0, CTL_ZERO_BYTES = 1 * MiB;
constexpr size_t WS_WIN = 2 * MiB;
constexpr size_t WS_WOUT = 8 * MiB;
constexpr size_t WS_WUP = 10 * MiB;
constexpr size_t WS_WDN = 18 * MiB;
constexpr size_t WS_W1K = 26 * MiB;
constexpr size_t WS_W1V = 27 * MiB;
constexpr size_t WS_W2K = 28 * MiB;
constexpr size_t WS_W2V = 28 * MiB + 65536;
constexpr size_t WS_B1K = 28 * MiB + 131072;
constexpr size_t WS_B1V = 28 * MiB + 131072 + 65536;
constexpr size_t WS_ROPEC = 29 * MiB;
constexpr size_t WS_ROPES = 29 * MiB + 524288;
constexpr size_t WS_FL = 30 * MiB;
constexpr size_t WS_CB = 31 * MiB;
constexpr size_t WS_XN = 32 * MiB;
constexpr size_t WS_U = 96 * MiB;
constexpr size_t WS_QF = 96 * MiB;
constexpr size_t WS_KF = 128 * MiB;
constexpr size_t WS_VF = 160 * MiB;
constexpr size_t WS_QN = 192 * MiB;
constexpr size_t WS_KC = 224 * MiB;
constexpr size_t WS_VC = 233 * MiB;
constexpr size_t WS_KS = 242 * MiB;
constexpr size_t WS_VS = 250 * MiB;
constexpr size_t WS_KW = 258 * MiB;
constexpr size_t WS_VW = 266 * MiB;
constexpr size_t WS_GATE = 274 * MiB;
constexpr size_t WS_KCMP = 277 * MiB;
constexpr size_t WS_VCMP = 277 * MiB + 524288;
constexpr size_t WS_Y = 280 * MiB;
constexpr size_t WS_SSQ1 = 352 * MiB;
constexpr size_t WS_XS = 353 * MiB;
constexpr size_t WS_END = 356 * MiB;

constexpr int CW_Q_ATT = 64;
constexpr int CW_CS = 128;
constexpr int CW_CMPT = 192;
constexpr int CW_CMP = 256;
constexpr int CW_BAR = 4096;
constexpr int CW_PANEL = 8192;

constexpr int L_K = 0;
constexpr int L_V = 32768;
constexpr int L_ACC = 65536;
constexpr int L_IMP = 131072;
constexpr int L_WS = 131072 + 17408;
constexpr int L_SEL = L_WS + 8192;
constexpr int L_ORD = L_SEL + 512;
constexpr int L_MISC = L_ORD + 4096;
constexpr int L_TL = L_MISC + 256;
constexpr int LDS_BYTES = L_TL + 256;
constexpr int SLOTB = 8192;

#define RLX_AGENT __ATOMIC_RELAXED, __HIP_MEMORY_SCOPE_AGENT
#define LDS_WAIT() asm volatile("s_waitcnt lgkmcnt(0)" ::: "memory")
#define VM_WAIT() asm volatile("s_waitcnt vmcnt(0)" ::: "memory")
__device__ __forceinline__ unsigned f2bf(float f) { unsigned u = __builtin_bit_cast(unsigned, f); return (u + 0x7fffu + ((u >> 16) & 1u)) >> 16; }
__device__ __forceinline__ unsigned pk2(float lo, float hi) { return f2bf(lo) | (f2bf(hi) << 16); }
__device__ __forceinline__ float bf2f(unsigned short b) { return __builtin_bit_cast(float, (unsigned)b << 16); }

#define XB_TMO      128
#define XB_XCNT(j)  (256  + 64 * (j))
#define XB_XSUB(j)  (1280 + 64 * (j))
#define XB_XGEN(j)  (2304 + 64 * (j))
#define XB_TOP      3328
#define XB_TOPGEN   3392
#define XCD_BAR_WORDS 3456
#define XB_SPIN_CAP (1u << 22)
__device__ __forceinline__ unsigned xb_ld(unsigned* p)              { return __hip_atomic_load(p, __ATOMIC_RELAXED, __HIP_MEMORY_SCOPE_AGENT); }
__device__ __forceinline__ unsigned xb_add(unsigned* p, unsigned v) { return __hip_atomic_fetch_add(p, v, __ATOMIC_RELAXED, __HIP_MEMORY_SCOPE_AGENT); }
__device__ __forceinline__ unsigned xb_xcc_id() { return (unsigned)__builtin_amdgcn_s_getreg((3 << 11) | 20) & 0xFu; }
#define XB_SPIN(cond, bar) do { unsigned _sp = 0; while (cond) { __builtin_amdgcn_s_sleep(1); \
    if ((++_sp & 255u) == 0u) { if (xb_ld(&(bar)[XB_TMO])) break; if (_sp > XB_SPIN_CAP) { atomicAdd(&(bar)[XB_TMO], 1u); break; } } } } while (0)
struct XcdBarrier { unsigned* bar; unsigned x; volatile LAS unsigned* st; int wave; };
__device__ __forceinline__ XcdBarrier xcd_barrier_post(unsigned* bar, volatile LAS unsigned* st) {
    XcdBarrier b; b.bar = bar; b.x = xb_xcc_id(); b.st = st; b.wave = 0;
    if (threadIdx.x == 0) (void)xb_add(&bar[XB_XCNT(b.x)], 1u);
    return b;
}
__device__ __forceinline__ void xcd_barrier_complete(unsigned* bar, unsigned x, unsigned& nloc, unsigned& nx) {
    const unsigned G = gridDim.x * gridDim.y * gridDim.z;
    unsigned sum, cnt, mine, sp = 0u;
    for (;;) {
        sum = 0u; cnt = 0u; mine = 0u;
#pragma unroll
        for (unsigned j = 0; j < 16; ++j) { const unsigned c = xb_ld(&bar[XB_XCNT(j)]); sum += c; cnt += (c > 0u) ? 1u : 0u; mine = (j == x) ? c : mine; }
        if (sum == G) break;
        __builtin_amdgcn_s_sleep(1);
        if ((++sp & 255u) == 0u) { if (xb_ld(&bar[XB_TMO])) break; if (sp > XB_SPIN_CAP) { atomicAdd(&bar[XB_TMO], 1u); break; } }
    }
    nloc = mine > 0u ? mine : 1u; nx = cnt > 0u ? cnt : 1u;
}
__device__ __forceinline__ void xcd_barrier(const XcdBarrier& b) {
    asm volatile("s_waitcnt vmcnt(0)" ::: "memory");
    __syncthreads();
    if (b.wave == 0 && lane_id() == 0) {
        unsigned* bar = b.bar;
        __builtin_amdgcn_s_waitcnt(0);
        unsigned nloc = b.st[0], nx = b.st[1];
        if (nloc == 0u) { xcd_barrier_complete(bar, b.x, nloc, nx); b.st[0] = nloc; b.st[1] = nx; }
        const unsigned old = xb_add(&bar[XB_XSUB(b.x)], 1u);
        const unsigned gen = old / nloc;
        if (old + 1u == (gen + 1u) * nloc) {
            __builtin_amdgcn_fence(__ATOMIC_RELEASE, "agent");
            asm volatile("s_waitcnt vmcnt(0)" ::: "memory");
            const unsigned og = xb_add(&bar[XB_TOP], 1u);
            const unsigned tg = og / nx;
            if (og + 1u == (tg + 1u) * nx) xb_add(&bar[XB_TOPGEN], 1u);
            else XB_SPIN(xb_ld(&bar[XB_TOPGEN]) == tg, bar);
            __builtin_amdgcn_fence(__ATOMIC_ACQUIRE, "agent");
            xb_add(&bar[XB_XGEN(b.x)], 1u);
            asm volatile("s_waitcnt vmcnt(0)" ::: "memory");
        } else {
            XB_SPIN(xb_ld(&bar[XB_XGEN(b.x)]) == gen, bar);
            __builtin_amdgcn_fence(__ATOMIC_ACQUIRE, "agent");
            asm volatile("s_waitcnt vmcnt(0)" ::: "memory");
        }
    }
    __syncthreads();
}

struct Args { const float* in[22]; float* out; unsigned char* ws; int ph_lo, ph_hi; };

struct Frame {
    LDSB* lds;
    volatile LAS unsigned* MISC;
    gu32* ctl;
    int tid, lane, wave, vcu, G;
    unsigned char* ws;
};

__device__ __forceinline__ float wave_sum(float v) {
#pragma unroll
    for (int o = 1; o < 64; o <<= 1) v += __shfl_xor(v, o);
    return v;
}

__device__ __forceinline__ int win_src_col(int n) {
    const int pn = n >> 8, c = n & 255, half = c >> 7, slot = (c >> 5) & 3, d = c & 31;
    if (pn < 8) {
        const int tsr = pn >> 1, j = pn & 1;
        const int tb = (tsr == 0) ? 0 : (tsr == 1) ? 512 : (tsr == 2) ? 1024 : 1544;
        return tb + 64 * (4 * j + slot) + 32 * half + d;
    }
    if (pn < 11) {
        const int base = 2056 + (pn - 8) * 256;
        return base + (slot >> 1) * 128 + (slot & 1) * 64 + 32 * half + d;
    }
    if (c < 8) return 1536 + c;
    if (c < 32) return 2824 + (c - 8);
    return -1;
}

template <bool MAPPED>
__device__ __forceinline__ void p0_transpose_item(const float* W, int K, int N, bf16* WT, LAS float* scr, int item, int lane, const float* kscale, int nblk) {
    const int kb = item / nblk, nb = item % nblk, k0 = 64 * kb, n0 = 32 * nb;
    int src = n0 + (lane & 31);
    if (MAPPED) src = win_src_col(src);
#pragma unroll 8
    for (int i = 0; i < 32; ++i) { const int kk = 2 * i + (lane >> 5);
        float v = 0.f; if (src >= 0) v = W[(size_t)(k0 + kk) * N + src];
        if (kscale) v *= kscale[k0 + kk];
        scr[kk * 33 + (lane & 31)] = v; }
    LDS_WAIT(); asm volatile("" ::: "memory");
    const int c = lane & 7;
#pragma unroll
    for (int j = 0; j < 4; ++j) { const int n = (lane >> 3) + 8 * j; const LAS float* s = scr + (8 * c) * 33 + n;
        v4u o; o.x = pk2(s[0 * 33], s[1 * 33]); o.y = pk2(s[2 * 33], s[3 * 33]); o.z = pk2(s[4 * 33], s[5 * 33]); o.w = pk2(s[6 * 33], s[7 * 33]);
        *(GAS v4u*)(WT + (size_t)(n0 + n) * K + k0 + 8 * c) = o; }
    LDS_WAIT(); asm volatile("" ::: "memory");
}

__device__ __forceinline__ void rms_row_to_bf16(int lane, const float* xrow, bf16* orow) {
    const GAS f32x4* xr = (const GAS f32x4*)xrow + lane;
    f32x4 v[4]; float s = 0.f;
#pragma unroll
    for (int j = 0; j < 4; ++j) { v[j] = xr[64 * j]; s += (v[j].x * v[j].x + v[j].y * v[j].y) + (v[j].z * v[j].z + v[j].w * v[j].w); }
    const float r = 1.f / sqrtf(wave_sum(s) * (1.f / DM) + EPS);
    GAS unsigned long long* o8 = (GAS unsigned long long*)orow + lane;
#pragma unroll
    for (int j = 0; j < 4; ++j) o8[64 * j] = (unsigned long long)pk2(v[j].x * r, v[j].y * r) | ((unsigned long long)pk2(v[j].z * r, v[j].w * r) << 32);
}

typedef __attribute__((address_space(4))) const char* kptr_t;
#define AIN(kp_, i) (*(const float* const __attribute__((address_space(4)))*)((kp_) + 8 * (i)))
__device__ __forceinline__ void p0_prologue(Frame& F, kptr_t kp) {
    const float* x = AIN(kp, 0); const float* g_attn = AIN(kp, 1); const float* w_in = AIN(kp, 2);
    const float* cmpk_pe = AIN(kp, 5); const float* cmpk_w1 = AIN(kp, 6); const float* cmpk_w2 = AIN(kp, 8);
    const float* cmpv_pe = AIN(kp, 10); const float* cmpv_w1 = AIN(kp, 11); const float* cmpv_w2 = AIN(kp, 13);
    const float* g_fox = AIN(kp, 15); const float* g_nsa = AIN(kp, 16); const float* w_out = AIN(kp, 17);
    const float* g_mlp = AIN(kp, 18); const float* w_up = AIN(kp, 19); const float* w_down = AIN(kp, 20);
    LAS float* scr = (LAS float*)(F.lds + F.wave * 16384);
    const int gw = F.vcu * NWAVES + F.wave, NGW = F.G * NWAVES;
    for (int it = gw; it < 128; it += NGW) {
        const int kv = it >> 6, kc = it & 63;
        const float* pe = kv ? cmpv_pe : cmpk_pe; const float* w1 = kv ? cmpv_w1 : cmpk_w1;
        f32x4 a = (f32x4){0.f, 0.f, 0.f, 0.f};
#pragma unroll 8
        for (int k = 32 * kc; k < 32 * kc + 32; ++k) { const f32x4 wv = *((const f32x4*)(w1 + (size_t)k * 256) + F.lane); a = a + wv * pe[k]; }
        *((f32x4*)(F.ws + (kv ? WS_B1V : WS_B1K)) + kc * 64 + F.lane) = a;
    }
    constexpr int I_IN = (DM / 64) * (NPROJ / 32), I_OUT = (DM / 64) * (DM / 32), I_UP = (DM / 64) * (FF / 32), I_DN = (FF / 64) * (DM / 32);
    constexpr int I_W1 = (2048 / 64) * (256 / 32), I_W2 = (256 / 64) * (64 / 32);
    constexpr int NITEMS = I_IN + I_OUT + I_UP + I_DN + 2 * I_W1 + 2 * I_W2;
    for (int it = gw; it < NITEMS; it += NGW) {
        int r = it;
        if (r < I_IN) { p0_transpose_item<true>(w_in, DM, N_IN, (bf16*)(F.ws + WS_WIN), scr, r, F.lane, g_attn, NPROJ / 32); continue; } r -= I_IN;
        if (r < I_OUT) {
            const int kb = r / (DM / 32);
            const float* ks = (kb < 8) ? g_fox : (g_nsa - 512);
            p0_transpose_item<false>(w_out, DM, DM, (bf16*)(F.ws + WS_WOUT), scr, r, F.lane, ks, DM / 32); continue; } r -= I_OUT;
        if (r < I_UP) { p0_transpose_item<false>(w_up, DM, FF, (bf16*)(F.ws + WS_WUP), scr, r, F.lane, g_mlp, FF / 32); continue; } r -= I_UP;
        if (r < I_DN) { p0_transpose_item<false>(w_down, FF, DM, (bf16*)(F.ws + WS_WDN), scr, r, F.lane, nullptr, DM / 32); continue; } r -= I_DN;
        if (r < I_W1) { p0_transpose_item<false>(cmpk_w1, 2048, 256, (bf16*)(F.ws + WS_W1K), scr, r, F.lane, nullptr, 8); continue; } r -= I_W1;
        if (r < I_W1) { p0_transpose_item<false>(cmpv_w1, 2048, 256, (bf16*)(F.ws + WS_W1V), scr, r, F.lane, nullptr, 8); continue; } r -= I_W1;
        if (r < I_W2) { p0_transpose_item<false>(cmpk_w2, 256, 64, (bf16*)(F.ws + WS_W2K), scr, r, F.lane, nullptr, 2); continue; } r -= I_W2;
        p0_transpose_item<false>(cmpv_w2, 256, 64, (bf16*)(F.ws + WS_W2V), scr, r, F.lane, nullptr, 2);
    }
    {
        float* rc = (float*)(F.ws + WS_ROPEC); float* rs = (float*)(F.ws + WS_ROPES);
        for (int i = F.vcu * NTHR + F.tid; i < SEQ * 32; i += F.G * NTHR) {
            const int pos = i >> 5, d = i & 31;
            const float inv = exp2f(-(float)d * (13.287712379549449f / 32.0f));
            const float ang = (float)pos * inv;
            const double a = (double)ang;
            const double k = __builtin_rint(a * 0.15915494309189535);
            const float red = (float)(a - k * 6.283185307179586);
            rc[i] = cosf(red); rs[i] = sinf(red);
        }
    }
    for (int m = gw; m < T; m += NGW) rms_row_to_bf16(F.lane, x + (size_t)m * DM, (bf16*)(F.ws + WS_XN) + (size_t)m * DM);
}

typedef pg8::f32x4 pf4;
__device__ __forceinline__ float log_sigmoidf(float v) { return v >= 0.f ? -log1pf(expf(-v)) : v - log1pf(expf(v)); }

struct EpiProj {
    static constexpr bool PERM = true;
    unsigned char* ws; const float* b_f; const float* b_gate;
    __device__ __forceinline__ void operator()(const pf4 (&acc)[2][2][4][2], const pg8::Unit& u, int wr, int wc, int fr, int fq) const {
        const int pn = u.pn; const int rbase = u.pm * 256 + wr * 64 + fr;
        if (pn == 11) {
            if (wc != 0) return;
            float* FL = (float*)(ws + WS_FL); float* GT = (float*)(ws + WS_GATE);
#pragma unroll
            for (int ai = 0; ai < 2; ++ai)
#pragma unroll
                for (int m = 0; m < 4; ++m) { const int row = rbase + ai * 128 + m * 16; const int b = row >> 12, s = row & 4095;
#pragma unroll
                    for (int n = 0; n < 2; ++n) { const pf4 v = acc[ai][0][m][n];
                        if (fq == 0) {
#pragma unroll
                            for (int i = 0; i < 4; ++i) { const int h = 4 * n + i; FL[(size_t)(b * 8 + h) * SEQ + s] = log_sigmoidf(v[i] + b_f[h]); }
                        } else { const int j0 = 8 * fq - 8 + 4 * n; pf4 o;
#pragma unroll
                            for (int i = 0; i < 4; ++i) { const float z = v[i] + b_gate[j0 + i]; o[i] = 1.f / (1.f + expf(-z)); }
                            *(pf4*)(GT + (size_t)row * 24 + j0) = o; } } }
            return;
        }
        const bool rope = (pn == 6) || (pn == 7) || ((pn == 9 || pn == 10) && wc < 2);
        const float sc = (pn < 2 || pn == 6 || pn == 7) ? C2 : 1.f;
        const float* RC = (const float*)(ws + WS_ROPEC); const float* RS = (const float*)(ws + WS_ROPES);
        size_t tb;
        if (pn < 8) { const int tsr = pn >> 1; tb = (tsr == 0) ? WS_QF : (tsr == 1) ? WS_KF : (tsr == 2) ? WS_VF : WS_QN; }
        else { const int vt = wc >> 1; tb = (pn == 8) ? (vt ? WS_VC : WS_KC) : (pn == 9) ? (vt ? WS_VS : WS_KS) : (vt ? WS_VW : WS_KW); }
        bf16* TB = (bf16*)(ws + tb);
#pragma unroll
        for (int ai = 0; ai < 2; ++ai)
#pragma unroll
            for (int m = 0; m < 4; ++m) { const int row = rbase + ai * 128 + m * 16;
                pf4 a0 = acc[ai][0][m][0], a1 = acc[ai][0][m][1], b0 = acc[ai][1][m][0], b1 = acc[ai][1][m][1];
                if (rope) { const int pos = row & 4095;
                    const pf4 c0 = *(const pf4*)(RC + pos * 32 + 8 * fq), c1 = *(const pf4*)(RC + pos * 32 + 8 * fq + 4);
                    const pf4 s0 = *(const pf4*)(RS + pos * 32 + 8 * fq), s1 = *(const pf4*)(RS + pos * 32 + 8 * fq + 4);
                    const pf4 x0 = a0 * c0 - b0 * s0, x1 = a1 * c1 - b1 * s1, y0 = a0 * s0 + b0 * c0, y1 = a1 * s1 + b1 * c1;
                    a0 = x0; a1 = x1; b0 = y0; b1 = y1; }
                a0 = a0 * sc; a1 = a1 * sc; b0 = b0 * sc; b1 = b1 * sc;
                v4u w0, w1; w0.x = pk2(a0[0], a0[1]); w0.y = pk2(a0[2], a0[3]); w0.z = pk2(a1[0], a1[1]); w0.w = pk2(a1[2], a1[3]);
                w1.x = pk2(b0[0], b0[1]); w1.y = pk2(b0[2], b0[3]); w1.z = pk2(b1[0], b1[1]); w1.w = pk2(b1[2], b1[3]);
                bf16* p;
                if (pn < 8) p = TB + (size_t)row * 512 + 64 * (4 * (pn & 1) + wc) + 8 * fq;
                else { const int b = row >> 12, s = row & 4095, g = wc & 1; p = TB + ((size_t)(b * 2 + g) * SEQ + s) * 64 + 8 * fq; }
                *(v4u*)p = w0; *(v4u*)(p + 32) = w1; }
    }
};

struct EpiOutRes {
    static constexpr bool PERM = true;
    const float* x; float* out; bf16* xn; float* ssq; LDSB* lds;
    __device__ __forceinline__ void operator()(const pf4 (&acc)[2][2][4][2], const pg8::Unit& u, int wr, int wc, int fr, int fq) const {
        const int col0 = u.pn * 256 + wc * 32 + 8 * fq;
        LAS float* P = (LAS float*)(lds + L_IMP);
#pragma unroll
        for (int ai = 0; ai < 2; ++ai)
#pragma unroll
            for (int m = 0; m < 4; ++m) { const int rl = ai * 128 + wr * 64 + m * 16 + fr; const size_t off = (size_t)(u.pm * 256 + rl) * DM + col0; float sq = 0.f;
#pragma unroll
                for (int bj = 0; bj < 2; ++bj) {
                    const pf4 h0 = *(const pf4*)(x + off + bj * 128) + acc[ai][bj][m][0], h1 = *(const pf4*)(x + off + bj * 128 + 4) + acc[ai][bj][m][1];
                    *(pf4*)(out + off + bj * 128) = h0; *(pf4*)(out + off + bj * 128 + 4) = h1;
                    sq += ((h0[0] * h0[0] + h0[1] * h0[1]) + (h0[2] * h0[2] + h0[3] * h0[3])) + ((h1[0] * h1[0] + h1[1] * h1[1]) + (h1[2] * h1[2] + h1[3] * h1[3]));
                    v4u w; w.x = pk2(h0[0], h0[1]); w.y = pk2(h0[2], h0[3]); w.z = pk2(h1[0], h1[1]); w.w = pk2(h1[2], h1[3]);
                    *(v4u*)(xn + off + bj * 128) = w; }
                sq += __shfl_xor(sq, 16); sq += __shfl_xor(sq, 32);
                if (fq == 0) P[rl * 4 + wc] = sq; }
        asm volatile("s_waitcnt lgkmcnt(0)\n\ts_barrier" ::: "memory");
        const int t = (wr * 4 + wc) * 64 + (fq * 16 + fr);
        if (t < 256) { const f32x4 p = *(const LAS f32x4*)(P + t * 4); ssq[(size_t)(u.pm * 256 + t) * 4 + u.pn] = (p[0] + p[1]) + (p[2] + p[3]); }
    }
};

struct EpiUp {
    static constexpr bool PERM = true;
    bf16* O; const float* ssq;
    __device__ __forceinline__ void operator()(const pf4 (&acc)[2][2][4][2], const pg8::Unit& u, int wr, int wc, int fr, int fq) const {
        const int row0 = u.pm * 256 + wr * 64 + fr, col0 = u.pn * 256 + wc * 32 + 8 * fq;
#pragma unroll
        for (int ai = 0; ai < 2; ++ai)
#pragma unroll
            for (int m = 0; m < 4; ++m) { const int row = row0 + ai * 128 + m * 16; bf16* rowp = O + (size_t)row * FF + col0;
                const pf4 s0 = *(const pf4*)(ssq + (size_t)row * 4);
                const float tot = (s0[0] + s0[1]) + (s0[2] + s0[3]);
                const float r2 = 1.f / (tot * (1.f / DM) + EPS);
#pragma unroll
                for (int bj = 0; bj < 2; ++bj) { pf4 v0 = acc[ai][bj][m][0], v1 = acc[ai][bj][m][1];
#pragma unroll
                    for (int i = 0; i < 4; ++i) { const float a = fmaxf(v0[i], 0.f), b = fmaxf(v1[i], 0.f); v0[i] = a * a * r2; v1[i] = b * b * r2; }
                    v4u w; w.x = pk2(v0[0], v0[1]); w.y = pk2(v0[2], v0[3]); w.z = pk2(v1[0], v1[1]); w.w = pk2(v1[2], v1[3]);
                    *(v4u*)(rowp + bj * 128) = w; } }
    }
};

struct EpiDownNorm {
    static constexpr bool PERM = true;
    float* out; const float* g; float* xs; gu32* cnt; LDSB* lds;
    __device__ __forceinline__ void operator()(pf4 (&acc)[2][2][4][2], const pg8::Unit& u, int wr, int wc, int fr, int fq) const {
        const int col0 = u.pn * 256 + wc * 32 + 8 * fq;
        LAS float* P = (LAS float*)(lds + L_IMP);
        LAS float* S = P + 1024;
#pragma unroll
        for (int ai = 0; ai < 2; ++ai)
#pragma unroll
            for (int m = 0; m < 4; ++m) { const int rl = ai * 128 + wr * 64 + m * 16 + fr; const size_t off = (size_t)(u.pm * 256 + rl) * DM + col0; float sq = 0.f;
#pragma unroll
                for (int bj = 0; bj < 2; ++bj) { const float* p = out + off + bj * 128;
                    const pf4 h0 = *(const pf4*)p + acc[ai][bj][m][0], h1 = *(const pf4*)(p + 4) + acc[ai][bj][m][1];
                    acc[ai][bj][m][0] = h0; acc[ai][bj][m][1] = h1;
                    sq += ((h0[0] * h0[0] + h0[1] * h0[1]) + (h0[2] * h0[2] + h0[3] * h0[3])) + ((h1[0] * h1[0] + h1[1] * h1[1]) + (h1[2] * h1[2] + h1[3] * h1[3])); }
                sq += __shfl_xor(sq, 16); sq += __shfl_xor(sq, 32);
                if (fq == 0) P[rl * 4 + wc] = sq; }
        asm volatile("s_waitcnt lgkmcnt(0)\n\ts_barrier" ::: "memory");
        const int wid = wr * 4 + wc, lane = fq * 16 + fr, t = wid * 64 + lane;
        if (t < 256) { const f32x4 p = *(const LAS f32x4*)(P + t * 4);
            __hip_atomic_store(xs + (size_t)(u.pm * 256 + t) * 4 + u.pn, (p[0] + p[1]) + (p[2] + p[3]), __ATOMIC_RELAXED, __HIP_MEMORY_SCOPE_AGENT); }
        asm volatile("s_waitcnt vmcnt(0)" ::: "memory");
        if (t < 256 && lane == 0) __hip_atomic_fetch_add(cnt + 64 * u.pm, 1u, RLX_AGENT);
        if (wid == 0) {
            unsigned sp = 0;
            while ((unsigned)__builtin_amdgcn_readfirstlane((int)__hip_atomic_load(cnt + 64 * u.pm, RLX_AGENT)) < 16u) { __builtin_amdgcn_s_sleep(2); if (++sp > (1u << 22)) break; }
            __builtin_amdgcn_fence(__ATOMIC_ACQUIRE, "agent");
            asm volatile("s_waitcnt vmcnt(0)" ::: "memory");
        }
        asm volatile("s_waitcnt lgkmcnt(0)\n\ts_barrier" ::: "memory");
        if (t < 256) { const float* sl = xs + (size_t)(u.pm * 256 + t) * 4;
            const float a0 = __hip_atomic_load(sl, RLX_AGENT), a1 = __hip_atomic_load(sl + 1, RLX_AGENT), a2 = __hip_atomic_load(sl + 2, RLX_AGENT), a3 = __hip_atomic_load(sl + 3, RLX_AGENT);
            S[t] = 1.f / sqrtf(((a0 + a1) + (a2 + a3)) * (1.f / DM) + EPS); }
        asm volatile("s_waitcnt lgkmcnt(0)\n\ts_barrier" ::: "memory");
#pragma unroll
        for (int bj = 0; bj < 2; ++bj) { const pf4 g0 = *(const pf4*)(g + col0 + bj * 128), g1 = *(const pf4*)(g + col0 + bj * 128 + 4);
#pragma unroll
            for (int ai = 0; ai < 2; ++ai)
#pragma unroll
                for (int m = 0; m < 4; ++m) { const int rl = ai * 128 + wr * 64 + m * 16 + fr; const float r = S[rl]; float* p = out + (size_t)(u.pm * 256 + rl) * DM + col0 + bj * 128;
                    *(pf4*)p = acc[ai][bj][m][0] * r * g0; *(pf4*)(p + 4) = acc[ai][bj][m][1] * r * g1; } }
    }
};

__device__ __forceinline__ void p2_cumsum_item(Frame& F, int item) {
    const float* fl = (const float*)(F.ws + WS_FL) + (size_t)item * SEQ; float* cb = (float*)(F.ws + WS_CB) + (size_t)item * SEQ;
    const int lane = F.lane;
    float v[64]; float run = 0.f;
#pragma unroll
    for (int i = 0; i < 16; ++i) { const f32x4 t = *(const f32x4*)(fl + lane * 64 + 4 * i); v[4 * i] = t[0]; v[4 * i + 1] = t[1]; v[4 * i + 2] = t[2]; v[4 * i + 3] = t[3]; }
#pragma unroll
    for (int i = 0; i < 64; ++i) { run += v[i]; v[i] = run; }
    float incl = run;
#pragma unroll
    for (int o = 1; o < 64; o <<= 1) { const float t = __shfl_up(incl, o); if (lane >= o) incl += t; }
    const float base = incl - run;
#pragma unroll
    for (int i = 0; i < 16; ++i) { f32x4 t; t[0] = -(v[4 * i] + base) * LOG2E; t[1] = -(v[4 * i + 1] + base) * LOG2E; t[2] = -(v[4 * i + 2] + base) * LOG2E; t[3] = -(v[4 * i + 3] + base) * LOG2E;
        *(f32x4*)(cb + lane * 64 + 4 * i) = t; }
}

__device__ __forceinline__ float gelu_tanh(float x) {
    const float u = 0.7978845608028654f * (x + 0.044715f * x * x * x);
    const float e = __expf(2.f * u);
    const float th = 1.f - 2.f / (e + 1.f);
    return 0.5f * x * (1.f + th);
}

__device__ __forceinline__ void p2_compress_item(Frame& F0, kptr_t kp, int item) {
    typedef float f4 __attribute__((ext_vector_type(4)));
    struct { unsigned char* ws; LDSB* lds; int tid, lane, wave; } F; F.ws = F0.ws; F.lds = F0.lds; F.wave = F0.wave;
    { int t_ = F0.tid; asm volatile("" : "+v"(t_)); F.tid = t_; F.lane = t_ & 63; }
    asm volatile("" : "+s"(F.ws));
    const int kv = item >> 6, bg = (item >> 2) & 15, cblk = item & 3, c0 = 64 * cblk;
    const int lane = F.lane, w = F.wave, fr = lane & 15, fq = lane >> 4;
    const bf16* Ab = (const bf16*)(F.ws + (kv ? WS_VC : WS_KC)) + (size_t)bg * SEQ * 64 + (size_t)c0 * 1024;
    const bf16* W1 = (const bf16*)(F.ws + (kv ? WS_W1V : WS_W1K));
    const bf16* W2 = (const bf16*)(F.ws + (kv ? WS_W2V : WS_W2K));
    const float* B1 = (const float*)(F.ws + (kv ? WS_B1V : WS_B1K));
    const float* b1 = AIN(kp, kv ? 12 : 7);
    const float* b2 = AIN(kp, kv ? 14 : 9);
    LDSB* lds = F.lds;
    LAS bf16* Hs = (LAS bf16*)(lds + 92160);
    f4 acc[4][2];
#pragma unroll
    for (int m = 0; m < 4; ++m) { acc[m][0] = (f4){0.f, 0.f, 0.f, 0.f}; acc[m][1] = (f4){0.f, 0.f, 0.f, 0.f}; }
    const int tid = F.tid, lrow = tid >> 3, lch = tid & 7;
    const bf16* ag = Ab + (size_t)lrow * 1024 + lch * 8;
    const bf16* bg_ = W1 + (size_t)lrow * 2048 + lch * 8;
    const int sto = (lrow * 72 + lch * 8) * 2;
    v4u ra = *(const v4u*)ag, rb[4];
#pragma unroll
    for (int i = 0; i < 4; ++i) rb[i] = *(const v4u*)(bg_ + (size_t)i * 64 * 2048);
    *(LAS v4u*)(lds + sto) = ra;
#pragma unroll
    for (int i = 0; i < 4; ++i) *(LAS v4u*)(lds + 18432 + sto + i * 64 * 144) = rb[i];
    __syncthreads();
    for (int ks = 0; ks < 32; ++ks) {
        const int cb = ks & 1;
        if (ks + 1 < 32) { ra = *(const v4u*)(ag + (ks + 1) * 64);
#pragma unroll
            for (int i = 0; i < 4; ++i) rb[i] = *(const v4u*)(bg_ + (size_t)i * 64 * 2048 + (ks + 1) * 64); }
        const LDSB* As = lds + cb * 9216; const LDSB* Bs = lds + 18432 + cb * 36864;
#pragma unroll
        for (int kh = 0; kh < 2; ++kh) {
            bf16x8 a[4], b[2];
#pragma unroll
            for (int m = 0; m < 4; ++m) a[m] = *(const LAS bf16x8*)(As + ((16 * m + fr) * 72 + 32 * kh + 8 * fq) * 2);
#pragma unroll
            for (int n = 0; n < 2; ++n) b[n] = *(const LAS bf16x8*)(Bs + ((32 * w + 16 * n + fr) * 72 + 32 * kh + 8 * fq) * 2);
#pragma unroll
            for (int m = 0; m < 4; ++m)
#pragma unroll
                for (int n = 0; n < 2; ++n) acc[m][n] = __builtin_amdgcn_mfma_f32_16x16x32_bf16(a[m], b[n], acc[m][n], 0, 0, 0);
        }
        if (ks + 1 < 32) {
            *(LAS v4u*)(lds + (cb ^ 1) * 9216 + sto) = ra;
#pragma unroll
            for (int i = 0; i < 4; ++i) *(LAS v4u*)(lds + 18432 + (cb ^ 1) * 36864 + sto + i * 64 * 144) = rb[i];
        }
        __syncthreads();
    }
    float bbv[2];
#pragma unroll
    for (int n = 0; n < 2; ++n) { const int col = 32 * w + 16 * n + fr; float bb = b1[col];
#pragma unroll 8
        for (int kc = 0; kc < 64; ++kc) bb += B1[kc * 256 + col];
        bbv[n] = bb; }
#pragma unroll
    for (int m = 0; m < 4; ++m)
#pragma unroll
        for (int n = 0; n < 2; ++n) { const int col = 32 * w + 16 * n + fr;
#pragma unroll
            for (int r = 0; r < 4; ++r) Hs[(16 * m + 4 * fq + r) * 264 + col] = (bf16)f2bf(gelu_tanh(acc[m][n][r] + bbv[n])); }
    __syncthreads();
    const int mt = w >> 1, ntA = (w & 1), ntB = (w & 1) + 2;
    f4 oa = (f4){0.f, 0.f, 0.f, 0.f}, ob = (f4){0.f, 0.f, 0.f, 0.f};
#pragma unroll
    for (int k0 = 0; k0 < 256; k0 += 32) {
        const bf16x8 a = *(const LAS bf16x8*)(Hs + (16 * mt + fr) * 264 + k0 + 8 * fq);
        const bf16x8 bA = *(const bf16x8*)(W2 + (size_t)(16 * ntA + fr) * 256 + k0 + 8 * fq);
        const bf16x8 bB = *(const bf16x8*)(W2 + (size_t)(16 * ntB + fr) * 256 + k0 + 8 * fq);
        oa = __builtin_amdgcn_mfma_f32_16x16x32_bf16(a, bA, oa, 0, 0, 0);
        ob = __builtin_amdgcn_mfma_f32_16x16x32_bf16(a, bB, ob, 0, 0, 0);
    }
    const int d1 = 16 * (w & 1) + fr;
    const float bb1 = b2[d1], bb2 = b2[d1 + 32];
    const float* RC = (const float*)(F.ws + WS_ROPEC); const float* RS = (const float*)(F.ws + WS_ROPES);
    bf16* O = (bf16*)(F.ws + (kv ? WS_VCMP : WS_KCMP)) + (size_t)bg * 256 * 64;
#pragma unroll
    for (int r = 0; r < 4; ++r) { const int c = c0 + 16 * mt + 4 * fq + r;
        float x1 = oa[r] + bb1, x2 = ob[r] + bb2;
        if (kv == 0) { int pos = 16 * c + 31; pos = pos > 4095 ? 4095 : pos; const float cs = RC[pos * 32 + d1], sn = RS[pos * 32 + d1];
            const float y1 = x1 * cs - x2 * sn, y2 = x1 * sn + x2 * cs; x1 = y1; x2 = y2; }
        O[(size_t)c * 64 + d1] = (bf16)f2bf(x1); O[(size_t)c * 64 + d1 + 32] = (bf16)f2bf(x2); }
    __syncthreads();
}

__device__ __forceinline__ int crow(int r, int hi) { return (r & 3) + 8 * (r >> 2) + 4 * hi; }
__device__ __forceinline__ void glds16(const void* gsrc, unsigned lds_dst) { unsigned keep;
    asm volatile("s_mov_b32 %0, m0\n\ts_mov_b32 m0, %2\n\ts_nop 0\n\tglobal_load_lds_dwordx4 %1, off\n\ts_mov_b32 m0, %0" : "=&s"(keep) : "v"(gsrc), "s"(lds_dst) : "memory"); }
#define WAIT_BAR(N) asm volatile("s_waitcnt vmcnt(" #N ") lgkmcnt(0)\n\ts_barrier" ::: "memory")
__device__ __forceinline__ unsigned cvtpk_s(float lo, float hi) { typedef float f2 __attribute__((ext_vector_type(2))); typedef __bf16 b2 __attribute__((ext_vector_type(2)));
    f2 v = {lo, hi}; b2 b = __builtin_convertvector(v, b2); return __builtin_bit_cast(unsigned, b); }
__device__ __forceinline__ s16x4 vtr(const LDSB* p) { return __builtin_bit_cast(s16x4, __builtin_amdgcn_ds_read_tr16_b64_v4i16((LAS v4i16_t*)p)); }

__device__ __forceinline__ float xh_max(float a) { auto r = __builtin_amdgcn_permlane32_swap(__float_as_uint(a), __float_as_uint(a), false, false); return fmaxf(__uint_as_float(r[0]), __uint_as_float(r[1])); }
__device__ __forceinline__ float xh_sum(float a) { auto r = __builtin_amdgcn_permlane32_swap(__float_as_uint(a), __float_as_uint(a), false, false); return __uint_as_float(r[0]) + __uint_as_float(r[1]); }
__device__ __forceinline__ float xh_other(float a, int hi) { auto r = __builtin_amdgcn_permlane32_swap(__float_as_uint(a), __float_as_uint(a), false, false); return hi ? __uint_as_float(r[0]) : __uint_as_float(r[1]); }
__device__ __forceinline__ void qkt(f32x16& p0, f32x16& p1, const LDSB* kslot, const bf16x8 (&qr)[4], const f32x16& cinit, int r32, int hi) {
    const LDSB* kb = kslot + hi * 1024 + r32 * 16;
#pragma unroll
    for (int d0 = 0; d0 < 4; ++d0) {
        const bf16x8 b0 = *(const LAS bf16x8*)(kb + d0 * 2048);
        const bf16x8 b1 = *(const LAS bf16x8*)(kb + d0 * 2048 + 512);
        if (d0 == 0) { p0 = __builtin_amdgcn_mfma_f32_32x32x16_bf16(b0, qr[0], cinit, 0, 0, 0); p1 = __builtin_amdgcn_mfma_f32_32x32x16_bf16(b1, qr[0], cinit, 0, 0, 0); }
        else { p0 = __builtin_amdgcn_mfma_f32_32x32x16_bf16(b0, qr[d0], p0, 0, 0, 0); p1 = __builtin_amdgcn_mfma_f32_32x32x16_bf16(b1, qr[d0], p1, 0, 0, 0); }
    }
}
__device__ __forceinline__ void pv(f32x16 (&o)[2], const LDSB* vp, const f32x16& p0, const f32x16& p1) {
    v4u pw[4];
    pw[0] = (v4u){cvtpk_s(p0[0], p0[1]), cvtpk_s(p0[2], p0[3]), cvtpk_s(p0[4], p0[5]), cvtpk_s(p0[6], p0[7])};
    pw[1] = (v4u){cvtpk_s(p0[8], p0[9]), cvtpk_s(p0[10], p0[11]), cvtpk_s(p0[12], p0[13]), cvtpk_s(p0[14], p0[15])};
    pw[2] = (v4u){cvtpk_s(p1[0], p1[1]), cvtpk_s(p1[2], p1[3]), cvtpk_s(p1[4], p1[5]), cvtpk_s(p1[6], p1[7])};
    pw[3] = (v4u){cvtpk_s(p1[8], p1[9]), cvtpk_s(p1[10], p1[11]), cvtpk_s(p1[12], p1[13]), cvtpk_s(p1[14], p1[15])};
#pragma unroll
    for (int d0 = 0; d0 < 2; ++d0)
#pragma unroll
        for (int ks = 0; ks < 4; ++ks) {
            const s16x4 lo = vtr(vp + d0 * 4096 + ks * 1024), hi = vtr(vp + d0 * 4096 + ks * 1024 + 512);
            const bf16x8 vf = (bf16x8){lo[0], lo[1], lo[2], lo[3], hi[0], hi[1], hi[2], hi[3]};
            o[d0] = __builtin_amdgcn_mfma_f32_32x32x16_bf16(__builtin_bit_cast(bf16x8, pw[ks]), vf, o[d0], 0, 0, 0);
        }
}
__device__ __forceinline__ float rowmax32(const f32x16& p0, const f32x16& p1) {
    float a = fmaxf(p0[0], p1[0]);
#pragma unroll
    for (int r = 1; r < 16; ++r) a = fmaxf(a, fmaxf(p0[r], p1[r]));
    return xh_max(a);
}
__device__ __forceinline__ float rowsum32(const f32x16& p0, const f32x16& p1) {
    float a = 0.f, b = 0.f;
#pragma unroll
    for (int r = 0; r < 16; ++r) { a += p0[r]; b += p1[r]; }
    return a + b;
}

template <int PITCH>
__device__ __forceinline__ void dma_kv(const bf16* Kh, const bf16* Vh, int key0, unsigned kdst, unsigned vdst, int wid, int lane) {
    const bf16* ksrc = Kh + (size_t)(key0 + lane) * PITCH + wid * 8;
    const bf16* vsrc = Vh + (size_t)(key0 + 16 * (wid & 3) + (lane >> 2)) * PITCH + (wid >> 2) * 32 + (lane & 3) * 8;
    glds16(ksrc, (unsigned)__builtin_amdgcn_readfirstlane(kdst + wid * 1024));
    glds16(vsrc, (unsigned)__builtin_amdgcn_readfirstlane(vdst + wid * 1024));
}


#define SBAR() __builtin_amdgcn_sched_barrier(0)
__device__ __forceinline__ void kload8(bf16x8* kf, const LDSB* kp) {
    kf[0] = *(const LAS bf16x8*)(kp);        kf[1] = *(const LAS bf16x8*)(kp + 512);
    kf[2] = *(const LAS bf16x8*)(kp + 2048); kf[3] = *(const LAS bf16x8*)(kp + 2560);
    kf[4] = *(const LAS bf16x8*)(kp + 4096); kf[5] = *(const LAS bf16x8*)(kp + 4608);
    kf[6] = *(const LAS bf16x8*)(kp + 6144); kf[7] = *(const LAS bf16x8*)(kp + 6656);
}
__device__ __forceinline__ void kload2(bf16x8* kf, const LDSB* kp, int j) { kf[2 * j] = *(const LAS bf16x8*)(kp + j * 2048); kf[2 * j + 1] = *(const LAS bf16x8*)(kp + j * 2048 + 512); }

template <int MODE>
__device__ __forceinline__ void att_mod(f32x16& C0, f32x16& C1, int j, int qabs, int qw0, int cur, unsigned sel_lo, unsigned sel_hi, const LAS float* kbias, int hi) {
    if (MODE == 0) {
        const LAS float* kb = kbias + 64 * j + 4 * hi;
#pragma unroll
        for (int g4 = 0; g4 < 4; ++g4) { const f32x4 b0 = *(const LAS f32x4*)(kb + 8 * g4), b1 = *(const LAS f32x4*)(kb + 32 + 8 * g4);
#pragma unroll
            for (int i = 0; i < 4; ++i) { C0[4 * g4 + i] += b0[i]; C1[4 * g4 + i] += b1[i]; } }
        if (64 * j + 63 > qw0) {
#pragma unroll
            for (int r = 0; r < 16; ++r) { const int kv = 64 * j + crow(r, hi); if (kv > qabs) C0[r] = NEGM; if (kv + 32 > qabs) C1[r] = NEGM; }
        }
    } else if (MODE == 1) {
        const bool sel = ((j < 32 ? (sel_lo >> j) : (sel_hi >> (j - 32))) & 1u) != 0u;
        if (j == cur) {
#pragma unroll
            for (int r = 0; r < 16; ++r) { const int kv = 64 * j + crow(r, hi); if (kv > qabs || !sel) C0[r] = NEGM; if (kv + 32 > qabs || !sel) C1[r] = NEGM; }
        } else {
#pragma unroll
            for (int r = 0; r < 16; ++r) { if (!sel) { C0[r] = NEGM; C1[r] = NEGM; } }
        }
    } else {
        if (j == cur || j + 8 <= cur) {
#pragma unroll
            for (int r = 0; r < 16; ++r) { const int kv = 64 * j + crow(r, hi);
                if (kv > qabs || kv < qabs - 511) C0[r] = NEGM; if (kv + 32 > qabs || kv + 32 < qabs - 511) C1[r] = NEGM; }
        }
    }
}

template <int MODE, int PITCH, int THRL>
__device__ __forceinline__ void attn_fast(LDSB* lds, const bf16* Kh, const bf16* Vh, const LAS unsigned char* tl, int NT, const bf16x8 (&qr)[4], int qabs, int qw0, int cur,
                                          unsigned sel_lo, unsigned sel_hi, const LAS float* kbias, f32x16 (&o)[2], float& l_out, int wid, int lane) {
    const int r32 = lane & 31, hi = lane >> 5;
    const unsigned lds0 = (unsigned)(uintptr_t)lds;
    LAS float* wsf = (LAS float*)(lds + L_WS) + wid * 256;
    const bf16* ksrc = Kh + (size_t)lane * PITCH + wid * 8;
    const bf16* vsrc = Vh + (size_t)(16 * (wid & 3) + (lane >> 2)) * PITCH + (wid >> 2) * 32 + (lane & 3) * 8;
    const unsigned kdst = lds0 + L_K + wid * 1024, vdst = lds0 + L_V + wid * 1024;
#define TILE(t) __builtin_amdgcn_readfirstlane((int)tl[t])
#define DMA_K(t, slot) glds16(ksrc + (size_t)TILE(t) * (64 * PITCH), (unsigned)__builtin_amdgcn_readfirstlane(kdst + (slot)))
#define DMA_V(t, slot) glds16(vsrc + (size_t)TILE(t) * (64 * PITCH), (unsigned)__builtin_amdgcn_readfirstlane(vdst + (slot)))
    const LDSB* kp0 = lds + L_K + hi * 1024 + r32 * 16;
    const LDSB* vp0 = lds + L_V + ((lane >> 4) & 1) * 32 + (lane & 3) * 8 + (4 * hi + ((lane & 15) >> 2)) * 64;
    bf16x8 kf[8];
    float mhat = 0.f, l_reg = 0.f;
    f32x16 negm;
#pragma unroll
    for (int r = 0; r < 16; ++r) { negm[r] = 0.f; o[0][r] = 0.f; o[1][r] = 0.f; }
    asm volatile("" : "+v"(negm));
    bool resc = false;
    f32x16 pA0, pA1, pB0, pB1;
    int sl_prev = 0, sl_cur = 0, sl_next = SLOTB, sl_last = 0;
#define ROT() do { sl_prev = sl_cur; sl_cur = sl_next; sl_next = (sl_next == 2 * SLOTB) ? 0 : sl_next + SLOTB; } while (0)
#define RESC() do { if (resc) { LDS_WAIT(); \
        _Pragma("unroll") for (int d_ = 0; d_ < 2; ++d_) _Pragma("unroll") for (int r = 0; r < 16; ++r) o[d_][r] *= wsf[crow(r, hi)]; } } while (0)
#define ENDW(tt) do { if ((tt) + 3 < NT) { WAIT_BAR(2); } else if ((tt) + 2 < NT) { WAIT_BAR(1); } else { WAIT_BAR(0); } } while (0)
    DMA_K(0, 0); DMA_V(0, 0); if (NT > 1) DMA_K(1, SLOTB); if (NT > 2) DMA_K(2, 2 * SLOTB);
    if (NT > 2) { WAIT_BAR(3); } else if (NT > 1) { WAIT_BAR(2); } else { WAIT_BAR(1); }
    {
        const int j0 = TILE(0);
        qkt(pA0, pA1, lds + L_K, qr, negm, r32, hi);
        att_mod<MODE>(pA0, pA1, j0, qabs, qw0, cur, sel_lo, sel_hi, kbias, hi);
        const float rm = rowmax32(pA0, pA1);
        mhat += rm;
#pragma unroll
        for (int r = 0; r < 16; ++r) { pA0[r] -= rm; pA1[r] -= rm; negm[r] = -mhat; }
        asm volatile("" : "+v"(negm));
#pragma unroll
        for (int r = 0; r < 16; ++r) { pA0[r] = __builtin_amdgcn_exp2f(pA0[r]); pA1[r] = __builtin_amdgcn_exp2f(pA1[r]); }
    }
    WAIT_BAR(0);
    if (NT > 3) DMA_K(3, 0);
    if (NT > 1) DMA_V(1, SLOTB);
    ROT();
    if (NT > 1) kload8(kf, kp0 + sl_cur);
    ENDW(0);
    s16x4 vlo[8], vhi[8]; v4u pw0, pw1, pw2, pw3;
#define PKW(P, B) cvtpk_s(P[B], P[B + 1])
#define PAF(k) __builtin_bit_cast(bf16x8, pw##k)
#define VFR(i) (bf16x8){vlo[i][0], vlo[i][1], vlo[i][2], vlo[i][3], vhi[i][0], vhi[i][1], vhi[i][2], vhi[i][3]}
#define PIN(x) asm volatile("" : "+v"(x))
#define MX3(a, b, c) __builtin_fmaxf(__builtin_fmaxf((a), (b)), (c))
#define GAPA(MF, A0, A1, A2, A3, W0, W1, PW) do { MF; sacc += A0; sacc += A1; sacc += A2; sacc += A3; PIN(sacc); W0; W1; PIN(PW); SBAR(); } while (0)
#define EX(v) __builtin_amdgcn_exp2f(v)
#define GAPB(MF, X, B) do { MF; X[B] = EX(X[B]); X[B + 1] = EX(X[B + 1]); X[B + 2] = EX(X[B + 2]); X[B + 3] = EX(X[B + 3]); PIN(X); SBAR(); } while (0)
#define VRD(i) do { vlo[i] = vtr(vp_ + (((i) >> 2) * 4096 + ((i) & 3) * 1024)); vhi[i] = vtr(vp_ + (((i) >> 2) * 4096 + ((i) & 3) * 1024 + 512)); } while (0)
#define KRD(G, j) do { if (G) { kload2(kf, kp0 + sl_next, j); SBAR(); } } while (0)
#define MFMA32 __builtin_amdgcn_mfma_f32_32x32x16_bf16
#define STEP(C0, C1, P0, P1, t) do { const int jt_ = TILE(t); const bool GK_ = (t) + 3 < NT, GV_ = (t) + 1 < NT; sl_last = sl_cur; SBAR(); \
    const LDSB* vp_ = vp0 + sl_prev; \
    VRD(0); SBAR(); float sacc = (P0[0] + P0[1]); \
    GAPA(C0 = MFMA32(kf[0], qr[0], negm, 0, 0, 0), P0[2], P0[3], P0[4], P0[5],     pw0[0] = PKW(P0, 0), pw0[1] = PKW(P0, 2), pw0); \
    VRD(4); SBAR(); GAPA(C1 = MFMA32(kf[1], qr[0], negm, 0, 0, 0), P0[6], P0[7], P0[8], P0[9],     pw0[2] = PKW(P0, 4), pw0[3] = PKW(P0, 6), pw0); \
    VRD(1); SBAR(); GAPA(C0 = MFMA32(kf[2], qr[1], C0, 0, 0, 0),   P0[10], P0[11], P0[12], P0[13], pw1[0] = PKW(P0, 8), pw1[1] = PKW(P0, 10), pw1); \
    VRD(5); SBAR(); GAPA(C1 = MFMA32(kf[3], qr[1], C1, 0, 0, 0),   P0[14], P0[15], P1[0], P1[1],   pw1[2] = PKW(P0, 12), pw1[3] = PKW(P0, 14), pw1); \
    VRD(2); SBAR(); GAPA(C0 = MFMA32(kf[4], qr[2], C0, 0, 0, 0),   P1[2], P1[3], P1[4], P1[5],     pw2[0] = PKW(P1, 0), pw2[1] = PKW(P1, 2), pw2); \
    VRD(6); SBAR(); GAPA(C1 = MFMA32(kf[5], qr[2], C1, 0, 0, 0),   P1[6], P1[7], P1[8], P1[9],     pw2[2] = PKW(P1, 4), pw2[3] = PKW(P1, 6), pw2); \
    VRD(3); SBAR(); GAPA(C0 = MFMA32(kf[6], qr[3], C0, 0, 0, 0),   P1[10], P1[11], P1[12], P1[13], pw3[0] = PKW(P1, 8), pw3[1] = PKW(P1, 10), pw3); \
    VRD(7); SBAR(); GAPA(C1 = MFMA32(kf[7], qr[3], C1, 0, 0, 0),   P1[14], P1[15], 0.f, 0.f,       pw3[2] = PKW(P1, 12), pw3[3] = PKW(P1, 14), pw3); \
    l_reg += sacc; \
    if (GK_) { DMA_K((t) + 3, sl_cur); } if (GV_) { DMA_V((t) + 1, sl_next); } \
    att_mod<MODE>(C0, C1, jt_, qabs, qw0, cur, sel_lo, sel_hi, kbias, hi); \
    { float a = MX3(C0[0], C0[1], C1[0]), b = MX3(C0[2], C0[3], C1[1]); a = MX3(a, C1[2], C1[3]); \
      _Pragma("unroll") for (int r = 4; r < 16; r += 4) { a = MX3(a, C0[r], C0[r + 1]); b = MX3(b, C0[r + 2], C0[r + 3]); a = MX3(a, C1[r], C1[r + 1]); b = MX3(b, C1[r + 2], C1[r + 3]); } \
      float rm = xh_max(__builtin_fmaxf(a, b)); \
      resc = false; \
      if (__builtin_expect(__any(rm > (float)THRL), 0)) { const float dl = __builtin_fmaxf(rm, 0.f); mhat += dl; \
        _Pragma("unroll") for (int r = 0; r < 16; ++r) { C0[r] -= dl; C1[r] -= dl; } \
        _Pragma("unroll") for (int r = 0; r < 16; ++r) negm[r] = -mhat; asm volatile("" : "+v"(negm)); \
        const float f = __builtin_amdgcn_exp2f(-dl); l_reg *= f; if (hi == 0) wsf[r32] = f; resc = true; } } \
    SBAR(); \
    GAPB(o[0] = MFMA32(PAF(0), VFR(0), o[0], 0, 0, 0), C0, 0); \
    GAPB(o[1] = MFMA32(PAF(0), VFR(4), o[1], 0, 0, 0), C0, 4); \
    KRD(GV_, 0); GAPB(o[0] = MFMA32(PAF(1), VFR(1), o[0], 0, 0, 0), C0, 8); \
    KRD(GV_, 1); GAPB(o[1] = MFMA32(PAF(1), VFR(5), o[1], 0, 0, 0), C0, 12); \
    KRD(GV_, 2); GAPB(o[0] = MFMA32(PAF(2), VFR(2), o[0], 0, 0, 0), C1, 0); \
    KRD(GV_, 3); GAPB(o[1] = MFMA32(PAF(2), VFR(6), o[1], 0, 0, 0), C1, 4); \
    GAPB(o[0] = MFMA32(PAF(3), VFR(3), o[0], 0, 0, 0), C1, 8); \
    GAPB(o[1] = MFMA32(PAF(3), VFR(7), o[1], 0, 0, 0), C1, 12); \
    } while (0)
    int t = 1;
    for (; t + 1 < NT; t += 2) {
        STEP(pB0, pB1, pA0, pA1, t);     ENDW(t);     RESC(); ROT();
        STEP(pA0, pA1, pB0, pB1, t + 1); ENDW(t + 1); RESC(); ROT();
    }
    const LDSB* vlane_p = lds + L_V + ((lane >> 4) & 1) * 32 + (lane & 3) * 8 + (4 * hi + ((lane & 15) >> 2)) * 64;
    if (t < NT) {
        STEP(pB0, pB1, pA0, pA1, t); ENDW(t); RESC();
        l_reg += rowsum32(pB0, pB1);
        pv(o, vlane_p + sl_last, pB0, pB1);
    } else {
        l_reg += rowsum32(pA0, pA1);
        pv(o, vlane_p + sl_last, pA0, pA1);
    }
    l_out = xh_sum(l_reg);
    asm volatile("s_waitcnt lgkmcnt(0)\n\ts_barrier" ::: "memory");
#undef TILE
#undef DMA_K
#undef DMA_V
#undef ROT
#undef RESC
#undef ENDW
#undef PKW
#undef PAF
#undef VFR
#undef PIN
#undef MX3
#undef GAPA
#undef EX
#undef GAPB
#undef VRD
#undef KRD
#undef MFMA32
#undef STEP
}

__device__ __forceinline__ void load_rowvec(float (&fac)[16], const LAS float* tab, int hi) {
#pragma unroll
    for (int g4 = 0; g4 < 4; ++g4) { const f32x4 ff = *(const LAS f32x4*)(tab + 8 * g4 + 4 * hi);
#pragma unroll
        for (int i = 0; i < 4; ++i) fac[4 * g4 + i] = ff[i]; }
}

template <int PITCHO>
__device__ __forceinline__ void store_o_tile(LDSB* stage, const f32x16 (&o)[2], bf16* Ow, int lane) {
    const int r32 = lane & 31, hi = lane >> 5;
    LAS bf16* stg = (LAS bf16*)stage;
#pragma unroll
    for (int r = 0; r < 16; ++r) { const int orow = crow(r, hi);
#pragma unroll
        for (int d0 = 0; d0 < 2; ++d0) stg[orow * 64 + d0 * 32 + r32] = (bf16)f2bf(o[d0][r]); }
    LDS_WAIT();
#pragma unroll
    for (int i = 0; i < 4; ++i) { const int row = i * 8 + (lane >> 3), ch = lane & 7; const v4u v = *(const LAS v4u*)(stg + row * 64 + ch * 8); *(v4u*)(Ow + (size_t)row * PITCHO + ch * 8) = v; }
    LDS_WAIT();
}

__device__ __forceinline__ void fox_unit(Frame& F0, int b, int h, int qb) {
    struct { unsigned char* ws; LDSB* lds; int tid, wave; } F; F.ws = F0.ws; F.lds = F0.lds; F.tid = F0.tid; F.wave = F0.wave;
    asm volatile("" : "+s"(F.ws));
    LDSB* lds = F.lds; int tid_ = F.tid; asm volatile("" : "+v"(tid_));
    const int tid = tid_, lane = tid & 63, wid = F.wave, r32 = lane & 31, hi = lane >> 5;
    const int q0 = 256 * qb, NT = 4 * qb + 4;
    const float* cb = (const float*)(F.ws + WS_CB) + (size_t)(b * 8 + h) * SEQ;
    LAS float* kb = (LAS float*)(lds + L_ACC);
    for (int i = tid; i < q0 + 256; i += NTHR) kb[i] = cb[i];
    LAS unsigned char* tl = (LAS unsigned char*)(lds + L_TL);
    if (tid < NT) tl[tid] = (unsigned char)(NT - 1 - tid);
    const bf16* Qw = (const bf16*)(F.ws + WS_QF) + ((size_t)b * SEQ + q0 + 32 * wid) * 512 + h * 64;
    bf16x8 qr[4];
#pragma unroll
    for (int d0 = 0; d0 < 4; ++d0) qr[d0] = *(const bf16x8*)(Qw + (size_t)r32 * 512 + d0 * 16 + hi * 8);
    __syncthreads();
    const bf16* Kh = (const bf16*)(F.ws + WS_KF) + (size_t)b * SEQ * 512 + h * 64;
    const bf16* Vh = (const bf16*)(F.ws + WS_VF) + (size_t)b * SEQ * 512 + h * 64;
    f32x16 o[2]; float l;
    attn_fast<0, 512, 8>(lds, Kh, Vh, tl, NT, qr, q0 + 32 * wid + r32, q0 + 32 * wid, 0, 0u, 0u, kb, o, l, wid, lane);
    LAS float* wsf = (LAS float*)(lds + L_WS) + wid * 256;
    if (hi == 0) wsf[32 + r32] = 1.f / l;
    LDS_WAIT();
    float fac[16]; load_rowvec(fac, wsf + 32, hi);
#pragma unroll
    for (int r = 0; r < 16; ++r) { o[0][r] *= fac[r]; o[1][r] *= fac[r]; }
    bf16* Ow = (bf16*)(F.ws + WS_Y) + ((size_t)b * SEQ + q0 + 32 * wid) * 1024 + h * 64;
    store_o_tile<1024>(lds + L_ACC + 16384 + wid * 4096, o, Ow, lane);
    __syncthreads();
}

__device__ __forceinline__ void nsa_unit(Frame& F0, int b, int g, int cur) {
    struct { unsigned char* ws; LDSB* lds; int tid, wave; } F; F.ws = F0.ws; F.lds = F0.lds; F.tid = F0.tid; F.wave = F0.wave;
    asm volatile("" : "+s"(F.ws));
    LDSB* lds = F.lds; int tid_ = F.tid; asm volatile("" : "+v"(tid_));
    const int tid = tid_, lane = tid & 63, wid = F.wave, r32 = lane & 31, hi = lane >> 5;
    const int bg = b * 2 + g, hh = wid >> 1, head = 4 * g + hh, qh = wid & 1, qq = 32 * qh + r32, qpos = 64 * cur + qq;
    const unsigned lds0 = (unsigned)(uintptr_t)lds;
    LAS float* wsf = (LAS float*)(lds + L_WS) + wid * 256;
    LAS float* accw = (LAS float*)(lds + L_ACC) + wid * 2048;
    const size_t row0 = (size_t)b * SEQ + 64 * cur + 32 * qh;
    const bf16* Qw = (const bf16*)(F.ws + WS_QN) + row0 * 512 + head * 64;
    bf16x8 qr[4];
#pragma unroll
    for (int d0 = 0; d0 < 4; ++d0) qr[d0] = *(const bf16x8*)(Qw + (size_t)r32 * 512 + d0 * 16 + hi * 8);
    if (tid < 2) ((LAS unsigned*)(lds + L_TL + 128))[tid] = 0u;
    if (lane < 32) { const float* gp = (const float*)(F.ws + WS_GATE) + (row0 + lane) * 24 + head * 3;
        wsf[64 + lane] = gp[0]; wsf[96 + lane] = gp[1]; wsf[128 + lane] = gp[2]; }
    LDS_WAIT();
    {
        const bf16* Kc = (const bf16*)(F.ws + WS_KCMP) + (size_t)bg * 256 * 64;
        const bf16* Vc = (const bf16*)(F.ws + WS_VCMP) + (size_t)bg * 256 * 64;
        const int ntl = (4 * cur + 66) >> 6;
#pragma unroll
        for (int tl = 0; tl < 4; ++tl) if (tl < ntl) dma_kv<64>(Kc, Vc, 64 * tl, lds0 + L_K + tl * SLOTB, lds0 + L_V + tl * SLOTB, wid, lane);
        WAIT_BAR(0);
        f32x16 zero;
#pragma unroll
        for (int r = 0; r < 16; ++r) zero[r] = 0.f;
        float mrun = -1e30f;
#pragma unroll 1
        for (int tl = 0; tl < ntl; ++tl) {
            f32x16 p0, p1;
            qkt(p0, p1, lds + L_K + tl * SLOTB, qr, zero, r32, hi);
#pragma unroll
            for (int r = 0; r < 16; ++r) { const int c = 64 * tl + crow(r, hi); if (16 * c + 31 > qpos) p0[r] = NEGM; if (16 * (c + 32) + 31 > qpos) p1[r] = NEGM; }
            mrun = fmaxf(mrun, rowmax32(p0, p1));
            asm volatile("" ::: "memory");
        }
        f32x16 o[2];
#pragma unroll
        for (int r = 0; r < 16; ++r) { o[0][r] = 0.f; o[1][r] = 0.f; }
        float impv[4][8]; float prevY3 = 0.f, lsum = 0.f;
        const int vlane = ((lane >> 4) & 1) * 32 + (lane & 3) * 8 + (4 * hi + ((lane & 15) >> 2)) * 64;
#pragma unroll
        for (int tl = 0; tl < 4; ++tl) {
            if (tl < ntl) {
                f32x16 p0, p1;
                qkt(p0, p1, lds + L_K + tl * SLOTB, qr, zero, r32, hi);
#pragma unroll
                for (int r = 0; r < 16; ++r) { const int c = 64 * tl + crow(r, hi);
                    p0[r] = (16 * c + 31 > qpos) ? 0.f : __builtin_amdgcn_exp2f(p0[r] - mrun);
                    p1[r] = (16 * (c + 32) + 31 > qpos) ? 0.f : __builtin_amdgcn_exp2f(p1[r] - mrun); }
                lsum += rowsum32(p0, p1);
                float rX[4], rY[4];
#pragma unroll
                for (int g4 = 0; g4 < 4; ++g4) { rX[g4] = xh_other(p0[4 * g4 + 3], hi); rY[g4] = xh_other(p1[4 * g4 + 3], hi); }
#pragma unroll
                for (int g4 = 0; g4 < 4; ++g4) {
                    const float qs0 = (p0[4 * g4] + p0[4 * g4 + 1]) + (p0[4 * g4 + 2] + p0[4 * g4 + 3]);
                    const float qs1 = (p1[4 * g4] + p1[4 * g4 + 1]) + (p1[4 * g4 + 2] + p1[4 * g4 + 3]);
                    const float lo0 = (g4 > 0) ? rX[g4 > 0 ? g4 - 1 : 0] : prevY3;
                    const float lo1 = (g4 > 0) ? rY[g4 > 0 ? g4 - 1 : 0] : rX[3];
                    impv[tl][g4] = qs0 + (hi ? rX[g4] : lo0);
                    impv[tl][4 + g4] = qs1 + (hi ? rY[g4] : lo1);
                }
                prevY3 = rY[3];
                pv(o, lds + L_V + tl * SLOTB + vlane, p0, p1);
                asm volatile("" ::: "memory");
            } else {
#pragma unroll
                for (int e = 0; e < 8; ++e) impv[tl][e] = 0.f;
            }
        }
        const float ltot = xh_sum(lsum);
        const float invl = ltot > 0.f ? 1.f / ltot : 0.f;
        LAS float* imp = (LAS float*)(lds + L_IMP);
#pragma unroll
        for (int hd = 0; hd < 4; ++hd) {
            if (hh == hd) {
#pragma unroll
                for (int tl = 0; tl < 4; ++tl)
#pragma unroll
                    for (int e = 0; e < 8; ++e) { const int jj = 16 * tl + 8 * (e >> 2) + 2 * (e & 3) + hi; LAS float* p = imp + qq * 65 + jj;
                        if (hd == 0) *p = impv[tl][e] * invl; else *p += impv[tl][e] * invl; }
            }
            LDS_WAIT(); __syncthreads();
        }
        if (hi == 0) wsf[32 + r32] = invl;
        LDS_WAIT();
        float gc[16], il[16]; load_rowvec(gc, wsf + 64, hi); load_rowvec(il, wsf + 32, hi);
#pragma unroll
        for (int d0 = 0; d0 < 2; ++d0)
#pragma unroll
            for (int r = 0; r < 16; ++r) accw[(d0 * 16 + r) * 64 + lane] = o[d0][r] * (gc[r] * il[r]);
        LDS_WAIT();
    }
    if (cur >= 16) {
        LAS float* imp = (LAS float*)(lds + L_IMP);
        const int q = tid >> 3, part = tid & 7;
        if (part == 0) { imp[q * 65] += 1e4f; imp[q * 65 + cur] += 1e4f; imp[q * 65 + cur - 1] += 1e4f; }
        LDS_WAIT(); __syncthreads();
        const LAS float* irow = imp + q * 65;
        float sc[8];
#pragma unroll
        for (int i = 0; i < 8; ++i) { const int jj = part * 8 + i; sc[i] = (jj <= cur) ? irow[jj] : -1.f; }
        int rank[8];
#pragma unroll
        for (int i = 0; i < 8; ++i) rank[i] = 0;
        const int nv = cur + 1, e0 = (8 * part < nv) ? 8 * part : nv, e1 = (8 * part + 8 < nv) ? 8 * part + 8 : nv;
        for (int jp = 0; jp < e0; ++jp) { const float v = irow[jp];
#pragma unroll
            for (int i = 0; i < 8; ++i) rank[i] += (v >= sc[i]) ? 1 : 0; }
        for (int jp = e0; jp < e1; ++jp) { const float v = irow[jp];
#pragma unroll
            for (int i = 0; i < 8; ++i) { const int jj = part * 8 + i; rank[i] += (v > sc[i] || (v == sc[i] && jp < jj)) ? 1 : 0; } }
        for (int jp = e1; jp < nv; ++jp) { const float v = irow[jp];
#pragma unroll
            for (int i = 0; i < 8; ++i) rank[i] += (v > sc[i]) ? 1 : 0; }
        unsigned bits = 0;
#pragma unroll
        for (int i = 0; i < 8; ++i) bits |= (rank[i] < 16 ? 1u : 0u) << i;
        ((LAS unsigned char*)(lds + L_SEL))[q * 8 + part] = (unsigned char)bits;
        __hip_atomic_fetch_or((LAS unsigned*)(lds + L_TL + 128) + (part >> 2), bits << (8 * (part & 3)), __ATOMIC_RELAXED, __HIP_MEMORY_SCOPE_WORKGROUP);
        LDS_WAIT(); __syncthreads();
    } else {
        if (tid < 128) ((LAS unsigned*)(lds + L_SEL))[tid] = (tid & 1) ? 0u : ((1u << (cur + 1)) - 1u);
        if (tid == 0) ((LAS unsigned*)(lds + L_TL + 128))[0] = (1u << (cur + 1)) - 1u;
        LDS_WAIT(); __syncthreads();
    }
    const LAS unsigned* selw = (const LAS unsigned*)(lds + L_SEL);
    const unsigned sel_lo = selw[qq * 2], sel_hi = selw[qq * 2 + 1];
    const unsigned ulo = ((const LAS unsigned*)(lds + L_TL + 128))[0], uhi = ((const LAS unsigned*)(lds + L_TL + 128))[1];
    unsigned long long umask = ((unsigned long long)uhi << 32) | ulo;
    umask &= (cur >= 63) ? ~0ull : ((1ull << (cur + 1)) - 1ull);
    const int jlo = cur >= 8 ? cur - 8 : 0;
    LAS unsigned char* tls = (LAS unsigned char*)(lds + L_TL);
    LAS unsigned char* tlw = tls + 64;
    if (tid < 64) {
        if ((umask >> tid) & 1ull) tls[__builtin_popcountll(umask & ((1ull << tid) - 1ull))] = (unsigned char)tid;
        if (tid <= cur - jlo) tlw[tid] = (unsigned char)(jlo + tid);
    }
    LDS_WAIT(); __syncthreads();
    const int NTs = __builtin_amdgcn_readfirstlane(__builtin_popcountll(umask)), NTw = cur - jlo + 1;
    {
        const bf16* Kh = (const bf16*)(F.ws + WS_KS) + (size_t)bg * SEQ * 64;
        const bf16* Vh = (const bf16*)(F.ws + WS_VS) + (size_t)bg * SEQ * 64;
        f32x16 o[2]; float l;
        attn_fast<1, 64, 8>(lds, Kh, Vh, tls, NTs, qr, qpos, 0, cur, sel_lo, sel_hi, nullptr, o, l, wid, lane);
        if (hi == 0) wsf[32 + r32] = 1.f / l;
        LDS_WAIT();
        float fl[16], gs[16]; load_rowvec(fl, wsf + 32, hi); load_rowvec(gs, wsf + 96, hi);
#pragma unroll
        for (int d0 = 0; d0 < 2; ++d0)
#pragma unroll
            for (int r = 0; r < 16; ++r) accw[(d0 * 16 + r) * 64 + lane] += o[d0][r] * (fl[r] * gs[r]);
        LDS_WAIT();
    }
    {
        const bf16* Kh = (const bf16*)(F.ws + WS_KW) + (size_t)bg * SEQ * 64;
        const bf16* Vh = (const bf16*)(F.ws + WS_VW) + (size_t)bg * SEQ * 64;
        f32x16 o[2]; float l;
        attn_fast<2, 64, 8>(lds, Kh, Vh, tlw, NTw, qr, qpos, 0, cur, 0u, 0u, nullptr, o, l, wid, lane);
        if (hi == 0) wsf[32 + r32] = 1.f / l;
        LDS_WAIT();
        float fl[16], gate_win[16]; load_rowvec(fl, wsf + 32, hi); load_rowvec(gate_win, wsf + 128, hi);
#pragma unroll
        for (int d0 = 0; d0 < 2; ++d0)
#pragma unroll
            for (int r = 0; r < 16; ++r) o[d0][r] = accw[(d0 * 16 + r) * 64 + lane] + o[d0][r] * (fl[r] * gate_win[r]);
        LDS_WAIT();
        bf16* Ow = (bf16*)(F.ws + WS_Y) + row0 * 1024 + 512 + head * 64;
        store_o_tile<1024>((LDSB*)accw, o, Ow, lane);
    }
    __syncthreads();
}

__device__ __forceinline__ void dep_publish(Frame& F, gu32* w0, gu32* w1) {
    asm volatile("s_waitcnt vmcnt(0)" ::: "memory"); __syncthreads();
    if (F.tid == 0) { __builtin_amdgcn_fence(__ATOMIC_RELEASE, "agent"); asm volatile("s_waitcnt vmcnt(0)" ::: "memory");
        __hip_atomic_fetch_add(w0, 1u, RLX_AGENT); if (w1) __hip_atomic_fetch_add(w1, 1u, RLX_AGENT); }
}
__device__ __forceinline__ void dep_wait(Frame& F, gu32* w, unsigned need, gu32* wall, unsigned needall, int flagword) {
    if (F.wave == 0) {
        unsigned sp = 0;
        while ((unsigned)__builtin_amdgcn_readfirstlane((int)__hip_atomic_load(w, RLX_AGENT)) < need) { __builtin_amdgcn_s_sleep(4); if (++sp > (1u << 22)) break; }
        const unsigned tot = wall ? (unsigned)__builtin_amdgcn_readfirstlane((int)__hip_atomic_load(wall, RLX_AGENT)) : 0u;
        __builtin_amdgcn_fence(__ATOMIC_ACQUIRE, "agent");
        asm volatile("s_waitcnt vmcnt(0)" ::: "memory");
        if (F.lane == 0 && (!wall || tot >= needall)) F.MISC[flagword] = 1u;
    }
    LDS_WAIT(); __syncthreads();
}

constexpr int NSA_COST0 = 24;
__device__ __forceinline__ void p3_attention(Frame& F, kptr_t kp) {
    LAS unsigned short* order = (LAS unsigned short*)(F.lds + L_ORD);
    for (int id = F.tid; id < 2048; id += NTHR) {
        int pos;
        if (id >= 1024 && ((id - 1024) >> 6) < 2) pos = id - 1024;
        else {
            const int c = id < 1024 ? (63 - (id >> 4)) + NSA_COST0 : 4 * (15 - ((id - 1024) >> 6)) + 4;
            pos = 128;
            { int lo = c - NSA_COST0 + 1; if (lo < 0) lo = 0; int cnt = 64 - lo; if (cnt < 0) cnt = 0; pos += 16 * cnt; }
            { int cnt = 0; for (int qb = 0; qb < 14; ++qb) cnt += (4 * qb + 4 > c) ? 1 : 0; pos += 64 * cnt; }
            if (id < 1024) pos += (id & 15);
            else { const int cn = c - NSA_COST0; if (cn >= 0 && cn <= 63) pos += 16; pos += (id & 63); }
        }
        order[pos] = (unsigned short)id;
    }
    if (F.vcu < 8) { p2_cumsum_item(F, F.vcu * NWAVES + F.wave); dep_publish(F, F.ctl + CW_CS, nullptr); }
    LDS_WAIT(); __syncthreads();
    if (F.vcu >= F.G - 128 || F.G < 136) {
        for (int it = (F.G < 136) ? F.vcu : F.vcu - (F.G - 128); it < 128; it += (F.G < 136) ? F.G : 128) {
            p2_compress_item(F, kp, it);
            dep_publish(F, F.ctl + CW_CMP + 64 * ((it >> 2) & 15), F.ctl + CW_CMPT);
        }
    }
    gu32* qhead = F.ctl + CW_Q_ATT;
    for (;;) {
        if (F.tid == 0) F.MISC[0] = __hip_atomic_fetch_add(qhead, 1u, RLX_AGENT);
        LDS_WAIT(); __syncthreads();
        const unsigned k = F.MISC[0];
        if (k >= 2048u) break;
        const int id = (int)order[k];
        __syncthreads();
        if (id < 1024) {
            if (F.MISC[17] == 0u) dep_wait(F, F.ctl + CW_CMP + 64 * (id & 15), 8u, F.ctl + CW_CMPT, 128u, 17);
            nsa_unit(F, (id & 15) >> 1, id & 1, 63 - (id >> 4));
        } else {
            if (F.MISC[16] == 0u) dep_wait(F, F.ctl + CW_CS, 8u, nullptr, 0u, 16);
            fox_unit(F, (id & 63) >> 3, id & 7, 15 - ((id - 1024) >> 6));
        }
    }
}

__device__ __forceinline__ void p4_ynorm(Frame& F) {
    const int gw = F.vcu * NWAVES + F.wave, NGW = F.G * NWAVES;
    for (int m = gw; m < T; m += NGW) {
        bf16* row = (bf16*)(F.ws + WS_Y) + (size_t)m * 1024 + F.lane * 16;
        v4u a = *(const v4u*)row, b = *(const v4u*)(row + 8);
        float v[16];
        const unsigned w[8] = {a.x, a.y, a.z, a.w, b.x, b.y, b.z, b.w};
#pragma unroll
        for (int i = 0; i < 8; ++i) { v[2 * i] = __builtin_bit_cast(float, w[i] << 16); v[2 * i + 1] = __builtin_bit_cast(float, w[i] & 0xffff0000u); }
        float s = 0.f;
#pragma unroll
        for (int i = 0; i < 16; ++i) s += v[i] * v[i];
#pragma unroll
        for (int o = 1; o < 32; o <<= 1) s += __shfl_xor(s, o);
        const float r = 1.f / sqrtf(s * (1.f / 512.f) + EPS);
        v4u oa, ob;
        oa.x = pk2(v[0] * r, v[1] * r); oa.y = pk2(v[2] * r, v[3] * r); oa.z = pk2(v[4] * r, v[5] * r); oa.w = pk2(v[6] * r, v[7] * r);
        ob.x = pk2(v[8] * r, v[9] * r); ob.y = pk2(v[10] * r, v[11] * r); ob.z = pk2(v[12] * r, v[13] * r); ob.w = pk2(v[14] * r, v[15] * r);
        *(v4u*)row = oa; *(v4u*)(row + 8) = ob;
    }
}
__device__ __forceinline__ void p6_hnorm(Frame& F, const float* h1) {
    const int gw = F.vcu * NWAVES + F.wave, NGW = F.G * NWAVES;
    for (int m = gw; m < T; m += NGW) rms_row_to_bf16(F.lane, h1 + (size_t)m * DM, (bf16*)(F.ws + WS_XN) + (size_t)m * DM);
}
__device__ __forceinline__ void p9_final(Frame& F, float* out, const float* g_final) {
    const int gw = F.vcu * NWAVES + F.wave, NGW = F.G * NWAVES;
    for (int m = gw; m < T; m += NGW) {
        GAS f32x4* xr = (GAS f32x4*)(out + (size_t)m * DM) + F.lane;
        f32x4 v[4]; float s = 0.f;
#pragma unroll
        for (int j = 0; j < 4; ++j) { v[j] = xr[64 * j]; s += (v[j].x * v[j].x + v[j].y * v[j].y) + (v[j].z * v[j].z + v[j].w * v[j].w); }
        const float r = 1.f / sqrtf(wave_sum(s) * (1.f / DM) + EPS);
#pragma unroll
        for (int j = 0; j < 4; ++j) { const f32x4 gg = *((const f32x4*)g_final + F.lane + 64 * j); xr[64 * j] = v[j] * r * gg; }
    }
}

constexpr int N_PHASES = 10;
__global__ void __launch_bounds__(NTHR, 2) hymba_fwd(Args args) {
    extern __shared__ __attribute__((aligned(16))) unsigned char lds_raw[];
    Frame F;
    F.lds = (LDSB*)lds_raw;
    F.MISC = (volatile LAS unsigned*)(F.lds + L_MISC);
    F.tid = threadIdx.x; F.lane = F.tid & 63; F.wave = __builtin_amdgcn_readfirstlane(F.tid >> 6);
    F.G = gridDim.x; { const int bx = blockIdx.x; F.vcu = (F.G % 8 == 0) ? (bx % 8) * (F.G / 8) + bx / 8 : bx; }
    kptr_t kp0 = (kptr_t)__builtin_amdgcn_kernarg_segment_ptr();
#define KP() ({ kptr_t k_ = kp0; asm volatile("" : "+s"(k_)); k_; })
    { kptr_t kp = KP(); F.ws = *(unsigned char* const __attribute__((address_space(4)))*)(kp + 8 * 23); }
    F.ctl = (gu32*)(F.ws + WS_CTL);
    if (F.tid < 64) F.MISC[F.tid] = 0u;
    __syncthreads();
    int lo, hi; { kptr_t kp = KP(); lo = *(const int __attribute__((address_space(4)))*)(kp + 192); hi = *(const int __attribute__((address_space(4)))*)(kp + 196); }
    const bool one_launch = (hi - lo) > 1;
    XcdBarrier bar; bar.bar = (unsigned*)(F.ctl + CW_BAR); bar.x = 0; bar.st = nullptr; bar.wave = F.wave;
    if (one_launch) { bar = xcd_barrier_post((unsigned*)(F.ctl + CW_BAR), F.MISC + 8); bar.wave = F.wave; }
#ifdef PHASE_MASK
#define IN(k) (((PHASE_MASK >> (k)) & 1) && lo <= (k) && (k) < hi)
#else
#define IN(k) (lo <= (k) && (k) < hi)
#endif
#define SEAM(k) do { if (IN(k) && IN((k) + 1)) xcd_barrier(bar); } while (0)
#define RELANE() do { F.lane = lane_id(); F.tid = F.wave * 64 + F.lane; } while (0)

    if (IN(0)) { RELANE(); p0_prologue(F, KP()); SEAM(0); }

    if (IN(1)) { RELANE();
        pg8::Gemm g{(const bf16*)(F.ws + WS_XN), (const bf16*)(F.ws + WS_WIN), T, NPROJ, DM}; pg8::StaticOrder S; S.init(T, NPROJ, F.G, (int)blockIdx.x);
        kptr_t kp = KP(); EpiProj E{F.ws, AIN(kp, 3), AIN(kp, 4)};
        pg8::gemm_phase<EpiProj, pg8::StaticOrder, true, true>(F.lds, g, S, E, F.wave);
        if (IN(1) && IN(3)) xcd_barrier(bar);
    }

    if (IN(3)) { RELANE(); p3_attention(F, KP()); SEAM(3); }

    if (IN(4)) { RELANE(); p4_ynorm(F); SEAM(4); }

    if (IN(5)) { RELANE();
        pg8::Gemm g{(const bf16*)(F.ws + WS_Y), (const bf16*)(F.ws + WS_WOUT), T, DM, DM}; pg8::StaticOrder S; S.init(T, DM, F.G, (int)blockIdx.x);
        kptr_t kp = KP(); EpiOutRes E{AIN(kp, 0), *(float* const __attribute__((address_space(4)))*)(kp + 8 * 22), (bf16*)(F.ws + WS_XN), (float*)(F.ws + WS_SSQ1), F.lds};
        pg8::gemm_phase<EpiOutRes, pg8::StaticOrder, true, true>(F.lds, g, S, E, F.wave);
        if (IN(5) && IN(7)) xcd_barrier(bar);
    }


    if (IN(7)) { RELANE();
        pg8::Gemm g{(const bf16*)(F.ws + WS_XN), (const bf16*)(F.ws + WS_WUP), T, FF, DM}; pg8::StaticOrder S; S.init(T, FF, F.G, (int)blockIdx.x);
        EpiUp E{(bf16*)(F.ws + WS_U), (const float*)(F.ws + WS_SSQ1)};
        pg8::gemm_phase<EpiUp, pg8::StaticOrder, true, true>(F.lds, g, S, E, F.wave);
        SEAM(7);
    }

    if (IN(8)) { RELANE();
        pg8::Gemm g{(const bf16*)(F.ws + WS_U), (const bf16*)(F.ws + WS_WDN), T, DM, FF}; pg8::StaticOrder S; S.init(T, DM, F.G, (int)blockIdx.x);
        kptr_t kp = KP(); EpiDownNorm E{*(float* const __attribute__((address_space(4)))*)(kp + 8 * 22), AIN(kp, 21), (float*)(F.ws + WS_XS), F.ctl + CW_PANEL, F.lds};
        pg8::gemm_phase<EpiDownNorm, pg8::StaticOrder, true, true>(F.lds, g, S, E, F.wave);
    }

#undef IN
#undef SEAM
}

extern "C" void kernel_launch(void* const* d_in, const int* in_sizes, int n_in, void* d_out, int out_size, void* d_ws, size_t ws_size, hipStream_t stream) {
    static int grid = 0;
    if (grid == 0) {
        if (n_in != 22 || out_size != T * DM || ws_size < WS_END) { fprintf(stderr, "kernel_launch: unexpected shapes (n_in %d out %d ws %zu)\n", n_in, out_size, ws_size); grid = -1; return; }
        int dev = 0, cus = 0, per_cu = 0;
        if (hipGetDevice(&dev) != hipSuccess || hipDeviceGetAttribute(&cus, hipDeviceAttributeMultiprocessorCount, dev) != hipSuccess) { grid = -1; return; }
        if (hipFuncSetAttribute((const void*)hymba_fwd, hipFuncAttributeMaxDynamicSharedMemorySize, LDS_BYTES) != hipSuccess) { fprintf(stderr, "kernel_launch: hipFuncSetAttribute failed\n"); grid = -1; return; }
        if (hipOccupancyMaxActiveBlocksPerMultiprocessor(&per_cu, (const void*)hymba_fwd, NTHR, LDS_BYTES) != hipSuccess || per_cu < 1) { fprintf(stderr, "kernel_launch: occupancy query says %d\n", per_cu); per_cu = 1; }
        (void)hipGetLastError();
        grid = cus;
    }
    if (grid < 0) return;
    (void)hipMemsetAsync((char*)d_ws + WS_CTL, 0, CTL_ZERO_BYTES, stream);
    Args a{};
    for (int i = 0; i < 22; ++i) a.in[i] = (const float*)d_in[i];
    a.out = (float*)d_out; a.ws = (unsigned char*)d_ws;
#if MK_N_LAUNCHES == 1
    a.ph_lo = 0; a.ph_hi = N_PHASES;
    void* kargs[] = {&a};
    hipError_t e = hipLaunchCooperativeKernel((const void*)hymba_fwd, dim3(grid), dim3(NTHR), kargs, LDS_BYTES, stream);
    if (e != hipSuccess) fprintf(stderr, "kernel_launch: cooperative launch failed: %s (grid %d)\n", hipGetErrorString(e), grid);
#else
    for (int p = 0; p < N_PHASES; ++p) { a.ph_lo = p; a.ph_hi = p + 1; hipLaunchKernelGGL(hymba_fwd, dim3(grid), dim3(NTHR), LDS_BYTES, stream, a); }
#endif
}
```

```cpp
#include <hip/hip_runtime.h>
#include <hip/hip_bf16.h>
#include <cstdio>
#include <cstdint>

#ifndef MK_N_LAUNCHES
#define MK_N_LAUNCHES 1
#endif

__device__ __forceinline__ int lane_id() { return (int)__builtin_amdgcn_mbcnt_hi(~0u, __builtin_amdgcn_mbcnt_lo(~0u, 0u)); }
namespace pg8 {
#define PG8_LAS __attribute__((address_space(3)))
typedef unsigned short bf16_t;
typedef short bf16x8 __attribute__((ext_vector_type(8)));
typedef float f32x4 __attribute__((ext_vector_type(4)));
typedef unsigned u32x4 __attribute__((ext_vector_type(4)));
constexpr int BM = 256, BK = 64, HALF = 128, HTB = HALF * BK * 2, STAGE_BYTES = 8 * HTB, NXCD = 8, WGM = 8;

__host__ __device__ __forceinline__ int lds_byte(int r, int c) { const int st = (r >> 4) * 2 + (c >> 5), rr = r & 15, cc = c & 31, ob = rr * 64 + cc * 2; return st * 1024 + (ob ^ (((ob >> 9) & 1) << 5)); }
__host__ __device__ __forceinline__ void stage_rc(int b, int& R, int& C) { const int st = b / 1024, sb = b % 1024, swz = sb ^ (((sb >> 9) & 1) << 5); R = (st >> 1) * 16 + swz / 64; C = (st & 1) * 32 + (swz % 64) / 2; }
__host__ __device__ __forceinline__ int perm32(int rho) { const int n = rho >> 4, i = rho & 15; return 8 * (i >> 2) + 4 * n + (i & 3); }

struct Unit { int pm, pn; };
struct Gemm { const bf16_t* A; const bf16_t* Bt; int M, N, K; };

struct StaticOrder {
    int nM, nN, nwg, G, c;
    __host__ __device__ void init(int M, int N, int G_, int c_) { nM = M / BM; nN = N / BM; nwg = nM * nN; G = G_; c = c_; }
    __host__ __device__ bool next(int i, Unit& u) const {
        const long L = (long)i * G + c; if (L >= nwg) return false;
        int wgid = (int)L; { const int q = nwg / NXCD, r = nwg % NXCD, xcd = wgid % NXCD, off = wgid / NXCD; wgid = (xcd < r ? xcd * (q + 1) : r * (q + 1) + (xcd - r) * q) + off; }
        const int nig = WGM * nN, gid = wgid / nig, fm = gid * WGM, gsz = (nM - fm) < WGM ? (nM - fm) : WGM;
        u.pm = fm + ((wgid % nig) % gsz); u.pn = (wgid % nig) / gsz; return true;
    }
    __device__ __forceinline__ void a_ready(const Unit&) const {}
    __device__ __forceinline__ void done(const Unit&) const {}
};

__device__ __forceinline__ unsigned cvt_pk_bf16(float lo, float hi) { unsigned r; asm volatile("v_cvt_pk_bf16_f32 %0, %1, %2" : "=v"(r) : "v"(lo), "v"(hi)); return r; }

template <class Epi, class Sched, bool ALIGN_EPI = false, bool SP2 = false>
__device__ __forceinline__ void gemm_phase(PG8_LAS unsigned char* lds, const Gemm g, const Sched& S, const Epi& E, int wave_id) {
    const int wid = wave_id, lane = lane_id(), tid = wid * 64 + lane, wr = wid >> 2, wc = wid & 3, fr = lane & 15, fq = lane >> 4;
    const int K = g.K, nt = K / BK;
    unsigned voffA[2], voffB[2];
#pragma unroll
    for (int i = 0; i < 2; ++i) { int R, C; stage_rc(tid * 16 + i * 8192, R, C); const int Rb = Epi::PERM ? ((R & ~31) + perm32(R & 31)) : R;
        voffA[i] = (unsigned)(R * K + C) * 2u; voffB[i] = (unsigned)(Rb * K + C) * 2u; }
    const size_t kstep = (size_t)(BK * 2);
    const size_t hstep = (size_t)HALF * K * 2;
    const size_t tstep = 2 * hstep;
    const unsigned ldsw = (unsigned)wid * 1024u;
    const int aoff = lds_byte(wr * 64 + fr, fq * 8), boff = lds_byte(wc * 32 + fr, fq * 8);
#define PG8_SA(b, h) (((b) * 2 + (h)) * HTB)
#define PG8_SB(b, h) ((4 + (b) * 2 + (h)) * HTB)
#define PG8_STAGE(bufoff, gbase, voff) do { _Pragma("unroll") for (int _i = 0; _i < 2; ++_i) \
        __builtin_amdgcn_global_load_lds((const unsigned*)((const char*)(gbase) + (voff)[_i]), (PG8_LAS unsigned*)(lds + (bufoff) + ldsw + _i * 8192), 16, 0, 0); } while (0)
#define PG8_LDA(dst, b, h) do { _Pragma("unroll") for (int m = 0; m < 4; ++m) _Pragma("unroll") for (int k = 0; k < 2; ++k) dst[m][k] = *(const PG8_LAS bf16x8*)(lds + PG8_SA(b, h) + aoff + m * 2048 + k * 1024); } while (0)
#define PG8_LDB(dst, b, h) do { _Pragma("unroll") for (int n = 0; n < 2; ++n) _Pragma("unroll") for (int k = 0; k < 2; ++k) dst[n][k] = *(const PG8_LAS bf16x8*)(lds + PG8_SB(b, h) + boff + n * 2048 + k * 1024); } while (0)
#define PG8_MMA(ai, bj, At, Bt) do { __builtin_amdgcn_s_setprio(1); _Pragma("unroll") for (int m = 0; m < 4; ++m) _Pragma("unroll") for (int n = 0; n < 2; ++n) _Pragma("unroll") for (int k = 0; k < 2; ++k) \
        acc[ai][bj][m][n] = __builtin_amdgcn_mfma_f32_16x16x32_bf16(Bt[n][k], At[m][k], acc[ai][bj][m][n], 0, 0, 0); __builtin_amdgcn_s_setprio(0); } while (0)
#define PG8_WAIT_V(n) asm volatile("s_waitcnt vmcnt(" #n ")" ::: "memory")
#define PG8_WAIT_L(n) asm volatile("s_waitcnt lgkmcnt(" #n ")" ::: "memory")
#define PG8_BAR __builtin_amdgcn_s_barrier()
#define PG8_SCHED __builtin_amdgcn_sched_barrier(0)
    Unit cur, nxt; int ui = 0;
    if (!S.next(0, cur)) return;
    f32x4 acc[2][2][4][2];
#pragma unroll
    for (int a = 0; a < 2; ++a)
#pragma unroll
        for (int b = 0; b < 2; ++b)
#pragma unroll
            for (int m = 0; m < 4; ++m)
#pragma unroll
                for (int n = 0; n < 2; ++n) acc[a][b][m][n] = (f32x4){0.f, 0.f, 0.f, 0.f};
    bf16x8 At[4][2], B0[2][2], B1[2][2];
    const char* cA = (const char*)g.A + (size_t)cur.pm * tstep; const char* cB = (const char*)g.Bt + (size_t)cur.pn * tstep;
    S.a_ready(cur);
    if constexpr (SP2) {
        PG8_STAGE(PG8_SB(0, 0), cB, voffB); PG8_STAGE(PG8_SB(0, 1), cB + hstep, voffB); PG8_STAGE(PG8_SA(0, 0), cA, voffA); PG8_STAGE(PG8_SA(0, 1), cA + hstep, voffA);
        if (wr == 1) PG8_BAR;
        PG8_WAIT_V(2); PG8_BAR;
        PG8_STAGE(PG8_SB(1, 0), cB + kstep, voffB); PG8_STAGE(PG8_SA(1, 0), cA + kstep, voffA); PG8_STAGE(PG8_SB(1, 1), cB + hstep + kstep, voffB);
        PG8_WAIT_V(6); PG8_BAR;
    } else {
        PG8_STAGE(PG8_SB(0, 0), cB, voffB); PG8_STAGE(PG8_SA(0, 0), cA, voffA); PG8_STAGE(PG8_SB(0, 1), cB + hstep, voffB); PG8_STAGE(PG8_SA(0, 1), cA + hstep, voffA);
        if (wr == 1) PG8_BAR;
        PG8_WAIT_V(4); PG8_BAR;
        PG8_STAGE(PG8_SB(1, 0), cB + kstep, voffB); PG8_STAGE(PG8_SA(1, 0), cA + kstep, voffA); PG8_STAGE(PG8_SB(1, 1), cB + hstep + kstep, voffB);
        PG8_WAIT_V(6); PG8_BAR;
    }
    for (;;) {
        const bool has_next = S.next(ui + 1, nxt);
        const char* nA = has_next ? (const char*)g.A + (size_t)nxt.pm * tstep : cA; const char* nB = has_next ? (const char*)g.Bt + (size_t)nxt.pn * tstep : cB;
        for (int t = 0; t < nt; t += 2) {
            const bool last = (t == nt - 2);
            const char* a1 = cA + (size_t)(t + 1) * kstep;
            const char* a2 = last ? nA : cA + (size_t)(t + 2) * kstep; const char* b2 = last ? nB : cB + (size_t)(t + 2) * kstep;
            const char* a3 = a2 + kstep; const char* b3 = b2 + kstep;
            if (last && has_next) S.a_ready(nxt);
            if constexpr (Epi::MID) { if (t == nt / 2) E.mid(acc, cur, wr, wc, fr, fq); }
            if constexpr (SP2) {
            PG8_LDB(B0, 0, 0); PG8_LDB(B1, 0, 1); PG8_SCHED; PG8_LDA(At, 0, 0); PG8_STAGE(PG8_SA(1, 1), a1 + hstep, voffA);
            PG8_WAIT_V(8); PG8_WAIT_L(0); PG8_BAR; PG8_MMA(0, 0, At, B0); PG8_MMA(0, 1, At, B1); PG8_BAR; PG8_SCHED;
            PG8_LDA(At, 0, 1); PG8_STAGE(PG8_SB(0, 0), b2, voffB); PG8_STAGE(PG8_SB(0, 1), b2 + hstep, voffB); PG8_STAGE(PG8_SA(0, 0), a2, voffA);
            PG8_WAIT_V(8); PG8_WAIT_L(0); PG8_BAR; PG8_MMA(1, 0, At, B0); PG8_MMA(1, 1, At, B1); PG8_BAR; PG8_SCHED;
            PG8_LDB(B0, 1, 0); PG8_LDB(B1, 1, 1); PG8_SCHED; PG8_LDA(At, 1, 0); PG8_STAGE(PG8_SA(0, 1), a2 + hstep, voffA);
            PG8_WAIT_V(8); PG8_WAIT_L(0); PG8_BAR; PG8_MMA(0, 0, At, B0); PG8_MMA(0, 1, At, B1); PG8_BAR; PG8_SCHED;
            PG8_LDA(At, 1, 1); PG8_STAGE(PG8_SB(1, 0), b3, voffB); PG8_STAGE(PG8_SB(1, 1), b3 + hstep, voffB); PG8_STAGE(PG8_SA(1, 0), a3, voffA);
            PG8_WAIT_V(8); PG8_WAIT_L(0); PG8_BAR; PG8_MMA(1, 0, At, B0); PG8_MMA(1, 1, At, B1); PG8_BAR; PG8_SCHED;
            } else {
            PG8_LDB(B0, 0, 0); PG8_SCHED; PG8_LDA(At, 0, 0); PG8_STAGE(PG8_SA(1, 1), a1 + hstep, voffA);
            PG8_WAIT_L(8); PG8_BAR; PG8_WAIT_L(0); PG8_MMA(0, 0, At, B0); PG8_BAR; PG8_SCHED;
            PG8_LDB(B1, 0, 1); PG8_STAGE(PG8_SB(0, 0), b2, voffB);
            PG8_BAR; PG8_WAIT_L(0); PG8_MMA(0, 1, At, B1); PG8_BAR;
            PG8_LDA(At, 0, 1); PG8_STAGE(PG8_SA(0, 0), a2, voffA);
            PG8_BAR; PG8_WAIT_L(0); PG8_MMA(1, 0, At, B0); PG8_BAR; PG8_SCHED;
            PG8_STAGE(PG8_SB(0, 1), b2 + hstep, voffB);
            PG8_WAIT_V(6); PG8_BAR; PG8_MMA(1, 1, At, B1); PG8_BAR;
            PG8_LDB(B0, 1, 0); PG8_SCHED; PG8_LDA(At, 1, 0); PG8_STAGE(PG8_SA(0, 1), a2 + hstep, voffA);
            PG8_WAIT_L(8); PG8_BAR; PG8_WAIT_L(0); PG8_MMA(0, 0, At, B0); PG8_BAR; PG8_SCHED;
            PG8_LDB(B1, 1, 1); PG8_STAGE(PG8_SB(1, 0), b3, voffB);
            PG8_BAR; PG8_WAIT_L(0); PG8_MMA(0, 1, At, B1); PG8_BAR;
            PG8_LDA(At, 1, 1); PG8_STAGE(PG8_SA(1, 0), a3, voffA);
            PG8_BAR; PG8_WAIT_L(0); PG8_MMA(1, 0, At, B0); PG8_BAR; PG8_SCHED;
            PG8_STAGE(PG8_SB(1, 1), b3 + hstep, voffB);
            PG8_WAIT_V(6); PG8_BAR; PG8_MMA(1, 1, At, B1); PG8_BAR;
            }
        }
        if constexpr (ALIGN_EPI) { if (wr == 0) PG8_BAR; }
        E(acc, cur, wr, wc, fr, fq); S.done(cur);
        if (!has_next) break;
#pragma unroll
        for (int a = 0; a < 2; ++a)
#pragma unroll
            for (int b = 0; b < 2; ++b)
#pragma unroll
                for (int m = 0; m < 4; ++m)
#pragma unroll
                    for (int n = 0; n < 2; ++n) acc[a][b][m][n] = (f32x4){0.f, 0.f, 0.f, 0.f};
        cur = nxt; cA = nA; cB = nB; ++ui;
        if constexpr (ALIGN_EPI) { if (wr == 1) PG8_BAR; }
    }
    PG8_WAIT_V(0);
    if constexpr (!ALIGN_EPI) { if (wr == 0) PG8_BAR; }
    PG8_BAR;
#undef PG8_SA
#undef PG8_SB
#undef PG8_STAGE
#undef PG8_LDA
#undef PG8_LDB
#undef PG8_MMA
#undef PG8_WAIT_V
#undef PG8_WAIT_L
#undef PG8_BAR
#undef PG8_SCHED
}
}

#define GAS __attribute__((address_space(1)))
#define LAS __attribute__((address_space(3)))
typedef unsigned short bf16;
typedef unsigned v4u __attribute__((ext_vector_type(4)));
typedef float f32x4 __attribute__((ext_vector_type(4)));
typedef float f32x16 __attribute__((ext_vector_type(16)));
typedef short bf16x8 __attribute__((ext_vector_type(8)));
typedef short s16x4 __attribute__((ext_vector_type(4)));
typedef short v4i16_t __attribute__((ext_vector_type(4)));
typedef LAS unsigned char LDSB;
typedef GAS unsigned gu32;

constexpr int NWAVES = 8, NTHR = 512;
constexpr int BATCH = 8, SEQ = 4096, DM = 1024, T = BATCH * SEQ;
constexpr int NPROJ = 3072;
constexpr int N_IN = 2848, FF = 4096;
constexpr float EPS = 1e-6f;
constexpr float C2 = 0.125f * 1.4426950408889634f;
constexpr float LOG2E = 1.4426950408889634f;
constexpr float NEGM = -1000.0f;

constexpr size_t MiB = 1u << 20;
constexpr size_t WS_CTL = 0, CTL_ZERO_BYTES = 1 * MiB;
constexpr size_t WS_WIN = 2 * MiB;
constexpr size_t WS_WOUT = 8 * MiB;
constexpr size_t WS_WUP = 10 * MiB;
constexpr size_t WS_WDN = 18 * MiB;
constexpr size_t WS_W1K = 26 * MiB;
constexpr size_t WS_W1V = 27 * MiB;
constexpr size_t WS_W2K = 28 * MiB;
constexpr size_t WS_W2V = 28 * MiB + 65536;
constexpr size_t WS_B1K = 28 * MiB + 131072;
constexpr size_t WS_B1V = 28 * MiB + 131072 + 65536;
constexpr size_t WS_ROPEC = 29 * MiB;
constexpr size_t WS_ROPES = 29 * MiB + 524288;
constexpr size_t WS_FL = 30 * MiB;
constexpr size_t WS_CB = 31 * MiB;
constexpr size_t WS_XN = 32 * MiB;
constexpr size_t WS_U = 96 * MiB;
constexpr size_t WS_QF = 96 * MiB;
constexpr size_t WS_KF = 128 * MiB;
constexpr size_t WS_VF = 160 * MiB;
constexpr size_t WS_QN = 192 * MiB;
constexpr size_t WS_KC = 224 * MiB;
constexpr size_t WS_VC = 233 * MiB;
constexpr size_t WS_KS = 242 * MiB;
constexpr size_t WS_VS = 250 * MiB;
constexpr size_t WS_KW = 258 * MiB;
constexpr size_t WS_VW = 266 * MiB;
constexpr size_t WS_GATE = 274 * MiB;
constexpr size_t WS_KCMP = 277 * MiB;
constexpr size_t WS_VCMP = 277 * MiB + 524288;
constexpr size_t WS_Y = 280 * MiB;
constexpr size_t WS_SSQ1 = 352 * MiB;
constexpr size_t WS_XS = 353 * MiB;
constexpr size_t WS_SSQY = 354 * MiB;
constexpr size_t WS_END = 356 * MiB;

constexpr int CW_Q_ATT = 64;
constexpr int CW_CS = 128;
constexpr int CW_CMPT = 192;
constexpr int CW_CMP = 256;
constexpr int CW_BAR = 4096;
constexpr int CW_PANEL = 8192;

constexpr int L_K = 0;
constexpr int L_V = 32768;
constexpr int L_ACC = 65536;
constexpr int L_IMP = 131072;
constexpr int L_WS = 131072 + 17408;
constexpr int L_SEL = L_WS + 8192;
constexpr int L_ORD = L_SEL + 512;
constexpr int L_MISC = L_ORD + 4096;
constexpr int L_TL = L_MISC + 256;
constexpr int LDS_BYTES = L_TL + 256;
constexpr int SLOTB = 8192;

#define RLX_AGENT __ATOMIC_RELAXED, __HIP_MEMORY_SCOPE_AGENT
#define LDS_WAIT() asm volatile("s_waitcnt lgkmcnt(0)" ::: "memory")
#define VM_WAIT() asm volatile("s_waitcnt vmcnt(0)" ::: "memory")
__device__ __forceinline__ unsigned f2bf(float f) { unsigned u = __builtin_bit_cast(unsigned, f); return (u + 0x7fffu + ((u >> 16) & 1u)) >> 16; }
__device__ __forceinline__ unsigned pk2(float lo, float hi) { return f2bf(lo) | (f2bf(hi) << 16); }
__device__ __forceinline__ float bf2f(unsigned short b) { return __builtin_bit_cast(float, (unsigned)b << 16); }

#define XB_TMO      128
#define XB_XCNT(j)  (256  + 64 * (j))
#define XB_XSUB(j)  (1280 + 64 * (j))
#define XB_XGEN(j)  (2304 + 64 * (j))
#define XB_TOP      3328
#define XB_TOPGEN   3392
#define XCD_BAR_WORDS 3456
#define XB_SPIN_CAP (1u << 22)
__device__ __forceinline__ unsigned xb_ld(unsigned* p)              { return __hip_atomic_load(p, __ATOMIC_RELAXED, __HIP_MEMORY_SCOPE_AGENT); }
__device__ __forceinline__ unsigned xb_add(unsigned* p, unsigned v) { return __hip_atomic_fetch_add(p, v, __ATOMIC_RELAXED, __HIP_MEMORY_SCOPE_AGENT); }
__device__ __forceinline__ unsigned xb_xcc_id() { return (unsigned)__builtin_amdgcn_s_getreg((3 << 11) | 20) & 0xFu; }
#define XB_SPIN(cond, bar) do { unsigned _sp = 0; while (cond) { __builtin_amdgcn_s_sleep(1); \
    if ((++_sp & 255u) == 0u) { if (xb_ld(&(bar)[XB_TMO])) break; if (_sp > XB_SPIN_CAP) { atomicAdd(&(bar)[XB_TMO], 1u); break; } } } } while (0)
struct XcdBarrier { unsigned* bar; unsigned x; volatile LAS unsigned* st; int wave; };
__device__ __forceinline__ XcdBarrier xcd_barrier_post(unsigned* bar, volatile LAS unsigned* st) {
    XcdBarrier b; b.bar = bar; b.x = xb_xcc_id(); b.st = st; b.wave = 0;
    if (threadIdx.x == 0) (void)xb_add(&bar[XB_XCNT(b.x)], 1u);
    return b;
}
__device__ __forceinline__ void xcd_barrier_complete(unsigned* bar, unsigned x, unsigned& nloc, unsigned& nx) {
    const unsigned G = gridDim.x * gridDim.y * gridDim.z;
    unsigned sum, cnt, mine, sp = 0u;
    for (;;) {
        sum = 0u; cnt = 0u; mine = 0u;
#pragma unroll
        for (unsigned j = 0; j < 16; ++j) { const unsigned c = xb_ld(&bar[XB_XCNT(j)]); sum += c; cnt += (c > 0u) ? 1u : 0u; mine = (j == x) ? c : mine; }
        if (sum == G) break;
        __builtin_amdgcn_s_sleep(1);
        if ((++sp & 255u) == 0u) { if (xb_ld(&bar[XB_TMO])) break; if (sp > XB_SPIN_CAP) { atomicAdd(&bar[XB_TMO], 1u); break; } }
    }
    nloc = mine > 0u ? mine : 1u; nx = cnt > 0u ? cnt : 1u;
}
__device__ __forceinline__ void xcd_barrier(const XcdBarrier& b) {
    asm volatile("s_waitcnt vmcnt(0)" ::: "memory");
    __syncthreads();
    if (b.wave == 0 && lane_id() == 0) {
        unsigned* bar = b.bar;
        __builtin_amdgcn_s_waitcnt(0);
        unsigned nloc = b.st[0], nx = b.st[1];
        if (nloc == 0u) { xcd_barrier_complete(bar, b.x, nloc, nx); b.st[0] = nloc; b.st[1] = nx; }
        const unsigned old = xb_add(&bar[XB_XSUB(b.x)], 1u);
        const unsigned gen = old / nloc;
        if (old + 1u == (gen + 1u) * nloc) {
            __builtin_amdgcn_fence(__ATOMIC_RELEASE, "agent");
            asm volatile("s_waitcnt vmcnt(0)" ::: "memory");
            const unsigned og = xb_add(&bar[XB_TOP], 1u);
            const unsigned tg = og / nx;
            if (og + 1u == (tg + 1u) * nx) xb_add(&bar[XB_TOPGEN], 1u);
            else XB_SPIN(xb_ld(&bar[XB_TOPGEN]) == tg, bar);
            __builtin_amdgcn_fence(__ATOMIC_ACQUIRE, "agent");
            xb_add(&bar[XB_XGEN(b.x)], 1u);
            asm volatile("s_waitcnt vmcnt(0)" ::: "memory");
        } else {
            XB_SPIN(xb_ld(&bar[XB_XGEN(b.x)]) == gen, bar);
            __builtin_amdgcn_fence(__ATOMIC_ACQUIRE, "agent");
            asm volatile("s_waitcnt vmcnt(0)" ::: "memory");
        }
    }
    __syncthreads();
}

struct Args { const float* in[22]; float* out; unsigned char* ws; int ph_lo, ph_hi; };

struct Frame {
    LDSB* lds;
    volatile LAS unsigned* MISC;
    gu32* ctl;
    int tid, lane, wave, vcu, G;
    unsigned char* ws;
};

__device__ __forceinline__ float wave_sum(float v) {
#pragma unroll
    for (int o = 1; o < 64; o <<= 1) v += __shfl_xor(v, o);
    return v;
}

__device__ __forceinline__ int win_src_col(int n) {
    const int pn = n >> 8, c = n & 255, half = c >> 7, slot = (c >> 5) & 3, d = c & 31;
    if (pn < 8) {
        const int tsr = pn >> 1, j = pn & 1;
        const int tb = (tsr == 0) ? 0 : (tsr == 1) ? 512 : (tsr == 2) ? 1024 : 1544;
        return tb + 64 * (4 * j + slot) + 32 * half + d;
    }
    if (pn < 11) {
        const int base = 2056 + (pn - 8) * 256;
        return base + (slot >> 1) * 128 + (slot & 1) * 64 + 32 * half + d;
    }
    if (c < 8) return 1536 + c;
    if (c < 32) return 2824 + (c - 8);
    return -1;
}

template <bool MAPPED>
__device__ __forceinline__ void p0_transpose_item(const float* W, int K, int N, bf16* WT, LAS float* scr, int item, int lane, const float* kscale, int nblk) {
    const int kb = item / nblk, nb = item % nblk, k0 = 64 * kb, n0 = 32 * nb;
    int src = n0 + (lane & 31);
    if (MAPPED) src = win_src_col(src);
#pragma unroll 8
    for (int i = 0; i < 32; ++i) { const int kk = 2 * i + (lane >> 5);
        float v = 0.f; if (src >= 0) v = W[(size_t)(k0 + kk) * N + src];
        if (kscale) v *= kscale[k0 + kk];
        scr[kk * 33 + (lane & 31)] = v; }
    LDS_WAIT(); asm volatile("" ::: "memory");
    const int c = lane & 7;
#pragma unroll
    for (int j = 0; j < 4; ++j) { const int n = (lane >> 3) + 8 * j; const LAS float* s = scr + (8 * c) * 33 + n;
        v4u o; o.x = pk2(s[0 * 33], s[1 * 33]); o.y = pk2(s[2 * 33], s[3 * 33]); o.z = pk2(s[4 * 33], s[5 * 33]); o.w = pk2(s[6 * 33], s[7 * 33]);
        *(GAS v4u*)(WT + (size_t)(n0 + n) * K + k0 + 8 * c) = o; }
    LDS_WAIT(); asm volatile("" ::: "memory");
}

__device__ __forceinline__ void rms_row_to_bf16(int lane, const float* xrow, bf16* orow) {
    const GAS f32x4* xr = (const GAS f32x4*)xrow + lane;
    f32x4 v[4]; float s = 0.f;
#pragma unroll
    for (int j = 0; j < 4; ++j) { v[j] = xr[64 * j]; s += (v[j].x * v[j].x + v[j].y * v[j].y) + (v[j].z * v[j].z + v[j].w * v[j].w); }
    const float r = 1.f / sqrtf(wave_sum(s) * (1.f / DM) + EPS);
    GAS unsigned long long* o8 = (GAS unsigned long long*)orow + lane;
#pragma unroll
    for (int j = 0; j < 4; ++j) o8[64 * j] = (unsigned long long)pk2(v[j].x * r, v[j].y * r) | ((unsigned long long)pk2(v[j].z * r, v[j].w * r) << 32);
}

typedef __attribute__((address_space(4))) const char* kptr_t;
#define AIN(kp_, i) (*(const float* const __attribute__((address_space(4)))*)((kp_) + 8 * (i)))
__device__ __forceinline__ void p0_prologue(Frame& F, kptr_t kp) {
    const float* x = AIN(kp, 0); const float* g_attn = AIN(kp, 1); const float* w_in = AIN(kp, 2);
    const float* cmpk_pe = AIN(kp, 5); const float* cmpk_w1 = AIN(kp, 6); const float* cmpk_w2 = AIN(kp, 8);
    const float* cmpv_pe = AIN(kp, 10); const float* cmpv_w1 = AIN(kp, 11); const float* cmpv_w2 = AIN(kp, 13);
    const float* g_fox = AIN(kp, 15); const float* g_nsa = AIN(kp, 16); const float* w_out = AIN(kp, 17);
    const float* g_mlp = AIN(kp, 18); const float* w_up = AIN(kp, 19); const float* w_down = AIN(kp, 20);
    LAS float* scr = (LAS float*)(F.lds + F.wave * 16384);
    const int gw = F.vcu * NWAVES + F.wave, NGW = F.G * NWAVES;
    for (int it = gw; it < 128; it += NGW) {
        const int kv = it >> 6, kc = it & 63;
        const float* pe = kv ? cmpv_pe : cmpk_pe; const float* w1 = kv ? cmpv_w1 : cmpk_w1;
        f32x4 a = (f32x4){0.f, 0.f, 0.f, 0.f};
#pragma unroll 8
        for (int k = 32 * kc; k < 32 * kc + 32; ++k) { const f32x4 wv = *((const f32x4*)(w1 + (size_t)k * 256) + F.lane); a = a + wv * pe[k]; }
        *((f32x4*)(F.ws + (kv ? WS_B1V : WS_B1K)) + kc * 64 + F.lane) = a;
    }
    constexpr int I_IN = (DM / 64) * (NPROJ / 32), I_OUT = (DM / 64) * (DM / 32), I_UP = (DM / 64) * (FF / 32), I_DN = (FF / 64) * (DM / 32);
    constexpr int I_W1 = (2048 / 64) * (256 / 32), I_W2 = (256 / 64) * (64 / 32);
    constexpr int NITEMS = I_IN + I_OUT + I_UP + I_DN + 2 * I_W1 + 2 * I_W2;
    for (int it = gw; it < NITEMS; it += NGW) {
        int r = it;
        if (r < I_IN) { p0_transpose_item<true>(w_in, DM, N_IN, (bf16*)(F.ws + WS_WIN), scr, r, F.lane, g_attn, NPROJ / 32); continue; } r -= I_IN;
        if (r < I_OUT) {
            const int kb = r / (DM / 32);
            const float* ks = (kb < 8) ? g_fox : (g_nsa - 512);
            p0_transpose_item<false>(w_out, DM, DM, (bf16*)(F.ws + WS_WOUT), scr, r, F.lane, ks, DM / 32); continue; } r -= I_OUT;
        if (r < I_UP) { p0_transpose_item<false>(w_up, DM, FF, (bf16*)(F.ws + WS_WUP), scr, r, F.lane, g_mlp, FF / 32); continue; } r -= I_UP;
        if (r < I_DN) { p0_transpose_item<false>(w_down, FF, DM, (bf16*)(F.ws + WS_WDN), scr, r, F.lane, nullptr, DM / 32); continue; } r -= I_DN;
        if (r < I_W1) { p0_transpose_item<false>(cmpk_w1, 2048, 256, (bf16*)(F.ws + WS_W1K), scr, r, F.lane, nullptr, 8); continue; } r -= I_W1;
        if (r < I_W1) { p0_transpose_item<false>(cmpv_w1, 2048, 256, (bf16*)(F.ws + WS_W1V), scr, r, F.lane, nullptr, 8); continue; } r -= I_W1;
        if (r < I_W2) { p0_transpose_item<false>(cmpk_w2, 256, 64, (bf16*)(F.ws + WS_W2K), scr, r, F.lane, nullptr, 2); continue; } r -= I_W2;
        p0_transpose_item<false>(cmpv_w2, 256, 64, (bf16*)(F.ws + WS_W2V), scr, r, F.lane, nullptr, 2);
    }
    {
        float* rc = (float*)(F.ws + WS_ROPEC); float* rs = (float*)(F.ws + WS_ROPES);
        for (int i = F.vcu * NTHR + F.tid; i < SEQ * 32; i += F.G * NTHR) {
            const int pos = i >> 5, d = i & 31;
            const float inv = exp2f(-(float)d * (13.287712379549449f / 32.0f));
            const float ang = (float)pos * inv;
            const double a = (double)ang;
            const double k = __builtin_rint(a * 0.15915494309189535);
            const float red = (float)(a - k * 6.283185307179586);
            rc[i] = cosf(red); rs[i] = sinf(red);
        }
    }
    for (int m = gw; m < T; m += NGW) rms_row_to_bf16(F.lane, x + (size_t)m * DM, (bf16*)(F.ws + WS_XN) + (size_t)m * DM);
}

typedef pg8::f32x4 pf4;
__device__ __forceinline__ float log_sigmoidf(float v) { return v >= 0.f ? -log1pf(expf(-v)) : v - log1pf(expf(v)); }

struct EpiProj { static constexpr bool MID = false;
    static constexpr bool PERM = true;
    unsigned char* ws; const float* b_f; const float* b_gate;
    __device__ __forceinline__ void operator()(const pf4 (&acc)[2][2][4][2], const pg8::Unit& u, int wr, int wc, int fr, int fq) const {
        const int pn = u.pn; const int rbase = u.pm * 256 + wr * 64 + fr;
        if (pn == 11) {
            if (wc != 0) return;
            float* FL = (float*)(ws + WS_FL); float* GT = (float*)(ws + WS_GATE);
#pragma unroll
            for (int ai = 0; ai < 2; ++ai)
#pragma unroll
                for (int m = 0; m < 4; ++m) { const int row = rbase + ai * 128 + m * 16; const int b = row >> 12, s = row & 4095;
#pragma unroll
                    for (int n = 0; n < 2; ++n) { const pf4 v = acc[ai][0][m][n];
                        if (fq == 0) {
#pragma unroll
                            for (int i = 0; i < 4; ++i) { const int h = 4 * n + i; FL[(size_t)(b * 8 + h) * SEQ + s] = log_sigmoidf(v[i] + b_f[h]); }
                        } else { const int j0 = 8 * fq - 8 + 4 * n; pf4 o;
#pragma unroll
                            for (int i = 0; i < 4; ++i) { const float z = v[i] + b_gate[j0 + i]; o[i] = 1.f / (1.f + expf(-z)); }
                            *(pf4*)(GT + (size_t)row * 24 + j0) = o; } } }
            return;
        }
        const bool rope = (pn == 6) || (pn == 7) || ((pn == 9 || pn == 10) && wc < 2);
        const float sc = (pn < 2 || pn == 6 || pn == 7) ? C2 : 1.f;
        const float* RC = (const float*)(ws + WS_ROPEC); const float* RS = (const float*)(ws + WS_ROPES);
        size_t tb;
        if (pn < 8) { const int tsr = pn >> 1; tb = (tsr == 0) ? WS_QF : (tsr == 1) ? WS_KF : (tsr == 2) ? WS_VF : WS_QN; }
        else { const int vt = wc >> 1; tb = (pn == 8) ? (vt ? WS_VC : WS_KC) : (pn == 9) ? (vt ? WS_VS : WS_KS) : (vt ? WS_VW : WS_KW); }
        bf16* TB = (bf16*)(ws + tb);
#pragma unroll
        for (int ai = 0; ai < 2; ++ai)
#pragma unroll
            for (int m = 0; m < 4; ++m) { const int row = rbase + ai * 128 + m * 16;
                pf4 a0 = acc[ai][0][m][0], a1 = acc[ai][0][m][1], b0 = acc[ai][1][m][0], b1 = acc[ai][1][m][1];
                if (rope) { const int pos = row & 4095;
                    const pf4 c0 = *(const pf4*)(RC + pos * 32 + 8 * fq), c1 = *(const pf4*)(RC + pos * 32 + 8 * fq + 4);
                    const pf4 s0 = *(const pf4*)(RS + pos * 32 + 8 * fq), s1 = *(const pf4*)(RS + pos * 32 + 8 * fq + 4);
                    const pf4 x0 = a0 * c0 - b0 * s0, x1 = a1 * c1 - b1 * s1, y0 = a0 * s0 + b0 * c0, y1 = a1 * s1 + b1 * c1;
                    a0 = x0; a1 = x1; b0 = y0; b1 = y1; }
                a0 = a0 * sc; a1 = a1 * sc; b0 = b0 * sc; b1 = b1 * sc;
                v4u w0, w1; w0.x = pk2(a0[0], a0[1]); w0.y = pk2(a0[2], a0[3]); w0.z = pk2(a1[0], a1[1]); w0.w = pk2(a1[2], a1[3]);
                w1.x = pk2(b0[0], b0[1]); w1.y = pk2(b0[2], b0[3]); w1.z = pk2(b1[0], b1[1]); w1.w = pk2(b1[2], b1[3]);
                bf16* p;
                if (pn < 8) p = TB + (size_t)row * 512 + 64 * (4 * (pn & 1) + wc) + 8 * fq;
                else { const int b = row >> 12, s = row & 4095, g = wc & 1; p = TB + ((size_t)(b * 2 + g) * SEQ + s) * 64 + 8 * fq; }
                *(v4u*)p = w0; *(v4u*)(p + 32) = w1; }
    }
};

struct EpiOutRes {
    static constexpr bool PERM = true, MID = true;
    const float* x; float* out; bf16* xn; float* ssq; LDSB* lds; int pm0;
    __device__ __forceinline__ const LAS float* tabrow(const pg8::Unit& u, int rl) const { return (const LAS float*)(lds + L_IMP + 8192) + (((u.pm == pm0) ? 0 : 256) + rl) * 2; }
    __device__ __forceinline__ void mid(pf4 (&acc)[2][2][4][2], const pg8::Unit& u, int wr, int wc, int fr, int fq) const {
#pragma unroll
        for (int ai = 0; ai < 2; ++ai)
#pragma unroll
            for (int m = 0; m < 4; ++m) { const float q = tabrow(u, ai * 128 + wr * 64 + m * 16 + fr)[0];
#pragma unroll
                for (int bj = 0; bj < 2; ++bj) { acc[ai][bj][m][0] = acc[ai][bj][m][0] * q; acc[ai][bj][m][1] = acc[ai][bj][m][1] * q; } }
    }
    __device__ __forceinline__ void operator()(const pf4 (&acc)[2][2][4][2], const pg8::Unit& u, int wr, int wc, int fr, int fq) const {
        const int col0 = u.pn * 256 + wc * 32 + 8 * fq;
        LAS float* P = (LAS float*)(lds + L_IMP);
#pragma unroll
        for (int ai = 0; ai < 2; ++ai)
#pragma unroll
            for (int m = 0; m < 4; ++m) { const int rl = ai * 128 + wr * 64 + m * 16 + fr; const size_t off = (size_t)(u.pm * 256 + rl) * DM + col0; float sq = 0.f;
                const float rn = tabrow(u, rl)[1];
#pragma unroll
                for (int bj = 0; bj < 2; ++bj) {
                    const pf4 h0 = *(const pf4*)(x + off + bj * 128) + acc[ai][bj][m][0] * rn, h1 = *(const pf4*)(x + off + bj * 128 + 4) + acc[ai][bj][m][1] * rn;
                    *(pf4*)(out + off + bj * 128) = h0; *(pf4*)(out + off + bj * 128 + 4) = h1;
                    sq += ((h0[0] * h0[0] + h0[1] * h0[1]) + (h0[2] * h0[2] + h0[3] * h0[3])) + ((h1[0] * h1[0] + h1[1] * h1[1]) + (h1[2] * h1[2] + h1[3] * h1[3]));
                    v4u w; w.x = pk2(h0[0], h0[1]); w.y = pk2(h0[2], h0[3]); w.z = pk2(h1[0], h1[1]); w.w = pk2(h1[2], h1[3]);
                    *(v4u*)(xn + off + bj * 128) = w; }
                sq += __shfl_xor(sq, 16); sq += __shfl_xor(sq, 32);
                if (fq == 0) P[rl * 4 + wc] = sq; }
        asm volatile("s_waitcnt lgkmcnt(0)\n\ts_barrier" ::: "memory");
        const int t = (wr * 4 + wc) * 64 + (fq * 16 + fr);
        if (t < 256) { const f32x4 p = *(const LAS f32x4*)(P + t * 4); ssq[(size_t)(u.pm * 256 + t) * 4 + u.pn] = (p[0] + p[1]) + (p[2] + p[3]); }
    }
};

struct EpiUp { static constexpr bool MID = false;
    static constexpr bool PERM = true;
    bf16* O; const float* ssq;
    __device__ __forceinline__ void operator()(const pf4 (&acc)[2][2][4][2], const pg8::Unit& u, int wr, int wc, int fr, int fq) const {
        const int row0 = u.pm * 256 + wr * 64 + fr, col0 = u.pn * 256 + wc * 32 + 8 * fq;
#pragma unroll
        for (int ai = 0; ai < 2; ++ai)
#pragma unroll
            for (int m = 0; m < 4; ++m) { const int row = row0 + ai * 128 + m * 16; bf16* rowp = O + (size_t)row * FF + col0;
                const pf4 s0 = *(const pf4*)(ssq + (size_t)row * 4);
                const float tot = (s0[0] + s0[1]) + (s0[2] + s0[3]);
                const float r2 = 1.f / (tot * (1.f / DM) + EPS);
#pragma unroll
                for (int bj = 0; bj < 2; ++bj) { pf4 v0 = acc[ai][bj][m][0], v1 = acc[ai][bj][m][1];
#pragma unroll
                    for (int i = 0; i < 4; ++i) { const float a = fmaxf(v0[i], 0.f), b = fmaxf(v1[i], 0.f); v0[i] = a * a * r2; v1[i] = b * b * r2; }
                    v4u w; w.x = pk2(v0[0], v0[1]); w.y = pk2(v0[2], v0[3]); w.z = pk2(v1[0], v1[1]); w.w = pk2(v1[2], v1[3]);
                    *(v4u*)(rowp + bj * 128) = w; } }
    }
};

struct EpiDownNorm { static constexpr bool MID = false;
    static constexpr bool PERM = true;
    float* out; const float* g; float* xs; gu32* cnt; LDSB* lds;
    __device__ __forceinline__ void operator()(pf4 (&acc)[2][2][4][2], const pg8::Unit& u, int wr, int wc, int fr, int fq) const {
        const int col0 = u.pn * 256 + wc * 32 + 8 * fq;
        LAS float* P = (LAS float*)(lds + L_IMP);
        LAS float* S = P + 1024;
#pragma unroll
        for (int ai = 0; ai < 2; ++ai)
#pragma unroll
            for (int m = 0; m < 4; ++m) { const int rl = ai * 128 + wr * 64 + m * 16 + fr; const size_t off = (size_t)(u.pm * 256 + rl) * DM + col0; float sq = 0.f;
#pragma unroll
                for (int bj = 0; bj < 2; ++bj) { const float* p = out + off + bj * 128;
                    const pf4 h0 = *(const pf4*)p + acc[ai][bj][m][0], h1 = *(const pf4*)(p + 4) + acc[ai][bj][m][1];
                    acc[ai][bj][m][0] = h0; acc[ai][bj][m][1] = h1;
                    sq += ((h0[0] * h0[0] + h0[1] * h0[1]) + (h0[2] * h0[2] + h0[3] * h0[3])) + ((h1[0] * h1[0] + h1[1] * h1[1]) + (h1[2] * h1[2] + h1[3] * h1[3])); }
                sq += __shfl_xor(sq, 16); sq += __shfl_xor(sq, 32);
                if (fq == 0) P[rl * 4 + wc] = sq; }
        asm volatile("s_waitcnt lgkmcnt(0)\n\ts_barrier" ::: "memory");
        const int wid = wr * 4 + wc, lane = fq * 16 + fr, t = wid * 64 + lane;
        if (t < 256) { const f32x4 p = *(const LAS f32x4*)(P + t * 4);
            __hip_atomic_store(xs + (size_t)(u.pm * 256 + t) * 4 + u.pn, (p[0] + p[1]) + (p[2] + p[3]), __ATOMIC_RELAXED, __HIP_MEMORY_SCOPE_AGENT); }
        asm volatile("s_waitcnt vmcnt(0)" ::: "memory");
        if (t < 256 && lane == 0) __hip_atomic_fetch_add(cnt + 64 * u.pm, 1u, RLX_AGENT);
        if (wid == 0) {
            unsigned sp = 0;
            while ((unsigned)__builtin_amdgcn_readfirstlane((int)__hip_atomic_load(cnt + 64 * u.pm, RLX_AGENT)) < 16u) { __builtin_amdgcn_s_sleep(2); if (++sp > (1u << 22)) break; }
            __builtin_amdgcn_fence(__ATOMIC_ACQUIRE, "agent");
            asm volatile("s_waitcnt vmcnt(0)" ::: "memory");
        }
        asm volatile("s_waitcnt lgkmcnt(0)\n\ts_barrier" ::: "memory");
        if (t < 256) { const float* sl = xs + (size_t)(u.pm * 256 + t) * 4;
            const float a0 = __hip_atomic_load(sl, RLX_AGENT), a1 = __hip_atomic_load(sl + 1, RLX_AGENT), a2 = __hip_atomic_load(sl + 2, RLX_AGENT), a3 = __hip_atomic_load(sl + 3, RLX_AGENT);
            S[t] = 1.f / sqrtf(((a0 + a1) + (a2 + a3)) * (1.f / DM) + EPS); }
        asm volatile("s_waitcnt lgkmcnt(0)\n\ts_barrier" ::: "memory");
#pragma unroll
        for (int bj = 0; bj < 2; ++bj) { const pf4 g0 = *(const pf4*)(g + col0 + bj * 128), g1 = *(const pf4*)(g + col0 + bj * 128 + 4);
#pragma unroll
            for (int ai = 0; ai < 2; ++ai)
#pragma unroll
                for (int m = 0; m < 4; ++m) { const int rl = ai * 128 + wr * 64 + m * 16 + fr; const float r = S[rl]; float* p = out + (size_t)(u.pm * 256 + rl) * DM + col0 + bj * 128;
                    *(pf4*)p = acc[ai][bj][m][0] * r * g0; *(pf4*)(p + 4) = acc[ai][bj][m][1] * r * g1; } }
    }
};

__device__ __forceinline__ void p2_cumsum_item(Frame& F, int item) {
    const float* fl = (const float*)(F.ws + WS_FL) + (size_t)item * SEQ; float* cb = (float*)(F.ws + WS_CB) + (size_t)item * SEQ;
    const int lane = F.lane;
    float v[64]; float run = 0.f;
#pragma unroll
    for (int i = 0; i < 16; ++i) { const f32x4 t = *(const f32x4*)(fl + lane * 64 + 4 * i); v[4 * i] = t[0]; v[4 * i + 1] = t[1]; v[4 * i + 2] = t[2]; v[4 * i + 3] = t[3]; }
#pragma unroll
    for (int i = 0; i < 64; ++i) { run += v[i]; v[i] = run; }
    float incl = run;
#pragma unroll
    for (int o = 1; o < 64; o <<= 1) { const float t = __shfl_up(incl, o); if (lane >= o) incl += t; }
    const float base = incl - run;
#pragma unroll
    for (int i = 0; i < 16; ++i) { f32x4 t; t[0] = -(v[4 * i] + base) * LOG2E; t[1] = -(v[4 * i + 1] + base) * LOG2E; t[2] = -(v[4 * i + 2] + base) * LOG2E; t[3] = -(v[4 * i + 3] + base) * LOG2E;
        *(f32x4*)(cb + lane * 64 + 4 * i) = t; }
}

__device__ __forceinline__ float gelu_tanh(float x) {
    const float u = 0.7978845608028654f * (x + 0.044715f * x * x * x);
    const float e = __expf(2.f * u);
    const float th = 1.f - 2.f / (e + 1.f);
    return 0.5f * x * (1.f + th);
}

__device__ __forceinline__ void p2_compress_item(Frame& F0, kptr_t kp, int item) {
    typedef float f4 __attribute__((ext_vector_type(4)));
    struct { unsigned char* ws; LDSB* lds; int tid, lane, wave; } F; F.ws = F0.ws; F.lds = F0.lds; F.wave = F0.wave;
    { int t_ = F0.tid; asm volatile("" : "+v"(t_)); F.tid = t_; F.lane = t_ & 63; }
    asm volatile("" : "+s"(F.ws));
    const int kv = item >> 6, bg = (item >> 2) & 15, cblk = item & 3, c0 = 64 * cblk;
    const int lane = F.lane, w = F.wave, fr = lane & 15, fq = lane >> 4;
    const bf16* Ab = (const bf16*)(F.ws + (kv ? WS_VC : WS_KC)) + (size_t)bg * SEQ * 64 + (size_t)c0 * 1024;
    const bf16* W1 = (const bf16*)(F.ws + (kv ? WS_W1V : WS_W1K));
    const bf16* W2 = (const bf16*)(F.ws + (kv ? WS_W2V : WS_W2K));
    const float* B1 = (const float*)(F.ws + (kv ? WS_B1V : WS_B1K));
    const float* b1 = AIN(kp, kv ? 12 : 7);
    const float* b2 = AIN(kp, kv ? 14 : 9);
    LDSB* lds = F.lds;
    LAS bf16* Hs = (LAS bf16*)(lds + 92160);
    f4 acc[4][2];
#pragma unroll
    for (int m = 0; m < 4; ++m) { acc[m][0] = (f4){0.f, 0.f, 0.f, 0.f}; acc[m][1] = (f4){0.f, 0.f, 0.f, 0.f}; }
    const int tid = F.tid, lrow = tid >> 3, lch = tid & 7;
    const bf16* ag = Ab + (size_t)lrow * 1024 + lch * 8;
    const bf16* bg_ = W1 + (size_t)lrow * 2048 + lch * 8;
    const int sto = (lrow * 72 + lch * 8) * 2;
    v4u ra = *(const v4u*)ag, rb[4];
#pragma unroll
    for (int i = 0; i < 4; ++i) rb[i] = *(const v4u*)(bg_ + (size_t)i * 64 * 2048);
    *(LAS v4u*)(lds + sto) = ra;
#pragma unroll
    for (int i = 0; i < 4; ++i) *(LAS v4u*)(lds + 18432 + sto + i * 64 * 144) = rb[i];
    __syncthreads();
    for (int ks = 0; ks < 32; ++ks) {
        const int cb = ks & 1;
        if (ks + 1 < 32) { ra = *(const v4u*)(ag + (ks + 1) * 64);
#pragma unroll
            for (int i = 0; i < 4; ++i) rb[i] = *(const v4u*)(bg_ + (size_t)i * 64 * 2048 + (ks + 1) * 64); }
        const LDSB* As = lds + cb * 9216; const LDSB* Bs = lds + 18432 + cb * 36864;
#pragma unroll
        for (int kh = 0; kh < 2; ++kh) {
            bf16x8 a[4], b[2];
#pragma unroll
            for (int m = 0; m < 4; ++m) a[m] = *(const LAS bf16x8*)(As + ((16 * m + fr) * 72 + 32 * kh + 8 * fq) * 2);
#pragma unroll
            for (int n = 0; n < 2; ++n) b[n] = *(const LAS bf16x8*)(Bs + ((32 * w + 16 * n + fr) * 72 + 32 * kh + 8 * fq) * 2);
#pragma unroll
            for (int m = 0; m < 4; ++m)
#pragma unroll
                for (int n = 0; n < 2; ++n) acc[m][n] = __builtin_amdgcn_mfma_f32_16x16x32_bf16(a[m], b[n], acc[m][n], 0, 0, 0);
        }
        if (ks + 1 < 32) {
            *(LAS v4u*)(lds + (cb ^ 1) * 9216 + sto) = ra;
#pragma unroll
            for (int i = 0; i < 4; ++i) *(LAS v4u*)(lds + 18432 + (cb ^ 1) * 36864 + sto + i * 64 * 144) = rb[i];
        }
        __syncthreads();
    }
    float bbv[2];
#pragma unroll
    for (int n = 0; n < 2; ++n) { const int col = 32 * w + 16 * n + fr; float bb = b1[col];
#pragma unroll 8
        for (int kc = 0; kc < 64; ++kc) bb += B1[kc * 256 + col];
        bbv[n] = bb; }
#pragma unroll
    for (int m = 0; m < 4; ++m)
#pragma unroll
        for (int n = 0; n < 2; ++n) { const int col = 32 * w + 16 * n + fr;
#pragma unroll
            for (int r = 0; r < 4; ++r) Hs[(16 * m + 4 * fq + r) * 264 + col] = (bf16)f2bf(gelu_tanh(acc[m][n][r] + bbv[n])); }
    __syncthreads();
    const int mt = w >> 1, ntA = (w & 1), ntB = (w & 1) + 2;
    f4 oa = (f4){0.f, 0.f, 0.f, 0.f}, ob = (f4){0.f, 0.f, 0.f, 0.f};
#pragma unroll
    for (int k0 = 0; k0 < 256; k0 += 32) {
        const bf16x8 a = *(const LAS bf16x8*)(Hs + (16 * mt + fr) * 264 + k0 + 8 * fq);
        const bf16x8 bA = *(const bf16x8*)(W2 + (size_t)(16 * ntA + fr) * 256 + k0 + 8 * fq);
        const bf16x8 bB = *(const bf16x8*)(W2 + (size_t)(16 * ntB + fr) * 256 + k0 + 8 * fq);
        oa = __builtin_amdgcn_mfma_f32_16x16x32_bf16(a, bA, oa, 0, 0, 0);
        ob = __builtin_amdgcn_mfma_f32_16x16x32_bf16(a, bB, ob, 0, 0, 0);
    }
    const int d1 = 16 * (w & 1) + fr;
    const float bb1 = b2[d1], bb2 = b2[d1 + 32];
    const float* RC = (const float*)(F.ws + WS_ROPEC); const float* RS = (const float*)(F.ws + WS_ROPES);
    bf16* O = (bf16*)(F.ws + (kv ? WS_VCMP : WS_KCMP)) + (size_t)bg * 256 * 64;
#pragma unroll
    for (int r = 0; r < 4; ++r) { const int c = c0 + 16 * mt + 4 * fq + r;
        float x1 = oa[r] + bb1, x2 = ob[r] + bb2;
        if (kv == 0) { int pos = 16 * c + 31; pos = pos > 4095 ? 4095 : pos; const float cs = RC[pos * 32 + d1], sn = RS[pos * 32 + d1];
            const float y1 = x1 * cs - x2 * sn, y2 = x1 * sn + x2 * cs; x1 = y1; x2 = y2; }
        O[(size_t)c * 64 + d1] = (bf16)f2bf(x1); O[(size_t)c * 64 + d1 + 32] = (bf16)f2bf(x2); }
    __syncthreads();
}

__device__ __forceinline__ int crow(int r, int hi) { return (r & 3) + 8 * (r >> 2) + 4 * hi; }
__device__ __forceinline__ void glds16(const void* gsrc, unsigned lds_dst) { unsigned keep;
    asm volatile("s_mov_b32 %0, m0\n\ts_mov_b32 m0, %2\n\ts_nop 0\n\tglobal_load_lds_dwordx4 %1, off\n\ts_mov_b32 m0, %0" : "=&s"(keep) : "v"(gsrc), "s"(lds_dst) : "memory"); }
#define WAIT_BAR(N) asm volatile("s_waitcnt vmcnt(" #N ") lgkmcnt(0)\n\ts_barrier" ::: "memory")
__device__ __forceinline__ unsigned cvtpk_s(float lo, float hi) { typedef float f2 __attribute__((ext_vector_type(2))); typedef __bf16 b2 __attribute__((ext_vector_type(2)));
    f2 v = {lo, hi}; b2 b = __builtin_convertvector(v, b2); return __builtin_bit_cast(unsigned, b); }
__device__ __forceinline__ s16x4 vtr(const LDSB* p) { return __builtin_bit_cast(s16x4, __builtin_amdgcn_ds_read_tr16_b64_v4i16((LAS v4i16_t*)p)); }

__device__ __forceinline__ float xh_max(float a) { auto r = __builtin_amdgcn_permlane32_swap(__float_as_uint(a), __float_as_uint(a), false, false); return fmaxf(__uint_as_float(r[0]), __uint_as_float(r[1])); }
__device__ __forceinline__ float xh_sum(float a) { auto r = __builtin_amdgcn_permlane32_swap(__float_as_uint(a), __float_as_uint(a), false, false); return __uint_as_float(r[0]) + __uint_as_float(r[1]); }
__device__ __forceinline__ float xh_other(float a, int hi) { auto r = __builtin_amdgcn_permlane32_swap(__float_as_uint(a), __float_as_uint(a), false, false); return hi ? __uint_as_float(r[0]) : __uint_as_float(r[1]); }
__device__ __forceinline__ void qkt(f32x16& p0, f32x16& p1, const LDSB* kslot, const bf16x8 (&qr)[4], const f32x16& cinit, int r32, int hi) {
    const LDSB* kb = kslot + hi * 1024 + r32 * 16;
#pragma unroll
    for (int d0 = 0; d0 < 4; ++d0) {
        const bf16x8 b0 = *(const LAS bf16x8*)(kb + d0 * 2048);
        const bf16x8 b1 = *(const LAS bf16x8*)(kb + d0 * 2048 + 512);
        if (d0 == 0) { p0 = __builtin_amdgcn_mfma_f32_32x32x16_bf16(b0, qr[0], cinit, 0, 0, 0); p1 = __builtin_amdgcn_mfma_f32_32x32x16_bf16(b1, qr[0], cinit, 0, 0, 0); }
        else { p0 = __builtin_amdgcn_mfma_f32_32x32x16_bf16(b0, qr[d0], p0, 0, 0, 0); p1 = __builtin_amdgcn_mfma_f32_32x32x16_bf16(b1, qr[d0], p1, 0, 0, 0); }
    }
}
__device__ __forceinline__ void pv(f32x16 (&o)[2], const LDSB* vp, const f32x16& p0, const f32x16& p1) {
    v4u pw[4];
    pw[0] = (v4u){cvtpk_s(p0[0], p0[1]), cvtpk_s(p0[2], p0[3]), cvtpk_s(p0[4], p0[5]), cvtpk_s(p0[6], p0[7])};
    pw[1] = (v4u){cvtpk_s(p0[8], p0[9]), cvtpk_s(p0[10], p0[11]), cvtpk_s(p0[12], p0[13]), cvtpk_s(p0[14], p0[15])};
    pw[2] = (v4u){cvtpk_s(p1[0], p1[1]), cvtpk_s(p1[2], p1[3]), cvtpk_s(p1[4], p1[5]), cvtpk_s(p1[6], p1[7])};
    pw[3] = (v4u){cvtpk_s(p1[8], p1[9]), cvtpk_s(p1[10], p1[11]), cvtpk_s(p1[12], p1[13]), cvtpk_s(p1[14], p1[15])};
#pragma unroll
    for (int d0 = 0; d0 < 2; ++d0)
#pragma unroll
        for (int ks = 0; ks < 4; ++ks) {
            const s16x4 lo = vtr(vp + d0 * 4096 + ks * 1024), hi = vtr(vp + d0 * 4096 + ks * 1024 + 512);
            const bf16x8 vf = (bf16x8){lo[0], lo[1], lo[2], lo[3], hi[0], hi[1], hi[2], hi[3]};
            o[d0] = __builtin_amdgcn_mfma_f32_32x32x16_bf16(__builtin_bit_cast(bf16x8, pw[ks]), vf, o[d0], 0, 0, 0);
        }
}
__device__ __forceinline__ float rowmax32(const f32x16& p0, const f32x16& p1) {
    float a = fmaxf(p0[0], p1[0]);
#pragma unroll
    for (int r = 1; r < 16; ++r) a = fmaxf(a, fmaxf(p0[r], p1[r]));
    return xh_max(a);
}
__device__ __forceinline__ float rowsum32(const f32x16& p0, const f32x16& p1) {
    float a = 0.f, b = 0.f;
#pragma unroll
    for (int r = 0; r < 16; ++r) { a += p0[r]; b += p1[r]; }
    return a + b;
}

template <int PITCH>
__device__ __forceinline__ void dma_kv(const bf16* Kh, const bf16* Vh, int key0, unsigned kdst, unsigned vdst, int wid, int lane) {
    const bf16* ksrc = Kh + (size_t)(key0 + lane) * PITCH + wid * 8;
    const bf16* vsrc = Vh + (size_t)(key0 + 16 * (wid & 3) + (lane >> 2)) * PITCH + (wid >> 2) * 32 + (lane & 3) * 8;
    glds16(ksrc, (unsigned)__builtin_amdgcn_readfirstlane(kdst + wid * 1024));
    glds16(vsrc, (unsigned)__builtin_amdgcn_readfirstlane(vdst + wid * 1024));
}


#define SBAR() __builtin_amdgcn_sched_barrier(0)
__device__ __forceinline__ void kload8(bf16x8* kf, const LDSB* kp) {
    kf[0] = *(const LAS bf16x8*)(kp);        kf[1] = *(const LAS bf16x8*)(kp + 512);
    kf[2] = *(const LAS bf16x8*)(kp + 2048); kf[3] = *(const LAS bf16x8*)(kp + 2560);
    kf[4] = *(const LAS bf16x8*)(kp + 4096); kf[5] = *(const LAS bf16x8*)(kp + 4608);
    kf[6] = *(const LAS bf16x8*)(kp + 6144); kf[7] = *(const LAS bf16x8*)(kp + 6656);
}
__device__ __forceinline__ void kload2(bf16x8* kf, const LDSB* kp, int j) { kf[2 * j] = *(const LAS bf16x8*)(kp + j * 2048); kf[2 * j + 1] = *(const LAS bf16x8*)(kp + j * 2048 + 512); }

template <int MODE>
__device__ __forceinline__ void att_mod(f32x16& C0, f32x16& C1, int j, int qabs, int qw0, int cur, unsigned sel_lo, unsigned sel_hi, const LAS float* kbias, int hi) {
    if (MODE == 0) {
        const LAS float* kb = kbias + 64 * j + 4 * hi;
#pragma unroll
        for (int g4 = 0; g4 < 4; ++g4) { const f32x4 b0 = *(const LAS f32x4*)(kb + 8 * g4), b1 = *(const LAS f32x4*)(kb + 32 + 8 * g4);
#pragma unroll
            for (int i = 0; i < 4; ++i) { C0[4 * g4 + i] += b0[i]; C1[4 * g4 + i] += b1[i]; } }
        if (64 * j + 63 > qw0) {
#pragma unroll
            for (int r = 0; r < 16; ++r) { const int kv = 64 * j + crow(r, hi); if (kv > qabs) C0[r] = NEGM; if (kv + 32 > qabs) C1[r] = NEGM; }
        }
    } else if (MODE == 1) {
        const bool sel = ((j < 32 ? (sel_lo >> j) : (sel_hi >> (j - 32))) & 1u) != 0u;
        if (j == cur) {
#pragma unroll
            for (int r = 0; r < 16; ++r) { const int kv = 64 * j + crow(r, hi); if (kv > qabs || !sel) C0[r] = NEGM; if (kv + 32 > qabs || !sel) C1[r] = NEGM; }
        } else {
#pragma unroll
            for (int r = 0; r < 16; ++r) { if (!sel) { C0[r] = NEGM; C1[r] = NEGM; } }
        }
    } else {
        if (j == cur || j + 8 <= cur) {
#pragma unroll
            for (int r = 0; r < 16; ++r) { const int kv = 64 * j + crow(r, hi);
                if (kv > qabs || kv < qabs - 511) C0[r] = NEGM; if (kv + 32 > qabs || kv + 32 < qabs - 511) C1[r] = NEGM; }
        }
    }
}

template <int MODE, int PITCH, int THRL>
__device__ __forceinline__ void attn_fast(LDSB* lds, const bf16* Kh, const bf16* Vh, const LAS unsigned char* tl, int NT, const bf16x8 (&qr)[4], int qabs, int qw0, int cur,
                                          unsigned sel_lo, unsigned sel_hi, const LAS float* kbias, f32x16 (&o)[2], float& l_out, int wid, int lane) {
    const int r32 = lane & 31, hi = lane >> 5;
    const unsigned lds0 = (unsigned)(uintptr_t)lds;
    LAS float* wsf = (LAS float*)(lds + L_WS) + wid * 256;
    const bf16* ksrc = Kh + (size_t)lane * PITCH + wid * 8;
    const bf16* vsrc = Vh + (size_t)(16 * (wid & 3) + (lane >> 2)) * PITCH + (wid >> 2) * 32 + (lane & 3) * 8;
    const unsigned kdst = lds0 + L_K + wid * 1024, vdst = lds0 + L_V + wid * 1024;
#define TILE(t) __builtin_amdgcn_readfirstlane((int)tl[t])
#define DMA_K(t, slot) glds16(ksrc + (size_t)TILE(t) * (64 * PITCH), (unsigned)__builtin_amdgcn_readfirstlane(kdst + (slot)))
#define DMA_V(t, slot) glds16(vsrc + (size_t)TILE(t) * (64 * PITCH), (unsigned)__builtin_amdgcn_readfirstlane(vdst + (slot)))
    const LDSB* kp0 = lds + L_K + hi * 1024 + r32 * 16;
    const LDSB* vp0 = lds + L_V + ((lane >> 4) & 1) * 32 + (lane & 3) * 8 + (4 * hi + ((lane & 15) >> 2)) * 64;
    bf16x8 kf[8];
    float mhat = 0.f, l_reg = 0.f;
    f32x16 negm;
#pragma unroll
    for (int r = 0; r < 16; ++r) { negm[r] = 0.f; o[0][r] = 0.f; o[1][r] = 0.f; }
    asm volatile("" : "+v"(negm));
    bool resc = false;
    f32x16 pA0, pA1, pB0, pB1;
    int sl_prev = 0, sl_cur = 0, sl_next = SLOTB, sl_last = 0;
#define ROT() do { sl_prev = sl_cur; sl_cur = sl_next; sl_next = (sl_next == 2 * SLOTB) ? 0 : sl_next + SLOTB; } while (0)
#define RESC() do { if (resc) { LDS_WAIT(); \
        _Pragma("unroll") for (int d_ = 0; d_ < 2; ++d_) _Pragma("unroll") for (int r = 0; r < 16; ++r) o[d_][r] *= wsf[crow(r, hi)]; } } while (0)
#define ENDW(tt) do { if ((tt) + 3 < NT) { WAIT_BAR(2); } else if ((tt) + 2 < NT) { WAIT_BAR(1); } else { WAIT_BAR(0); } } while (0)
    DMA_K(0, 0); DMA_V(0, 0); if (NT > 1) DMA_K(1, SLOTB); if (NT > 2) DMA_K(2, 2 * SLOTB);
    if (NT > 2) { WAIT_BAR(3); } else if (NT > 1) { WAIT_BAR(2); } else { WAIT_BAR(1); }
    {
        const int j0 = TILE(0);
        qkt(pA0, pA1, lds + L_K, qr, negm, r32, hi);
        att_mod<MODE>(pA0, pA1, j0, qabs, qw0, cur, sel_lo, sel_hi, kbias, hi);
        const float rm = rowmax32(pA0, pA1);
        mhat += rm;
#pragma unroll
        for (int r = 0; r < 16; ++r) { pA0[r] -= rm; pA1[r] -= rm; negm[r] = -mhat; }
        asm volatile("" : "+v"(negm));
#pragma unroll
        for (int r = 0; r < 16; ++r) { pA0[r] = __builtin_amdgcn_exp2f(pA0[r]); pA1[r] = __builtin_amdgcn_exp2f(pA1[r]); }
    }
    WAIT_BAR(0);
    if (NT > 3) DMA_K(3, 0);
    if (NT > 1) DMA_V(1, SLOTB);
    ROT();
    if (NT > 1) kload8(kf, kp0 + sl_cur);
    ENDW(0);
    s16x4 vlo[8], vhi[8]; v4u pw0, pw1, pw2, pw3;
#define PKW(P, B) cvtpk_s(P[B], P[B + 1])
#define PAF(k) __builtin_bit_cast(bf16x8, pw##k)
#define VFR(i) (bf16x8){vlo[i][0], vlo[i][1], vlo[i][2], vlo[i][3], vhi[i][0], vhi[i][1], vhi[i][2], vhi[i][3]}
#define PIN(x) asm volatile("" : "+v"(x))
#define MX3(a, b, c) __builtin_fmaxf(__builtin_fmaxf((a), (b)), (c))
#define GAPA(MF, A0, A1, A2, A3, W0, W1, PW) do { MF; sacc += A0; sacc += A1; sacc += A2; sacc += A3; PIN(sacc); W0; W1; PIN(PW); SBAR(); } while (0)
#define EX(v) __builtin_amdgcn_exp2f(v)
#define GAPB(MF, X, B) do { MF; X[B] = EX(X[B]); X[B + 1] = EX(X[B + 1]); X[B + 2] = EX(X[B + 2]); X[B + 3] = EX(X[B + 3]); PIN(X); SBAR(); } while (0)
#define VRD(i) do { vlo[i] = vtr(vp_ + (((i) >> 2) * 4096 + ((i) & 3) * 1024)); vhi[i] = vtr(vp_ + (((i) >> 2) * 4096 + ((i) & 3) * 1024 + 512)); } while (0)
#define KRD(G, j) do { if (G) { kload2(kf, kp0 + sl_next, j); SBAR(); } } while (0)
#define MFMA32 __builtin_amdgcn_mfma_f32_32x32x16_bf16
#define STEP(C0, C1, P0, P1, t) do { const int jt_ = TILE(t); const bool GK_ = (t) + 3 < NT, GV_ = (t) + 1 < NT; sl_last = sl_cur; SBAR(); \
    const LDSB* vp_ = vp0 + sl_prev; \
    VRD(0); SBAR(); float sacc = (P0[0] + P0[1]); \
    GAPA(C0 = MFMA32(kf[0], qr[0], negm, 0, 0, 0), P0[2], P0[3], P0[4], P0[5],     pw0[0] = PKW(P0, 0), pw0[1] = PKW(P0, 2), pw0); \
    VRD(4); SBAR(); GAPA(C1 = MFMA32(kf[1], qr[0], negm, 0, 0, 0), P0[6], P0[7], P0[8], P0[9],     pw0[2] = PKW(P0, 4), pw0[3] = PKW(P0, 6), pw0); \
    VRD(1); SBAR(); GAPA(C0 = MFMA32(kf[2], qr[1], C0, 0, 0, 0),   P0[10], P0[11], P0[12], P0[13], pw1[0] = PKW(P0, 8), pw1[1] = PKW(P0, 10), pw1); \
    VRD(5); SBAR(); GAPA(C1 = MFMA32(kf[3], qr[1], C1, 0, 0, 0),   P0[14], P0[15], P1[0], P1[1],   pw1[2] = PKW(P0, 12), pw1[3] = PKW(P0, 14), pw1); \
    VRD(2); SBAR(); GAPA(C0 = MFMA32(kf[4], qr[2], C0, 0, 0, 0),   P1[2], P1[3], P1[4], P1[5],     pw2[0] = PKW(P1, 0), pw2[1] = PKW(P1, 2), pw2); \
    VRD(6); SBAR(); GAPA(C1 = MFMA32(kf[5], qr[2], C1, 0, 0, 0),   P1[6], P1[7], P1[8], P1[9],     pw2[2] = PKW(P1, 4), pw2[3] = PKW(P1, 6), pw2); \
    VRD(3); SBAR(); GAPA(C0 = MFMA32(kf[6], qr[3], C0, 0, 0, 0),   P1[10], P1[11], P1[12], P1[13], pw3[0] = PKW(P1, 8), pw3[1] = PKW(P1, 10), pw3); \
    VRD(7); SBAR(); GAPA(C1 = MFMA32(kf[7], qr[3], C1, 0, 0, 0),   P1[14], P1[15], 0.f, 0.f,       pw3[2] = PKW(P1, 12), pw3[3] = PKW(P1, 14), pw3); \
    l_reg += sacc; \
    if (GK_) { DMA_K((t) + 3, sl_cur); } if (GV_) { DMA_V((t) + 1, sl_next); } \
    att_mod<MODE>(C0, C1, jt_, qabs, qw0, cur, sel_lo, sel_hi, kbias, hi); \
    { float a = MX3(C0[0], C0[1], C1[0]), b = MX3(C0[2], C0[3], C1[1]); a = MX3(a, C1[2], C1[3]); \
      _Pragma("unroll") for (int r = 4; r < 16; r += 4) { a = MX3(a, C0[r], C0[r + 1]); b = MX3(b, C0[r + 2], C0[r + 3]); a = MX3(a, C1[r], C1[r + 1]); b = MX3(b, C1[r + 2], C1[r + 3]); } \
      float rm = xh_max(__builtin_fmaxf(a, b)); \
      resc = false; \
      if (__builtin_expect(__any(rm > (float)THRL), 0)) { const float dl = __builtin_fmaxf(rm, 0.f); mhat += dl; \
        _Pragma("unroll") for (int r = 0; r < 16; ++r) { C0[r] -= dl; C1[r] -= dl; } \
        _Pragma("unroll") for (int r = 0; r < 16; ++r) negm[r] = -mhat; asm volatile("" : "+v"(negm)); \
        const float f = __builtin_amdgcn_exp2f(-dl); l_reg *= f; if (hi == 0) wsf[r32] = f; resc = true; } } \
    SBAR(); \
    GAPB(o[0] = MFMA32(PAF(0), VFR(0), o[0], 0, 0, 0), C0, 0); \
    GAPB(o[1] = MFMA32(PAF(0), VFR(4), o[1], 0, 0, 0), C0, 4); \
    KRD(GV_, 0); GAPB(o[0] = MFMA32(PAF(1), VFR(1), o[0], 0, 0, 0), C0, 8); \
    KRD(GV_, 1); GAPB(o[1] = MFMA32(PAF(1), VFR(5), o[1], 0, 0, 0), C0, 12); \
    KRD(GV_, 2); GAPB(o[0] = MFMA32(PAF(2), VFR(2), o[0], 0, 0, 0), C1, 0); \
    KRD(GV_, 3); GAPB(o[1] = MFMA32(PAF(2), VFR(6), o[1], 0, 0, 0), C1, 4); \
    GAPB(o[0] = MFMA32(PAF(3), VFR(3), o[0], 0, 0, 0), C1, 8); \
    GAPB(o[1] = MFMA32(PAF(3), VFR(7), o[1], 0, 0, 0), C1, 12); \
    } while (0)
    int t = 1;
    for (; t + 1 < NT; t += 2) {
        STEP(pB0, pB1, pA0, pA1, t);     ENDW(t);     RESC(); ROT();
        STEP(pA0, pA1, pB0, pB1, t + 1); ENDW(t + 1); RESC(); ROT();
    }
    const LDSB* vlane_p = lds + L_V + ((lane >> 4) & 1) * 32 + (lane & 3) * 8 + (4 * hi + ((lane & 15) >> 2)) * 64;
    if (t < NT) {
        STEP(pB0, pB1, pA0, pA1, t); ENDW(t); RESC();
        l_reg += rowsum32(pB0, pB1);
        pv(o, vlane_p + sl_last, pB0, pB1);
    } else {
        l_reg += rowsum32(pA0, pA1);
        pv(o, vlane_p + sl_last, pA0, pA1);
    }
    l_out = xh_sum(l_reg);
    asm volatile("s_waitcnt lgkmcnt(0)\n\ts_barrier" ::: "memory");
#undef TILE
#undef DMA_K
#undef DMA_V
#undef ROT
#undef RESC
#undef ENDW
#undef PKW
#undef PAF
#undef VFR
#undef PIN
#undef MX3
#undef GAPA
#undef EX
#undef GAPB
#undef VRD
#undef KRD
#undef MFMA32
#undef STEP
}

__device__ __forceinline__ void load_rowvec(float (&fac)[16], const LAS float* tab, int hi) {
#pragma unroll
    for (int g4 = 0; g4 < 4; ++g4) { const f32x4 ff = *(const LAS f32x4*)(tab + 8 * g4 + 4 * hi);
#pragma unroll
        for (int i = 0; i < 4; ++i) fac[4 * g4 + i] = ff[i]; }
}

template <int PITCHO>
__device__ __forceinline__ void store_o_tile(LDSB* stage, const f32x16 (&o)[2], bf16* Ow, float* ssq, int lane) {
    const int r32 = lane & 31, hi = lane >> 5;
    LAS bf16* stg = (LAS bf16*)stage;
#pragma unroll
    for (int r = 0; r < 16; ++r) { const int orow = crow(r, hi);
#pragma unroll
        for (int d0 = 0; d0 < 2; ++d0) stg[orow * 64 + d0 * 32 + r32] = (bf16)f2bf(o[d0][r]); }
    LDS_WAIT();
#pragma unroll
    for (int i = 0; i < 4; ++i) { const int row = i * 8 + (lane >> 3), ch = lane & 7; const v4u v = *(const LAS v4u*)(stg + row * 64 + ch * 8); *(v4u*)(Ow + (size_t)row * PITCHO + ch * 8) = v;
        const unsigned w[4] = {v.x, v.y, v.z, v.w}; float sq = 0.f;
#pragma unroll
        for (int k = 0; k < 4; ++k) { const float a = __builtin_bit_cast(float, w[k] << 16), b = __builtin_bit_cast(float, w[k] & 0xffff0000u); sq += a * a + b * b; }
        sq += __builtin_bit_cast(float, __builtin_amdgcn_update_dpp(0, __builtin_bit_cast(int, sq), 0xB1, 0xF, 0xF, true));
        sq += __builtin_bit_cast(float, __builtin_amdgcn_update_dpp(0, __builtin_bit_cast(int, sq), 0x4E, 0xF, 0xF, true));
        sq += __builtin_bit_cast(float, __builtin_amdgcn_update_dpp(0, __builtin_bit_cast(int, sq), 0x141, 0xF, 0xF, true));
        if (ch == 0) ssq[(size_t)row * 16] = sq; }
    LDS_WAIT();
}

__device__ __forceinline__ void fox_unit(Frame& F0, int b, int h, int qb) {
    struct { unsigned char* ws; LDSB* lds; int tid, wave; } F; F.ws = F0.ws; F.lds = F0.lds; F.tid = F0.tid; F.wave = F0.wave;
    asm volatile("" : "+s"(F.ws));
    LDSB* lds = F.lds; int tid_ = F.tid; asm volatile("" : "+v"(tid_));
    const int tid = tid_, lane = tid & 63, wid = F.wave, r32 = lane & 31, hi = lane >> 5;
    const int q0 = 256 * qb, NT = 4 * qb + 4;
    const float* cb = (const float*)(F.ws + WS_CB) + (size_t)(b * 8 + h) * SEQ;
    LAS float* kb = (LAS float*)(lds + L_ACC);
    for (int i = tid; i < q0 + 256; i += NTHR) kb[i] = cb[i];
    LAS unsigned char* tl = (LAS unsigned char*)(lds + L_TL);
    if (tid < NT) tl[tid] = (unsigned char)(NT - 1 - tid);
    const bf16* Qw = (const bf16*)(F.ws + WS_QF) + ((size_t)b * SEQ + q0 + 32 * wid) * 512 + h * 64;
    bf16x8 qr[4];
#pragma unroll
    for (int d0 = 0; d0 < 4; ++d0) qr[d0] = *(const bf16x8*)(Qw + (size_t)r32 * 512 + d0 * 16 + hi * 8);
    __syncthreads();
    const bf16* Kh = (const bf16*)(F.ws + WS_KF) + (size_t)b * SEQ * 512 + h * 64;
    const bf16* Vh = (const bf16*)(F.ws + WS_VF) + (size_t)b * SEQ * 512 + h * 64;
    f32x16 o[2]; float l;
    attn_fast<0, 512, 8>(lds, Kh, Vh, tl, NT, qr, q0 + 32 * wid + r32, q0 + 32 * wid, 0, 0u, 0u, kb, o, l, wid, lane);
    LAS float* wsf = (LAS float*)(lds + L_WS) + wid * 256;
    if (hi == 0) wsf[32 + r32] = 1.f / l;
    LDS_WAIT();
    float fac[16]; load_rowvec(fac, wsf + 32, hi);
#pragma unroll
    for (int r = 0; r < 16; ++r) { o[0][r] *= fac[r]; o[1][r] *= fac[r]; }
    bf16* Ow = (bf16*)(F.ws + WS_Y) + ((size_t)b * SEQ + q0 + 32 * wid) * 1024 + h * 64;
    store_o_tile<1024>(lds + L_ACC + 16384 + wid * 4096, o, Ow, (float*)(F.ws + WS_SSQY) + ((size_t)b * SEQ + q0 + 32 * wid) * 16 + h, lane);
    __syncthreads();
}

__device__ __forceinline__ void nsa_unit(Frame& F0, int b, int g, int cur) {
    struct { unsigned char* ws; LDSB* lds; int tid, wave; } F; F.ws = F0.ws; F.lds = F0.lds; F.tid = F0.tid; F.wave = F0.wave;
    asm volatile("" : "+s"(F.ws));
    LDSB* lds = F.lds; int tid_ = F.tid; asm volatile("" : "+v"(tid_));
    const int tid = tid_, lane = tid & 63, wid = F.wave, r32 = lane & 31, hi = lane >> 5;
    const int bg = b * 2 + g, hh = wid >> 1, head = 4 * g + hh, qh = wid & 1, qq = 32 * qh + r32, qpos = 64 * cur + qq;
    const unsigned lds0 = (unsigned)(uintptr_t)lds;
    LAS float* wsf = (LAS float*)(lds + L_WS) + wid * 256;
    LAS float* accw = (LAS float*)(lds + L_ACC) + wid * 2048;
    const size_t row0 = (size_t)b * SEQ + 64 * cur + 32 * qh;
    const bf16* Qw = (const bf16*)(F.ws + WS_QN) + row0 * 512 + head * 64;
    bf16x8 qr[4];
#pragma unroll
    for (int d0 = 0; d0 < 4; ++d0) qr[d0] = *(const bf16x8*)(Qw + (size_t)r32 * 512 + d0 * 16 + hi * 8);
    if (tid < 2) ((LAS unsigned*)(lds + L_TL + 128))[tid] = 0u;
    if (lane < 32) { const float* gp = (const float*)(F.ws + WS_GATE) + (row0 + lane) * 24 + head * 3;
        wsf[64 + lane] = gp[0]; wsf[96 + lane] = gp[1]; wsf[128 + lane] = gp[2]; }
    LDS_WAIT();
    {
        const bf16* Kc = (const bf16*)(F.ws + WS_KCMP) + (size_t)bg * 256 * 64;
        const bf16* Vc = (const bf16*)(F.ws + WS_VCMP) + (size_t)bg * 256 * 64;
        const int ntl = (4 * cur + 66) >> 6;
#pragma unroll
        for (int tl = 0; tl < 4; ++tl) if (tl < ntl) dma_kv<64>(Kc, Vc, 64 * tl, lds0 + L_K + tl * SLOTB, lds0 + L_V + tl * SLOTB, wid, lane);
        WAIT_BAR(0);
        f32x16 zero;
#pragma unroll
        for (int r = 0; r < 16; ++r) zero[r] = 0.f;
        float mrun = -1e30f;
#pragma unroll 1
        for (int tl = 0; tl < ntl; ++tl) {
            f32x16 p0, p1;
            qkt(p0, p1, lds + L_K + tl * SLOTB, qr, zero, r32, hi);
#pragma unroll
            for (int r = 0; r < 16; ++r) { const int c = 64 * tl + crow(r, hi); if (16 * c + 31 > qpos) p0[r] = NEGM; if (16 * (c + 32) + 31 > qpos) p1[r] = NEGM; }
            mrun = fmaxf(mrun, rowmax32(p0, p1));
            asm volatile("" ::: "memory");
        }
        f32x16 o[2];
#pragma unroll
        for (int r = 0; r < 16; ++r) { o[0][r] = 0.f; o[1][r] = 0.f; }
        float impv[4][8]; float prevY3 = 0.f, lsum = 0.f;
        const int vlane = ((lane >> 4) & 1) * 32 + (lane & 3) * 8 + (4 * hi + ((lane & 15) >> 2)) * 64;
#pragma unroll
        for (int tl = 0; tl < 4; ++tl) {
            if (tl < ntl) {
                f32x16 p0, p1;
                qkt(p0, p1, lds + L_K + tl * SLOTB, qr, zero, r32, hi);
#pragma unroll
                for (int r = 0; r < 16; ++r) { const int c = 64 * tl + crow(r, hi);
                    p0[r] = (16 * c + 31 > qpos) ? 0.f : __builtin_amdgcn_exp2f(p0[r] - mrun);
                    p1[r] = (16 * (c + 32) + 31 > qpos) ? 0.f : __builtin_amdgcn_exp2f(p1[r] - mrun); }
                lsum += rowsum32(p0, p1);
                float rX[4], rY[4];
#pragma unroll
                for (int g4 = 0; g4 < 4; ++g4) { rX[g4] = xh_other(p0[4 * g4 + 3], hi); rY[g4] = xh_other(p1[4 * g4 + 3], hi); }
#pragma unroll
                for (int g4 = 0; g4 < 4; ++g4) {
                    const float qs0 = (p0[4 * g4] + p0[4 * g4 + 1]) + (p0[4 * g4 + 2] + p0[4 * g4 + 3]);
                    const float qs1 = (p1[4 * g4] + p1[4 * g4 + 1]) + (p1[4 * g4 + 2] + p1[4 * g4 + 3]);
                    const float lo0 = (g4 > 0) ? rX[g4 > 0 ? g4 - 1 : 0] : prevY3;
                    const float lo1 = (g4 > 0) ? rY[g4 > 0 ? g4 - 1 : 0] : rX[3];
                    impv[tl][g4] = qs0 + (hi ? rX[g4] : lo0);
                    impv[tl][4 + g4] = qs1 + (hi ? rY[g4] : lo1);
                }
                prevY3 = rY[3];
                pv(o, lds + L_V + tl * SLOTB + vlane, p0, p1);
                asm volatile("" ::: "memory");
            } else {
#pragma unroll
                for (int e = 0; e < 8; ++e) impv[tl][e] = 0.f;
            }
        }
        const float ltot = xh_sum(lsum);
        const float invl = ltot > 0.f ? 1.f / ltot : 0.f;
        LAS float* imp = (LAS float*)(lds + L_IMP);
#pragma unroll
        for (int hd = 0; hd < 4; ++hd) {
            if (hh == hd) {
#pragma unroll
                for (int tl = 0; tl < 4; ++tl)
#pragma unroll
                    for (int e = 0; e < 8; ++e) { const int jj = 16 * tl + 8 * (e >> 2) + 2 * (e & 3) + hi; LAS float* p = imp + qq * 65 + jj;
                        if (hd == 0) *p = impv[tl][e] * invl; else *p += impv[tl][e] * invl; }
            }
            LDS_WAIT(); __syncthreads();
        }
        if (hi == 0) wsf[32 + r32] = invl;
        LDS_WAIT();
        float gc[16], il[16]; load_rowvec(gc, wsf + 64, hi); load_rowvec(il, wsf + 32, hi);
#pragma unroll
        for (int d0 = 0; d0 < 2; ++d0)
#pragma unroll
            for (int r = 0; r < 16; ++r) accw[(d0 * 16 + r) * 64 + lane] = o[d0][r] * (gc[r] * il[r]);
        LDS_WAIT();
    }
    if (cur >= 16) {
        LAS float* imp = (LAS float*)(lds + L_IMP);
        const int q = tid >> 3, part = tid & 7;
        if (part == 0) { imp[q * 65] += 1e4f; imp[q * 65 + cur] += 1e4f; imp[q * 65 + cur - 1] += 1e4f; }
        LDS_WAIT(); __syncthreads();
        const LAS float* irow = imp + q * 65;
        float sc[8];
#pragma unroll
        for (int i = 0; i < 8; ++i) { const int jj = part * 8 + i; sc[i] = (jj <= cur) ? irow[jj] : -1.f; }
        int rank[8];
#pragma unroll
        for (int i = 0; i < 8; ++i) rank[i] = 0;
        const int nv = cur + 1, e0 = (8 * part < nv) ? 8 * part : nv, e1 = (8 * part + 8 < nv) ? 8 * part + 8 : nv;
        for (int jp = 0; jp < e0; ++jp) { const float v = irow[jp];
#pragma unroll
            for (int i = 0; i < 8; ++i) rank[i] += (v >= sc[i]) ? 1 : 0; }
        for (int jp = e0; jp < e1; ++jp) { const float v = irow[jp];
#pragma unroll
            for (int i = 0; i < 8; ++i) { const int jj = part * 8 + i; rank[i] += (v > sc[i] || (v == sc[i] && jp < jj)) ? 1 : 0; } }
        for (int jp = e1; jp < nv; ++jp) { const float v = irow[jp];
#pragma unroll
            for (int i = 0; i < 8; ++i) rank[i] += (v > sc[i]) ? 1 : 0; }
        unsigned bits = 0;
#pragma unroll
        for (int i = 0; i < 8; ++i) bits |= (rank[i] < 16 ? 1u : 0u) << i;
        ((LAS unsigned char*)(lds + L_SEL))[q * 8 + part] = (unsigned char)bits;
        __hip_atomic_fetch_or((LAS unsigned*)(lds + L_TL + 128) + (part >> 2), bits << (8 * (part & 3)), __ATOMIC_RELAXED, __HIP_MEMORY_SCOPE_WORKGROUP);
        LDS_WAIT(); __syncthreads();
    } else {
        if (tid < 128) ((LAS unsigned*)(lds + L_SEL))[tid] = (tid & 1) ? 0u : ((1u << (cur + 1)) - 1u);
        if (tid == 0) ((LAS unsigned*)(lds + L_TL + 128))[0] = (1u << (cur + 1)) - 1u;
        LDS_WAIT(); __syncthreads();
    }
    const LAS unsigned* selw = (const LAS unsigned*)(lds + L_SEL);
    const unsigned sel_lo = selw[qq * 2], sel_hi = selw[qq * 2 + 1];
    const unsigned ulo = ((const LAS unsigned*)(lds + L_TL + 128))[0], uhi = ((const LAS unsigned*)(lds + L_TL + 128))[1];
    unsigned long long umask = ((unsigned long long)uhi << 32) | ulo;
    umask &= (cur >= 63) ? ~0ull : ((1ull << (cur + 1)) - 1ull);
    const int jlo = cur >= 8 ? cur - 8 : 0;
    LAS unsigned char* tls = (LAS unsigned char*)(lds + L_TL);
    LAS unsigned char* tlw = tls + 64;
    if (tid < 64) {
        if ((umask >> tid) & 1ull) tls[__builtin_popcountll(umask & ((1ull << tid) - 1ull))] = (unsigned char)tid;
        if (tid <= cur - jlo) tlw[tid] = (unsigned char)(jlo + tid);
    }
    LDS_WAIT(); __syncthreads();
    const int NTs = __builtin_amdgcn_readfirstlane(__builtin_popcountll(umask)), NTw = cur - jlo + 1;
    {
        const bf16* Kh = (const bf16*)(F.ws + WS_KS) + (size_t)bg * SEQ * 64;
        const bf16* Vh = (const bf16*)(F.ws + WS_VS) + (size_t)bg * SEQ * 64;
        f32x16 o[2]; float l;
        attn_fast<1, 64, 8>(lds, Kh, Vh, tls, NTs, qr, qpos, 0, cur, sel_lo, sel_hi, nullptr, o, l, wid, lane);
        if (hi == 0) wsf[32 + r32] = 1.f / l;
        LDS_WAIT();
        float fl[16], gs[16]; load_rowvec(fl, wsf + 32, hi); load_rowvec(gs, wsf + 96, hi);
#pragma unroll
        for (int d0 = 0; d0 < 2; ++d0)
#pragma unroll
            for (int r = 0; r < 16; ++r) accw[(d0 * 16 + r) * 64 + lane] += o[d0][r] * (fl[r] * gs[r]);
        LDS_WAIT();
    }
    {
        const bf16* Kh = (const bf16*)(F.ws + WS_KW) + (size_t)bg * SEQ * 64;
        const bf16* Vh = (const bf16*)(F.ws + WS_VW) + (size_t)bg * SEQ * 64;
        f32x16 o[2]; float l;
        attn_fast<2, 64, 8>(lds, Kh, Vh, tlw, NTw, qr, qpos, 0, cur, 0u, 0u, nullptr, o, l, wid, lane);
        if (hi == 0) wsf[32 + r32] = 1.f / l;
        LDS_WAIT();
        float fl[16], gate_win[16]; load_rowvec(fl, wsf + 32, hi); load_rowvec(gate_win, wsf + 128, hi);
#pragma unroll
        for (int d0 = 0; d0 < 2; ++d0)
#pragma unroll
            for (int r = 0; r < 16; ++r) o[d0][r] = accw[(d0 * 16 + r) * 64 + lane] + o[d0][r] * (fl[r] * gate_win[r]);
        LDS_WAIT();
        bf16* Ow = (bf16*)(F.ws + WS_Y) + row0 * 1024 + 512 + head * 64;
        store_o_tile<1024>((LDSB*)accw, o, Ow, (float*)(F.ws + WS_SSQY) + row0 * 16 + 8 + head, lane);
    }
    __syncthreads();
}

__device__ __forceinline__ void dep_publish(Frame& F, gu32* w0, gu32* w1) {
    asm volatile("s_waitcnt vmcnt(0)" ::: "memory"); __syncthreads();
    if (F.tid == 0) { __builtin_amdgcn_fence(__ATOMIC_RELEASE, "agent"); asm volatile("s_waitcnt vmcnt(0)" ::: "memory");
        __hip_atomic_fetch_add(w0, 1u, RLX_AGENT); if (w1) __hip_atomic_fetch_add(w1, 1u, RLX_AGENT); }
}
__device__ __forceinline__ void dep_wait(Frame& F, gu32* w, unsigned need, gu32* wall, unsigned needall, int flagword) {
    if (F.wave == 0) {
        unsigned sp = 0;
        while ((unsigned)__builtin_amdgcn_readfirstlane((int)__hip_atomic_load(w, RLX_AGENT)) < need) { __builtin_amdgcn_s_sleep(4); if (++sp > (1u << 22)) break; }
        const unsigned tot = wall ? (unsigned)__builtin_amdgcn_readfirstlane((int)__hip_atomic_load(wall, RLX_AGENT)) : 0u;
        __builtin_amdgcn_fence(__ATOMIC_ACQUIRE, "agent");
        asm volatile("s_waitcnt vmcnt(0)" ::: "memory");
        if (F.lane == 0 && (!wall || tot >= needall)) F.MISC[flagword] = 1u;
    }
    LDS_WAIT(); __syncthreads();
}

constexpr int NSA_COST0 = 24;
__device__ __forceinline__ void p3_attention(Frame& F, kptr_t kp) {
    LAS unsigned short* order = (LAS unsigned short*)(F.lds + L_ORD);
    for (int id = F.tid; id < 2048; id += NTHR) {
        int pos;
        if (id >= 1024 && ((id - 1024) >> 6) < 2) pos = id - 1024;
        else {
            const int c = id < 1024 ? (63 - (id >> 4)) + NSA_COST0 : 4 * (15 - ((id - 1024) >> 6)) + 4;
            pos = 128;
            { int lo = c - NSA_COST0 + 1; if (lo < 0) lo = 0; int cnt = 64 - lo; if (cnt < 0) cnt = 0; pos += 16 * cnt; }
            { int cnt = 0; for (int qb = 0; qb < 14; ++qb) cnt += (4 * qb + 4 > c) ? 1 : 0; pos += 64 * cnt; }
            if (id < 1024) pos += (id & 15);
            else { const int cn = c - NSA_COST0; if (cn >= 0 && cn <= 63) pos += 16; pos += (id & 63); }
        }
        order[pos] = (unsigned short)id;
    }
    if (F.vcu < 8) { p2_cumsum_item(F, F.vcu * NWAVES + F.wave); dep_publish(F, F.ctl + CW_CS, nullptr); }
    LDS_WAIT(); __syncthreads();
    if (F.vcu >= F.G - 128 || F.G < 136) {
        for (int it = (F.G < 136) ? F.vcu : F.vcu - (F.G - 128); it < 128; it += (F.G < 136) ? F.G : 128) {
            p2_compress_item(F, kp, it);
            dep_publish(F, F.ctl + CW_CMP + 64 * ((it >> 2) & 15), F.ctl + CW_CMPT);
        }
    }
    gu32* qhead = F.ctl + CW_Q_ATT;
    for (;;) {
        if (F.tid == 0) F.MISC[0] = __hip_atomic_fetch_add(qhead, 1u, RLX_AGENT);
        LDS_WAIT(); __syncthreads();
        const unsigned k = F.MISC[0];
        if (k >= 2048u) break;
        const int id = (int)order[k];
        __syncthreads();
        if (id < 1024) {
            if (F.MISC[17] == 0u) dep_wait(F, F.ctl + CW_CMP + 64 * (id & 15), 8u, F.ctl + CW_CMPT, 128u, 17);
            nsa_unit(F, (id & 15) >> 1, id & 1, 63 - (id >> 4));
        } else {
            if (F.MISC[16] == 0u) dep_wait(F, F.ctl + CW_CS, 8u, nullptr, 0u, 16);
            fox_unit(F, (id & 63) >> 3, id & 7, 15 - ((id - 1024) >> 6));
        }
    }
}

__device__ __forceinline__ void p4_ynorm(Frame& F) {
    const int gw = F.vcu * NWAVES + F.wave, NGW = F.G * NWAVES;
    for (int m = gw; m < T; m += NGW) {
        bf16* row = (bf16*)(F.ws + WS_Y) + (size_t)m * 1024 + F.lane * 16;
        v4u a = *(const v4u*)row, b = *(const v4u*)(row + 8);
        float v[16];
        const unsigned w[8] = {a.x, a.y, a.z, a.w, b.x, b.y, b.z, b.w};
#pragma unroll
        for (int i = 0; i < 8; ++i) { v[2 * i] = __builtin_bit_cast(float, w[i] << 16); v[2 * i + 1] = __builtin_bit_cast(float, w[i] & 0xffff0000u); }
        float s = 0.f;
#pragma unroll
        for (int i = 0; i < 16; ++i) s += v[i] * v[i];
#pragma unroll
        for (int o = 1; o < 32; o <<= 1) s += __shfl_xor(s, o);
        const float r = 1.f / sqrtf(s * (1.f / 512.f) + EPS);
        v4u oa, ob;
        oa.x = pk2(v[0] * r, v[1] * r); oa.y = pk2(v[2] * r, v[3] * r); oa.z = pk2(v[4] * r, v[5] * r); oa.w = pk2(v[6] * r, v[7] * r);
        ob.x = pk2(v[8] * r, v[9] * r); ob.y = pk2(v[10] * r, v[11] * r); ob.z = pk2(v[12] * r, v[13] * r); ob.w = pk2(v[14] * r, v[15] * r);
        *(v4u*)row = oa; *(v4u*)(row + 8) = ob;
    }
}
__device__ __forceinline__ void p6_hnorm(Frame& F, const float* h1) {
    const int gw = F.vcu * NWAVES + F.wave, NGW = F.G * NWAVES;
    for (int m = gw; m < T; m += NGW) rms_row_to_bf16(F.lane, h1 + (size_t)m * DM, (bf16*)(F.ws + WS_XN) + (size_t)m * DM);
}
__device__ __forceinline__ void p9_final(Frame& F, float* out, const float* g_final) {
    const int gw = F.vcu * NWAVES + F.wave, NGW = F.G * NWAVES;
    for (int m = gw; m < T; m += NGW) {
        GAS f32x4* xr = (GAS f32x4*)(out + (size_t)m * DM) + F.lane;
        f32x4 v[4]; float s = 0.f;
#pragma unroll
        for (int j = 0; j < 4; ++j) { v[j] = xr[64 * j]; s += (v[j].x * v[j].x + v[j].y * v[j].y) + (v[j].z * v[j].z + v[j].w * v[j].w); }
        const float r = 1.f / sqrtf(wave_sum(s) * (1.f / DM) + EPS);
#pragma unroll
        for (int j = 0; j < 4; ++j) { const f32x4 gg = *((const f32x4*)g_final + F.lane + 64 * j); xr[64 * j] = v[j] * r * gg; }
    }
}

constexpr int N_PHASES = 10;
__global__ void __launch_bounds__(NTHR, 2) hymba_fwd(Args args) {
    extern __shared__ __attribute__((aligned(16))) unsigned char lds_raw[];
    Frame F;
    F.lds = (LDSB*)lds_raw;
    F.MISC = (volatile LAS unsigned*)(F.lds + L_MISC);
    F.tid = threadIdx.x; F.lane = F.tid & 63; F.wave = __builtin_amdgcn_readfirstlane(F.tid >> 6);
    F.G = gridDim.x; { const int bx = blockIdx.x; F.vcu = (F.G % 8 == 0) ? (bx % 8) * (F.G / 8) + bx / 8 : bx; }
    kptr_t kp0 = (kptr_t)__builtin_amdgcn_kernarg_segment_ptr();
#define KP() ({ kptr_t k_ = kp0; asm volatile("" : "+s"(k_)); k_; })
    { kptr_t kp = KP(); F.ws = *(unsigned char* const __attribute__((address_space(4)))*)(kp + 8 * 23); }
    F.ctl = (gu32*)(F.ws + WS_CTL);
    if (F.tid < 64) F.MISC[F.tid] = 0u;
    __syncthreads();
    int lo, hi; { kptr_t kp = KP(); lo = *(const int __attribute__((address_space(4)))*)(kp + 192); hi = *(const int __attribute__((address_space(4)))*)(kp + 196); }
    const bool one_launch = (hi - lo) > 1;
    XcdBarrier bar; bar.bar = (unsigned*)(F.ctl + CW_BAR); bar.x = 0; bar.st = nullptr; bar.wave = F.wave;
    if (one_launch) { bar = xcd_barrier_post((unsigned*)(F.ctl + CW_BAR), F.MISC + 8); bar.wave = F.wave; }
#ifdef PHASE_MASK
#define IN(k) (((PHASE_MASK >> (k)) & 1) && lo <= (k) && (k) < hi)
#else
#define IN(k) (lo <= (k) && (k) < hi)
#endif
#define SEAM(k) do { if (IN(k) && IN((k) + 1)) xcd_barrier(bar); } while (0)
#define RELANE() do { F.lane = lane_id(); F.tid = F.wave * 64 + F.lane; } while (0)

    if (IN(0)) { RELANE(); p0_prologue(F, KP()); SEAM(0); }

    if (IN(1)) { RELANE();
        pg8::Gemm g{(const bf16*)(F.ws + WS_XN), (const bf16*)(F.ws + WS_WIN), T, NPROJ, DM}; pg8::StaticOrder S; S.init(T, NPROJ, F.G, (int)blockIdx.x);
        kptr_t kp = KP(); EpiProj E{F.ws, AIN(kp, 3), AIN(kp, 4)};
        pg8::gemm_phase<EpiProj, pg8::StaticOrder, true, true>(F.lds, g, S, E, F.wave);
        if (IN(1) && IN(3)) xcd_barrier(bar);
    }

    if (IN(3)) { RELANE(); p3_attention(F, KP()); if (IN(3) && IN(5)) xcd_barrier(bar); }


    if (IN(5)) { RELANE();
        pg8::Gemm g{(const bf16*)(F.ws + WS_Y), (const bf16*)(F.ws + WS_WOUT), T, DM, DM}; pg8::StaticOrder S; S.init(T, DM, F.G, (int)blockIdx.x);
        pg8::Unit u0, u1; const bool hv0 = S.next(0, u0), hv1 = S.next(1, u1);
        {
            const int i = F.tid >> 8, rl = F.tid & 255; const bool hv = i ? hv1 : hv0; const int pm = i ? u1.pm : u0.pm;
            if (hv) { const f32x4* sp = (const f32x4*)((const float*)(F.ws + WS_SSQY) + (size_t)(pm * 256 + rl) * 16); const f32x4 a = sp[0], b = sp[1], c = sp[2], d = sp[3];
                const float rf = 1.f / sqrtf((((a[0] + a[1]) + (a[2] + a[3])) + ((b[0] + b[1]) + (b[2] + b[3]))) * (1.f / 512.f) + EPS);
                const float rn = 1.f / sqrtf((((c[0] + c[1]) + (c[2] + c[3])) + ((d[0] + d[1]) + (d[2] + d[3]))) * (1.f / 512.f) + EPS);
                LAS float* tab = (LAS float*)(F.lds + L_IMP + 8192) + F.tid * 2; tab[0] = rf / rn; tab[1] = rn; }
            LDS_WAIT(); __syncthreads();
        }
        kptr_t kp = KP(); EpiOutRes E{AIN(kp, 0), *(float* const __attribute__((address_space(4)))*)(kp + 8 * 22), (bf16*)(F.ws + WS_XN), (float*)(F.ws + WS_SSQ1), F.lds, u0.pm};
        pg8::gemm_phase<EpiOutRes, pg8::StaticOrder, true, true>(F.lds, g, S, E, F.wave);
        if (IN(5) && IN(7)) xcd_barrier(bar);
    }


    if (IN(7)) { RELANE();
        pg8::Gemm g{(const bf16*)(F.ws + WS_XN), (const bf16*)(F.ws + WS_WUP), T, FF, DM}; pg8::StaticOrder S; S.init(T, FF, F.G, (int)blockIdx.x);
        EpiUp E{(bf16*)(F.ws + WS_U), (const float*)(F.ws + WS_SSQ1)};
        pg8::gemm_phase<EpiUp, pg8::StaticOrder, true, true>(F.lds, g, S, E, F.wave);
        SEAM(7);
    }

    if (IN(8)) { RELANE();
        pg8::Gemm g{(const bf16*)(F.ws + WS_U), (const bf16*)(F.ws + WS_WDN), T, DM, FF}; pg8::StaticOrder S; S.init(T, DM, F.G, (int)blockIdx.x);
        kptr_t kp = KP(); EpiDownNorm E{*(float* const __attribute__((address_space(4)))*)(kp + 8 * 22), AIN(kp, 21), (float*)(F.ws + WS_XS), F.ctl + CW_PANEL, F.lds};
        pg8::gemm_phase<EpiDownNorm, pg8::StaticOrder, true, true>(F.lds, g, S, E, F.wave);
    }

#undef IN
#undef SEAM
}

extern "C" void kernel_launch(void* const* d_in, const int* in_sizes, int n_in, void* d_out, int out_size, void* d_ws, size_t ws_size, hipStream_t stream) {
    static int grid = 0;
    if (grid == 0) {
        if (n_in != 22 || out_size != T * DM || ws_size < WS_END) { fprintf(stderr, "kernel_launch: unexpected shapes (n_in %d out %d ws %zu)\n", n_in, out_size, ws_size); grid = -1; return; }
        int dev = 0, cus = 0, per_cu = 0;
        if (hipGetDevice(&dev) != hipSuccess || hipDeviceGetAttribute(&cus, hipDeviceAttributeMultiprocessorCount, dev) != hipSuccess) { grid = -1; return; }
        if (hipFuncSetAttribute((const void*)hymba_fwd, hipFuncAttributeMaxDynamicSharedMemorySize, LDS_BYTES) != hipSuccess) { fprintf(stderr, "kernel_launch: hipFuncSetAttribute failed\n"); grid = -1; return; }
        if (hipOccupancyMaxActiveBlocksPerMultiprocessor(&per_cu, (const void*)hymba_fwd, NTHR, LDS_BYTES) != hipSuccess || per_cu < 1) { fprintf(stderr, "kernel_launch: occupancy query says %d\n", per_cu); per_cu = 1; }
        (void)hipGetLastError();
        grid = cus;
    }
    if (grid < 0) return;
    (void)hipMemsetAsync((char*)d_ws + WS_CTL, 0, CTL_ZERO_BYTES, stream);
    Args a{};
    for (int i = 0; i < 22; ++i) a.in[i] = (const float*)d_in[i];
    a.out = (float*)d_out; a.ws = (unsigned char*)d_ws;
#if MK_N_LAUNCHES == 1
    a.ph_lo = 0; a.ph_hi = N_PHASES;
    void* kargs[] = {&a};
    hipError_t e = hipLaunchCooperativeKernel((const void*)hymba_fwd, dim3(grid), dim3(NTHR), kargs, LDS_BYTES, stream);
    if (e != hipSuccess) fprintf(stderr, "kernel_launch: cooperative launch failed: %s (grid %d)\n", hipGetErrorString(e), grid);
#else
    for (int p = 0; p < N_PHASES; ++p) { a.ph_lo = p; a.ph_hi = p + 1; hipLaunchKernelGGL(hymba_fwd, dim3(grid), dim3(NTHR), LDS_BYTES, stream, a); }
#endif
}
```

```cpp
#include <hip/hip_runtime.h>
#include <hip/hip_bf16.h>
#include <cstdio>
#include <cstdint>

#ifndef MK_N_LAUNCHES
#define MK_N_LAUNCHES 1
#endif

__device__ __forceinline__ int lane_id() { return (int)__builtin_amdgcn_mbcnt_hi(~0u, __builtin_amdgcn_mbcnt_lo(~0u, 0u)); }
namespace pg8 {
#define PG8_LAS __attribute__((address_space(3)))
typedef unsigned short bf16_t;
typedef short bf16x8 __attribute__((ext_vector_type(8)));
typedef float f32x4 __attribute__((ext_vector_type(4)));
typedef unsigned u32x4 __attribute__((ext_vector_type(4)));
constexpr int BM = 256, BK = 64, HALF = 128, HTB = HALF * BK * 2, STAGE_BYTES = 8 * HTB, NXCD = 8, WGM = 8;

__host__ __device__ __forceinline__ int lds_byte(int r, int c) { const int st = (r >> 4) * 2 + (c >> 5), rr = r & 15, cc = c & 31, ob = rr * 64 + cc * 2; return st * 1024 + (ob ^ (((ob >> 9) & 1) << 5)); }
__host__ __device__ __forceinline__ void stage_rc(int b, int& R, int& C) { const int st = b / 1024, sb = b % 1024, swz = sb ^ (((sb >> 9) & 1) << 5); R = (st >> 1) * 16 + swz / 64; C = (st & 1) * 32 + (swz % 64) / 2; }
__host__ __device__ __forceinline__ int perm32(int rho) { const int n = rho >> 4, i = rho & 15; return 8 * (i >> 2) + 4 * n + (i & 3); }

struct Unit { int pm, pn; };
struct Gemm { const bf16_t* A; const bf16_t* Bt; int M, N, K; };

struct StaticOrder {
    int nM, nN, nwg, G, c;
    __host__ __device__ void init(int M, int N, int G_, int c_) { nM = M / BM; nN = N / BM; nwg = nM * nN; G = G_; c = c_; }
    __host__ __device__ bool next(int i, Unit& u) const {
        const long L = (long)i * G + c; if (L >= nwg) return false;
        int wgid = (int)L; { const int q = nwg / NXCD, r = nwg % NXCD, xcd = wgid % NXCD, off = wgid / NXCD; wgid = (xcd < r ? xcd * (q + 1) : r * (q + 1) + (xcd - r) * q) + off; }
        const int nig = WGM * nN, gid = wgid / nig, fm = gid * WGM, gsz = (nM - fm) < WGM ? (nM - fm) : WGM;
        u.pm = fm + ((wgid % nig) % gsz); u.pn = (wgid % nig) / gsz; return true;
    }
    __device__ __forceinline__ void a_ready(const Unit&) const {}
    __device__ __forceinline__ void done(const Unit&) const {}
};

__device__ __forceinline__ unsigned cvt_pk_bf16(float lo, float hi) { unsigned r; asm volatile("v_cvt_pk_bf16_f32 %0, %1, %2" : "=v"(r) : "v"(lo), "v"(hi)); return r; }

template <class Epi, class Sched, bool ALIGN_EPI = false, bool SP2 = false>
__device__ __forceinline__ void gemm_phase(PG8_LAS unsigned char* lds, const Gemm g, const Sched& S, const Epi& E, int wave_id) {
    const int wid = wave_id, lane = lane_id(), tid = wid * 64 + lane, wr = wid >> 2, wc = wid & 3, fr = lane & 15, fq = lane >> 4;
    const int K = g.K, nt = K / BK;
    unsigned voffA[2], voffB[2];
#pragma unroll
    for (int i = 0; i < 2; ++i) { int R, C; stage_rc(tid * 16 + i * 8192, R, C); const int Rb = Epi::PERM ? ((R & ~31) + perm32(R & 31)) : R;
        voffA[i] = (unsigned)(R * K + C) * 2u; voffB[i] = (unsigned)(Rb * K + C) * 2u; }
    const size_t kstep = (size_t)(BK * 2);
    const size_t hstep = (size_t)HALF * K * 2;
    const size_t tstep = 2 * hstep;
    const unsigned ldsw = (unsigned)wid * 1024u;
    const int aoff = lds_byte(wr * 64 + fr, fq * 8), boff = lds_byte(wc * 32 + fr, fq * 8);
#define PG8_SA(b, h) (((b) * 2 + (h)) * HTB)
#define PG8_SB(b, h) ((4 + (b) * 2 + (h)) * HTB)
#define PG8_STAGE(bufoff, gbase, voff) do { _Pragma("unroll") for (int _i = 0; _i < 2; ++_i) \
        __builtin_amdgcn_global_load_lds((const unsigned*)((const char*)(gbase) + (voff)[_i]), (PG8_LAS unsigned*)(lds + (bufoff) + ldsw + _i * 8192), 16, 0, 0); } while (0)
#define PG8_LDA(dst, b, h) do { _Pragma("unroll") for (int m = 0; m < 4; ++m) _Pragma("unroll") for (int k = 0; k < 2; ++k) dst[m][k] = *(const PG8_LAS bf16x8*)(lds + PG8_SA(b, h) + aoff + m * 2048 + k * 1024); } while (0)
#define PG8_LDB(dst, b, h) do { _Pragma("unroll") for (int n = 0; n < 2; ++n) _Pragma("unroll") for (int k = 0; k < 2; ++k) dst[n][k] = *(const PG8_LAS bf16x8*)(lds + PG8_SB(b, h) + boff + n * 2048 + k * 1024); } while (0)
#define PG8_MMA(ai, bj, At, Bt) do { __builtin_amdgcn_s_setprio(1); _Pragma("unroll") for (int m = 0; m < 4; ++m) _Pragma("unroll") for (int n = 0; n < 2; ++n) _Pragma("unroll") for (int k = 0; k < 2; ++k) \
        acc[ai][bj][m][n] = __builtin_amdgcn_mfma_f32_16x16x32_bf16(Bt[n][k], At[m][k], acc[ai][bj][m][n], 0, 0, 0); __builtin_amdgcn_s_setprio(0); } while (0)
#define PG8_WAIT_V(n) asm volatile("s_waitcnt vmcnt(" #n ")" ::: "memory")
#define PG8_WAIT_L(n) asm volatile("s_waitcnt lgkmcnt(" #n ")" ::: "memory")
#define PG8_BAR __builtin_amdgcn_s_barrier()
#define PG8_SCHED __builtin_amdgcn_sched_barrier(0)
    Unit cur, nxt; int ui = 0;
    if (!S.next(0, cur)) return;
    f32x4 acc[2][2][4][2];
#pragma unroll
    for (int a = 0; a < 2; ++a)
#pragma unroll
        for (int b = 0; b < 2; ++b)
#pragma unroll
            for (int m = 0; m < 4; ++m)
#pragma unroll
                for (int n = 0; n < 2; ++n) acc[a][b][m][n] = (f32x4){0.f, 0.f, 0.f, 0.f};
    bf16x8 At[4][2], B0[2][2], B1[2][2];
    const char* cA = (const char*)g.A + (size_t)cur.pm * tstep; const char* cB = (const char*)g.Bt + (size_t)cur.pn * tstep;
    S.a_ready(cur);
    if constexpr (SP2) {
        PG8_STAGE(PG8_SB(0, 0), cB, voffB); PG8_STAGE(PG8_SB(0, 1), cB + hstep, voffB); PG8_STAGE(PG8_SA(0, 0), cA, voffA); PG8_STAGE(PG8_SA(0, 1), cA + hstep, voffA);
        if (wr == 1) PG8_BAR;
        PG8_WAIT_V(2); PG8_BAR;
        PG8_STAGE(PG8_SB(1, 0), cB + kstep, voffB); PG8_STAGE(PG8_SA(1, 0), cA + kstep, voffA); PG8_STAGE(PG8_SB(1, 1), cB + hstep + kstep, voffB);
        PG8_WAIT_V(6); PG8_BAR;
    } else {
        PG8_STAGE(PG8_SB(0, 0), cB, voffB); PG8_STAGE(PG8_SA(0, 0), cA, voffA); PG8_STAGE(PG8_SB(0, 1), cB + hstep, voffB); PG8_STAGE(PG8_SA(0, 1), cA + hstep, voffA);
        if (wr == 1) PG8_BAR;
        PG8_WAIT_V(4); PG8_BAR;
        PG8_STAGE(PG8_SB(1, 0), cB + kstep, voffB); PG8_STAGE(PG8_SA(1, 0), cA + kstep, voffA); PG8_STAGE(PG8_SB(1, 1), cB + hstep + kstep, voffB);
        PG8_WAIT_V(6); PG8_BAR;
    }
    for (;;) {
        const bool has_next = S.next(ui + 1, nxt);
        const char* nA = has_next ? (const char*)g.A + (size_t)nxt.pm * tstep : cA; const char* nB = has_next ? (const char*)g.Bt + (size_t)nxt.pn * tstep : cB;
        for (int t = 0; t < nt; t += 2) {
            const bool last = (t == nt - 2);
            const char* a1 = cA + (size_t)(t + 1) * kstep;
            const char* a2 = last ? nA : cA + (size_t)(t + 2) * kstep; const char* b2 = last ? nB : cB + (size_t)(t + 2) * kstep;
            const char* a3 = a2 + kstep; const char* b3 = b2 + kstep;
            if (last && has_next) S.a_ready(nxt);
            if constexpr (Epi::MID) { if (t == nt / 2) E.mid(acc, cur, wr, wc, fr, fq); }
            if constexpr (SP2) {
            PG8_LDB(B0, 0, 0); PG8_LDB(B1, 0, 1); PG8_SCHED; PG8_LDA(At, 0, 0); PG8_STAGE(PG8_SA(1, 1), a1 + hstep, voffA);
            PG8_WAIT_V(8); PG8_WAIT_L(0); PG8_BAR; PG8_MMA(0, 0, At, B0); PG8_MMA(0, 1, At, B1); PG8_BAR; PG8_SCHED;
            PG8_LDA(At, 0, 1); PG8_STAGE(PG8_SB(0, 0), b2, voffB); PG8_STAGE(PG8_SB(0, 1), b2 + hstep, voffB); PG8_STAGE(PG8_SA(0, 0), a2, voffA);
            PG8_WAIT_V(8); PG8_WAIT_L(0); PG8_BAR; PG8_MMA(1, 0, At, B0); PG8_MMA(1, 1, At, B1); PG8_BAR; PG8_SCHED;
            PG8_LDB(B0, 1, 0); PG8_LDB(B1, 1, 1); PG8_SCHED; PG8_LDA(At, 1, 0); PG8_STAGE(PG8_SA(0, 1), a2 + hstep, voffA);
            PG8_WAIT_V(8); PG8_WAIT_L(0); PG8_BAR; PG8_MMA(0, 0, At, B0); PG8_MMA(0, 1, At, B1); PG8_BAR; PG8_SCHED;
            PG8_LDA(At, 1, 1); PG8_STAGE(PG8_SB(1, 0), b3, voffB); PG8_STAGE(PG8_SB(1, 1), b3 + hstep, voffB); PG8_STAGE(PG8_SA(1, 0), a3, voffA);
            PG8_WAIT_V(8); PG8_WAIT_L(0); PG8_BAR; PG8_MMA(1, 0, At, B0); PG8_MMA(1, 1, At, B1); PG8_BAR; PG8_SCHED;
            } else {
            PG8_LDB(B0, 0, 0); PG8_SCHED; PG8_LDA(At, 0, 0); PG8_STAGE(PG8_SA(1, 1), a1 + hstep, voffA);
            PG8_WAIT_L(8); PG8_BAR; PG8_WAIT_L(0); PG8_MMA(0, 0, At, B0); PG8_BAR; PG8_SCHED;
            PG8_LDB(B1, 0, 1); PG8_STAGE(PG8_SB(0, 0), b2, voffB);
            PG8_BAR; PG8_WAIT_L(0); PG8_MMA(0, 1, At, B1); PG8_BAR;
            PG8_LDA(At, 0, 1); PG8_STAGE(PG8_SA(0, 0), a2, voffA);
            PG8_BAR; PG8_WAIT_L(0); PG8_MMA(1, 0, At, B0); PG8_BAR; PG8_SCHED;
            PG8_STAGE(PG8_SB(0, 1), b2 + hstep, voffB);
            PG8_WAIT_V(6); PG8_BAR; PG8_MMA(1, 1, At, B1); PG8_BAR;
            PG8_LDB(B0, 1, 0); PG8_SCHED; PG8_LDA(At, 1, 0); PG8_STAGE(PG8_SA(0, 1), a2 + hstep, voffA);
            PG8_WAIT_L(8); PG8_BAR; PG8_WAIT_L(0); PG8_MMA(0, 0, At, B0); PG8_BAR; PG8_SCHED;
            PG8_LDB(B1, 1, 1); PG8_STAGE(PG8_SB(1, 0), b3, voffB);
            PG8_BAR; PG8_WAIT_L(0); PG8_MMA(0, 1, At, B1); PG8_BAR;
            PG8_LDA(At, 1, 1); PG8_STAGE(PG8_SA(1, 0), a3, voffA);
            PG8_BAR; PG8_WAIT_L(0); PG8_MMA(1, 0, At, B0); PG8_BAR; PG8_SCHED;
            PG8_STAGE(PG8_SB(1, 1), b3 + hstep, voffB);
            PG8_WAIT_V(6); PG8_BAR; PG8_MMA(1, 1, At, B1); PG8_BAR;
            }
        }
        if constexpr (ALIGN_EPI) { if (wr == 0) PG8_BAR; }
        E(acc, cur, wr, wc, fr, fq); S.done(cur);
        if (!has_next) break;
#pragma unroll
        for (int a = 0; a < 2; ++a)
#pragma unroll
            for (int b = 0; b < 2; ++b)
#pragma unroll
                for (int m = 0; m < 4; ++m)
#pragma unroll
                    for (int n = 0; n < 2; ++n) acc[a][b][m][n] = (f32x4){0.f, 0.f, 0.f, 0.f};
        cur = nxt; cA = nA; cB = nB; ++ui;
        if constexpr (ALIGN_EPI) { if (wr == 1) PG8_BAR; }
    }
    PG8_WAIT_V(0);
    if constexpr (!ALIGN_EPI) { if (wr == 0) PG8_BAR; }
    PG8_BAR;
#undef PG8_SA
#undef PG8_SB
#undef PG8_STAGE
#undef PG8_LDA
#undef PG8_LDB
#undef PG8_MMA
#undef PG8_WAIT_V
#undef PG8_WAIT_L
#undef PG8_BAR
#undef PG8_SCHED
}
}

#define GAS __attribute__((address_space(1)))
#define LAS __attribute__((address_space(3)))
typedef unsigned short bf16;
typedef unsigned v4u __attribute__((ext_vector_type(4)));
typedef float f32x4 __attribute__((ext_vector_type(4)));
typedef float f32x16 __attribute__((ext_vector_type(16)));
typedef short bf16x8 __attribute__((ext_vector_type(8)));
typedef short s16x4 __attribute__((ext_vector_type(4)));
typedef short v4i16_t __attribute__((ext_vector_type(4)));
typedef LAS unsigned char LDSB;
typedef GAS unsigned gu32;

constexpr int NWAVES = 8, NTHR = 512;
constexpr int BATCH = 8, SEQ = 4096, DM = 1024, T = BATCH * SEQ;
constexpr int NPROJ = 3072;
constexpr int N_IN = 2848, FF = 4096;
constexpr float EPS = 1e-6f;
constexpr float C2 = 0.125f * 1.4426950408889634f;
constexpr float LOG2E = 1.4426950408889634f;
constexpr float NEGM = -1000.0f;

constexpr size_t MiB = 1u << 20;
constexpr size_t WS_CTL = 0, CTL_ZERO_BYTES = 1 * MiB;
constexpr size_t WS_WIN = 2 * MiB;
constexpr size_t WS_WOUT = 8 * MiB;
constexpr size_t WS_WUP = 10 * MiB;
constexpr size_t WS_WDN = 18 * MiB;
constexpr size_t WS_W1K = 26 * MiB;
constexpr size_t WS_W1V = 27 * MiB;
constexpr size_t WS_W2K = 28 * MiB;
constexpr size_t WS_W2V = 28 * MiB + 65536;
constexpr size_t WS_B1K = 28 * MiB + 131072;
constexpr size_t WS_B1V = 28 * MiB + 131072 + 65536;
constexpr size_t WS_ROPEC = 29 * MiB;
constexpr size_t WS_ROPES = 29 * MiB + 524288;
constexpr size_t WS_FL = 30 * MiB;
constexpr size_t WS_CB = 31 * MiB;
constexpr size_t WS_XN = 32 * MiB;
constexpr size_t WS_U = 96 * MiB;
constexpr size_t WS_QF = 96 * MiB;
constexpr size_t WS_KF = 128 * MiB;
constexpr size_t WS_VF = 160 * MiB;
constexpr size_t WS_QN = 192 * MiB;
constexpr size_t WS_KC = 224 * MiB;
constexpr size_t WS_VC = 233 * MiB;
constexpr size_t WS_KS = 242 * MiB;
constexpr size_t WS_VS = 250 * MiB;
constexpr size_t WS_KW = 258 * MiB;
constexpr size_t WS_VW = 266 * MiB;
constexpr size_t WS_GATE = 274 * MiB;
constexpr size_t WS_KCMP = 277 * MiB;
constexpr size_t WS_VCMP = 277 * MiB + 524288;
constexpr size_t WS_Y = 280 * MiB;
constexpr size_t WS_SSQ1 = 352 * MiB;
constexpr size_t WS_XS = 353 * MiB;
constexpr size_t WS_SSQY = 354 * MiB;
constexpr size_t WS_END = 356 * MiB;

constexpr int CW_Q_ATT = 64;
constexpr int CW_CS = 128;
constexpr int CW_CMPT = 192;
constexpr int CW_CMP = 256;
constexpr int CW_BAR = 4096;
constexpr int CW_PANEL = 8192;

constexpr int L_K = 0;
constexpr int L_V = 32768;
constexpr int L_ACC = 65536;
constexpr int L_IMP = 131072;
constexpr int L_WS = 131072 + 17408;
constexpr int L_SEL = L_WS + 8192;
constexpr int L_ORD = L_SEL + 512;
constexpr int L_MISC = L_ORD + 4096;
constexpr int L_TL = L_MISC + 256;
constexpr int LDS_BYTES = L_TL + 256;
constexpr int SLOTB = 8192;

#define RLX_AGENT __ATOMIC_RELAXED, __HIP_MEMORY_SCOPE_AGENT
#define LDS_WAIT() asm volatile("s_waitcnt lgkmcnt(0)" ::: "memory")
#define VM_WAIT() asm volatile("s_waitcnt vmcnt(0)" ::: "memory")
__device__ __forceinline__ unsigned f2bf(float f) { unsigned u = __builtin_bit_cast(unsigned, f); return (u + 0x7fffu + ((u >> 16) & 1u)) >> 16; }
__device__ __forceinline__ unsigned pk2(float lo, float hi) { return f2bf(lo) | (f2bf(hi) << 16); }
__device__ __forceinline__ float bf2f(unsigned short b) { return __builtin_bit_cast(float, (unsigned)b << 16); }

#define XB_TMO      128
#define XB_XCNT(j)  (256  + 64 * (j))
#define XB_XSUB(j)  (1280 + 64 * (j))
#define XB_XGEN(j)  (2304 + 64 * (j))
#define XB_TOP      3328
#define XB_TOPGEN   3392
#define XCD_BAR_WORDS 3456
#define XB_SPIN_CAP (1u << 22)
__device__ __forceinline__ unsigned xb_ld(unsigned* p)              { return __hip_atomic_load(p, __ATOMIC_RELAXED, __HIP_MEMORY_SCOPE_AGENT); }
__device__ __forceinline__ unsigned xb_add(unsigned* p, unsigned v) { return __hip_atomic_fetch_add(p, v, __ATOMIC_RELAXED, __HIP_MEMORY_SCOPE_AGENT); }
__device__ __forceinline__ unsigned xb_xcc_id() { return (unsigned)__builtin_amdgcn_s_getreg((3 << 11) | 20) & 0xFu; }
#define XB_SPIN(cond, bar) do { unsigned _sp = 0; while (cond) { __builtin_amdgcn_s_sleep(1); \
    if ((++_sp & 255u) == 0u) { if (xb_ld(&(bar)[XB_TMO])) break; if (_sp > XB_SPIN_CAP) { atomicAdd(&(bar)[XB_TMO], 1u); break; } } } } while (0)
struct XcdBarrier { unsigned* bar; unsigned x; volatile LAS unsigned* st; int wave; };
__device__ __forceinline__ XcdBarrier xcd_barrier_post(unsigned* bar, volatile LAS unsigned* st) {
    XcdBarrier b; b.bar = bar; b.x = xb_xcc_id(); b.st = st; b.wave = 0;
    if (threadIdx.x == 0) (void)xb_add(&bar[XB_XCNT(b.x)], 1u);
    return b;
}
__device__ __forceinline__ void xcd_barrier_complete(unsigned* bar, unsigned x, unsigned& nloc, unsigned& nx) {
    const unsigned G = gridDim.x * gridDim.y * gridDim.z;
    unsigned sum, cnt, mine, sp = 0u;
    for (;;) {
        sum = 0u; cnt = 0u; mine = 0u;
#pragma unroll
        for (unsigned j = 0; j < 16; ++j) { const unsigned c = xb_ld(&bar[XB_XCNT(j)]); sum += c; cnt += (c > 0u) ? 1u : 0u; mine = (j == x) ? c : mine; }
        if (sum == G) break;
        __builtin_amdgcn_s_sleep(1);
        if ((++sp & 255u) == 0u) { if (xb_ld(&bar[XB_TMO])) break; if (sp > XB_SPIN_CAP) { atomicAdd(&bar[XB_TMO], 1u); break; } }
    }
    nloc = mine > 0u ? mine : 1u; nx = cnt > 0u ? cnt : 1u;
}
__device__ __forceinline__ void xcd_barrier(const XcdBarrier& b) {
    asm volatile("s_waitcnt vmcnt(0)" ::: "memory");
    __syncthreads();
    if (b.wave == 0 && lane_id() == 0) {
        unsigned* bar = b.bar;
        __builtin_amdgcn_s_waitcnt(0);
        unsigned nloc = b.st[0], nx = b.st[1];
        if (nloc == 0u) { xcd_barrier_complete(bar, b.x, nloc, nx); b.st[0] = nloc; b.st[1] = nx; }
        const unsigned old = xb_add(&bar[XB_XSUB(b.x)], 1u);
        const unsigned gen = old / nloc;
        if (old + 1u == (gen + 1u) * nloc) {
            __builtin_amdgcn_fence(__ATOMIC_RELEASE, "agent");
            asm volatile("s_waitcnt vmcnt(0)" ::: "memory");
            const unsigned og = xb_add(&bar[XB_TOP], 1u);
            const unsigned tg = og / nx;
            if (og + 1u == (tg + 1u) * nx) xb_add(&bar[XB_TOPGEN], 1u);
            else XB_SPIN(xb_ld(&bar[XB_TOPGEN]) == tg, bar);
            __builtin_amdgcn_fence(__ATOMIC_ACQUIRE, "agent");
            xb_add(&bar[XB_XGEN(b.x)], 1u);
            asm volatile("s_waitcnt vmcnt(0)" ::: "memory");
        } else {
            XB_SPIN(xb_ld(&bar[XB_XGEN(b.x)]) == gen, bar);
            __builtin_amdgcn_fence(__ATOMIC_ACQUIRE, "agent");
            asm volatile("s_waitcnt vmcnt(0)" ::: "memory");
        }
    }
    __syncthreads();
}

struct Args { const float* in[22]; float* out; unsigned char* ws; int ph_lo, ph_hi; };

struct Frame {
    LDSB* lds;
    volatile LAS unsigned* MISC;
    gu32* ctl;
    int tid, lane, wave, vcu, G;
    unsigned char* ws;
};

__device__ __forceinline__ float wave_sum(float v) {
#pragma unroll
    for (int o = 1; o < 64; o <<= 1) v += __shfl_xor(v, o);
    return v;
}

__device__ __forceinline__ int win_src_col(int n) {
    const int pn = n >> 8, c = n & 255, half = c >> 7, slot = (c >> 5) & 3, d = c & 31;
    if (pn < 8) {
        const int tsr = pn >> 1, j = pn & 1;
        const int tb = (tsr == 0) ? 0 : (tsr == 1) ? 512 : (tsr == 2) ? 1024 : 1544;
        return tb + 64 * (4 * j + slot) + 32 * half + d;
    }
    if (pn < 11) {
        const int base = 2056 + (pn - 8) * 256;
        return base + (slot >> 1) * 128 + (slot & 1) * 64 + 32 * half + d;
    }
    if (c < 8) return 1536 + c;
    if (c < 32) return 2824 + (c - 8);
    return -1;
}

template <bool MAPPED>
__device__ __forceinline__ void p0_transpose_item(const float* W, int K, int N, bf16* WT, LAS float* scr, int item, int lane, const float* kscale, int nblk) {
    const int kb = item / nblk, nb = item % nblk, k0 = 64 * kb, n0 = 32 * nb;
    int src = n0 + 4 * (lane & 7);
    if (MAPPED) src = win_src_col(src);
    f32x4 v[8];
#pragma unroll
    for (int i = 0; i < 8; ++i) { const int kk = 8 * i + (lane >> 3);
        v[i] = (src >= 0) ? *(const f32x4*)(W + (size_t)(k0 + kk) * N + src) : (f32x4){0.f, 0.f, 0.f, 0.f}; }
#pragma unroll
    for (int i = 0; i < 8; ++i) { const int kk = 8 * i + (lane >> 3); const float sc = kscale ? kscale[k0 + kk] : 1.f;
        LAS float* p = scr + kk * 33 + 4 * (lane & 7); p[0] = v[i][0] * sc; p[1] = v[i][1] * sc; p[2] = v[i][2] * sc; p[3] = v[i][3] * sc; }
    LDS_WAIT(); asm volatile("" ::: "memory");
    const int c = lane & 7;
#pragma unroll
    for (int j = 0; j < 4; ++j) { const int n = (lane >> 3) + 8 * j; const LAS float* sp = scr + (8 * c) * 33 + n;
        v4u o; o.x = pk2(sp[0 * 33], sp[1 * 33]); o.y = pk2(sp[2 * 33], sp[3 * 33]); o.z = pk2(sp[4 * 33], sp[5 * 33]); o.w = pk2(sp[6 * 33], sp[7 * 33]);
        *(GAS v4u*)(WT + (size_t)(n0 + n) * K + k0 + 8 * c) = o; }
    LDS_WAIT(); asm volatile("" ::: "memory");
}

__device__ __forceinline__ void rms_row_to_bf16(int lane, const float* xrow, bf16* orow) {
    const GAS f32x4* xr = (const GAS f32x4*)xrow + lane;
    f32x4 v[4]; float s = 0.f;
#pragma unroll
    for (int j = 0; j < 4; ++j) { v[j] = xr[64 * j]; s += (v[j].x * v[j].x + v[j].y * v[j].y) + (v[j].z * v[j].z + v[j].w * v[j].w); }
    const float r = 1.f / sqrtf(wave_sum(s) * (1.f / DM) + EPS);
    GAS unsigned long long* o8 = (GAS unsigned long long*)orow + lane;
#pragma unroll
    for (int j = 0; j < 4; ++j) o8[64 * j] = (unsigned long long)pk2(v[j].x * r, v[j].y * r) | ((unsigned long long)pk2(v[j].z * r, v[j].w * r) << 32);
}

typedef __attribute__((address_space(4))) const char* kptr_t;
#define AIN(kp_, i) (*(const float* const __attribute__((address_space(4)))*)((kp_) + 8 * (i)))
__device__ __forceinline__ void p0_prologue(Frame& F, kptr_t kp) {
    const float* x = AIN(kp, 0); const float* g_attn = AIN(kp, 1); const float* w_in = AIN(kp, 2);
    const float* cmpk_pe = AIN(kp, 5); const float* cmpk_w1 = AIN(kp, 6); const float* cmpk_w2 = AIN(kp, 8);
    const float* cmpv_pe = AIN(kp, 10); const float* cmpv_w1 = AIN(kp, 11); const float* cmpv_w2 = AIN(kp, 13);
    const float* g_fox = AIN(kp, 15); const float* g_nsa = AIN(kp, 16); const float* w_out = AIN(kp, 17);
    const float* g_mlp = AIN(kp, 18); const float* w_up = AIN(kp, 19); const float* w_down = AIN(kp, 20);
    LAS float* scr = (LAS float*)(F.lds + F.wave * 16384);
    const int gw = F.vcu * NWAVES + F.wave, NGW = F.G * NWAVES;
    for (int it = gw; it < 128; it += NGW) {
        const int kv = it >> 6, kc = it & 63;
        const float* pe = kv ? cmpv_pe : cmpk_pe; const float* w1 = kv ? cmpv_w1 : cmpk_w1;
        f32x4 a = (f32x4){0.f, 0.f, 0.f, 0.f};
#pragma unroll 8
        for (int k = 32 * kc; k < 32 * kc + 32; ++k) { const f32x4 wv = *((const f32x4*)(w1 + (size_t)k * 256) + F.lane); a = a + wv * pe[k]; }
        *((f32x4*)(F.ws + (kv ? WS_B1V : WS_B1K)) + kc * 64 + F.lane) = a;
    }
    constexpr int I_IN = (DM / 64) * (NPROJ / 32), I_OUT = (DM / 64) * (DM / 32), I_UP = (DM / 64) * (FF / 32), I_DN = (FF / 64) * (DM / 32);
    constexpr int I_W1 = (2048 / 64) * (256 / 32), I_W2 = (256 / 64) * (64 / 32);
    constexpr int NITEMS = I_IN + I_OUT + I_UP + I_DN + 2 * I_W1 + 2 * I_W2;
    for (int it = gw; it < NITEMS; it += NGW) {
        int r = it;
        if (r < I_IN) { p0_transpose_item<true>(w_in, DM, N_IN, (bf16*)(F.ws + WS_WIN), scr, r, F.lane, g_attn, NPROJ / 32); continue; } r -= I_IN;
        if (r < I_OUT) {
            const int kb = r / (DM / 32);
            const float* ks = (kb < 8) ? g_fox : (g_nsa - 512);
            p0_transpose_item<false>(w_out, DM, DM, (bf16*)(F.ws + WS_WOUT), scr, r, F.lane, ks, DM / 32); continue; } r -= I_OUT;
        if (r < I_UP) { p0_transpose_item<false>(w_up, DM, FF, (bf16*)(F.ws + WS_WUP), scr, r, F.lane, g_mlp, FF / 32); continue; } r -= I_UP;
        if (r < I_DN) { p0_transpose_item<false>(w_down, FF, DM, (bf16*)(F.ws + WS_WDN), scr, r, F.lane, nullptr, DM / 32); continue; } r -= I_DN;
        if (r < I_W1) { p0_transpose_item<false>(cmpk_w1, 2048, 256, (bf16*)(F.ws + WS_W1K), scr, r, F.lane, nullptr, 8); continue; } r -= I_W1;
        if (r < I_W1) { p0_transpose_item<false>(cmpv_w1, 2048, 256, (bf16*)(F.ws + WS_W1V), scr, r, F.lane, nullptr, 8); continue; } r -= I_W1;
        if (r < I_W2) { p0_transpose_item<false>(cmpk_w2, 256, 64, (bf16*)(F.ws + WS_W2K), scr, r, F.lane, nullptr, 2); continue; } r -= I_W2;
        p0_transpose_item<false>(cmpv_w2, 256, 64, (bf16*)(F.ws + WS_W2V), scr, r, F.lane, nullptr, 2);
    }
    {
        float* rc = (float*)(F.ws + WS_ROPEC); float* rs = (float*)(F.ws + WS_ROPES);
        for (int i = F.vcu * NTHR + F.tid; i < SEQ * 32; i += F.G * NTHR) {
            const int pos = i >> 5, d = i & 31;
            const float inv = exp2f(-(float)d * (13.287712379549449f / 32.0f));
            const float ang = (float)pos * inv;
            const double a = (double)ang;
            const double k = __builtin_rint(a * 0.15915494309189535);
            const float red = (float)(a - k * 6.283185307179586);
            rc[i] = cosf(red); rs[i] = sinf(red);
        }
    }
    for (int m = gw; m < T; m += 4 * NGW) {
        f32x4 v[4][4]; float ss[4];
#pragma unroll
        for (int r = 0; r < 4; ++r) { const int mr = (m + r * NGW < T) ? m + r * NGW : m; const GAS f32x4* xr = (const GAS f32x4*)(x + (size_t)mr * DM) + F.lane;
#pragma unroll
            for (int j = 0; j < 4; ++j) v[r][j] = xr[64 * j]; }
#pragma unroll
        for (int r = 0; r < 4; ++r) { float a = 0.f;
#pragma unroll
            for (int j = 0; j < 4; ++j) a += (v[r][j].x * v[r][j].x + v[r][j].y * v[r][j].y) + (v[r][j].z * v[r][j].z + v[r][j].w * v[r][j].w);
            ss[r] = a; }
#pragma unroll
        for (int o = 1; o < 64; o <<= 1) {
#pragma unroll
            for (int r = 0; r < 4; ++r) ss[r] += __shfl_xor(ss[r], o); }
#pragma unroll
        for (int r = 0; r < 4; ++r) { const float rs = 1.f / sqrtf(ss[r] * (1.f / DM) + EPS);
            const int mr = (m + r * NGW < T) ? m + r * NGW : m;
            GAS unsigned long long* o8 = (GAS unsigned long long*)((bf16*)(F.ws + WS_XN) + (size_t)mr * DM) + F.lane;
#pragma unroll
            for (int j = 0; j < 4; ++j) o8[64 * j] = (unsigned long long)pk2(v[r][j].x * rs, v[r][j].y * rs) | ((unsigned long long)pk2(v[r][j].z * rs, v[r][j].w * rs) << 32); }
    }
}

typedef pg8::f32x4 pf4;
__device__ __forceinline__ float log_sigmoidf(float v) { return v >= 0.f ? -log1pf(expf(-v)) : v - log1pf(expf(v)); }

struct EpiProj { static constexpr bool MID = false;
    static constexpr bool PERM = true;
    unsigned char* ws; const float* b_f; const float* b_gate;
    __device__ __forceinline__ void operator()(const pf4 (&acc)[2][2][4][2], const pg8::Unit& u, int wr, int wc, int fr, int fq) const {
        const int pn = u.pn; const int rbase = u.pm * 256 + wr * 64 + fr;
        if (pn == 11) {
            if (wc != 0) return;
            float* FL = (float*)(ws + WS_FL); float* GT = (float*)(ws + WS_GATE);
#pragma unroll
            for (int ai = 0; ai < 2; ++ai)
#pragma unroll
                for (int m = 0; m < 4; ++m) { const int row = rbase + ai * 128 + m * 16; const int b = row >> 12, s = row & 4095;
#pragma unroll
                    for (int n = 0; n < 2; ++n) { const pf4 v = acc[ai][0][m][n];
                        if (fq == 0) {
#pragma unroll
                            for (int i = 0; i < 4; ++i) { const int h = 4 * n + i; FL[(size_t)(b * 8 + h) * SEQ + s] = log_sigmoidf(v[i] + b_f[h]); }
                        } else { const int j0 = 8 * fq - 8 + 4 * n; pf4 o;
#pragma unroll
                            for (int i = 0; i < 4; ++i) { const float z = v[i] + b_gate[j0 + i]; o[i] = 1.f / (1.f + expf(-z)); }
                            *(pf4*)(GT + (size_t)row * 24 + j0) = o; } } }
            return;
        }
        const bool rope = (pn == 6) || (pn == 7) || ((pn == 9 || pn == 10) && wc < 2);
        const float sc = (pn < 2 || pn == 6 || pn == 7) ? C2 : 1.f;
        const float* RC = (const float*)(ws + WS_ROPEC); const float* RS = (const float*)(ws + WS_ROPES);
        size_t tb;
        if (pn < 8) { const int tsr = pn >> 1; tb = (tsr == 0) ? WS_QF : (tsr == 1) ? WS_KF : (tsr == 2) ? WS_VF : WS_QN; }
        else { const int vt = wc >> 1; tb = (pn == 8) ? (vt ? WS_VC : WS_KC) : (pn == 9) ? (vt ? WS_VS : WS_KS) : (vt ? WS_VW : WS_KW); }
        bf16* TB = (bf16*)(ws + tb);
#pragma unroll
        for (int ai = 0; ai < 2; ++ai)
#pragma unroll
            for (int m = 0; m < 4; ++m) { const int row = rbase + ai * 128 + m * 16;
                pf4 a0 = acc[ai][0][m][0], a1 = acc[ai][0][m][1], b0 = acc[ai][1][m][0], b1 = acc[ai][1][m][1];
                if (rope) { const int pos = row & 4095;
                    const pf4 c0 = *(const pf4*)(RC + pos * 32 + 8 * fq), c1 = *(const pf4*)(RC + pos * 32 + 8 * fq + 4);
                    const pf4 s0 = *(const pf4*)(RS + pos * 32 + 8 * fq), s1 = *(const pf4*)(RS + pos * 32 + 8 * fq + 4);
                    const pf4 x0 = a0 * c0 - b0 * s0, x1 = a1 * c1 - b1 * s1, y0 = a0 * s0 + b0 * c0, y1 = a1 * s1 + b1 * c1;
                    a0 = x0; a1 = x1; b0 = y0; b1 = y1; }
                a0 = a0 * sc; a1 = a1 * sc; b0 = b0 * sc; b1 = b1 * sc;
                v4u w0, w1; w0.x = pk2(a0[0], a0[1]); w0.y = pk2(a0[2], a0[3]); w0.z = pk2(a1[0], a1[1]); w0.w = pk2(a1[2], a1[3]);
                w1.x = pk2(b0[0], b0[1]); w1.y = pk2(b0[2], b0[3]); w1.z = pk2(b1[0], b1[1]); w1.w = pk2(b1[2], b1[3]);
                bf16* p;
                if (pn < 8) p = TB + (size_t)row * 512 + 64 * (4 * (pn & 1) + wc) + 8 * fq;
                else { const int b = row >> 12, s = row & 4095, g = wc & 1; p = TB + ((size_t)(b * 2 + g) * SEQ + s) * 64 + 8 * fq; }
                *(v4u*)p = w0; *(v4u*)(p + 32) = w1; }
    }
};

struct EpiOutRes {
    static constexpr bool PERM = true, MID = true;
    const float* x; float* out; bf16* xn; float* ssq; LDSB* lds; int pm0;
    __device__ __forceinline__ const LAS float* tabrow(const pg8::Unit& u, int rl) const { return (const LAS float*)(lds + L_IMP + 8192) + (((u.pm == pm0) ? 0 : 256) + rl) * 2; }
    __device__ __forceinline__ void mid(pf4 (&acc)[2][2][4][2], const pg8::Unit& u, int wr, int wc, int fr, int fq) const {
#pragma unroll
        for (int ai = 0; ai < 2; ++ai)
#pragma unroll
            for (int m = 0; m < 4; ++m) { const float q = tabrow(u, ai * 128 + wr * 64 + m * 16 + fr)[0];
#pragma unroll
                for (int bj = 0; bj < 2; ++bj) { acc[ai][bj][m][0] = acc[ai][bj][m][0] * q; acc[ai][bj][m][1] = acc[ai][bj][m][1] * q; } }
    }
    __device__ __forceinline__ void operator()(const pf4 (&acc)[2][2][4][2], const pg8::Unit& u, int wr, int wc, int fr, int fq) const {
        const int col0 = u.pn * 256 + wc * 32 + 8 * fq;
        LAS float* P = (LAS float*)(lds + L_IMP);
#pragma unroll
        for (int ai = 0; ai < 2; ++ai)
#pragma unroll
            for (int m = 0; m < 4; ++m) { const int rl = ai * 128 + wr * 64 + m * 16 + fr; const size_t off = (size_t)(u.pm * 256 + rl) * DM + col0; float sq = 0.f;
                const float rn = tabrow(u, rl)[1];
#pragma unroll
                for (int bj = 0; bj < 2; ++bj) {
                    const pf4 h0 = *(const pf4*)(x + off + bj * 128) + acc[ai][bj][m][0] * rn, h1 = *(const pf4*)(x + off + bj * 128 + 4) + acc[ai][bj][m][1] * rn;
                    *(pf4*)(out + off + bj * 128) = h0; *(pf4*)(out + off + bj * 128 + 4) = h1;
                    sq += ((h0[0] * h0[0] + h0[1] * h0[1]) + (h0[2] * h0[2] + h0[3] * h0[3])) + ((h1[0] * h1[0] + h1[1] * h1[1]) + (h1[2] * h1[2] + h1[3] * h1[3]));
                    v4u w; w.x = pk2(h0[0], h0[1]); w.y = pk2(h0[2], h0[3]); w.z = pk2(h1[0], h1[1]); w.w = pk2(h1[2], h1[3]);
                    *(v4u*)(xn + off + bj * 128) = w; }
                sq += __shfl_xor(sq, 16); sq += __shfl_xor(sq, 32);
                if (fq == 0) P[rl * 4 + wc] = sq; }
        asm volatile("s_waitcnt lgkmcnt(0)\n\ts_barrier" ::: "memory");
        const int t = (wr * 4 + wc) * 64 + (fq * 16 + fr);
        if (t < 256) { const f32x4 p = *(const LAS f32x4*)(P + t * 4); ssq[(size_t)(u.pm * 256 + t) * 4 + u.pn] = (p[0] + p[1]) + (p[2] + p[3]); }
    }
};

struct EpiUp { static constexpr bool MID = false;
    static constexpr bool PERM = true;
    bf16* O; const float* ssq;
    __device__ __forceinline__ void operator()(const pf4 (&acc)[2][2][4][2], const pg8::Unit& u, int wr, int wc, int fr, int fq) const {
        const int row0 = u.pm * 256 + wr * 64 + fr, col0 = u.pn * 256 + wc * 32 + 8 * fq;
#pragma unroll
        for (int ai = 0; ai < 2; ++ai)
#pragma unroll
            for (int m = 0; m < 4; ++m) { const int row = row0 + ai * 128 + m * 16; bf16* rowp = O + (size_t)row * FF + col0;
                const pf4 s0 = *(const pf4*)(ssq + (size_t)row * 4);
                const float tot = (s0[0] + s0[1]) + (s0[2] + s0[3]);
                const float r2 = 1.f / (tot * (1.f / DM) + EPS);
#pragma unroll
                for (int bj = 0; bj < 2; ++bj) { pf4 v0 = acc[ai][bj][m][0], v1 = acc[ai][bj][m][1];
#pragma unroll
                    for (int i = 0; i < 4; ++i) { const float a = fmaxf(v0[i], 0.f), b = fmaxf(v1[i], 0.f); v0[i] = a * a * r2; v1[i] = b * b * r2; }
                    v4u w; w.x = pk2(v0[0], v0[1]); w.y = pk2(v0[2], v0[3]); w.z = pk2(v1[0], v1[1]); w.w = pk2(v1[2], v1[3]);
                    *(v4u*)(rowp + bj * 128) = w; } }
    }
};

struct EpiDownNorm { static constexpr bool MID = false;
    static constexpr bool PERM = true;
    float* out; const float* g; float* xs; gu32* cnt; LDSB* lds;
    __device__ __forceinline__ void operator()(pf4 (&acc)[2][2][4][2], const pg8::Unit& u, int wr, int wc, int fr, int fq) const {
        const int col0 = u.pn * 256 + wc * 32 + 8 * fq;
        LAS float* P = (LAS float*)(lds + L_IMP);
        LAS float* S = P + 1024;
#pragma unroll
        for (int ai = 0; ai < 2; ++ai)
#pragma unroll
            for (int m = 0; m < 4; ++m) { const int rl = ai * 128 + wr * 64 + m * 16 + fr; const size_t off = (size_t)(u.pm * 256 + rl) * DM + col0; float sq = 0.f;
#pragma unroll
                for (int bj = 0; bj < 2; ++bj) { const float* p = out + off + bj * 128;
                    const pf4 h0 = *(const pf4*)p + acc[ai][bj][m][0], h1 = *(const pf4*)(p + 4) + acc[ai][bj][m][1];
                    acc[ai][bj][m][0] = h0; acc[ai][bj][m][1] = h1;
                    sq += ((h0[0] * h0[0] + h0[1] * h0[1]) + (h0[2] * h0[2] + h0[3] * h0[3])) + ((h1[0] * h1[0] + h1[1] * h1[1]) + (h1[2] * h1[2] + h1[3] * h1[3])); }
                sq += __shfl_xor(sq, 16); sq += __shfl_xor(sq, 32);
                if (fq == 0) P[rl * 4 + wc] = sq; }
        asm volatile("s_waitcnt lgkmcnt(0)\n\ts_barrier" ::: "memory");
        const int wid = wr * 4 + wc, lane = fq * 16 + fr, t = wid * 64 + lane;
        if (t < 256) { const f32x4 p = *(const LAS f32x4*)(P + t * 4);
            __hip_atomic_store(xs + (size_t)(u.pm * 256 + t) * 4 + u.pn, (p[0] + p[1]) + (p[2] + p[3]), __ATOMIC_RELAXED, __HIP_MEMORY_SCOPE_AGENT); }
        asm volatile("s_waitcnt vmcnt(0)" ::: "memory");
        if (t < 256 && lane == 0) __hip_atomic_fetch_add(cnt + 64 * u.pm, 1u, RLX_AGENT);
        if (wid == 0) {
            unsigned sp = 0;
            while ((unsigned)__builtin_amdgcn_readfirstlane((int)__hip_atomic_load(cnt + 64 * u.pm, RLX_AGENT)) < 16u) { __builtin_amdgcn_s_sleep(2); if (++sp > (1u << 22)) break; }
            __builtin_amdgcn_fence(__ATOMIC_ACQUIRE, "agent");
            asm volatile("s_waitcnt vmcnt(0)" ::: "memory");
        }
        asm volatile("s_waitcnt lgkmcnt(0)\n\ts_barrier" ::: "memory");
        if (t < 256) { const float* sl = xs + (size_t)(u.pm * 256 + t) * 4;
            const float a0 = __hip_atomic_load(sl, RLX_AGENT), a1 = __hip_atomic_load(sl + 1, RLX_AGENT), a2 = __hip_atomic_load(sl + 2, RLX_AGENT), a3 = __hip_atomic_load(sl + 3, RLX_AGENT);
            S[t] = 1.f / sqrtf(((a0 + a1) + (a2 + a3)) * (1.f / DM) + EPS); }
        asm volatile("s_waitcnt lgkmcnt(0)\n\ts_barrier" ::: "memory");
#pragma unroll
        for (int bj = 0; bj < 2; ++bj) { const pf4 g0 = *(const pf4*)(g + col0 + bj * 128), g1 = *(const pf4*)(g + col0 + bj * 128 + 4);
#pragma unroll
            for (int ai = 0; ai < 2; ++ai)
#pragma unroll
                for (int m = 0; m < 4; ++m) { const int rl = ai * 128 + wr * 64 + m * 16 + fr; const float r = S[rl]; float* p = out + (size_t)(u.pm * 256 + rl) * DM + col0 + bj * 128;
                    *(pf4*)p = acc[ai][bj][m][0] * r * g0; *(pf4*)(p + 4) = acc[ai][bj][m][1] * r * g1; } }
    }
};

__device__ __forceinline__ void p2_cumsum_item(Frame& F, int item) {
    const float* fl = (const float*)(F.ws + WS_FL) + (size_t)item * SEQ; float* cb = (float*)(F.ws + WS_CB) + (size_t)item * SEQ;
    const int lane = F.lane;
    float v[64]; float run = 0.f;
#pragma unroll
    for (int i = 0; i < 16; ++i) { const f32x4 t = *(const f32x4*)(fl + lane * 64 + 4 * i); v[4 * i] = t[0]; v[4 * i + 1] = t[1]; v[4 * i + 2] = t[2]; v[4 * i + 3] = t[3]; }
#pragma unroll
    for (int i = 0; i < 64; ++i) { run += v[i]; v[i] = run; }
    float incl = run;
#pragma unroll
    for (int o = 1; o < 64; o <<= 1) { const float t = __shfl_up(incl, o); if (lane >= o) incl += t; }
    const float base = incl - run;
#pragma unroll
    for (int i = 0; i < 16; ++i) { f32x4 t; t[0] = -(v[4 * i] + base) * LOG2E; t[1] = -(v[4 * i + 1] + base) * LOG2E; t[2] = -(v[4 * i + 2] + base) * LOG2E; t[3] = -(v[4 * i + 3] + base) * LOG2E;
        *(f32x4*)(cb + lane * 64 + 4 * i) = t; }
}

__device__ __forceinline__ float gelu_tanh(float x) {
    const float u = 0.7978845608028654f * (x + 0.044715f * x * x * x);
    const float e = __expf(2.f * u);
    const float th = 1.f - 2.f / (e + 1.f);
    return 0.5f * x * (1.f + th);
}

__device__ __forceinline__ void p2_compress_item(Frame& F0, kptr_t kp, int item) {
    typedef float f4 __attribute__((ext_vector_type(4)));
    struct { unsigned char* ws; LDSB* lds; int tid, lane, wave; } F; F.ws = F0.ws; F.lds = F0.lds; F.wave = F0.wave;
    { int t_ = F0.tid; asm volatile("" : "+v"(t_)); F.tid = t_; F.lane = t_ & 63; }
    asm volatile("" : "+s"(F.ws));
    const int kv = item >> 6, bg = (item >> 2) & 15, cblk = item & 3, c0 = 64 * cblk;
    const int lane = F.lane, w = F.wave, fr = lane & 15, fq = lane >> 4;
    const bf16* Ab = (const bf16*)(F.ws + (kv ? WS_VC : WS_KC)) + (size_t)bg * SEQ * 64 + (size_t)c0 * 1024;
    const bf16* W1 = (const bf16*)(F.ws + (kv ? WS_W1V : WS_W1K));
    const bf16* W2 = (const bf16*)(F.ws + (kv ? WS_W2V : WS_W2K));
    const float* B1 = (const float*)(F.ws + (kv ? WS_B1V : WS_B1K));
    const float* b1 = AIN(kp, kv ? 12 : 7);
    const float* b2 = AIN(kp, kv ? 14 : 9);
    LDSB* lds = F.lds;
    LAS bf16* Hs = (LAS bf16*)(lds + 92160);
    f4 acc[4][2];
#pragma unroll
    for (int m = 0; m < 4; ++m) { acc[m][0] = (f4){0.f, 0.f, 0.f, 0.f}; acc[m][1] = (f4){0.f, 0.f, 0.f, 0.f}; }
    const int tid = F.tid, lrow = tid >> 3, lch = tid & 7;
    const bf16* ag = Ab + (size_t)lrow * 1024 + lch * 8;
    const bf16* bg_ = W1 + (size_t)lrow * 2048 + lch * 8;
    const int sto = (lrow * 72 + lch * 8) * 2;
    v4u ra = *(const v4u*)ag, rb[4];
#pragma unroll
    for (int i = 0; i < 4; ++i) rb[i] = *(const v4u*)(bg_ + (size_t)i * 64 * 2048);
    *(LAS v4u*)(lds + sto) = ra;
#pragma unroll
    for (int i = 0; i < 4; ++i) *(LAS v4u*)(lds + 18432 + sto + i * 64 * 144) = rb[i];
    __syncthreads();
    for (int ks = 0; ks < 32; ++ks) {
        const int cb = ks & 1;
        if (ks + 1 < 32) { ra = *(const v4u*)(ag + (ks + 1) * 64);
#pragma unroll
            for (int i = 0; i < 4; ++i) rb[i] = *(const v4u*)(bg_ + (size_t)i * 64 * 2048 + (ks + 1) * 64); }
        const LDSB* As = lds + cb * 9216; const LDSB* Bs = lds + 18432 + cb * 36864;
#pragma unroll
        for (int kh = 0; kh < 2; ++kh) {
            bf16x8 a[4], b[2];
#pragma unroll
            for (int m = 0; m < 4; ++m) a[m] = *(const LAS bf16x8*)(As + ((16 * m + fr) * 72 + 32 * kh + 8 * fq) * 2);
#pragma unroll
            for (int n = 0; n < 2; ++n) b[n] = *(const LAS bf16x8*)(Bs + ((32 * w + 16 * n + fr) * 72 + 32 * kh + 8 * fq) * 2);
#pragma unroll
            for (int m = 0; m < 4; ++m)
#pragma unroll
                for (int n = 0; n < 2; ++n) acc[m][n] = __builtin_amdgcn_mfma_f32_16x16x32_bf16(a[m], b[n], acc[m][n], 0, 0, 0);
        }
        if (ks + 1 < 32) {
            *(LAS v4u*)(lds + (cb ^ 1) * 9216 + sto) = ra;
#pragma unroll
            for (int i = 0; i < 4; ++i) *(LAS v4u*)(lds + 18432 + (cb ^ 1) * 36864 + sto + i * 64 * 144) = rb[i];
        }
        __syncthreads();
    }
    float bbv[2];
#pragma unroll
    for (int n = 0; n < 2; ++n) { const int col = 32 * w + 16 * n + fr; float bb = b1[col];
#pragma unroll 8
        for (int kc = 0; kc < 64; ++kc) bb += B1[kc * 256 + col];
        bbv[n] = bb; }
#pragma unroll
    for (int m = 0; m < 4; ++m)
#pragma unroll
        for (int n = 0; n < 2; ++n) { const int col = 32 * w + 16 * n + fr;
#pragma unroll
            for (int r = 0; r < 4; ++r) Hs[(16 * m + 4 * fq + r) * 264 + col] = (bf16)f2bf(gelu_tanh(acc[m][n][r] + bbv[n])); }
    __syncthreads();
    const int mt = w >> 1, ntA = (w & 1), ntB = (w & 1) + 2;
    f4 oa = (f4){0.f, 0.f, 0.f, 0.f}, ob = (f4){0.f, 0.f, 0.f, 0.f};
#pragma unroll
    for (int k0 = 0; k0 < 256; k0 += 32) {
        const bf16x8 a = *(const LAS bf16x8*)(Hs + (16 * mt + fr) * 264 + k0 + 8 * fq);
        const bf16x8 bA = *(const bf16x8*)(W2 + (size_t)(16 * ntA + fr) * 256 + k0 + 8 * fq);
        const bf16x8 bB = *(const bf16x8*)(W2 + (size_t)(16 * ntB + fr) * 256 + k0 + 8 * fq);
        oa = __builtin_amdgcn_mfma_f32_16x16x32_bf16(a, bA, oa, 0, 0, 0);
        ob = __builtin_amdgcn_mfma_f32_16x16x32_bf16(a, bB, ob, 0, 0, 0);
    }
    const int d1 = 16 * (w & 1) + fr;
    const float bb1 = b2[d1], bb2 = b2[d1 + 32];
    const float* RC = (const float*)(F.ws + WS_ROPEC); const float* RS = (const float*)(F.ws + WS_ROPES);
    bf16* O = (bf16*)(F.ws + (kv ? WS_VCMP : WS_KCMP)) + (size_t)bg * 256 * 64;
#pragma unroll
    for (int r = 0; r < 4; ++r) { const int c = c0 + 16 * mt + 4 * fq + r;
        float x1 = oa[r] + bb1, x2 = ob[r] + bb2;
        if (kv == 0) { int pos = 16 * c + 31; pos = pos > 4095 ? 4095 : pos; const float cs = RC[pos * 32 + d1], sn = RS[pos * 32 + d1];
            const float y1 = x1 * cs - x2 * sn, y2 = x1 * sn + x2 * cs; x1 = y1; x2 = y2; }
        O[(size_t)c * 64 + d1] = (bf16)f2bf(x1); O[(size_t)c * 64 + d1 + 32] = (bf16)f2bf(x2); }
    __syncthreads();
}

__device__ __forceinline__ int crow(int r, int hi) { return (r & 3) + 8 * (r >> 2) + 4 * hi; }
__device__ __forceinline__ void glds16(const void* gsrc, unsigned lds_dst) { unsigned keep;
    asm volatile("s_mov_b32 %0, m0\n\ts_mov_b32 m0, %2\n\ts_nop 0\n\tglobal_load_lds_dwordx4 %1, off\n\ts_mov_b32 m0, %0" : "=&s"(keep) : "v"(gsrc), "s"(lds_dst) : "memory"); }
#define WAIT_BAR(N) asm volatile("s_waitcnt vmcnt(" #N ") lgkmcnt(0)\n\ts_barrier" ::: "memory")
__device__ __forceinline__ unsigned cvtpk_s(float lo, float hi) { typedef float f2 __attribute__((ext_vector_type(2))); typedef __bf16 b2 __attribute__((ext_vector_type(2)));
    f2 v = {lo, hi}; b2 b = __builtin_convertvector(v, b2); return __builtin_bit_cast(unsigned, b); }
__device__ __forceinline__ s16x4 vtr(const LDSB* p) { return __builtin_bit_cast(s16x4, __builtin_amdgcn_ds_read_tr16_b64_v4i16((LAS v4i16_t*)p)); }

__device__ __forceinline__ float xh_max(float a) { auto r = __builtin_amdgcn_permlane32_swap(__float_as_uint(a), __float_as_uint(a), false, false); return fmaxf(__uint_as_float(r[0]), __uint_as_float(r[1])); }
__device__ __forceinline__ float xh_sum(float a) { auto r = __builtin_amdgcn_permlane32_swap(__float_as_uint(a), __float_as_uint(a), false, false); return __uint_as_float(r[0]) + __uint_as_float(r[1]); }
__device__ __forceinline__ float xh_other(float a, int hi) { auto r = __builtin_amdgcn_permlane32_swap(__float_as_uint(a), __float_as_uint(a), false, false); return hi ? __uint_as_float(r[0]) : __uint_as_float(r[1]); }
__device__ __forceinline__ void qkt(f32x16& p0, f32x16& p1, const LDSB* kslot, const bf16x8 (&qr)[4], const f32x16& cinit, int r32, int hi) {
    const LDSB* kb = kslot + hi * 1024 + r32 * 16;
#pragma unroll
    for (int d0 = 0; d0 < 4; ++d0) {
        const bf16x8 b0 = *(const LAS bf16x8*)(kb + d0 * 2048);
        const bf16x8 b1 = *(const LAS bf16x8*)(kb + d0 * 2048 + 512);
        if (d0 == 0) { p0 = __builtin_amdgcn_mfma_f32_32x32x16_bf16(b0, qr[0], cinit, 0, 0, 0); p1 = __builtin_amdgcn_mfma_f32_32x32x16_bf16(b1, qr[0], cinit, 0, 0, 0); }
        else { p0 = __builtin_amdgcn_mfma_f32_32x32x16_bf16(b0, qr[d0], p0, 0, 0, 0); p1 = __builtin_amdgcn_mfma_f32_32x32x16_bf16(b1, qr[d0], p1, 0, 0, 0); }
    }
}
__device__ __forceinline__ void pv(f32x16 (&o)[2], const LDSB* vp, const f32x16& p0, const f32x16& p1) {
    v4u pw[4];
    pw[0] = (v4u){cvtpk_s(p0[0], p0[1]), cvtpk_s(p0[2], p0[3]), cvtpk_s(p0[4], p0[5]), cvtpk_s(p0[6], p0[7])};
    pw[1] = (v4u){cvtpk_s(p0[8], p0[9]), cvtpk_s(p0[10], p0[11]), cvtpk_s(p0[12], p0[13]), cvtpk_s(p0[14], p0[15])};
    pw[2] = (v4u){cvtpk_s(p1[0], p1[1]), cvtpk_s(p1[2], p1[3]), cvtpk_s(p1[4], p1[5]), cvtpk_s(p1[6], p1[7])};
    pw[3] = (v4u){cvtpk_s(p1[8], p1[9]), cvtpk_s(p1[10], p1[11]), cvtpk_s(p1[12], p1[13]), cvtpk_s(p1[14], p1[15])};
#pragma unroll
    for (int d0 = 0; d0 < 2; ++d0)
#pragma unroll
        for (int ks = 0; ks < 4; ++ks) {
            const s16x4 lo = vtr(vp + d0 * 4096 + ks * 1024), hi = vtr(vp + d0 * 4096 + ks * 1024 + 512);
            const bf16x8 vf = (bf16x8){lo[0], lo[1], lo[2], lo[3], hi[0], hi[1], hi[2], hi[3]};
            o[d0] = __builtin_amdgcn_mfma_f32_32x32x16_bf16(__builtin_bit_cast(bf16x8, pw[ks]), vf, o[d0], 0, 0, 0);
        }
}
__device__ __forceinline__ float rowmax32(const f32x16& p0, const f32x16& p1) {
    float a = fmaxf(p0[0], p1[0]);
#pragma unroll
    for (int r = 1; r < 16; ++r) a = fmaxf(a, fmaxf(p0[r], p1[r]));
    return xh_max(a);
}
__device__ __forceinline__ float rowsum32(const f32x16& p0, const f32x16& p1) {
    float a = 0.f, b = 0.f;
#pragma unroll
    for (int r = 0; r < 16; ++r) { a += p0[r]; b += p1[r]; }
    return a + b;
}

template <int PITCH>
__device__ __forceinline__ void dma_kv(const bf16* Kh, const bf16* Vh, int key0, unsigned kdst, unsigned vdst, int wid, int lane) {
    const bf16* ksrc = Kh + (size_t)(key0 + lane) * PITCH + wid * 8;
    const bf16* vsrc = Vh + (size_t)(key0 + 16 * (wid & 3) + (lane >> 2)) * PITCH + (wid >> 2) * 32 + (lane & 3) * 8;
    glds16(ksrc, (unsigned)__builtin_amdgcn_readfirstlane(kdst + wid * 1024));
    glds16(vsrc, (unsigned)__builtin_amdgcn_readfirstlane(vdst + wid * 1024));
}


#define SBAR() __builtin_amdgcn_sched_barrier(0)
__device__ __forceinline__ void kload8(bf16x8* kf, const LDSB* kp) {
    kf[0] = *(const LAS bf16x8*)(kp);        kf[1] = *(const LAS bf16x8*)(kp + 512);
    kf[2] = *(const LAS bf16x8*)(kp + 2048); kf[3] = *(const LAS bf16x8*)(kp + 2560);
    kf[4] = *(const LAS bf16x8*)(kp + 4096); kf[5] = *(const LAS bf16x8*)(kp + 4608);
    kf[6] = *(const LAS bf16x8*)(kp + 6144); kf[7] = *(const LAS bf16x8*)(kp + 6656);
}
__device__ __forceinline__ void kload2(bf16x8* kf, const LDSB* kp, int j) { kf[2 * j] = *(const LAS bf16x8*)(kp + j * 2048); kf[2 * j + 1] = *(const LAS bf16x8*)(kp + j * 2048 + 512); }

template <int MODE>
__device__ __forceinline__ void att_mod(f32x16& C0, f32x16& C1, int j, int qabs, int qw0, int cur, unsigned sel_lo, unsigned sel_hi, const LAS float* kbias, int hi) {
    if (MODE == 0) {
        const LAS float* kb = kbias + 64 * j + 4 * hi;
#pragma unroll
        for (int g4 = 0; g4 < 4; ++g4) { const f32x4 b0 = *(const LAS f32x4*)(kb + 8 * g4), b1 = *(const LAS f32x4*)(kb + 32 + 8 * g4);
#pragma unroll
            for (int i = 0; i < 4; ++i) { C0[4 * g4 + i] += b0[i]; C1[4 * g4 + i] += b1[i]; } }
        if (64 * j + 63 > qw0) {
#pragma unroll
            for (int r = 0; r < 16; ++r) { const int kv = 64 * j + crow(r, hi); if (kv > qabs) C0[r] = NEGM; if (kv + 32 > qabs) C1[r] = NEGM; }
        }
    } else if (MODE == 1) {
        const bool sel = ((j < 32 ? (sel_lo >> j) : (sel_hi >> (j - 32))) & 1u) != 0u;
        if (j == cur) {
#pragma unroll
            for (int r = 0; r < 16; ++r) { const int kv = 64 * j + crow(r, hi); if (kv > qabs || !sel) C0[r] = NEGM; if (kv + 32 > qabs || !sel) C1[r] = NEGM; }
        } else {
#pragma unroll
            for (int r = 0; r < 16; ++r) { if (!sel) { C0[r] = NEGM; C1[r] = NEGM; } }
        }
    } else {
        if (j == cur || j + 8 <= cur) {
#pragma unroll
            for (int r = 0; r < 16; ++r) { const int kv = 64 * j + crow(r, hi);
                if (kv > qabs || kv < qabs - 511) C0[r] = NEGM; if (kv + 32 > qabs || kv + 32 < qabs - 511) C1[r] = NEGM; }
        }
    }
}

template <int MODE, int PITCH, int THRL>
__device__ __forceinline__ void attn_fast(LDSB* lds, const bf16* Kh, const bf16* Vh, const LAS unsigned char* tl, int NT, const bf16x8 (&qr)[4], int qabs, int qw0, int cur,
                                          unsigned sel_lo, unsigned sel_hi, const LAS float* kbias, f32x16 (&o)[2], float& l_out, int wid, int lane) {
    const int r32 = lane & 31, hi = lane >> 5;
    const unsigned lds0 = (unsigned)(uintptr_t)lds;
    LAS float* wsf = (LAS float*)(lds + L_WS) + wid * 256;
    const bf16* ksrc = Kh + (size_t)lane * PITCH + wid * 8;
    const bf16* vsrc = Vh + (size_t)(16 * (wid & 3) + (lane >> 2)) * PITCH + (wid >> 2) * 32 + (lane & 3) * 8;
    const unsigned kdst = lds0 + L_K + wid * 1024, vdst = lds0 + L_V + wid * 1024;
#define TILE(t) __builtin_amdgcn_readfirstlane((int)tl[t])
#define DMA_K(t, slot) glds16(ksrc + (size_t)TILE(t) * (64 * PITCH), (unsigned)__builtin_amdgcn_readfirstlane(kdst + (slot)))
#define DMA_V(t, slot) glds16(vsrc + (size_t)TILE(t) * (64 * PITCH), (unsigned)__builtin_amdgcn_readfirstlane(vdst + (slot)))
    const LDSB* kp0 = lds + L_K + hi * 1024 + r32 * 16;
    const LDSB* vp0 = lds + L_V + ((lane >> 4) & 1) * 32 + (lane & 3) * 8 + (4 * hi + ((lane & 15) >> 2)) * 64;
    bf16x8 kf[8];
    float mhat = 0.f, l_reg = 0.f;
    f32x16 negm;
#pragma unroll
    for (int r = 0; r < 16; ++r) { negm[r] = 0.f; o[0][r] = 0.f; o[1][r] = 0.f; }
    asm volatile("" : "+v"(negm));
    bool resc = false;
    f32x16 pA0, pA1, pB0, pB1;
    int sl_prev = 0, sl_cur = 0, sl_next = SLOTB, sl_last = 0;
#define ROT() do { sl_prev = sl_cur; sl_cur = sl_next; sl_next = (sl_next == 2 * SLOTB) ? 0 : sl_next + SLOTB; } while (0)
#define RESC() do { if (resc) { LDS_WAIT(); \
        _Pragma("unroll") for (int d_ = 0; d_ < 2; ++d_) _Pragma("unroll") for (int r = 0; r < 16; ++r) o[d_][r] *= wsf[crow(r, hi)]; } } while (0)
#define ENDW(tt) do { if ((tt) + 3 < NT) { WAIT_BAR(2); } else if ((tt) + 2 < NT) { WAIT_BAR(1); } else { WAIT_BAR(0); } } while (0)
    DMA_K(0, 0); DMA_V(0, 0); if (NT > 1) DMA_K(1, SLOTB); if (NT > 2) DMA_K(2, 2 * SLOTB);
    if (NT > 2) { WAIT_BAR(3); } else if (NT > 1) { WAIT_BAR(2); } else { WAIT_BAR(1); }
    {
        const int j0 = TILE(0);
        qkt(pA0, pA1, lds + L_K, qr, negm, r32, hi);
        att_mod<MODE>(pA0, pA1, j0, qabs, qw0, cur, sel_lo, sel_hi, kbias, hi);
        const float rm = rowmax32(pA0, pA1);
        mhat += rm;
#pragma unroll
        for (int r = 0; r < 16; ++r) { pA0[r] -= rm; pA1[r] -= rm; negm[r] = -mhat; }
        asm volatile("" : "+v"(negm));
#pragma unroll
        for (int r = 0; r < 16; ++r) { pA0[r] = __builtin_amdgcn_exp2f(pA0[r]); pA1[r] = __builtin_amdgcn_exp2f(pA1[r]); }
    }
    WAIT_BAR(0);
    if (NT > 3) DMA_K(3, 0);
    if (NT > 1) DMA_V(1, SLOTB);
    ROT();
    if (NT > 1) kload8(kf, kp0 + sl_cur);
    ENDW(0);
    s16x4 vlo[8], vhi[8]; v4u pw0, pw1, pw2, pw3;
#define PKW(P, B) cvtpk_s(P[B], P[B + 1])
#define PAF(k) __builtin_bit_cast(bf16x8, pw##k)
#define VFR(i) (bf16x8){vlo[i][0], vlo[i][1], vlo[i][2], vlo[i][3], vhi[i][0], vhi[i][1], vhi[i][2], vhi[i][3]}
#define PIN(x) asm volatile("" : "+v"(x))
#define MX3(a, b, c) __builtin_fmaxf(__builtin_fmaxf((a), (b)), (c))
#define GAPA(MF, A0, A1, A2, A3, W0, W1, PW) do { MF; sacc += A0; sacc += A1; sacc += A2; sacc += A3; PIN(sacc); W0; W1; PIN(PW); SBAR(); } while (0)
#define EX(v) __builtin_amdgcn_exp2f(v)
#define GAPB(MF, X, B) do { MF; X[B] = EX(X[B]); X[B + 1] = EX(X[B + 1]); X[B + 2] = EX(X[B + 2]); X[B + 3] = EX(X[B + 3]); PIN(X); SBAR(); } while (0)
#define VRD(i) do { vlo[i] = vtr(vp_ + (((i) >> 2) * 4096 + ((i) & 3) * 1024)); vhi[i] = vtr(vp_ + (((i) >> 2) * 4096 + ((i) & 3) * 1024 + 512)); } while (0)
#define KRD(G, j) do { if (G) { kload2(kf, kp0 + sl_next, j); SBAR(); } } while (0)
#define MFMA32 __builtin_amdgcn_mfma_f32_32x32x16_bf16
#define STEP(C0, C1, P0, P1, t) do { const int jt_ = TILE(t); const bool GK_ = (t) + 3 < NT, GV_ = (t) + 1 < NT; sl_last = sl_cur; SBAR(); \
    const LDSB* vp_ = vp0 + sl_prev; \
    VRD(0); SBAR(); float sacc = (P0[0] + P0[1]); \
    GAPA(C0 = MFMA32(kf[0], qr[0], negm, 0, 0, 0), P0[2], P0[3], P0[4], P0[5],     pw0[0] = PKW(P0, 0), pw0[1] = PKW(P0, 2), pw0); \
    VRD(4); SBAR(); GAPA(C1 = MFMA32(kf[1], qr[0], negm, 0, 0, 0), P0[6], P0[7], P0[8], P0[9],     pw0[2] = PKW(P0, 4), pw0[3] = PKW(P0, 6), pw0); \
    VRD(1); SBAR(); GAPA(C0 = MFMA32(kf[2], qr[1], C0, 0, 0, 0),   P0[10], P0[11], P0[12], P0[13], pw1[0] = PKW(P0, 8), pw1[1] = PKW(P0, 10), pw1); \
    VRD(5); SBAR(); GAPA(C1 = MFMA32(kf[3], qr[1], C1, 0, 0, 0),   P0[14], P0[15], P1[0], P1[1],   pw1[2] = PKW(P0, 12), pw1[3] = PKW(P0, 14), pw1); \
    VRD(2); SBAR(); GAPA(C0 = MFMA32(kf[4], qr[2], C0, 0, 0, 0),   P1[2], P1[3], P1[4], P1[5],     pw2[0] = PKW(P1, 0), pw2[1] = PKW(P1, 2), pw2); \
    VRD(6); SBAR(); GAPA(C1 = MFMA32(kf[5], qr[2], C1, 0, 0, 0),   P1[6], P1[7], P1[8], P1[9],     pw2[2] = PKW(P1, 4), pw2[3] = PKW(P1, 6), pw2); \
    VRD(3); SBAR(); GAPA(C0 = MFMA32(kf[6], qr[3], C0, 0, 0, 0),   P1[10], P1[11], P1[12], P1[13], pw3[0] = PKW(P1, 8), pw3[1] = PKW(P1, 10), pw3); \
    VRD(7); SBAR(); GAPA(C1 = MFMA32(kf[7], qr[3], C1, 0, 0, 0),   P1[14], P1[15], 0.f, 0.f,       pw3[2] = PKW(P1, 12), pw3[3] = PKW(P1, 14), pw3); \
    l_reg += sacc; \
    if (GK_) { DMA_K((t) + 3, sl_cur); } if (GV_) { DMA_V((t) + 1, sl_next); } \
    att_mod<MODE>(C0, C1, jt_, qabs, qw0, cur, sel_lo, sel_hi, kbias, hi); \
    { float a = MX3(C0[0], C0[1], C1[0]), b = MX3(C0[2], C0[3], C1[1]); a = MX3(a, C1[2], C1[3]); \
      _Pragma("unroll") for (int r = 4; r < 16; r += 4) { a = MX3(a, C0[r], C0[r + 1]); b = MX3(b, C0[r + 2], C0[r + 3]); a = MX3(a, C1[r], C1[r + 1]); b = MX3(b, C1[r + 2], C1[r + 3]); } \
      float rm = xh_max(__builtin_fmaxf(a, b)); \
      resc = false; \
      if (__builtin_expect(__any(rm > (float)THRL), 0)) { const float dl = __builtin_fmaxf(rm, 0.f); mhat += dl; \
        _Pragma("unroll") for (int r = 0; r < 16; ++r) { C0[r] -= dl; C1[r] -= dl; } \
        _Pragma("unroll") for (int r = 0; r < 16; ++r) negm[r] = -mhat; asm volatile("" : "+v"(negm)); \
        const float f = __builtin_amdgcn_exp2f(-dl); l_reg *= f; if (hi == 0) wsf[r32] = f; resc = true; } } \
    SBAR(); \
    GAPB(o[0] = MFMA32(PAF(0), VFR(0), o[0], 0, 0, 0), C0, 0); \
    GAPB(o[1] = MFMA32(PAF(0), VFR(4), o[1], 0, 0, 0), C0, 4); \
    KRD(GV_, 0); GAPB(o[0] = MFMA32(PAF(1), VFR(1), o[0], 0, 0, 0), C0, 8); \
    KRD(GV_, 1); GAPB(o[1] = MFMA32(PAF(1), VFR(5), o[1], 0, 0, 0), C0, 12); \
    KRD(GV_, 2); GAPB(o[0] = MFMA32(PAF(2), VFR(2), o[0], 0, 0, 0), C1, 0); \
    KRD(GV_, 3); GAPB(o[1] = MFMA32(PAF(2), VFR(6), o[1], 0, 0, 0), C1, 4); \
    GAPB(o[0] = MFMA32(PAF(3), VFR(3), o[0], 0, 0, 0), C1, 8); \
    GAPB(o[1] = MFMA32(PAF(3), VFR(7), o[1], 0, 0, 0), C1, 12); \
    } while (0)
    int t = 1;
    for (; t + 1 < NT; t += 2) {
        STEP(pB0, pB1, pA0, pA1, t);     ENDW(t);     RESC(); ROT();
        STEP(pA0, pA1, pB0, pB1, t + 1); ENDW(t + 1); RESC(); ROT();
    }
    const LDSB* vlane_p = lds + L_V + ((lane >> 4) & 1) * 32 + (lane & 3) * 8 + (4 * hi + ((lane & 15) >> 2)) * 64;
    if (t < NT) {
        STEP(pB0, pB1, pA0, pA1, t); ENDW(t); RESC();
        l_reg += rowsum32(pB0, pB1);
        pv(o, vlane_p + sl_last, pB0, pB1);
    } else {
        l_reg += rowsum32(pA0, pA1);
        pv(o, vlane_p + sl_last, pA0, pA1);
    }
    l_out = xh_sum(l_reg);
    asm volatile("s_waitcnt lgkmcnt(0)\n\ts_barrier" ::: "memory");
#undef TILE
#undef DMA_K
#undef DMA_V
#undef ROT
#undef RESC
#undef ENDW
#undef PKW
#undef PAF
#undef VFR
#undef PIN
#undef MX3
#undef GAPA
#undef EX
#undef GAPB
#undef VRD
#undef KRD
#undef MFMA32
#undef STEP
}

__device__ __forceinline__ void load_rowvec(float (&fac)[16], const LAS float* tab, int hi) {
#pragma unroll
    for (int g4 = 0; g4 < 4; ++g4) { const f32x4 ff = *(const LAS f32x4*)(tab + 8 * g4 + 4 * hi);
#pragma unroll
        for (int i = 0; i < 4; ++i) fac[4 * g4 + i] = ff[i]; }
}

template <int PITCHO>
__device__ __forceinline__ void store_o_tile(LDSB* stage, const f32x16 (&o)[2], bf16* Ow, float* ssq, int lane) {
    const int r32 = lane & 31, hi = lane >> 5;
    LAS bf16* stg = (LAS bf16*)stage;
#pragma unroll
    for (int r = 0; r < 16; ++r) { const int orow = crow(r, hi);
#pragma unroll
        for (int d0 = 0; d0 < 2; ++d0) stg[orow * 64 + d0 * 32 + r32] = (bf16)f2bf(o[d0][r]); }
    LDS_WAIT();
#pragma unroll
    for (int i = 0; i < 4; ++i) { const int row = i * 8 + (lane >> 3), ch = lane & 7; const v4u v = *(const LAS v4u*)(stg + row * 64 + ch * 8); *(v4u*)(Ow + (size_t)row * PITCHO + ch * 8) = v;
        const unsigned w[4] = {v.x, v.y, v.z, v.w}; float sq = 0.f;
#pragma unroll
        for (int k = 0; k < 4; ++k) { const float a = __builtin_bit_cast(float, w[k] << 16), b = __builtin_bit_cast(float, w[k] & 0xffff0000u); sq += a * a + b * b; }
        sq += __builtin_bit_cast(float, __builtin_amdgcn_update_dpp(0, __builtin_bit_cast(int, sq), 0xB1, 0xF, 0xF, true));
        sq += __builtin_bit_cast(float, __builtin_amdgcn_update_dpp(0, __builtin_bit_cast(int, sq), 0x4E, 0xF, 0xF, true));
        sq += __builtin_bit_cast(float, __builtin_amdgcn_update_dpp(0, __builtin_bit_cast(int, sq), 0x141, 0xF, 0xF, true));
        if (ch == 0) ssq[(size_t)row * 16] = sq; }
    LDS_WAIT();
}

__device__ __forceinline__ void fox_unit(Frame& F0, int b, int h, int qb) {
    struct { unsigned char* ws; LDSB* lds; int tid, wave; } F; F.ws = F0.ws; F.lds = F0.lds; F.tid = F0.tid; F.wave = F0.wave;
    asm volatile("" : "+s"(F.ws));
    LDSB* lds = F.lds; int tid_ = F.tid; asm volatile("" : "+v"(tid_));
    const int tid = tid_, lane = tid & 63, wid = F.wave, r32 = lane & 31, hi = lane >> 5;
    const int q0 = 256 * qb, NT = 4 * qb + 4;
    const float* cb = (const float*)(F.ws + WS_CB) + (size_t)(b * 8 + h) * SEQ;
    LAS float* kb = (LAS float*)(lds + L_ACC);
    for (int i = tid; i < q0 + 256; i += NTHR) kb[i] = cb[i];
    LAS unsigned char* tl = (LAS unsigned char*)(lds + L_TL);
    if (tid < NT) tl[tid] = (unsigned char)(NT - 1 - tid);
    const bf16* Qw = (const bf16*)(F.ws + WS_QF) + ((size_t)b * SEQ + q0 + 32 * wid) * 512 + h * 64;
    bf16x8 qr[4];
#pragma unroll
    for (int d0 = 0; d0 < 4; ++d0) qr[d0] = *(const bf16x8*)(Qw + (size_t)r32 * 512 + d0 * 16 + hi * 8);
    __syncthreads();
    const bf16* Kh = (const bf16*)(F.ws + WS_KF) + (size_t)b * SEQ * 512 + h * 64;
    const bf16* Vh = (const bf16*)(F.ws + WS_VF) + (size_t)b * SEQ * 512 + h * 64;
    f32x16 o[2]; float l;
    attn_fast<0, 512, 8>(lds, Kh, Vh, tl, NT, qr, q0 + 32 * wid + r32, q0 + 32 * wid, 0, 0u, 0u, kb, o, l, wid, lane);
    LAS float* wsf = (LAS float*)(lds + L_WS) + wid * 256;
    if (hi == 0) wsf[32 + r32] = 1.f / l;
    LDS_WAIT();
    float fac[16]; load_rowvec(fac, wsf + 32, hi);
#pragma unroll
    for (int r = 0; r < 16; ++r) { o[0][r] *= fac[r]; o[1][r] *= fac[r]; }
    bf16* Ow = (bf16*)(F.ws + WS_Y) + ((size_t)b * SEQ + q0 + 32 * wid) * 1024 + h * 64;
    store_o_tile<1024>(lds + L_ACC + 16384 + wid * 4096, o, Ow, (float*)(F.ws + WS_SSQY) + ((size_t)b * SEQ + q0 + 32 * wid) * 16 + h, lane);
    __syncthreads();
}

__device__ __forceinline__ void nsa_unit(Frame& F0, int b, int g, int cur) {
    struct { unsigned char* ws; LDSB* lds; int tid, wave; } F; F.ws = F0.ws; F.lds = F0.lds; F.tid = F0.tid; F.wave = F0.wave;
    asm volatile("" : "+s"(F.ws));
    LDSB* lds = F.lds; int tid_ = F.tid; asm volatile("" : "+v"(tid_));
    const int tid = tid_, lane = tid & 63, wid = F.wave, r32 = lane & 31, hi = lane >> 5;
    const int bg = b * 2 + g, hh = wid >> 1, head = 4 * g + hh, qh = wid & 1, qq = 32 * qh + r32, qpos = 64 * cur + qq;
    const unsigned lds0 = (unsigned)(uintptr_t)lds;
    LAS float* wsf = (LAS float*)(lds + L_WS) + wid * 256;
    LAS float* accw = (LAS float*)(lds + L_ACC) + wid * 2048;
    const size_t row0 = (size_t)b * SEQ + 64 * cur + 32 * qh;
    const bf16* Qw = (const bf16*)(F.ws + WS_QN) + row0 * 512 + head * 64;
    bf16x8 qr[4];
#pragma unroll
    for (int d0 = 0; d0 < 4; ++d0) qr[d0] = *(const bf16x8*)(Qw + (size_t)r32 * 512 + d0 * 16 + hi * 8);
    if (tid < 2) ((LAS unsigned*)(lds + L_TL + 128))[tid] = 0u;
    if (lane < 32) { const float* gp = (const float*)(F.ws + WS_GATE) + (row0 + lane) * 24 + head * 3;
        wsf[64 + lane] = gp[0]; wsf[96 + lane] = gp[1]; wsf[128 + lane] = gp[2]; }
    LDS_WAIT();
    {
        const bf16* Kc = (const bf16*)(F.ws + WS_KCMP) + (size_t)bg * 256 * 64;
        const bf16* Vc = (const bf16*)(F.ws + WS_VCMP) + (size_t)bg * 256 * 64;
        const int ntl = (4 * cur + 66) >> 6;
#pragma unroll
        for (int tl = 0; tl < 4; ++tl) if (tl < ntl) dma_kv<64>(Kc, Vc, 64 * tl, lds0 + L_K + tl * SLOTB, lds0 + L_V + tl * SLOTB, wid, lane);
        WAIT_BAR(0);
        f32x16 zero;
#pragma unroll
        for (int r = 0; r < 16; ++r) zero[r] = 0.f;
        float mrun = -1e30f;
#pragma unroll 1
        for (int tl = 0; tl < ntl; ++tl) {
            f32x16 p0, p1;
            qkt(p0, p1, lds + L_K + tl * SLOTB, qr, zero, r32, hi);
#pragma unroll
            for (int r = 0; r < 16; ++r) { const int c = 64 * tl + crow(r, hi); if (16 * c + 31 > qpos) p0[r] = NEGM; if (16 * (c + 32) + 31 > qpos) p1[r] = NEGM; }
            mrun = fmaxf(mrun, rowmax32(p0, p1));
            asm volatile("" ::: "memory");
        }
        f32x16 o[2];
#pragma unroll
        for (int r = 0; r < 16; ++r) { o[0][r] = 0.f; o[1][r] = 0.f; }
        float impv[4][8]; float prevY3 = 0.f, lsum = 0.f;
        const int vlane = ((lane >> 4) & 1) * 32 + (lane & 3) * 8 + (4 * hi + ((lane & 15) >> 2)) * 64;
#pragma unroll
        for (int tl = 0; tl < 4; ++tl) {
            if (tl < ntl) {
                f32x16 p0, p1;
                qkt(p0, p1, lds + L_K + tl * SLOTB, qr, zero, r32, hi);
#pragma unroll
                for (int r = 0; r < 16; ++r) { const int c = 64 * tl + crow(r, hi);
                    p0[r] = (16 * c + 31 > qpos) ? 0.f : __builtin_amdgcn_exp2f(p0[r] - mrun);
                    p1[r] = (16 * (c + 32) + 31 > qpos) ? 0.f : __builtin_amdgcn_exp2f(p1[r] - mrun); }
                lsum += rowsum32(p0, p1);
                float rX[4], rY[4];
#pragma unroll
                for (int g4 = 0; g4 < 4; ++g4) { rX[g4] = xh_other(p0[4 * g4 + 3], hi); rY[g4] = xh_other(p1[4 * g4 + 3], hi); }
#pragma unroll
                for (int g4 = 0; g4 < 4; ++g4) {
                    const float qs0 = (p0[4 * g4] + p0[4 * g4 + 1]) + (p0[4 * g4 + 2] + p0[4 * g4 + 3]);
                    const float qs1 = (p1[4 * g4] + p1[4 * g4 + 1]) + (p1[4 * g4 + 2] + p1[4 * g4 + 3]);
                    const float lo0 = (g4 > 0) ? rX[g4 > 0 ? g4 - 1 : 0] : prevY3;
                    const float lo1 = (g4 > 0) ? rY[g4 > 0 ? g4 - 1 : 0] : rX[3];
                    impv[tl][g4] = qs0 + (hi ? rX[g4] : lo0);
                    impv[tl][4 + g4] = qs1 + (hi ? rY[g4] : lo1);
                }
                prevY3 = rY[3];
                pv(o, lds + L_V + tl * SLOTB + vlane, p0, p1);
                asm volatile("" ::: "memory");
            } else {
#pragma unroll
                for (int e = 0; e < 8; ++e) impv[tl][e] = 0.f;
            }
        }
        const float ltot = xh_sum(lsum);
        const float invl = ltot > 0.f ? 1.f / ltot : 0.f;
        LAS float* imp = (LAS float*)(lds + L_IMP);
#pragma unroll
        for (int hd = 0; hd < 4; ++hd) {
            if (hh == hd) {
#pragma unroll
                for (int tl = 0; tl < 4; ++tl)
#pragma unroll
                    for (int e = 0; e < 8; ++e) { const int jj = 16 * tl + 8 * (e >> 2) + 2 * (e & 3) + hi; LAS float* p = imp + qq * 65 + jj;
                        if (hd == 0) *p = impv[tl][e] * invl; else *p += impv[tl][e] * invl; }
            }
            LDS_WAIT(); __syncthreads();
        }
        if (hi == 0) wsf[32 + r32] = invl;
        LDS_WAIT();
        float gc[16], il[16]; load_rowvec(gc, wsf + 64, hi); load_rowvec(il, wsf + 32, hi);
#pragma unroll
        for (int d0 = 0; d0 < 2; ++d0)
#pragma unroll
            for (int r = 0; r < 16; ++r) accw[(d0 * 16 + r) * 64 + lane] = o[d0][r] * (gc[r] * il[r]);
        LDS_WAIT();
    }
    if (cur >= 16) {
        LAS float* imp = (LAS float*)(lds + L_IMP);
        const int q = tid >> 3, part = tid & 7;
        if (part == 0) { imp[q * 65] += 1e4f; imp[q * 65 + cur] += 1e4f; imp[q * 65 + cur - 1] += 1e4f; }
        LDS_WAIT(); __syncthreads();
        const LAS float* irow = imp + q * 65;
        float sc[8];
#pragma unroll
        for (int i = 0; i < 8; ++i) { const int jj = part * 8 + i; sc[i] = (jj <= cur) ? irow[jj] : -1.f; }
        int rank[8];
#pragma unroll
        for (int i = 0; i < 8; ++i) rank[i] = 0;
        const int nv = cur + 1, e0 = (8 * part < nv) ? 8 * part : nv, e1 = (8 * part + 8 < nv) ? 8 * part + 8 : nv;
        for (int jp = 0; jp < e0; ++jp) { const float v = irow[jp];
#pragma unroll
            for (int i = 0; i < 8; ++i) rank[i] += (v >= sc[i]) ? 1 : 0; }
        for (int jp = e0; jp < e1; ++jp) { const float v = irow[jp];
#pragma unroll
            for (int i = 0; i < 8; ++i) { const int jj = part * 8 + i; rank[i] += (v > sc[i] || (v == sc[i] && jp < jj)) ? 1 : 0; } }
        for (int jp = e1; jp < nv; ++jp) { const float v = irow[jp];
#pragma unroll
            for (int i = 0; i < 8; ++i) rank[i] += (v > sc[i]) ? 1 : 0; }
        unsigned bits = 0;
#pragma unroll
        for (int i = 0; i < 8; ++i) bits |= (rank[i] < 16 ? 1u : 0u) << i;
        ((LAS unsigned char*)(lds + L_SEL))[q * 8 + part] = (unsigned char)bits;
        __hip_atomic_fetch_or((LAS unsigned*)(lds + L_TL + 128) + (part >> 2), bits << (8 * (part & 3)), __ATOMIC_RELAXED, __HIP_MEMORY_SCOPE_WORKGROUP);
        LDS_WAIT(); __syncthreads();
    } else {
        if (tid < 128) ((LAS unsigned*)(lds + L_SEL))[tid] = (tid & 1) ? 0u : ((1u << (cur + 1)) - 1u);
        if (tid == 0) ((LAS unsigned*)(lds + L_TL + 128))[0] = (1u << (cur + 1)) - 1u;
        LDS_WAIT(); __syncthreads();
    }
    const LAS unsigned* selw = (const LAS unsigned*)(lds + L_SEL);
    const unsigned sel_lo = selw[qq * 2], sel_hi = selw[qq * 2 + 1];
    const unsigned ulo = ((const LAS unsigned*)(lds + L_TL + 128))[0], uhi = ((const LAS unsigned*)(lds + L_TL + 128))[1];
    unsigned long long umask = ((unsigned long long)uhi << 32) | ulo;
    umask &= (cur >= 63) ? ~0ull : ((1ull << (cur + 1)) - 1ull);
    const int jlo = cur >= 8 ? cur - 8 : 0;
    LAS unsigned char* tls = (LAS unsigned char*)(lds + L_TL);
    LAS unsigned char* tlw = tls + 64;
    if (tid < 64) {
        if ((umask >> tid) & 1ull) tls[__builtin_popcountll(umask & ((1ull << tid) - 1ull))] = (unsigned char)tid;
        if (tid <= cur - jlo) tlw[tid] = (unsigned char)(jlo + tid);
    }
    LDS_WAIT(); __syncthreads();
    const int NTs = __builtin_amdgcn_readfirstlane(__builtin_popcountll(umask)), NTw = cur - jlo + 1;
    {
        const bf16* Kh = (const bf16*)(F.ws + WS_KS) + (size_t)bg * SEQ * 64;
        const bf16* Vh = (const bf16*)(F.ws + WS_VS) + (size_t)bg * SEQ * 64;
        f32x16 o[2]; float l;
        attn_fast<1, 64, 8>(lds, Kh, Vh, tls, NTs, qr, qpos, 0, cur, sel_lo, sel_hi, nullptr, o, l, wid, lane);
        if (hi == 0) wsf[32 + r32] = 1.f / l;
        LDS_WAIT();
        float fl[16], gs[16]; load_rowvec(fl, wsf + 32, hi); load_rowvec(gs, wsf + 96, hi);
#pragma unroll
        for (int d0 = 0; d0 < 2; ++d0)
#pragma unroll
            for (int r = 0; r < 16; ++r) accw[(d0 * 16 + r) * 64 + lane] += o[d0][r] * (fl[r] * gs[r]);
        LDS_WAIT();
    }
    {
        const bf16* Kh = (const bf16*)(F.ws + WS_KW) + (size_t)bg * SEQ * 64;
        const bf16* Vh = (const bf16*)(F.ws + WS_VW) + (size_t)bg * SEQ * 64;
        f32x16 o[2]; float l;
        attn_fast<2, 64, 8>(lds, Kh, Vh, tlw, NTw, qr, qpos, 0, cur, 0u, 0u, nullptr, o, l, wid, lane);
        if (hi == 0) wsf[32 + r32] = 1.f / l;
        LDS_WAIT();
        float fl[16], gate_win[16]; load_rowvec(fl, wsf + 32, hi); load_rowvec(gate_win, wsf + 128, hi);
#pragma unroll
        for (int d0 = 0; d0 < 2; ++d0)
#pragma unroll
            for (int r = 0; r < 16; ++r) o[d0][r] = accw[(d0 * 16 + r) * 64 + lane] + o[d0][r] * (fl[r] * gate_win[r]);
        LDS_WAIT();
        bf16* Ow = (bf16*)(F.ws + WS_Y) + row0 * 1024 + 512 + head * 64;
        store_o_tile<1024>((LDSB*)accw, o, Ow, (float*)(F.ws + WS_SSQY) + row0 * 16 + 8 + head, lane);
    }
    __syncthreads();
}

__device__ __forceinline__ void dep_publish(Frame& F, gu32* w0, gu32* w1) {
    asm volatile("s_waitcnt vmcnt(0)" ::: "memory"); __syncthreads();
    if (F.tid == 0) { __builtin_amdgcn_fence(__ATOMIC_RELEASE, "agent"); asm volatile("s_waitcnt vmcnt(0)" ::: "memory");
        __hip_atomic_fetch_add(w0, 1u, RLX_AGENT); if (w1) __hip_atomic_fetch_add(w1, 1u, RLX_AGENT); }
}
__device__ __forceinline__ void dep_wait(Frame& F, gu32* w, unsigned need, gu32* wall, unsigned needall, int flagword) {
    if (F.wave == 0) {
        unsigned sp = 0;
        while ((unsigned)__builtin_amdgcn_readfirstlane((int)__hip_atomic_load(w, RLX_AGENT)) < need) { __builtin_amdgcn_s_sleep(4); if (++sp > (1u << 22)) break; }
        const unsigned tot = wall ? (unsigned)__builtin_amdgcn_readfirstlane((int)__hip_atomic_load(wall, RLX_AGENT)) : 0u;
        __builtin_amdgcn_fence(__ATOMIC_ACQUIRE, "agent");
        asm volatile("s_waitcnt vmcnt(0)" ::: "memory");
        if (F.lane == 0 && (!wall || tot >= needall)) F.MISC[flagword] = 1u;
    }
    LDS_WAIT(); __syncthreads();
}

constexpr int NSA_COST0 = 24;
__device__ __forceinline__ void p3_attention(Frame& F, kptr_t kp) {
    LAS unsigned short* order = (LAS unsigned short*)(F.lds + L_ORD);
    for (int id = F.tid; id < 2048; id += NTHR) {
        int pos;
        if (id >= 1024 && ((id - 1024) >> 6) < 2) pos = id - 1024;
        else {
            const int c = id < 1024 ? (63 - (id >> 4)) + NSA_COST0 : 4 * (15 - ((id - 1024) >> 6)) + 4;
            pos = 128;
            { int lo = c - NSA_COST0 + 1; if (lo < 0) lo = 0; int cnt = 64 - lo; if (cnt < 0) cnt = 0; pos += 16 * cnt; }
            { int cnt = 0; for (int qb = 0; qb < 14; ++qb) cnt += (4 * qb + 4 > c) ? 1 : 0; pos += 64 * cnt; }
            if (id < 1024) pos += (id & 15);
            else { const int cn = c - NSA_COST0; if (cn >= 0 && cn <= 63) pos += 16; pos += (id & 63); }
        }
        order[pos] = (unsigned short)id;
    }
    if (F.vcu < 8) { p2_cumsum_item(F, F.vcu * NWAVES + F.wave); dep_publish(F, F.ctl + CW_CS, nullptr); }
    LDS_WAIT(); __syncthreads();
    if (F.vcu >= F.G - 128 || F.G < 136) {
        for (int it = (F.G < 136) ? F.vcu : F.vcu - (F.G - 128); it < 128; it += (F.G < 136) ? F.G : 128) {
            p2_compress_item(F, kp, it);
            dep_publish(F, F.ctl + CW_CMP + 64 * ((it >> 2) & 15), F.ctl + CW_CMPT);
        }
    }
    gu32* qhead = F.ctl + CW_Q_ATT;
    for (;;) {
        if (F.tid == 0) F.MISC[0] = __hip_atomic_fetch_add(qhead, 1u, RLX_AGENT);
        LDS_WAIT(); __syncthreads();
        const unsigned k = F.MISC[0];
        if (k >= 2048u) break;
        const int id = (int)order[k];
        __syncthreads();
        if (id < 1024) {
            if (F.MISC[17] == 0u) dep_wait(F, F.ctl + CW_CMP + 64 * (id & 15), 8u, F.ctl + CW_CMPT, 128u, 17);
            nsa_unit(F, (id & 15) >> 1, id & 1, 63 - (id >> 4));
        } else {
            if (F.MISC[16] == 0u) dep_wait(F, F.ctl + CW_CS, 8u, nullptr, 0u, 16);
            fox_unit(F, (id & 63) >> 3, id & 7, 15 - ((id - 1024) >> 6));
        }
    }
}

__device__ __forceinline__ void p4_ynorm(Frame& F) {
    const int gw = F.vcu * NWAVES + F.wave, NGW = F.G * NWAVES;
    for (int m = gw; m < T; m += NGW) {
        bf16* row = (bf16*)(F.ws + WS_Y) + (size_t)m * 1024 + F.lane * 16;
        v4u a = *(const v4u*)row, b = *(const v4u*)(row + 8);
        float v[16];
        const unsigned w[8] = {a.x, a.y, a.z, a.w, b.x, b.y, b.z, b.w};
#pragma unroll
        for (int i = 0; i < 8; ++i) { v[2 * i] = __builtin_bit_cast(float, w[i] << 16); v[2 * i + 1] = __builtin_bit_cast(float, w[i] & 0xffff0000u); }
        float s = 0.f;
#pragma unroll
        for (int i = 0; i < 16; ++i) s += v[i] * v[i];
#pragma unroll
        for (int o = 1; o < 32; o <<= 1) s += __shfl_xor(s, o);
        const float r = 1.f / sqrtf(s * (1.f / 512.f) + EPS);
        v4u oa, ob;
        oa.x = pk2(v[0] * r, v[1] * r); oa.y = pk2(v[2] * r, v[3] * r); oa.z = pk2(v[4] * r, v[5] * r); oa.w = pk2(v[6] * r, v[7] * r);
        ob.x = pk2(v[8] * r, v[9] * r); ob.y = pk2(v[10] * r, v[11] * r); ob.z = pk2(v[12] * r, v[13] * r); ob.w = pk2(v[14] * r, v[15] * r);
        *(v4u*)row = oa; *(v4u*)(row + 8) = ob;
    }
}
__device__ __forceinline__ void p6_hnorm(Frame& F, const float* h1) {
    const int gw = F.vcu * NWAVES + F.wave, NGW = F.G * NWAVES;
    for (int m = gw; m < T; m += NGW) rms_row_to_bf16(F.lane, h1 + (size_t)m * DM, (bf16*)(F.ws + WS_XN) + (size_t)m * DM);
}
__device__ __forceinline__ void p9_final(Frame& F, float* out, const float* g_final) {
    const int gw = F.vcu * NWAVES + F.wave, NGW = F.G * NWAVES;
    for (int m = gw; m < T; m += NGW) {
        GAS f32x4* xr = (GAS f32x4*)(out + (size_t)m * DM) + F.lane;
        f32x4 v[4]; float s = 0.f;
#pragma unroll
        for (int j = 0; j < 4; ++j) { v[j] = xr[64 * j]; s += (v[j].x * v[j].x + v[j].y * v[j].y) + (v[j].z * v[j].z + v[j].w * v[j].w); }
        const float r = 1.f / sqrtf(wave_sum(s) * (1.f / DM) + EPS);
#pragma unroll
        for (int j = 0; j < 4; ++j) { const f32x4 gg = *((const f32x4*)g_final + F.lane + 64 * j); xr[64 * j] = v[j] * r * gg; }
    }
}

constexpr int N_PHASES = 10;
__global__ void __launch_bounds__(NTHR, 2) hymba_fwd(Args args) {
    extern __shared__ __attribute__((aligned(16))) unsigned char lds_raw[];
    Frame F;
    F.lds = (LDSB*)lds_raw;
    F.MISC = (volatile LAS unsigned*)(F.lds + L_MISC);
    F.tid = threadIdx.x; F.lane = F.tid & 63; F.wave = __builtin_amdgcn_readfirstlane(F.tid >> 6);
    F.G = gridDim.x; { const int bx = blockIdx.x; F.vcu = (F.G % 8 == 0) ? (bx % 8) * (F.G / 8) + bx / 8 : bx; }
    kptr_t kp0 = (kptr_t)__builtin_amdgcn_kernarg_segment_ptr();
#define KP() ({ kptr_t k_ = kp0; asm volatile("" : "+s"(k_)); k_; })
    { kptr_t kp = KP(); F.ws = *(unsigned char* const __attribute__((address_space(4)))*)(kp + 8 * 23); }
    F.ctl = (gu32*)(F.ws + WS_CTL);
    if (F.tid < 64) F.MISC[F.tid] = 0u;
    __syncthreads();
    int lo, hi; { kptr_t kp = KP(); lo = *(const int __attribute__((address_space(4)))*)(kp + 192); hi = *(const int __attribute__((address_space(4)))*)(kp + 196); }
    const bool one_launch = (hi - lo) > 1;
    XcdBarrier bar; bar.bar = (unsigned*)(F.ctl + CW_BAR); bar.x = 0; bar.st = nullptr; bar.wave = F.wave;
    if (one_launch) { bar = xcd_barrier_post((unsigned*)(F.ctl + CW_BAR), F.MISC + 8); bar.wave = F.wave; }
#ifdef PHASE_MASK
#define IN(k) (((PHASE_MASK >> (k)) & 1) && lo <= (k) && (k) < hi)
#else
#define IN(k) (lo <= (k) && (k) < hi)
#endif
#define SEAM(k) do { if (IN(k) && IN((k) + 1)) xcd_barrier(bar); } while (0)
#define RELANE() do { F.lane = lane_id(); F.tid = F.wave * 64 + F.lane; } while (0)

    if (IN(0)) { RELANE(); p0_prologue(F, KP()); SEAM(0); }

    if (IN(1)) { RELANE();
        pg8::Gemm g{(const bf16*)(F.ws + WS_XN), (const bf16*)(F.ws + WS_WIN), T, NPROJ, DM}; pg8::StaticOrder S; S.init(T, NPROJ, F.G, (int)blockIdx.x);
        kptr_t kp = KP(); EpiProj E{F.ws, AIN(kp, 3), AIN(kp, 4)};
        pg8::gemm_phase<EpiProj, pg8::StaticOrder, true, true>(F.lds, g, S, E, F.wave);
        if (IN(1) && IN(3)) xcd_barrier(bar);
    }

    if (IN(3)) { RELANE(); p3_attention(F, KP()); if (IN(3) && IN(5)) xcd_barrier(bar); }


    if (IN(5)) { RELANE();
        pg8::Gemm g{(const bf16*)(F.ws + WS_Y), (const bf16*)(F.ws + WS_WOUT), T, DM, DM}; pg8::StaticOrder S; S.init(T, DM, F.G, (int)blockIdx.x);
        pg8::Unit u0, u1; const bool hv0 = S.next(0, u0), hv1 = S.next(1, u1);
        {
            const int i = F.tid >> 8, rl = F.tid & 255; const bool hv = i ? hv1 : hv0; const int pm = i ? u1.pm : u0.pm;
            if (hv) { const f32x4* sp = (const f32x4*)((const float*)(F.ws + WS_SSQY) + (size_t)(pm * 256 + rl) * 16); const f32x4 a = sp[0], b = sp[1], c = sp[2], d = sp[3];
                const float rf = 1.f / sqrtf((((a[0] + a[1]) + (a[2] + a[3])) + ((b[0] + b[1]) + (b[2] + b[3]))) * (1.f / 512.f) + EPS);
                const float rn = 1.f / sqrtf((((c[0] + c[1]) + (c[2] + c[3])) + ((d[0] + d[1]) + (d[2] + d[3]))) * (1.f / 512.f) + EPS);
                LAS float* tab = (LAS float*)(F.lds + L_IMP + 8192) + F.tid * 2; tab[0] = rf / rn; tab[1] = rn; }
            LDS_WAIT(); __syncthreads();
        }
        kptr_t kp = KP(); EpiOutRes E{AIN(kp, 0), *(float* const __attribute__((address_space(4)))*)(kp + 8 * 22), (bf16*)(F.ws + WS_XN), (float*)(F.ws + WS_SSQ1), F.lds, u0.pm};
        pg8::gemm_phase<EpiOutRes, pg8::StaticOrder, true, true>(F.lds, g, S, E, F.wave);
        if (IN(5) && IN(7)) xcd_barrier(bar);
    }


    if (IN(7)) { RELANE();
        pg8::Gemm g{(const bf16*)(F.ws + WS_XN), (const bf16*)(F.ws + WS_WUP), T, FF, DM}; pg8::StaticOrder S; S.init(T, FF, F.G, (int)blockIdx.x);
        EpiUp E{(bf16*)(F.ws + WS_U), (const float*)(F.ws + WS_SSQ1)};
        pg8::gemm_phase<EpiUp, pg8::StaticOrder, true, true>(F.lds, g, S, E, F.wave);
        SEAM(7);
    }

    if (IN(8)) { RELANE();
        pg8::Gemm g{(const bf16*)(F.ws + WS_U), (const bf16*)(F.ws + WS_WDN), T, DM, FF}; pg8::StaticOrder S; S.init(T, DM, F.G, (int)blockIdx.x);
        kptr_t kp = KP(); EpiDownNorm E{*(float* const __attribute__((address_space(4)))*)(kp + 8 * 22), AIN(kp, 21), (float*)(F.ws + WS_XS), F.ctl + CW_PANEL, F.lds};
        pg8::gemm_phase<EpiDownNorm, pg8::StaticOrder, true, true>(F.lds, g, S, E, F.wave);
    }

#undef IN
#undef SEAM
}

extern "C" void kernel_launch(void* const* d_in, const int* in_sizes, int n_in, void* d_out, int out_size, void* d_ws, size_t ws_size, hipStream_t stream) {
    static int grid = 0;
    if (grid == 0) {
        if (n_in != 22 || out_size != T * DM || ws_size < WS_END) { fprintf(stderr, "kernel_launch: unexpected shapes (n_in %d out %d ws %zu)\n", n_in, out_size, ws_size); grid = -1; return; }
        int dev = 0, cus = 0, per_cu = 0;
        if (hipGetDevice(&dev) != hipSuccess || hipDeviceGetAttribute(&cus, hipDeviceAttributeMultiprocessorCount, dev) != hipSuccess) { grid = -1; return; }
        if (hipFuncSetAttribute((const void*)hymba_fwd, hipFuncAttributeMaxDynamicSharedMemorySize, LDS_BYTES) != hipSuccess) { fprintf(stderr, "kernel_launch: hipFuncSetAttribute failed\n"); grid = -1; return; }
        if (hipOccupancyMaxActiveBlocksPerMultiprocessor(&per_cu, (const void*)hymba_fwd, NTHR, LDS_BYTES) != hipSuccess || per_cu < 1) { fprintf(stderr, "kernel_launch: occupancy query says %d\n", per_cu); per_cu = 1; }
        (void)hipGetLastError();
        grid = cus;
    }
    if (grid < 0) return;
    (void)hipMemsetAsync((char*)d_ws + WS_CTL, 0, CTL_ZERO_BYTES, stream);
    Args a{};
    for (int i = 0; i < 22; ++i) a.in[i] = (const float*)d_in[i];
    a.out = (float*)d_out; a.ws = (unsigned char*)d_ws;
#if MK_N_LAUNCHES == 1
    a.ph_lo = 0; a.ph_hi = N_PHASES;
    void* kargs[] = {&a};
    hipError_t e = hipLaunchCooperativeKernel((const void*)hymba_fwd, dim3(grid), dim3(NTHR), kargs, LDS_BYTES, stream);
    if (e != hipSuccess) fprintf(stderr, "kernel_launch: cooperative launch failed: %s (grid %d)\n", hipGetErrorString(e), grid);
#else
    for (int p = 0; p < N_PHASES; ++p) { a.ph_lo = p; a.ph_hi = p + 1; hipLaunchKernelGGL(hymba_fwd, dim3(grid), dim3(NTHR), LDS_BYTES, stream, a); }
#endif
}
```

```cpp
#include <hip/hip_runtime.h>
#include <hip/hip_bf16.h>
#include <cstdio>
#include <cstdint>

#ifndef MK_N_LAUNCHES
#define MK_N_LAUNCHES 1
#endif

__device__ __forceinline__ int lane_id() { return (int)__builtin_amdgcn_mbcnt_hi(~0u, __builtin_amdgcn_mbcnt_lo(~0u, 0u)); }
namespace pg8 {
#define PG8_LAS __attribute__((address_space(3)))
typedef unsigned short bf16_t;
typedef short bf16x8 __attribute__((ext_vector_type(8)));
typedef float f32x4 __attribute__((ext_vector_type(4)));
typedef unsigned u32x4 __attribute__((ext_vector_type(4)));
constexpr int BM = 256, BK = 64, HALF = 128, HTB = HALF * BK * 2, STAGE_BYTES = 8 * HTB, NXCD = 8, WGM = 8;

__host__ __device__ __forceinline__ int lds_byte(int r, int c) { const int st = (r >> 4) * 2 + (c >> 5), rr = r & 15, cc = c & 31, ob = rr * 64 + cc * 2; return st * 1024 + (ob ^ (((ob >> 9) & 1) << 5)); }
__host__ __device__ __forceinline__ void stage_rc(int b, int& R, int& C) { const int st = b / 1024, sb = b % 1024, swz = sb ^ (((sb >> 9) & 1) << 5); R = (st >> 1) * 16 + swz / 64; C = (st & 1) * 32 + (swz % 64) / 2; }
__host__ __device__ __forceinline__ int perm32(int rho) { const int n = rho >> 4, i = rho & 15; return 8 * (i >> 2) + 4 * n + (i & 3); }

struct Unit { int pm, pn; };
struct Gemm { const bf16_t* A; const bf16_t* Bt; int M, N, K; };

struct StaticOrder {
    int nM, nN, nwg, G, c;
    __host__ __device__ void init(int M, int N, int G_, int c_) { nM = M / BM; nN = N / BM; nwg = nM * nN; G = G_; c = c_; }
    __host__ __device__ bool next(int i, Unit& u) const {
        const long L = (long)i * G + c; if (L >= nwg) return false;
        int wgid = (int)L; { const int q = nwg / NXCD, r = nwg % NXCD, xcd = wgid % NXCD, off = wgid / NXCD; wgid = (xcd < r ? xcd * (q + 1) : r * (q + 1) + (xcd - r) * q) + off; }
        const int nig = WGM * nN, gid = wgid / nig, fm = gid * WGM, gsz = (nM - fm) < WGM ? (nM - fm) : WGM;
        u.pm = fm + ((wgid % nig) % gsz); u.pn = (wgid % nig) / gsz; return true;
    }
    __device__ __forceinline__ void a_ready(const Unit&) const {}
    __device__ __forceinline__ void done(const Unit&) const {}
};

__device__ __forceinline__ unsigned cvt_pk_bf16(float lo, float hi) { unsigned r; asm volatile("v_cvt_pk_bf16_f32 %0, %1, %2" : "=v"(r) : "v"(lo), "v"(hi)); return r; }

template <class Epi, class Sched, bool ALIGN_EPI = false, bool SP2 = false>
__device__ __forceinline__ void gemm_phase(PG8_LAS unsigned char* lds, const Gemm g, const Sched& S, const Epi& E, int wave_id) {
    const int wid = wave_id, lane = lane_id(), tid = wid * 64 + lane, wr = wid >> 2, wc = wid & 3, fr = lane & 15, fq = lane >> 4;
    const int K = g.K, nt = K / BK;
    unsigned voffA[2], voffB[2];
#pragma unroll
    for (int i = 0; i < 2; ++i) { int R, C; stage_rc(tid * 16 + i * 8192, R, C); const int Rb = Epi::PERM ? ((R & ~31) + perm32(R & 31)) : R;
        voffA[i] = (unsigned)(R * K + C) * 2u; voffB[i] = (unsigned)(Rb * K + C) * 2u; }
    const size_t kstep = (size_t)(BK * 2);
    const size_t hstep = (size_t)HALF * K * 2;
    const size_t tstep = 2 * hstep;
    const unsigned ldsw = (unsigned)wid * 1024u;
    const int aoff = lds_byte(wr * 64 + fr, fq * 8), boff = lds_byte(wc * 32 + fr, fq * 8);
#define PG8_SA(b, h) (((b) * 2 + (h)) * HTB)
#define PG8_SB(b, h) ((4 + (b) * 2 + (h)) * HTB)
#define PG8_STAGE(bufoff, gbase, voff) do { _Pragma("unroll") for (int _i = 0; _i < 2; ++_i) \
        __builtin_amdgcn_global_load_lds((const unsigned*)((const char*)(gbase) + (voff)[_i]), (PG8_LAS unsigned*)(lds + (bufoff) + ldsw + _i * 8192), 16, 0, 0); } while (0)
#define PG8_LDA(dst, b, h) do { _Pragma("unroll") for (int m = 0; m < 4; ++m) _Pragma("unroll") for (int k = 0; k < 2; ++k) dst[m][k] = *(const PG8_LAS bf16x8*)(lds + PG8_SA(b, h) + aoff + m * 2048 + k * 1024); } while (0)
#define PG8_LDB(dst, b, h) do { _Pragma("unroll") for (int n = 0; n < 2; ++n) _Pragma("unroll") for (int k = 0; k < 2; ++k) dst[n][k] = *(const PG8_LAS bf16x8*)(lds + PG8_SB(b, h) + boff + n * 2048 + k * 1024); } while (0)
#define PG8_MMA(ai, bj, At, Bt) do { __builtin_amdgcn_s_setprio(1); _Pragma("unroll") for (int m = 0; m < 4; ++m) _Pragma("unroll") for (int n = 0; n < 2; ++n) _Pragma("unroll") for (int k = 0; k < 2; ++k) \
        acc[ai][bj][m][n] = __builtin_amdgcn_mfma_f32_16x16x32_bf16(Bt[n][k], At[m][k], acc[ai][bj][m][n], 0, 0, 0); __builtin_amdgcn_s_setprio(0); } while (0)
#define PG8_WAIT_V(n) asm volatile("s_waitcnt vmcnt(" #n ")" ::: "memory")
#define PG8_WAIT_L(n) asm volatile("s_waitcnt lgkmcnt(" #n ")" ::: "memory")
#define PG8_BAR __builtin_amdgcn_s_barrier()
#define PG8_SCHED __builtin_amdgcn_sched_barrier(0)
    Unit cur, nxt; int ui = 0;
    if (!S.next(0, cur)) return;
    f32x4 acc[2][2][4][2];
#pragma unroll
    for (int a = 0; a < 2; ++a)
#pragma unroll
        for (int b = 0; b < 2; ++b)
#pragma unroll
            for (int m = 0; m < 4; ++m)
#pragma unroll
                for (int n = 0; n < 2; ++n) acc[a][b][m][n] = (f32x4){0.f, 0.f, 0.f, 0.f};
    bf16x8 At[4][2], B0[2][2], B1[2][2];
    const char* cA = (const char*)g.A + (size_t)cur.pm * tstep; const char* cB = (const char*)g.Bt + (size_t)cur.pn * tstep;
    S.a_ready(cur);
    if constexpr (SP2) {
        PG8_STAGE(PG8_SB(0, 0), cB, voffB); PG8_STAGE(PG8_SB(0, 1), cB + hstep, voffB); PG8_STAGE(PG8_SA(0, 0), cA, voffA); PG8_STAGE(PG8_SA(0, 1), cA + hstep, voffA);
        if (wr == 1) PG8_BAR;
        PG8_WAIT_V(2); PG8_BAR;
        PG8_STAGE(PG8_SB(1, 0), cB + kstep, voffB); PG8_STAGE(PG8_SA(1, 0), cA + kstep, voffA); PG8_STAGE(PG8_SB(1, 1), cB + hstep + kstep, voffB);
        PG8_WAIT_V(6); PG8_BAR;
    } else {
        PG8_STAGE(PG8_SB(0, 0), cB, voffB); PG8_STAGE(PG8_SA(0, 0), cA, voffA); PG8_STAGE(PG8_SB(0, 1), cB + hstep, voffB); PG8_STAGE(PG8_SA(0, 1), cA + hstep, voffA);
        if (wr == 1) PG8_BAR;
        PG8_WAIT_V(4); PG8_BAR;
        PG8_STAGE(PG8_SB(1, 0), cB + kstep, voffB); PG8_STAGE(PG8_SA(1, 0), cA + kstep, voffA); PG8_STAGE(PG8_SB(1, 1), cB + hstep + kstep, voffB);
        PG8_WAIT_V(6); PG8_BAR;
    }
    for (;;) {
        const bool has_next = S.next(ui + 1, nxt);
        const char* nA = has_next ? (const char*)g.A + (size_t)nxt.pm * tstep : cA; const char* nB = has_next ? (const char*)g.Bt + (size_t)nxt.pn * tstep : cB;
        for (int t = 0; t < nt; t += 2) {
            const bool last = (t == nt - 2);
            const char* a1 = cA + (size_t)(t + 1) * kstep;
            const char* a2 = last ? nA : cA + (size_t)(t + 2) * kstep; const char* b2 = last ? nB : cB + (size_t)(t + 2) * kstep;
            const char* a3 = a2 + kstep; const char* b3 = b2 + kstep;
            if (last && has_next) S.a_ready(nxt);
            if constexpr (Epi::MID) { if (t == nt / 2) E.mid(acc, cur, wr, wc, fr, fq); }
            if constexpr (SP2) {
            PG8_LDB(B0, 0, 0); PG8_LDB(B1, 0, 1); PG8_SCHED; PG8_LDA(At, 0, 0); PG8_STAGE(PG8_SA(1, 1), a1 + hstep, voffA);
            PG8_WAIT_V(8); PG8_WAIT_L(0); PG8_BAR; PG8_MMA(0, 0, At, B0); PG8_MMA(0, 1, At, B1); PG8_BAR; PG8_SCHED;
            PG8_LDA(At, 0, 1); PG8_STAGE(PG8_SB(0, 0), b2, voffB); PG8_STAGE(PG8_SB(0, 1), b2 + hstep, voffB); PG8_STAGE(PG8_SA(0, 0), a2, voffA);
            PG8_WAIT_V(8); PG8_WAIT_L(0); PG8_BAR; PG8_MMA(1, 0, At, B0); PG8_MMA(1, 1, At, B1); PG8_BAR; PG8_SCHED;
            PG8_LDB(B0, 1, 0); PG8_LDB(B1, 1, 1); PG8_SCHED; PG8_LDA(At, 1, 0); PG8_STAGE(PG8_SA(0, 1), a2 + hstep, voffA);
            PG8_WAIT_V(8); PG8_WAIT_L(0); PG8_BAR; PG8_MMA(0, 0, At, B0); PG8_MMA(0, 1, At, B1); PG8_BAR; PG8_SCHED;
            PG8_LDA(At, 1, 1); PG8_STAGE(PG8_SB(1, 0), b3, voffB); PG8_STAGE(PG8_SB(1, 1), b3 + hstep, voffB); PG8_STAGE(PG8_SA(1, 0), a3, voffA);
            PG8_WAIT_V(8); PG8_WAIT_L(0); PG8_BAR; PG8_MMA(1, 0, At, B0); PG8_MMA(1, 1, At, B1); PG8_BAR; PG8_SCHED;
            } else {
            PG8_LDB(B0, 0, 0); PG8_SCHED; PG8_LDA(At, 0, 0); PG8_STAGE(PG8_SA(1, 1), a1 + hstep, voffA);
            PG8_WAIT_L(8); PG8_BAR; PG8_WAIT_L(0); PG8_MMA(0, 0, At, B0); PG8_BAR; PG8_SCHED;
            PG8_LDB(B1, 0, 1); PG8_STAGE(PG8_SB(0, 0), b2, voffB);
            PG8_BAR; PG8_WAIT_L(0); PG8_MMA(0, 1, At, B1); PG8_BAR;
            PG8_LDA(At, 0, 1); PG8_STAGE(PG8_SA(0, 0), a2, voffA);
            PG8_BAR; PG8_WAIT_L(0); PG8_MMA(1, 0, At, B0); PG8_BAR; PG8_SCHED;
            PG8_STAGE(PG8_SB(0, 1), b2 + hstep, voffB);
            PG8_WAIT_V(6); PG8_BAR; PG8_MMA(1, 1, At, B1); PG8_BAR;
            PG8_LDB(B0, 1, 0); PG8_SCHED; PG8_LDA(At, 1, 0); PG8_STAGE(PG8_SA(0, 1), a2 + hstep, voffA);
            PG8_WAIT_L(8); PG8_BAR; PG8_WAIT_L(0); PG8_MMA(0, 0, At, B0); PG8_BAR; PG8_SCHED;
            PG8_LDB(B1, 1, 1); PG8_STAGE(PG8_SB(1, 0), b3, voffB);
            PG8_BAR; PG8_WAIT_L(0); PG8_MMA(0, 1, At, B1); PG8_BAR;
            PG8_LDA(At, 1, 1); PG8_STAGE(PG8_SA(1, 0), a3, voffA);
            PG8_BAR; PG8_WAIT_L(0); PG8_MMA(1, 0, At, B0); PG8_BAR; PG8_SCHED;
            PG8_STAGE(PG8_SB(1, 1), b3 + hstep, voffB);
            PG8_WAIT_V(6); PG8_BAR; PG8_MMA(1, 1, At, B1); PG8_BAR;
            }
        }
        if constexpr (ALIGN_EPI) { if (wr == 0) PG8_BAR; }
        E(acc, cur, wr, wc, fr, fq); S.done(cur);
        if (!has_next) break;
#pragma unroll
        for (int a = 0; a < 2; ++a)
#pragma unroll
            for (int b = 0; b < 2; ++b)
#pragma unroll
                for (int m = 0; m < 4; ++m)
#pragma unroll
                    for (int n = 0; n < 2; ++n) acc[a][b][m][n] = (f32x4){0.f, 0.f, 0.f, 0.f};
        cur = nxt; cA = nA; cB = nB; ++ui;
        if constexpr (ALIGN_EPI) { if (wr == 1) PG8_BAR; }
    }
    PG8_WAIT_V(0);
    if constexpr (!ALIGN_EPI) { if (wr == 0) PG8_BAR; }
    PG8_BAR;
#undef PG8_SA
#undef PG8_SB
#undef PG8_STAGE
#undef PG8_LDA
#undef PG8_LDB
#undef PG8_MMA
#undef PG8_WAIT_V
#undef PG8_WAIT_L
#undef PG8_BAR
#undef PG8_SCHED
}
}

#define GAS __attribute__((address_space(1)))
#define LAS __attribute__((address_space(3)))
typedef unsigned short bf16;
typedef unsigned v4u __attribute__((ext_vector_type(4)));
typedef float f32x4 __attribute__((ext_vector_type(4)));
typedef float f32x16 __attribute__((ext_vector_type(16)));
typedef short bf16x8 __attribute__((ext_vector_type(8)));
typedef short s16x4 __attribute__((ext_vector_type(4)));
typedef short v4i16_t __attribute__((ext_vector_type(4)));
typedef LAS unsigned char LDSB;
typedef GAS unsigned gu32;

constexpr int NWAVES = 8, NTHR = 512;
constexpr int BATCH = 8, SEQ = 4096, DM = 1024, T = BATCH * SEQ;
constexpr int NPROJ = 3072;
constexpr int N_IN = 2848, FF = 4096;
constexpr float EPS = 1e-6f;
constexpr float C2 = 0.125f * 1.4426950408889634f;
constexpr float LOG2E = 1.4426950408889634f;
constexpr float NEGM = -1000.0f;

constexpr size_t MiB = 1u << 20;
constexpr size_t WS_CTL = 0, CTL_ZERO_BYTES = 1 * MiB;
constexpr size_t WS_WIN = 2 * MiB;
constexpr size_t WS_WOUT = 8 * MiB;
constexpr size_t WS_WUP = 10 * MiB;
constexpr size_t WS_WDN = 18 * MiB;
constexpr size_t WS_W1K = 26 * MiB;
constexpr size_t WS_W1V = 27 * MiB;
constexpr size_t WS_W2K = 28 * MiB;
constexpr size_t WS_W2V = 28 * MiB + 65536;
constexpr size_t WS_B1K = 28 * MiB + 131072;
constexpr size_t WS_B1V = 28 * MiB + 131072 + 65536;
constexpr size_t WS_ROPEC = 29 * MiB;
constexpr size_t WS_ROPES = 29 * MiB + 524288;
constexpr size_t WS_FL = 30 * MiB;
constexpr size_t WS_CB = 31 * MiB;
constexpr size_t WS_XN = 32 * MiB;
constexpr size_t WS_U = 96 * MiB;
constexpr size_t WS_QF = 96 * MiB;
constexpr size_t WS_KF = 128 * MiB;
constexpr size_t WS_VF = 160 * MiB;
constexpr size_t WS_QN = 192 * MiB;
constexpr size_t WS_KC = 224 * MiB;
constexpr size_t WS_VC = 233 * MiB;
constexpr size_t WS_KS = 242 * MiB;
constexpr size_t WS_VS = 250 * MiB;
constexpr size_t WS_KW = 258 * MiB;
constexpr size_t WS_VW = 266 * MiB;
constexpr size_t WS_GATE = 274 * MiB;
constexpr size_t WS_KCMP = 277 * MiB;
constexpr size_t WS_VCMP = 277 * MiB + 524288;
constexpr size_t WS_Y = 280 * MiB;
constexpr size_t WS_SSQ1 = 352 * MiB;
constexpr size_t WS_XS = 353 * MiB;
constexpr size_t WS_SSQY = 354 * MiB;
constexpr size_t WS_END = 356 * MiB;

constexpr int CW_Q_ATT = 64;
constexpr int CW_CS = 128;
constexpr int CW_CMPT = 192;
constexpr int CW_CMP = 256;
constexpr int CW_BAR = 4096;
constexpr int CW_KMAX = 2048;
constexpr int CW_PANEL = 8192;

constexpr int L_K = 0;
constexpr int L_V = 32768;
constexpr int L_ACC = 65536;
constexpr int L_IMP = 131072;
constexpr int L_WS = 131072 + 17408;
constexpr int L_SEL = L_WS + 8192;
constexpr int L_ORD = L_SEL + 512;
constexpr int L_MISC = L_ORD + 4096;
constexpr int L_TL = L_MISC + 256;
constexpr int LDS_BYTES = L_TL + 256;
constexpr int SLOTB = 8192;

#define RLX_AGENT __ATOMIC_RELAXED, __HIP_MEMORY_SCOPE_AGENT
#define LDS_WAIT() asm volatile("s_waitcnt lgkmcnt(0)" ::: "memory")
#define VM_WAIT() asm volatile("s_waitcnt vmcnt(0)" ::: "memory")
__device__ __forceinline__ unsigned f2bf(float f) { unsigned u = __builtin_bit_cast(unsigned, f); return (u + 0x7fffu + ((u >> 16) & 1u)) >> 16; }
__device__ __forceinline__ unsigned pk2(float lo, float hi) { return f2bf(lo) | (f2bf(hi) << 16); }
__device__ __forceinline__ float bf2f(unsigned short b) { return __builtin_bit_cast(float, (unsigned)b << 16); }

#define XB_TMO      128
#define XB_XCNT(j)  (256  + 64 * (j))
#define XB_XSUB(j)  (1280 + 64 * (j))
#define XB_XGEN(j)  (2304 + 64 * (j))
#define XB_TOP      3328
#define XB_TOPGEN   3392
#define XCD_BAR_WORDS 3456
#define XB_SPIN_CAP (1u << 22)
__device__ __forceinline__ unsigned xb_ld(unsigned* p)              { return __hip_atomic_load(p, __ATOMIC_RELAXED, __HIP_MEMORY_SCOPE_AGENT); }
__device__ __forceinline__ unsigned xb_add(unsigned* p, unsigned v) { return __hip_atomic_fetch_add(p, v, __ATOMIC_RELAXED, __HIP_MEMORY_SCOPE_AGENT); }
__device__ __forceinline__ unsigned xb_xcc_id() { return (unsigned)__builtin_amdgcn_s_getreg((3 << 11) | 20) & 0xFu; }
#define XB_SPIN(cond, bar) do { unsigned _sp = 0; while (cond) { __builtin_amdgcn_s_sleep(1); \
    if ((++_sp & 255u) == 0u) { if (xb_ld(&(bar)[XB_TMO])) break; if (_sp > XB_SPIN_CAP) { atomicAdd(&(bar)[XB_TMO], 1u); break; } } } } while (0)
struct XcdBarrier { unsigned* bar; unsigned x; volatile LAS unsigned* st; int wave; };
__device__ __forceinline__ XcdBarrier xcd_barrier_post(unsigned* bar, volatile LAS unsigned* st) {
    XcdBarrier b; b.bar = bar; b.x = xb_xcc_id(); b.st = st; b.wave = 0;
    if (threadIdx.x == 0) (void)xb_add(&bar[XB_XCNT(b.x)], 1u);
    return b;
}
__device__ __forceinline__ void xcd_barrier_complete(unsigned* bar, unsigned x, unsigned& nloc, unsigned& nx) {
    const unsigned G = gridDim.x * gridDim.y * gridDim.z;
    unsigned sum, cnt, mine, sp = 0u;
    for (;;) {
        sum = 0u; cnt = 0u; mine = 0u;
#pragma unroll
        for (unsigned j = 0; j < 16; ++j) { const unsigned c = xb_ld(&bar[XB_XCNT(j)]); sum += c; cnt += (c > 0u) ? 1u : 0u; mine = (j == x) ? c : mine; }
        if (sum == G) break;
        __builtin_amdgcn_s_sleep(1);
        if ((++sp & 255u) == 0u) { if (xb_ld(&bar[XB_TMO])) break; if (sp > XB_SPIN_CAP) { atomicAdd(&bar[XB_TMO], 1u); break; } }
    }
    nloc = mine > 0u ? mine : 1u; nx = cnt > 0u ? cnt : 1u;
}
__device__ __forceinline__ void xcd_barrier(const XcdBarrier& b) {
    asm volatile("s_waitcnt vmcnt(0)" ::: "memory");
    __syncthreads();
    if (b.wave == 0 && lane_id() == 0) {
        unsigned* bar = b.bar;
        __builtin_amdgcn_s_waitcnt(0);
        unsigned nloc = b.st[0], nx = b.st[1];
        if (nloc == 0u) { xcd_barrier_complete(bar, b.x, nloc, nx); b.st[0] = nloc; b.st[1] = nx; }
        const unsigned old = xb_add(&bar[XB_XSUB(b.x)], 1u);
        const unsigned gen = old / nloc;
        if (old + 1u == (gen + 1u) * nloc) {
            __builtin_amdgcn_fence(__ATOMIC_RELEASE, "agent");
            asm volatile("s_waitcnt vmcnt(0)" ::: "memory");
            const unsigned og = xb_add(&bar[XB_TOP], 1u);
            const unsigned tg = og / nx;
            if (og + 1u == (tg + 1u) * nx) xb_add(&bar[XB_TOPGEN], 1u);
            else XB_SPIN(xb_ld(&bar[XB_TOPGEN]) == tg, bar);
            __builtin_amdgcn_fence(__ATOMIC_ACQUIRE, "agent");
            xb_add(&bar[XB_XGEN(b.x)], 1u);
            asm volatile("s_waitcnt vmcnt(0)" ::: "memory");
        } else {
            XB_SPIN(xb_ld(&bar[XB_XGEN(b.x)]) == gen, bar);
            __builtin_amdgcn_fence(__ATOMIC_ACQUIRE, "agent");
            asm volatile("s_waitcnt vmcnt(0)" ::: "memory");
        }
    }
    __syncthreads();
}

struct Args { const float* in[22]; float* out; unsigned char* ws; int ph_lo, ph_hi; };

struct Frame {
    LDSB* lds;
    volatile LAS unsigned* MISC;
    gu32* ctl;
    int tid, lane, wave, vcu, G;
    unsigned char* ws;
};

__device__ __forceinline__ float wave_sum(float v) {
#pragma unroll
    for (int o = 1; o < 64; o <<= 1) v += __shfl_xor(v, o);
    return v;
}

__device__ __forceinline__ int win_src_col(int n) {
    const int pn = n >> 8, c = n & 255, half = c >> 7, slot = (c >> 5) & 3, d = c & 31;
    if (pn < 8) {
        const int tsr = pn >> 1, j = pn & 1;
        const int tb = (tsr == 0) ? 0 : (tsr == 1) ? 512 : (tsr == 2) ? 1024 : 1544;
        return tb + 64 * (4 * j + slot) + 32 * half + d;
    }
    if (pn < 11) {
        const int base = 2056 + (pn - 8) * 256;
        return base + (slot >> 1) * 128 + (slot & 1) * 64 + 32 * half + d;
    }
    if (c < 8) return 1536 + c;
    if (c < 32) return 2824 + (c - 8);
    return -1;
}

template <bool MAPPED>
__device__ __forceinline__ void p0_transpose_item(const float* W, int K, int N, bf16* WT, LAS float* scr, int item, int lane, const float* kscale, int nblk) {
    const int kb = item / nblk, nb = item % nblk, k0 = 64 * kb, n0 = 32 * nb;
    int src = n0 + 4 * (lane & 7);
    if (MAPPED) src = win_src_col(src);
    f32x4 v[8];
#pragma unroll
    for (int i = 0; i < 8; ++i) { const int kk = 8 * i + (lane >> 3);
        v[i] = (src >= 0) ? *(const f32x4*)(W + (size_t)(k0 + kk) * N + src) : (f32x4){0.f, 0.f, 0.f, 0.f}; }
#pragma unroll
    for (int i = 0; i < 8; ++i) { const int kk = 8 * i + (lane >> 3); const float sc = kscale ? kscale[k0 + kk] : 1.f;
        LAS float* p = scr + kk * 33 + 4 * (lane & 7); p[0] = v[i][0] * sc; p[1] = v[i][1] * sc; p[2] = v[i][2] * sc; p[3] = v[i][3] * sc; }
    LDS_WAIT(); asm volatile("" ::: "memory");
    const int c = lane & 7;
#pragma unroll
    for (int j = 0; j < 4; ++j) { const int n = (lane >> 3) + 8 * j; const LAS float* sp = scr + (8 * c) * 33 + n;
        v4u o; o.x = pk2(sp[0 * 33], sp[1 * 33]); o.y = pk2(sp[2 * 33], sp[3 * 33]); o.z = pk2(sp[4 * 33], sp[5 * 33]); o.w = pk2(sp[6 * 33], sp[7 * 33]);
        *(GAS v4u*)(WT + (size_t)(n0 + n) * K + k0 + 8 * c) = o; }
    LDS_WAIT(); asm volatile("" ::: "memory");
}

__device__ __forceinline__ void rms_row_to_bf16(int lane, const float* xrow, bf16* orow) {
    const GAS f32x4* xr = (const GAS f32x4*)xrow + lane;
    f32x4 v[4]; float s = 0.f;
#pragma unroll
    for (int j = 0; j < 4; ++j) { v[j] = xr[64 * j]; s += (v[j].x * v[j].x + v[j].y * v[j].y) + (v[j].z * v[j].z + v[j].w * v[j].w); }
    const float r = 1.f / sqrtf(wave_sum(s) * (1.f / DM) + EPS);
    GAS unsigned long long* o8 = (GAS unsigned long long*)orow + lane;
#pragma unroll
    for (int j = 0; j < 4; ++j) o8[64 * j] = (unsigned long long)pk2(v[j].x * r, v[j].y * r) | ((unsigned long long)pk2(v[j].z * r, v[j].w * r) << 32);
}

typedef __attribute__((address_space(4))) const char* kptr_t;
#define AIN(kp_, i) (*(const float* const __attribute__((address_space(4)))*)((kp_) + 8 * (i)))
__device__ __forceinline__ void p0_prologue(Frame& F, kptr_t kp) {
    const float* x = AIN(kp, 0); const float* g_attn = AIN(kp, 1); const float* w_in = AIN(kp, 2);
    const float* cmpk_pe = AIN(kp, 5); const float* cmpk_w1 = AIN(kp, 6); const float* cmpk_w2 = AIN(kp, 8);
    const float* cmpv_pe = AIN(kp, 10); const float* cmpv_w1 = AIN(kp, 11); const float* cmpv_w2 = AIN(kp, 13);
    const float* g_fox = AIN(kp, 15); const float* g_nsa = AIN(kp, 16); const float* w_out = AIN(kp, 17);
    const float* g_mlp = AIN(kp, 18); const float* w_up = AIN(kp, 19); const float* w_down = AIN(kp, 20);
    LAS float* scr = (LAS float*)(F.lds + F.wave * 16384);
    const int gw = F.vcu * NWAVES + F.wave, NGW = F.G * NWAVES;
    for (int it = gw; it < 128; it += NGW) {
        const int kv = it >> 6, kc = it & 63;
        const float* pe = kv ? cmpv_pe : cmpk_pe; const float* w1 = kv ? cmpv_w1 : cmpk_w1;
        f32x4 a = (f32x4){0.f, 0.f, 0.f, 0.f};
#pragma unroll 8
        for (int k = 32 * kc; k < 32 * kc + 32; ++k) { const f32x4 wv = *((const f32x4*)(w1 + (size_t)k * 256) + F.lane); a = a + wv * pe[k]; }
        *((f32x4*)(F.ws + (kv ? WS_B1V : WS_B1K)) + kc * 64 + F.lane) = a;
    }
    constexpr int I_IN = (DM / 64) * (NPROJ / 32), I_OUT = (DM / 64) * (DM / 32), I_UP = (DM / 64) * (FF / 32), I_DN = (FF / 64) * (DM / 32);
    constexpr int I_W1 = (2048 / 64) * (256 / 32), I_W2 = (256 / 64) * (64 / 32);
    constexpr int NITEMS = I_IN + I_OUT + I_UP + I_DN + 2 * I_W1 + 2 * I_W2;
    for (int it = gw; it < NITEMS; it += NGW) {
        int r = it;
        if (r < I_IN) { p0_transpose_item<true>(w_in, DM, N_IN, (bf16*)(F.ws + WS_WIN), scr, r, F.lane, g_attn, NPROJ / 32); continue; } r -= I_IN;
        if (r < I_OUT) {
            const int kb = r / (DM / 32);
            const float* ks = (kb < 8) ? g_fox : (g_nsa - 512);
            p0_transpose_item<false>(w_out, DM, DM, (bf16*)(F.ws + WS_WOUT), scr, r, F.lane, ks, DM / 32); continue; } r -= I_OUT;
        if (r < I_UP) { p0_transpose_item<false>(w_up, DM, FF, (bf16*)(F.ws + WS_WUP), scr, r, F.lane, g_mlp, FF / 32); continue; } r -= I_UP;
        if (r < I_DN) { p0_transpose_item<false>(w_down, FF, DM, (bf16*)(F.ws + WS_WDN), scr, r, F.lane, nullptr, DM / 32); continue; } r -= I_DN;
        if (r < I_W1) { p0_transpose_item<false>(cmpk_w1, 2048, 256, (bf16*)(F.ws + WS_W1K), scr, r, F.lane, nullptr, 8); continue; } r -= I_W1;
        if (r < I_W1) { p0_transpose_item<false>(cmpv_w1, 2048, 256, (bf16*)(F.ws + WS_W1V), scr, r, F.lane, nullptr, 8); continue; } r -= I_W1;
        if (r < I_W2) { p0_transpose_item<false>(cmpk_w2, 256, 64, (bf16*)(F.ws + WS_W2K), scr, r, F.lane, nullptr, 2); continue; } r -= I_W2;
        p0_transpose_item<false>(cmpv_w2, 256, 64, (bf16*)(F.ws + WS_W2V), scr, r, F.lane, nullptr, 2);
    }
    {
        float* rc = (float*)(F.ws + WS_ROPEC); float* rs = (float*)(F.ws + WS_ROPES);
        for (int i = F.vcu * NTHR + F.tid; i < SEQ * 32; i += F.G * NTHR) {
            const int pos = i >> 5, d = i & 31;
            const float inv = exp2f(-(float)d * (13.287712379549449f / 32.0f));
            const float ang = (float)pos * inv;
            const double a = (double)ang;
            const double k = __builtin_rint(a * 0.15915494309189535);
            const float red = (float)(a - k * 6.283185307179586);
            rc[i] = cosf(red); rs[i] = sinf(red);
        }
    }
    for (int m = gw; m < T; m += 4 * NGW) {
        f32x4 v[4][4]; float ss[4];
#pragma unroll
        for (int r = 0; r < 4; ++r) { const int mr = (m + r * NGW < T) ? m + r * NGW : m; const GAS f32x4* xr = (const GAS f32x4*)(x + (size_t)mr * DM) + F.lane;
#pragma unroll
            for (int j = 0; j < 4; ++j) v[r][j] = xr[64 * j]; }
#pragma unroll
        for (int r = 0; r < 4; ++r) { float a = 0.f;
#pragma unroll
            for (int j = 0; j < 4; ++j) a += (v[r][j].x * v[r][j].x + v[r][j].y * v[r][j].y) + (v[r][j].z * v[r][j].z + v[r][j].w * v[r][j].w);
            ss[r] = a; }
#pragma unroll
        for (int o = 1; o < 64; o <<= 1) {
#pragma unroll
            for (int r = 0; r < 4; ++r) ss[r] += __shfl_xor(ss[r], o); }
#pragma unroll
        for (int r = 0; r < 4; ++r) { const float rs = 1.f / sqrtf(ss[r] * (1.f / DM) + EPS);
            const int mr = (m + r * NGW < T) ? m + r * NGW : m;
            GAS unsigned long long* o8 = (GAS unsigned long long*)((bf16*)(F.ws + WS_XN) + (size_t)mr * DM) + F.lane;
#pragma unroll
            for (int j = 0; j < 4; ++j) o8[64 * j] = (unsigned long long)pk2(v[r][j].x * rs, v[r][j].y * rs) | ((unsigned long long)pk2(v[r][j].z * rs, v[r][j].w * rs) << 32); }
    }
}

typedef pg8::f32x4 pf4;
__device__ __forceinline__ float log_sigmoidf(float v) { return v >= 0.f ? -log1pf(expf(-v)) : v - log1pf(expf(v)); }

struct EpiProj { static constexpr bool MID = false;
    static constexpr bool PERM = true;
    unsigned char* ws; const float* b_f; const float* b_gate;
    __device__ __forceinline__ void operator()(const pf4 (&acc)[2][2][4][2], const pg8::Unit& u, int wr, int wc, int fr, int fq) const {
        const int pn = u.pn; const int rbase = u.pm * 256 + wr * 64 + fr;
        if (pn == 11) {
            if (wc != 0) return;
            float* FL = (float*)(ws + WS_FL); float* GT = (float*)(ws + WS_GATE);
#pragma unroll
            for (int ai = 0; ai < 2; ++ai)
#pragma unroll
                for (int m = 0; m < 4; ++m) { const int row = rbase + ai * 128 + m * 16; const int b = row >> 12, s = row & 4095;
#pragma unroll
                    for (int n = 0; n < 2; ++n) { const pf4 v = acc[ai][0][m][n];
                        if (fq == 0) {
#pragma unroll
                            for (int i = 0; i < 4; ++i) { const int h = 4 * n + i; FL[(size_t)(b * 8 + h) * SEQ + s] = log_sigmoidf(v[i] + b_f[h]); }
                        } else { const int j0 = 8 * fq - 8 + 4 * n; pf4 o;
#pragma unroll
                            for (int i = 0; i < 4; ++i) { const float z = v[i] + b_gate[j0 + i]; o[i] = 1.f / (1.f + expf(-z)); }
                            *(pf4*)(GT + (size_t)row * 24 + j0) = o; } } }
            return;
        }
        const bool rope = (pn == 6) || (pn == 7) || ((pn == 9 || pn == 10) && wc < 2);
        const float sc = (pn < 2 || pn == 6 || pn == 7) ? C2 : 1.f;
        const float* RC = (const float*)(ws + WS_ROPEC); const float* RS = (const float*)(ws + WS_ROPES);
        size_t tb;
        if (pn < 8) { const int tsr = pn >> 1; tb = (tsr == 0) ? WS_QF : (tsr == 1) ? WS_KF : (tsr == 2) ? WS_VF : WS_QN; }
        else { const int vt = wc >> 1; tb = (pn == 8) ? (vt ? WS_VC : WS_KC) : (pn == 9) ? (vt ? WS_VS : WS_KS) : (vt ? WS_VW : WS_KW); }
        bf16* TB = (bf16*)(ws + tb);
        float kmx = 0.f;
#pragma unroll
        for (int ai = 0; ai < 2; ++ai)
#pragma unroll
            for (int m = 0; m < 4; ++m) { const int row = rbase + ai * 128 + m * 16;
                pf4 a0 = acc[ai][0][m][0], a1 = acc[ai][0][m][1], b0 = acc[ai][1][m][0], b1 = acc[ai][1][m][1];
                if (rope) { const int pos = row & 4095;
                    const pf4 c0 = *(const pf4*)(RC + pos * 32 + 8 * fq), c1 = *(const pf4*)(RC + pos * 32 + 8 * fq + 4);
                    const pf4 s0 = *(const pf4*)(RS + pos * 32 + 8 * fq), s1 = *(const pf4*)(RS + pos * 32 + 8 * fq + 4);
                    const pf4 x0 = a0 * c0 - b0 * s0, x1 = a1 * c1 - b1 * s1, y0 = a0 * s0 + b0 * c0, y1 = a1 * s1 + b1 * c1;
                    a0 = x0; a1 = x1; b0 = y0; b1 = y1; }
                a0 = a0 * sc; a1 = a1 * sc; b0 = b0 * sc; b1 = b1 * sc;
                v4u w0, w1; w0.x = pk2(a0[0], a0[1]); w0.y = pk2(a0[2], a0[3]); w0.z = pk2(a1[0], a1[1]); w0.w = pk2(a1[2], a1[3]);
                w1.x = pk2(b0[0], b0[1]); w1.y = pk2(b0[2], b0[3]); w1.z = pk2(b1[0], b1[1]); w1.w = pk2(b1[2], b1[3]);
                if (pn == 2 || pn == 3) { float q2 = 0.f;
#pragma unroll
                    for (int i = 0; i < 4; ++i) q2 += (a0[i] * a0[i] + a1[i] * a1[i]) + (b0[i] * b0[i] + b1[i] * b1[i]);
                    q2 += __shfl_xor(q2, 16); q2 += __shfl_xor(q2, 32); kmx = fmaxf(kmx, q2); }
                bf16* p;
                if (pn < 8) p = TB + (size_t)row * 512 + 64 * (4 * (pn & 1) + wc) + 8 * fq;
                else { const int b = row >> 12, s = row & 4095, g = wc & 1; p = TB + ((size_t)(b * 2 + g) * SEQ + s) * 64 + 8 * fq; }
                *(v4u*)p = w0; *(v4u*)(p + 32) = w1; }
        if (pn == 2 || pn == 3) {
#pragma unroll
            for (int o = 1; o < 16; o <<= 1) kmx = fmaxf(kmx, __shfl_xor(kmx, o));
            if (fr == 0 && fq == 0) atomicMax((unsigned*)(ws + WS_CTL) + CW_KMAX + (rbase >> 12) * 8 + 4 * (pn & 1) + wc, __float_as_uint(kmx));
        }
    }
};

struct EpiOutRes {
    static constexpr bool PERM = true, MID = true;
    const float* x; float* out; bf16* xn; float* ssq; LDSB* lds; int pm0;
    __device__ __forceinline__ const LAS float* tabrow(const pg8::Unit& u, int rl) const { return (const LAS float*)(lds + L_IMP + 8192) + (((u.pm == pm0) ? 0 : 256) + rl) * 2; }
    __device__ __forceinline__ void mid(pf4 (&acc)[2][2][4][2], const pg8::Unit& u, int wr, int wc, int fr, int fq) const {
#pragma unroll
        for (int ai = 0; ai < 2; ++ai)
#pragma unroll
            for (int m = 0; m < 4; ++m) { const float q = tabrow(u, ai * 128 + wr * 64 + m * 16 + fr)[0];
#pragma unroll
                for (int bj = 0; bj < 2; ++bj) { acc[ai][bj][m][0] = acc[ai][bj][m][0] * q; acc[ai][bj][m][1] = acc[ai][bj][m][1] * q; } }
    }
    __device__ __forceinline__ void operator()(const pf4 (&acc)[2][2][4][2], const pg8::Unit& u, int wr, int wc, int fr, int fq) const {
        const int col0 = u.pn * 256 + wc * 32 + 8 * fq;
        LAS float* P = (LAS float*)(lds + L_IMP);
#pragma unroll
        for (int ai = 0; ai < 2; ++ai)
#pragma unroll
            for (int m = 0; m < 4; ++m) { const int rl = ai * 128 + wr * 64 + m * 16 + fr; const size_t off = (size_t)(u.pm * 256 + rl) * DM + col0; float sq = 0.f;
                const float rn = tabrow(u, rl)[1];
#pragma unroll
                for (int bj = 0; bj < 2; ++bj) {
                    const pf4 h0 = *(const pf4*)(x + off + bj * 128) + acc[ai][bj][m][0] * rn, h1 = *(const pf4*)(x + off + bj * 128 + 4) + acc[ai][bj][m][1] * rn;
                    *(pf4*)(out + off + bj * 128) = h0; *(pf4*)(out + off + bj * 128 + 4) = h1;
                    sq += ((h0[0] * h0[0] + h0[1] * h0[1]) + (h0[2] * h0[2] + h0[3] * h0[3])) + ((h1[0] * h1[0] + h1[1] * h1[1]) + (h1[2] * h1[2] + h1[3] * h1[3]));
                    v4u w; w.x = pk2(h0[0], h0[1]); w.y = pk2(h0[2], h0[3]); w.z = pk2(h1[0], h1[1]); w.w = pk2(h1[2], h1[3]);
                    *(v4u*)(xn + off + bj * 128) = w; }
                sq += __shfl_xor(sq, 16); sq += __shfl_xor(sq, 32);
                if (fq == 0) P[rl * 4 + wc] = sq; }
        asm volatile("s_waitcnt lgkmcnt(0)\n\ts_barrier" ::: "memory");
        const int t = (wr * 4 + wc) * 64 + (fq * 16 + fr);
        if (t < 256) { const f32x4 p = *(const LAS f32x4*)(P + t * 4); ssq[(size_t)(u.pm * 256 + t) * 4 + u.pn] = (p[0] + p[1]) + (p[2] + p[3]); }
    }
};

struct EpiUp { static constexpr bool MID = false;
    static constexpr bool PERM = true;
    bf16* O; const float* ssq;
    __device__ __forceinline__ void operator()(const pf4 (&acc)[2][2][4][2], const pg8::Unit& u, int wr, int wc, int fr, int fq) const {
        const int row0 = u.pm * 256 + wr * 64 + fr, col0 = u.pn * 256 + wc * 32 + 8 * fq;
#pragma unroll
        for (int ai = 0; ai < 2; ++ai)
#pragma unroll
            for (int m = 0; m < 4; ++m) { const int row = row0 + ai * 128 + m * 16; bf16* rowp = O + (size_t)row * FF + col0;
                const pf4 s0 = *(const pf4*)(ssq + (size_t)row * 4);
                const float tot = (s0[0] + s0[1]) + (s0[2] + s0[3]);
                const float r2 = 1.f / (tot * (1.f / DM) + EPS);
#pragma unroll
                for (int bj = 0; bj < 2; ++bj) { pf4 v0 = acc[ai][bj][m][0], v1 = acc[ai][bj][m][1];
#pragma unroll
                    for (int i = 0; i < 4; ++i) { const float a = fmaxf(v0[i], 0.f), b = fmaxf(v1[i], 0.f); v0[i] = a * a * r2; v1[i] = b * b * r2; }
                    v4u w; w.x = pk2(v0[0], v0[1]); w.y = pk2(v0[2], v0[3]); w.z = pk2(v1[0], v1[1]); w.w = pk2(v1[2], v1[3]);
                    *(v4u*)(rowp + bj * 128) = w; } }
    }
};

struct EpiDownNorm { static constexpr bool MID = false;
    static constexpr bool PERM = true;
    float* out; const float* g; float* xs; gu32* cnt; LDSB* lds;
    __device__ __forceinline__ void operator()(pf4 (&acc)[2][2][4][2], const pg8::Unit& u, int wr, int wc, int fr, int fq) const {
        const int col0 = u.pn * 256 + wc * 32 + 8 * fq;
        LAS float* P = (LAS float*)(lds + L_IMP);
        LAS float* S = P + 1024;
#pragma unroll
        for (int ai = 0; ai < 2; ++ai)
#pragma unroll
            for (int m = 0; m < 4; ++m) { const int rl = ai * 128 + wr * 64 + m * 16 + fr; const size_t off = (size_t)(u.pm * 256 + rl) * DM + col0; float sq = 0.f;
#pragma unroll
                for (int bj = 0; bj < 2; ++bj) { const float* p = out + off + bj * 128;
                    const pf4 h0 = *(const pf4*)p + acc[ai][bj][m][0], h1 = *(const pf4*)(p + 4) + acc[ai][bj][m][1];
                    acc[ai][bj][m][0] = h0; acc[ai][bj][m][1] = h1;
                    sq += ((h0[0] * h0[0] + h0[1] * h0[1]) + (h0[2] * h0[2] + h0[3] * h0[3])) + ((h1[0] * h1[0] + h1[1] * h1[1]) + (h1[2] * h1[2] + h1[3] * h1[3])); }
                sq += __shfl_xor(sq, 16); sq += __shfl_xor(sq, 32);
                if (fq == 0) P[rl * 4 + wc] = sq; }
        asm volatile("s_waitcnt lgkmcnt(0)\n\ts_barrier" ::: "memory");
        const int wid = wr * 4 + wc, lane = fq * 16 + fr, t = wid * 64 + lane;
        if (t < 256) { const f32x4 p = *(const LAS f32x4*)(P + t * 4);
            __hip_atomic_store(xs + (size_t)(u.pm * 256 + t) * 4 + u.pn, (p[0] + p[1]) + (p[2] + p[3]), __ATOMIC_RELAXED, __HIP_MEMORY_SCOPE_AGENT); }
        asm volatile("s_waitcnt vmcnt(0)" ::: "memory");
        if (t < 256 && lane == 0) __hip_atomic_fetch_add(cnt + 64 * u.pm, 1u, RLX_AGENT);
        if (wid == 0) {
            unsigned sp = 0;
            while ((unsigned)__builtin_amdgcn_readfirstlane((int)__hip_atomic_load(cnt + 64 * u.pm, RLX_AGENT)) < 16u) { __builtin_amdgcn_s_sleep(2); if (++sp > (1u << 22)) break; }
            __builtin_amdgcn_fence(__ATOMIC_ACQUIRE, "agent");
            asm volatile("s_waitcnt vmcnt(0)" ::: "memory");
        }
        asm volatile("s_waitcnt lgkmcnt(0)\n\ts_barrier" ::: "memory");
        if (t < 256) { const float* sl = xs + (size_t)(u.pm * 256 + t) * 4;
            const float a0 = __hip_atomic_load(sl, RLX_AGENT), a1 = __hip_atomic_load(sl + 1, RLX_AGENT), a2 = __hip_atomic_load(sl + 2, RLX_AGENT), a3 = __hip_atomic_load(sl + 3, RLX_AGENT);
            S[t] = 1.f / sqrtf(((a0 + a1) + (a2 + a3)) * (1.f / DM) + EPS); }
        asm volatile("s_waitcnt lgkmcnt(0)\n\ts_barrier" ::: "memory");
#pragma unroll
        for (int bj = 0; bj < 2; ++bj) { const pf4 g0 = *(const pf4*)(g + col0 + bj * 128), g1 = *(const pf4*)(g + col0 + bj * 128 + 4);
#pragma unroll
            for (int ai = 0; ai < 2; ++ai)
#pragma unroll
                for (int m = 0; m < 4; ++m) { const int rl = ai * 128 + wr * 64 + m * 16 + fr; const float r = S[rl]; float* p = out + (size_t)(u.pm * 256 + rl) * DM + col0 + bj * 128;
                    *(pf4*)p = acc[ai][bj][m][0] * r * g0; *(pf4*)(p + 4) = acc[ai][bj][m][1] * r * g1; } }
    }
};

__device__ __forceinline__ void p2_cumsum_item(Frame& F, int item) {
    const float* fl = (const float*)(F.ws + WS_FL) + (size_t)item * SEQ; float* cb = (float*)(F.ws + WS_CB) + (size_t)item * SEQ;
    const int lane = F.lane;
    float v[64]; float run = 0.f;
#pragma unroll
    for (int i = 0; i < 16; ++i) { const f32x4 t = *(const f32x4*)(fl + lane * 64 + 4 * i); v[4 * i] = t[0]; v[4 * i + 1] = t[1]; v[4 * i + 2] = t[2]; v[4 * i + 3] = t[3]; }
#pragma unroll
    for (int i = 0; i < 64; ++i) { run += v[i]; v[i] = run; }
    float incl = run;
#pragma unroll
    for (int o = 1; o < 64; o <<= 1) { const float t = __shfl_up(incl, o); if (lane >= o) incl += t; }
    const float base = incl - run;
#pragma unroll
    for (int i = 0; i < 16; ++i) { f32x4 t; t[0] = -(v[4 * i] + base) * LOG2E; t[1] = -(v[4 * i + 1] + base) * LOG2E; t[2] = -(v[4 * i + 2] + base) * LOG2E; t[3] = -(v[4 * i + 3] + base) * LOG2E;
        *(f32x4*)(cb + lane * 64 + 4 * i) = t; }
}

__device__ __forceinline__ float gelu_tanh(float x) {
    const float u = 0.7978845608028654f * (x + 0.044715f * x * x * x);
    const float e = __expf(2.f * u);
    const float th = 1.f - 2.f / (e + 1.f);
    return 0.5f * x * (1.f + th);
}

__device__ __forceinline__ void p2_compress_item(Frame& F0, kptr_t kp, int item) {
    typedef float f4 __attribute__((ext_vector_type(4)));
    struct { unsigned char* ws; LDSB* lds; int tid, lane, wave; } F; F.ws = F0.ws; F.lds = F0.lds; F.wave = F0.wave;
    { int t_ = F0.tid; asm volatile("" : "+v"(t_)); F.tid = t_; F.lane = t_ & 63; }
    asm volatile("" : "+s"(F.ws));
    const int kv = item >> 6, bg = (item >> 2) & 15, cblk = item & 3, c0 = 64 * cblk;
    const int lane = F.lane, w = F.wave, fr = lane & 15, fq = lane >> 4;
    const bf16* Ab = (const bf16*)(F.ws + (kv ? WS_VC : WS_KC)) + (size_t)bg * SEQ * 64 + (size_t)c0 * 1024;
    const bf16* W1 = (const bf16*)(F.ws + (kv ? WS_W1V : WS_W1K));
    const bf16* W2 = (const bf16*)(F.ws + (kv ? WS_W2V : WS_W2K));
    const float* B1 = (const float*)(F.ws + (kv ? WS_B1V : WS_B1K));
    const float* b1 = AIN(kp, kv ? 12 : 7);
    const float* b2 = AIN(kp, kv ? 14 : 9);
    LDSB* lds = F.lds;
    LAS bf16* Hs = (LAS bf16*)(lds + 92160);
    f4 acc[4][2];
#pragma unroll
    for (int m = 0; m < 4; ++m) { acc[m][0] = (f4){0.f, 0.f, 0.f, 0.f}; acc[m][1] = (f4){0.f, 0.f, 0.f, 0.f}; }
    const int tid = F.tid, lrow = tid >> 3, lch = tid & 7;
    const bf16* ag = Ab + (size_t)lrow * 1024 + lch * 8;
    const bf16* bg_ = W1 + (size_t)lrow * 2048 + lch * 8;
    const int sto = (lrow * 72 + lch * 8) * 2;
    v4u ra = *(const v4u*)ag, rb[4];
#pragma unroll
    for (int i = 0; i < 4; ++i) rb[i] = *(const v4u*)(bg_ + (size_t)i * 64 * 2048);
    *(LAS v4u*)(lds + sto) = ra;
#pragma unroll
    for (int i = 0; i < 4; ++i) *(LAS v4u*)(lds + 18432 + sto + i * 64 * 144) = rb[i];
    __syncthreads();
    for (int ks = 0; ks < 32; ++ks) {
        const int cb = ks & 1;
        if (ks + 1 < 32) { ra = *(const v4u*)(ag + (ks + 1) * 64);
#pragma unroll
            for (int i = 0; i < 4; ++i) rb[i] = *(const v4u*)(bg_ + (size_t)i * 64 * 2048 + (ks + 1) * 64); }
        const LDSB* As = lds + cb * 9216; const LDSB* Bs = lds + 18432 + cb * 36864;
#pragma unroll
        for (int kh = 0; kh < 2; ++kh) {
            bf16x8 a[4], b[2];
#pragma unroll
            for (int m = 0; m < 4; ++m) a[m] = *(const LAS bf16x8*)(As + ((16 * m + fr) * 72 + 32 * kh + 8 * fq) * 2);
#pragma unroll
            for (int n = 0; n < 2; ++n) b[n] = *(const LAS bf16x8*)(Bs + ((32 * w + 16 * n + fr) * 72 + 32 * kh + 8 * fq) * 2);
#pragma unroll
            for (int m = 0; m < 4; ++m)
#pragma unroll
                for (int n = 0; n < 2; ++n) acc[m][n] = __builtin_amdgcn_mfma_f32_16x16x32_bf16(a[m], b[n], acc[m][n], 0, 0, 0);
        }
        if (ks + 1 < 32) {
            *(LAS v4u*)(lds + (cb ^ 1) * 9216 + sto) = ra;
#pragma unroll
            for (int i = 0; i < 4; ++i) *(LAS v4u*)(lds + 18432 + (cb ^ 1) * 36864 + sto + i * 64 * 144) = rb[i];
        }
        __syncthreads();
    }
    float bbv[2];
#pragma unroll
    for (int n = 0; n < 2; ++n) { const int col = 32 * w + 16 * n + fr; float bb = b1[col];
#pragma unroll 8
        for (int kc = 0; kc < 64; ++kc) bb += B1[kc * 256 + col];
        bbv[n] = bb; }
#pragma unroll
    for (int m = 0; m < 4; ++m)
#pragma unroll
        for (int n = 0; n < 2; ++n) { const int col = 32 * w + 16 * n + fr;
#pragma unroll
            for (int r = 0; r < 4; ++r) Hs[(16 * m + 4 * fq + r) * 264 + col] = (bf16)f2bf(gelu_tanh(acc[m][n][r] + bbv[n])); }
    __syncthreads();
    const int mt = w >> 1, ntA = (w & 1), ntB = (w & 1) + 2;
    f4 oa = (f4){0.f, 0.f, 0.f, 0.f}, ob = (f4){0.f, 0.f, 0.f, 0.f};
#pragma unroll
    for (int k0 = 0; k0 < 256; k0 += 32) {
        const bf16x8 a = *(const LAS bf16x8*)(Hs + (16 * mt + fr) * 264 + k0 + 8 * fq);
        const bf16x8 bA = *(const bf16x8*)(W2 + (size_t)(16 * ntA + fr) * 256 + k0 + 8 * fq);
        const bf16x8 bB = *(const bf16x8*)(W2 + (size_t)(16 * ntB + fr) * 256 + k0 + 8 * fq);
        oa = __builtin_amdgcn_mfma_f32_16x16x32_bf16(a, bA, oa, 0, 0, 0);
        ob = __builtin_amdgcn_mfma_f32_16x16x32_bf16(a, bB, ob, 0, 0, 0);
    }
    const int d1 = 16 * (w & 1) + fr;
    const float bb1 = b2[d1], bb2 = b2[d1 + 32];
    const float* RC = (const float*)(F.ws + WS_ROPEC); const float* RS = (const float*)(F.ws + WS_ROPES);
    bf16* O = (bf16*)(F.ws + (kv ? WS_VCMP : WS_KCMP)) + (size_t)bg * 256 * 64;
#pragma unroll
    for (int r = 0; r < 4; ++r) { const int c = c0 + 16 * mt + 4 * fq + r;
        float x1 = oa[r] + bb1, x2 = ob[r] + bb2;
        if (kv == 0) { int pos = 16 * c + 31; pos = pos > 4095 ? 4095 : pos; const float cs = RC[pos * 32 + d1], sn = RS[pos * 32 + d1];
            const float y1 = x1 * cs - x2 * sn, y2 = x1 * sn + x2 * cs; x1 = y1; x2 = y2; }
        O[(size_t)c * 64 + d1] = (bf16)f2bf(x1); O[(size_t)c * 64 + d1 + 32] = (bf16)f2bf(x2); }
    __syncthreads();
}

__device__ __forceinline__ int crow(int r, int hi) { return (r & 3) + 8 * (r >> 2) + 4 * hi; }
__device__ __forceinline__ void glds16(const void* gsrc, unsigned lds_dst) { unsigned keep;
    asm volatile("s_mov_b32 %0, m0\n\ts_mov_b32 m0, %2\n\ts_nop 0\n\tglobal_load_lds_dwordx4 %1, off\n\ts_mov_b32 m0, %0" : "=&s"(keep) : "v"(gsrc), "s"(lds_dst) : "memory"); }
#define WAIT_BAR(N) asm volatile("s_waitcnt vmcnt(" #N ") lgkmcnt(0)\n\ts_barrier" ::: "memory")
__device__ __forceinline__ unsigned cvtpk_s(float lo, float hi) { typedef float f2 __attribute__((ext_vector_type(2))); typedef __bf16 b2 __attribute__((ext_vector_type(2)));
    f2 v = {lo, hi}; b2 b = __builtin_convertvector(v, b2); return __builtin_bit_cast(unsigned, b); }
__device__ __forceinline__ s16x4 vtr(const LDSB* p) { return __builtin_bit_cast(s16x4, __builtin_amdgcn_ds_read_tr16_b64_v4i16((LAS v4i16_t*)p)); }

__device__ __forceinline__ float xh_max(float a) { auto r = __builtin_amdgcn_permlane32_swap(__float_as_uint(a), __float_as_uint(a), false, false); return fmaxf(__uint_as_float(r[0]), __uint_as_float(r[1])); }
__device__ __forceinline__ float xh_sum(float a) { auto r = __builtin_amdgcn_permlane32_swap(__float_as_uint(a), __float_as_uint(a), false, false); return __uint_as_float(r[0]) + __uint_as_float(r[1]); }
__device__ __forceinline__ float xh_other(float a, int hi) { auto r = __builtin_amdgcn_permlane32_swap(__float_as_uint(a), __float_as_uint(a), false, false); return hi ? __uint_as_float(r[0]) : __uint_as_float(r[1]); }
__device__ __forceinline__ float wave_max_u(float v) {
#define DPPMAX_(ctrl) v = fmaxf(v, __builtin_bit_cast(float, __builtin_amdgcn_update_dpp(__builtin_bit_cast(int, v), __builtin_bit_cast(int, v), ctrl, 0xF, 0xF, false)))
    DPPMAX_(0x111); DPPMAX_(0x112); DPPMAX_(0x114); DPPMAX_(0x118);
#undef DPPMAX_
    const float a = __builtin_bit_cast(float, __builtin_amdgcn_readlane(__builtin_bit_cast(int, v), 15)), b = __builtin_bit_cast(float, __builtin_amdgcn_readlane(__builtin_bit_cast(int, v), 31));
    const float c = __builtin_bit_cast(float, __builtin_amdgcn_readlane(__builtin_bit_cast(int, v), 47)), d = __builtin_bit_cast(float, __builtin_amdgcn_readlane(__builtin_bit_cast(int, v), 63));
    return fmaxf(fmaxf(a, b), fmaxf(c, d));
}
__device__ __forceinline__ void qkt(f32x16& p0, f32x16& p1, const LDSB* kslot, const bf16x8 (&qr)[4], const f32x16& cinit, int r32, int hi) {
    const LDSB* kb = kslot + hi * 1024 + r32 * 16;
#pragma unroll
    for (int d0 = 0; d0 < 4; ++d0) {
        const bf16x8 b0 = *(const LAS bf16x8*)(kb + d0 * 2048);
        const bf16x8 b1 = *(const LAS bf16x8*)(kb + d0 * 2048 + 512);
        if (d0 == 0) { p0 = __builtin_amdgcn_mfma_f32_32x32x16_bf16(b0, qr[0], cinit, 0, 0, 0); p1 = __builtin_amdgcn_mfma_f32_32x32x16_bf16(b1, qr[0], cinit, 0, 0, 0); }
        else { p0 = __builtin_amdgcn_mfma_f32_32x32x16_bf16(b0, qr[d0], p0, 0, 0, 0); p1 = __builtin_amdgcn_mfma_f32_32x32x16_bf16(b1, qr[d0], p1, 0, 0, 0); }
    }
}
__device__ __forceinline__ void pv(f32x16 (&o)[2], const LDSB* vp, const f32x16& p0, const f32x16& p1) {
    v4u pw[4];
    pw[0] = (v4u){cvtpk_s(p0[0], p0[1]), cvtpk_s(p0[2], p0[3]), cvtpk_s(p0[4], p0[5]), cvtpk_s(p0[6], p0[7])};
    pw[1] = (v4u){cvtpk_s(p0[8], p0[9]), cvtpk_s(p0[10], p0[11]), cvtpk_s(p0[12], p0[13]), cvtpk_s(p0[14], p0[15])};
    pw[2] = (v4u){cvtpk_s(p1[0], p1[1]), cvtpk_s(p1[2], p1[3]), cvtpk_s(p1[4], p1[5]), cvtpk_s(p1[6], p1[7])};
    pw[3] = (v4u){cvtpk_s(p1[8], p1[9]), cvtpk_s(p1[10], p1[11]), cvtpk_s(p1[12], p1[13]), cvtpk_s(p1[14], p1[15])};
#pragma unroll
    for (int d0 = 0; d0 < 2; ++d0)
#pragma unroll
        for (int ks = 0; ks < 4; ++ks) {
            const s16x4 lo = vtr(vp + d0 * 4096 + ks * 1024), hi = vtr(vp + d0 * 4096 + ks * 1024 + 512);
            const bf16x8 vf = (bf16x8){lo[0], lo[1], lo[2], lo[3], hi[0], hi[1], hi[2], hi[3]};
            o[d0] = __builtin_amdgcn_mfma_f32_32x32x16_bf16(__builtin_bit_cast(bf16x8, pw[ks]), vf, o[d0], 0, 0, 0);
        }
}
__device__ __forceinline__ float rowmax32(const f32x16& p0, const f32x16& p1) {
    float a = fmaxf(p0[0], p1[0]);
#pragma unroll
    for (int r = 1; r < 16; ++r) a = fmaxf(a, fmaxf(p0[r], p1[r]));
    return xh_max(a);
}
__device__ __forceinline__ float rowsum32(const f32x16& p0, const f32x16& p1) {
    float a = 0.f, b = 0.f;
#pragma unroll
    for (int r = 0; r < 16; ++r) { a += p0[r]; b += p1[r]; }
    return a + b;
}

template <int PITCH>
__device__ __forceinline__ void dma_kv(const bf16* Kh, const bf16* Vh, int key0, unsigned kdst, unsigned vdst, int wid, int lane) {
    const bf16* ksrc = Kh + (size_t)(key0 + lane) * PITCH + wid * 8;
    const bf16* vsrc = Vh + (size_t)(key0 + 16 * (wid & 3) + (lane >> 2)) * PITCH + (wid >> 2) * 32 + (lane & 3) * 8;
    glds16(ksrc, (unsigned)__builtin_amdgcn_readfirstlane(kdst + wid * 1024));
    glds16(vsrc, (unsigned)__builtin_amdgcn_readfirstlane(vdst + wid * 1024));
}


#define SBAR() __builtin_amdgcn_sched_barrier(0)
__device__ __forceinline__ void kload8(bf16x8* kf, const LDSB* kp) {
    kf[0] = *(const LAS bf16x8*)(kp);        kf[1] = *(const LAS bf16x8*)(kp + 512);
    kf[2] = *(const LAS bf16x8*)(kp + 2048); kf[3] = *(const LAS bf16x8*)(kp + 2560);
    kf[4] = *(const LAS bf16x8*)(kp + 4096); kf[5] = *(const LAS bf16x8*)(kp + 4608);
    kf[6] = *(const LAS bf16x8*)(kp + 6144); kf[7] = *(const LAS bf16x8*)(kp + 6656);
}
__device__ __forceinline__ void kload2(bf16x8* kf, const LDSB* kp, int j) { kf[2 * j] = *(const LAS bf16x8*)(kp + j * 2048); kf[2 * j + 1] = *(const LAS bf16x8*)(kp + j * 2048 + 512); }

template <int MODE>
__device__ __forceinline__ void att_mod(f32x16& C0, f32x16& C1, int j, int qabs, int qw0, int cur, unsigned sel_lo, unsigned sel_hi, const LAS float* kbias, int hi) {
    if (MODE == 0) {
        const LAS float* kb = kbias + 64 * j + 4 * hi;
#pragma unroll
        for (int g4 = 0; g4 < 4; ++g4) { const f32x4 b0 = *(const LAS f32x4*)(kb + 8 * g4), b1 = *(const LAS f32x4*)(kb + 32 + 8 * g4);
#pragma unroll
            for (int i = 0; i < 4; ++i) { C0[4 * g4 + i] += b0[i]; C1[4 * g4 + i] += b1[i]; } }
        if (64 * j + 63 > qw0) {
#pragma unroll
            for (int r = 0; r < 16; ++r) { const int kv = 64 * j + crow(r, hi); if (kv > qabs) C0[r] = NEGM; if (kv + 32 > qabs) C1[r] = NEGM; }
        }
    } else if (MODE == 1) {
        const bool sel = ((j < 32 ? (sel_lo >> j) : (sel_hi >> (j - 32))) & 1u) != 0u;
        if (j == cur) {
#pragma unroll
            for (int r = 0; r < 16; ++r) { const int kv = 64 * j + crow(r, hi); if (kv > qabs || !sel) C0[r] = NEGM; if (kv + 32 > qabs || !sel) C1[r] = NEGM; }
        } else {
#pragma unroll
            for (int r = 0; r < 16; ++r) { if (!sel) { C0[r] = NEGM; C1[r] = NEGM; } }
        }
    } else {
        if (j == cur || j + 8 <= cur) {
#pragma unroll
            for (int r = 0; r < 16; ++r) { const int kv = 64 * j + crow(r, hi);
                if (kv > qabs || kv < qabs - 511) C0[r] = NEGM; if (kv + 32 > qabs || kv + 32 < qabs - 511) C1[r] = NEGM; }
        }
    }
}

template <int MODE, int PITCH, int THRL>
__device__ __forceinline__ void attn_fast(LDSB* lds, const bf16* Kh, const bf16* Vh, const LAS unsigned char* tl, int NT_in, const bf16x8 (&qr)[4], int qabs, int qw0, int cur,
                                          unsigned sel_lo, unsigned sel_hi, const LAS float* kbias, float skipb, f32x16 (&o)[2], float& l_out, int wid, int lane) {
    int NT = NT_in;
    const int r32 = lane & 31, hi = lane >> 5;
    const unsigned lds0 = (unsigned)(uintptr_t)lds;
    LAS float* wsf = (LAS float*)(lds + L_WS) + wid * 256;
    const bf16* ksrc = Kh + (size_t)lane * PITCH + wid * 8;
    const bf16* vsrc = Vh + (size_t)(16 * (wid & 3) + (lane >> 2)) * PITCH + (wid >> 2) * 32 + (lane & 3) * 8;
    const unsigned kdst = lds0 + L_K + wid * 1024, vdst = lds0 + L_V + wid * 1024;
#define TILE(t) __builtin_amdgcn_readfirstlane((int)tl[t])
#define DMA_K(t, slot) glds16(ksrc + (size_t)TILE(t) * (64 * PITCH), (unsigned)__builtin_amdgcn_readfirstlane(kdst + (slot)))
#define DMA_V(t, slot) glds16(vsrc + (size_t)TILE(t) * (64 * PITCH), (unsigned)__builtin_amdgcn_readfirstlane(vdst + (slot)))
    const LDSB* kp0 = lds + L_K + hi * 1024 + r32 * 16;
    const LDSB* vp0 = lds + L_V + ((lane >> 4) & 1) * 32 + (lane & 3) * 8 + (4 * hi + ((lane & 15) >> 2)) * 64;
    bf16x8 kf[8];
    float mhat = 0.f, l_reg = 0.f;
    f32x16 negm;
#pragma unroll
    for (int r = 0; r < 16; ++r) { negm[r] = 0.f; o[0][r] = 0.f; o[1][r] = 0.f; }
    asm volatile("" : "+v"(negm));
    bool resc = false;
    f32x16 pA0, pA1, pB0, pB1;
    int sl_prev = 0, sl_cur = 0, sl_next = SLOTB, sl_last = 0;
#define ROT() do { sl_prev = sl_cur; sl_cur = sl_next; sl_next = (sl_next == 2 * SLOTB) ? 0 : sl_next + SLOTB; } while (0)
#define RESC() do { if (resc) { LDS_WAIT(); \
        _Pragma("unroll") for (int d_ = 0; d_ < 2; ++d_) _Pragma("unroll") for (int r = 0; r < 16; ++r) o[d_][r] *= wsf[crow(r, hi)]; } } while (0)
#define ENDW(tt) do { if ((tt) + 3 < NT) { WAIT_BAR(2); } else if ((tt) + 2 < NT) { WAIT_BAR(1); } else { WAIT_BAR(0); } } while (0)
    DMA_K(0, 0); DMA_V(0, 0); if (NT > 1) DMA_K(1, SLOTB); if (NT > 2) DMA_K(2, 2 * SLOTB);
    if (NT > 2) { WAIT_BAR(3); } else if (NT > 1) { WAIT_BAR(2); } else { WAIT_BAR(1); }
    {
        const int j0 = TILE(0);
        qkt(pA0, pA1, lds + L_K, qr, negm, r32, hi);
        att_mod<MODE>(pA0, pA1, j0, qabs, qw0, cur, sel_lo, sel_hi, kbias, hi);
        const float rm = rowmax32(pA0, pA1);
        mhat += rm;
#pragma unroll
        for (int r = 0; r < 16; ++r) { pA0[r] -= rm; pA1[r] -= rm; negm[r] = -mhat; }
        asm volatile("" : "+v"(negm));
#pragma unroll
        for (int r = 0; r < 16; ++r) { pA0[r] = __builtin_amdgcn_exp2f(pA0[r]); pA1[r] = __builtin_amdgcn_exp2f(pA1[r]); }
    }
    WAIT_BAR(0);
    if (NT > 3) DMA_K(3, 0);
    if (NT > 1) DMA_V(1, SLOTB);
    ROT();
    if (NT > 1) kload8(kf, kp0 + sl_cur);
    ENDW(0);
    s16x4 vlo[8], vhi[8]; v4u pw0, pw1, pw2, pw3;
#define PKW(P, B) cvtpk_s(P[B], P[B + 1])
#define PAF(k) __builtin_bit_cast(bf16x8, pw##k)
#define VFR(i) (bf16x8){vlo[i][0], vlo[i][1], vlo[i][2], vlo[i][3], vhi[i][0], vhi[i][1], vhi[i][2], vhi[i][3]}
#define PIN(x) asm volatile("" : "+v"(x))
#define MX3(a, b, c) __builtin_fmaxf(__builtin_fmaxf((a), (b)), (c))
#define GAPA(MF, A0, A1, A2, A3, W0, W1, PW) do { MF; sacc += A0; sacc += A1; sacc += A2; sacc += A3; PIN(sacc); W0; W1; PIN(PW); SBAR(); } while (0)
#define EX(v) __builtin_amdgcn_exp2f(v)
#define GAPB(MF, X, B) do { MF; X[B] = EX(X[B]); X[B + 1] = EX(X[B + 1]); X[B + 2] = EX(X[B + 2]); X[B + 3] = EX(X[B + 3]); PIN(X); SBAR(); } while (0)
#define VRD(i) do { vlo[i] = vtr(vp_ + (((i) >> 2) * 4096 + ((i) & 3) * 1024)); vhi[i] = vtr(vp_ + (((i) >> 2) * 4096 + ((i) & 3) * 1024 + 512)); } while (0)
#define KRD(G, j) do { if (G) { kload2(kf, kp0 + sl_next, j); SBAR(); } } while (0)
#define MFMA32 __builtin_amdgcn_mfma_f32_32x32x16_bf16
#define STEP(C0, C1, P0, P1, t) do { const int jt_ = TILE(t); const bool GK_ = (t) + 3 < NT, GV_ = (t) + 1 < NT; sl_last = sl_cur; SBAR(); \
    const LDSB* vp_ = vp0 + sl_prev; \
    VRD(0); SBAR(); float sacc = (P0[0] + P0[1]); \
    GAPA(C0 = MFMA32(kf[0], qr[0], negm, 0, 0, 0), P0[2], P0[3], P0[4], P0[5],     pw0[0] = PKW(P0, 0), pw0[1] = PKW(P0, 2), pw0); \
    VRD(4); SBAR(); GAPA(C1 = MFMA32(kf[1], qr[0], negm, 0, 0, 0), P0[6], P0[7], P0[8], P0[9],     pw0[2] = PKW(P0, 4), pw0[3] = PKW(P0, 6), pw0); \
    VRD(1); SBAR(); GAPA(C0 = MFMA32(kf[2], qr[1], C0, 0, 0, 0),   P0[10], P0[11], P0[12], P0[13], pw1[0] = PKW(P0, 8), pw1[1] = PKW(P0, 10), pw1); \
    VRD(5); SBAR(); GAPA(C1 = MFMA32(kf[3], qr[1], C1, 0, 0, 0),   P0[14], P0[15], P1[0], P1[1],   pw1[2] = PKW(P0, 12), pw1[3] = PKW(P0, 14), pw1); \
    VRD(2); SBAR(); GAPA(C0 = MFMA32(kf[4], qr[2], C0, 0, 0, 0),   P1[2], P1[3], P1[4], P1[5],     pw2[0] = PKW(P1, 0), pw2[1] = PKW(P1, 2), pw2); \
    VRD(6); SBAR(); GAPA(C1 = MFMA32(kf[5], qr[2], C1, 0, 0, 0),   P1[6], P1[7], P1[8], P1[9],     pw2[2] = PKW(P1, 4), pw2[3] = PKW(P1, 6), pw2); \
    VRD(3); SBAR(); GAPA(C0 = MFMA32(kf[6], qr[3], C0, 0, 0, 0),   P1[10], P1[11], P1[12], P1[13], pw3[0] = PKW(P1, 8), pw3[1] = PKW(P1, 10), pw3); \
    VRD(7); SBAR(); GAPA(C1 = MFMA32(kf[7], qr[3], C1, 0, 0, 0),   P1[14], P1[15], 0.f, 0.f,       pw3[2] = PKW(P1, 12), pw3[3] = PKW(P1, 14), pw3); \
    l_reg += sacc; \
    if (GK_) { DMA_K((t) + 3, sl_cur); } if (GV_) { DMA_V((t) + 1, sl_next); } \
    att_mod<MODE>(C0, C1, jt_, qabs, qw0, cur, sel_lo, sel_hi, kbias, hi); \
    { float a = MX3(C0[0], C0[1], C1[0]), b = MX3(C0[2], C0[3], C1[1]); a = MX3(a, C1[2], C1[3]); \
      _Pragma("unroll") for (int r = 4; r < 16; r += 4) { a = MX3(a, C0[r], C0[r + 1]); b = MX3(b, C0[r + 2], C0[r + 3]); a = MX3(a, C1[r], C1[r + 1]); b = MX3(b, C1[r + 2], C1[r + 3]); } \
      float rm = xh_max(__builtin_fmaxf(a, b)); \
      resc = false; \
      if (__builtin_expect(__any(rm > (float)THRL), 0)) { const float dl = __builtin_fmaxf(rm, 0.f); mhat += dl; \
        _Pragma("unroll") for (int r = 0; r < 16; ++r) { C0[r] -= dl; C1[r] -= dl; } \
        _Pragma("unroll") for (int r = 0; r < 16; ++r) negm[r] = -mhat; asm volatile("" : "+v"(negm)); \
        const float f = __builtin_amdgcn_exp2f(-dl); l_reg *= f; if (hi == 0) wsf[r32] = f; resc = true; } } \
    SBAR(); \
    GAPB(o[0] = MFMA32(PAF(0), VFR(0), o[0], 0, 0, 0), C0, 0); \
    GAPB(o[1] = MFMA32(PAF(0), VFR(4), o[1], 0, 0, 0), C0, 4); \
    KRD(GV_, 0); GAPB(o[0] = MFMA32(PAF(1), VFR(1), o[0], 0, 0, 0), C0, 8); \
    KRD(GV_, 1); GAPB(o[1] = MFMA32(PAF(1), VFR(5), o[1], 0, 0, 0), C0, 12); \
    KRD(GV_, 2); GAPB(o[0] = MFMA32(PAF(2), VFR(2), o[0], 0, 0, 0), C1, 0); \
    KRD(GV_, 3); GAPB(o[1] = MFMA32(PAF(2), VFR(6), o[1], 0, 0, 0), C1, 4); \
    GAPB(o[0] = MFMA32(PAF(3), VFR(3), o[0], 0, 0, 0), C1, 8); \
    GAPB(o[1] = MFMA32(PAF(3), VFR(7), o[1], 0, 0, 0), C1, 12); \
    } while (0)
    int t = 1;
    for (; t + 1 < NT; t += 2) {
        STEP(pB0, pB1, pA0, pA1, t);
        if (MODE == 0 && t == 3 && NT_in > 8) { const float wm = -wave_max_u(-mhat); if (lane == 0) wsf[192] = wm; }
        ENDW(t);     RESC(); ROT();
        if (MODE == 0 && t == 3 && NT_in > 8) {
            const LAS float* wsall = (const LAS float*)(lds + L_WS);
            float mn = wsall[192];
#pragma unroll
            for (int w = 1; w < 8; ++w) mn = fminf(mn, wsall[w * 256 + 192]);
            const float thr = mn - skipb;
            const bool keep = (lane < NT_in) && (kbias[64 * lane + 63] >= thr);
            const unsigned long long bal = __ballot(keep);
            const int jkeep = bal ? __builtin_ctzll(bal) : 0;
            int ntn = NT_in - jkeep; if (ntn < 8) ntn = 8;
            NT = __builtin_amdgcn_readfirstlane(ntn < NT ? ntn : NT);
        }
        STEP(pA0, pA1, pB0, pB1, t + 1); ENDW(t + 1); RESC(); ROT();
    }
    const LDSB* vlane_p = lds + L_V + ((lane >> 4) & 1) * 32 + (lane & 3) * 8 + (4 * hi + ((lane & 15) >> 2)) * 64;
    if (t < NT) {
        STEP(pB0, pB1, pA0, pA1, t); ENDW(t); RESC();
        l_reg += rowsum32(pB0, pB1);
        pv(o, vlane_p + sl_last, pB0, pB1);
    } else {
        l_reg += rowsum32(pA0, pA1);
        pv(o, vlane_p + sl_last, pA0, pA1);
    }
    l_out = xh_sum(l_reg);
    asm volatile("s_waitcnt lgkmcnt(0)\n\ts_barrier" ::: "memory");
#undef TILE
#undef DMA_K
#undef DMA_V
#undef ROT
#undef RESC
#undef ENDW
#undef PKW
#undef PAF
#undef VFR
#undef PIN
#undef MX3
#undef GAPA
#undef EX
#undef GAPB
#undef VRD
#undef KRD
#undef MFMA32
#undef STEP
}

__device__ __forceinline__ void load_rowvec(float (&fac)[16], const LAS float* tab, int hi) {
#pragma unroll
    for (int g4 = 0; g4 < 4; ++g4) { const f32x4 ff = *(const LAS f32x4*)(tab + 8 * g4 + 4 * hi);
#pragma unroll
        for (int i = 0; i < 4; ++i) fac[4 * g4 + i] = ff[i]; }
}

template <int PITCHO>
__device__ __forceinline__ void store_o_tile(LDSB* stage, const f32x16 (&o)[2], bf16* Ow, float* ssq, int lane) {
    const int r32 = lane & 31, hi = lane >> 5;
    LAS bf16* stg = (LAS bf16*)stage;
#pragma unroll
    for (int r = 0; r < 16; ++r) { const int orow = crow(r, hi);
#pragma unroll
        for (int d0 = 0; d0 < 2; ++d0) stg[orow * 64 + d0 * 32 + r32] = (bf16)f2bf(o[d0][r]); }
    LDS_WAIT();
#pragma unroll
    for (int i = 0; i < 4; ++i) { const int row = i * 8 + (lane >> 3), ch = lane & 7; const v4u v = *(const LAS v4u*)(stg + row * 64 + ch * 8); *(v4u*)(Ow + (size_t)row * PITCHO + ch * 8) = v;
        const unsigned w[4] = {v.x, v.y, v.z, v.w}; float sq = 0.f;
#pragma unroll
        for (int k = 0; k < 4; ++k) { const float a = __builtin_bit_cast(float, w[k] << 16), b = __builtin_bit_cast(float, w[k] & 0xffff0000u); sq += a * a + b * b; }
        sq += __builtin_bit_cast(float, __builtin_amdgcn_update_dpp(0, __builtin_bit_cast(int, sq), 0xB1, 0xF, 0xF, true));
        sq += __builtin_bit_cast(float, __builtin_amdgcn_update_dpp(0, __builtin_bit_cast(int, sq), 0x4E, 0xF, 0xF, true));
        sq += __builtin_bit_cast(float, __builtin_amdgcn_update_dpp(0, __builtin_bit_cast(int, sq), 0x141, 0xF, 0xF, true));
        if (ch == 0) ssq[(size_t)row * 16] = sq; }
    LDS_WAIT();
}

__device__ __forceinline__ void fox_unit(Frame& F0, int b, int h, int qb) {
    struct { unsigned char* ws; LDSB* lds; int tid, wave; } F; F.ws = F0.ws; F.lds = F0.lds; F.tid = F0.tid; F.wave = F0.wave;
    asm volatile("" : "+s"(F.ws));
    LDSB* lds = F.lds; int tid_ = F.tid; asm volatile("" : "+v"(tid_));
    const int tid = tid_, lane = tid & 63, wid = F.wave, r32 = lane & 31, hi = lane >> 5;
    const int q0 = 256 * qb, NT = 4 * qb + 4;
    const float* cb = (const float*)(F.ws + WS_CB) + (size_t)(b * 8 + h) * SEQ;
    LAS float* kb = (LAS float*)(lds + L_ACC);
    for (int i = tid; i < q0 + 256; i += NTHR) kb[i] = cb[i];
    LAS unsigned char* tl = (LAS unsigned char*)(lds + L_TL);
    if (tid < NT) tl[tid] = (unsigned char)(NT - 1 - tid);
    const bf16* Qw = (const bf16*)(F.ws + WS_QF) + ((size_t)b * SEQ + q0 + 32 * wid) * 512 + h * 64;
    bf16x8 qr[4];
#pragma unroll
    for (int d0 = 0; d0 < 4; ++d0) qr[d0] = *(const bf16x8*)(Qw + (size_t)r32 * 512 + d0 * 16 + hi * 8);
    {
        float q2 = 0.f;
#pragma unroll
        for (int d0 = 0; d0 < 4; ++d0)
#pragma unroll
            for (int e = 0; e < 8; ++e) { const float v = bf2f((unsigned short)qr[d0][e]); q2 += v * v; }
        q2 = xh_sum(q2);
        const float wq = wave_max_u(q2);
        if (lane == 0) ((LAS float*)(lds + L_WS))[wid * 256 + 193] = wq;
    }
    LDS_WAIT(); __syncthreads();
    float skipb;
    {   const LAS float* wsall = (const LAS float*)(lds + L_WS); float qm = wsall[193];
#pragma unroll
        for (int w = 1; w < 8; ++w) qm = fmaxf(qm, wsall[w * 256 + 193]);
        const float km = __uint_as_float(((const unsigned*)(F.ws + WS_CTL))[CW_KMAX + b * 8 + h]);
        skipb = 161.f + 1.02f * sqrtf(qm * km); }
    const bf16* Kh = (const bf16*)(F.ws + WS_KF) + (size_t)b * SEQ * 512 + h * 64;
    const bf16* Vh = (const bf16*)(F.ws + WS_VF) + (size_t)b * SEQ * 512 + h * 64;
    f32x16 o[2]; float l;
    attn_fast<0, 512, 8>(lds, Kh, Vh, tl, NT, qr, q0 + 32 * wid + r32, q0 + 32 * wid, 0, 0u, 0u, kb, skipb, o, l, wid, lane);
    LAS float* wsf = (LAS float*)(lds + L_WS) + wid * 256;
    if (hi == 0) wsf[32 + r32] = 1.f / l;
    LDS_WAIT();
    float fac[16]; load_rowvec(fac, wsf + 32, hi);
#pragma unroll
    for (int r = 0; r < 16; ++r) { o[0][r] *= fac[r]; o[1][r] *= fac[r]; }
    bf16* Ow = (bf16*)(F.ws + WS_Y) + ((size_t)b * SEQ + q0 + 32 * wid) * 1024 + h * 64;
    store_o_tile<1024>(lds + L_ACC + 16384 + wid * 4096, o, Ow, (float*)(F.ws + WS_SSQY) + ((size_t)b * SEQ + q0 + 32 * wid) * 16 + h, lane);
    __syncthreads();
}

__device__ __forceinline__ void nsa_unit(Frame& F0, int b, int g, int cur) {
    struct { unsigned char* ws; LDSB* lds; int tid, wave; } F; F.ws = F0.ws; F.lds = F0.lds; F.tid = F0.tid; F.wave = F0.wave;
    asm volatile("" : "+s"(F.ws));
    LDSB* lds = F.lds; int tid_ = F.tid; asm volatile("" : "+v"(tid_));
    const int tid = tid_, lane = tid & 63, wid = F.wave, r32 = lane & 31, hi = lane >> 5;
    const int bg = b * 2 + g, hh = wid >> 1, head = 4 * g + hh, qh = wid & 1, qq = 32 * qh + r32, qpos = 64 * cur + qq;
    const unsigned lds0 = (unsigned)(uintptr_t)lds;
    LAS float* wsf = (LAS float*)(lds + L_WS) + wid * 256;
    LAS float* accw = (LAS float*)(lds + L_ACC) + wid * 2048;
    const size_t row0 = (size_t)b * SEQ + 64 * cur + 32 * qh;
    const bf16* Qw = (const bf16*)(F.ws + WS_QN) + row0 * 512 + head * 64;
    bf16x8 qr[4];
#pragma unroll
    for (int d0 = 0; d0 < 4; ++d0) qr[d0] = *(const bf16x8*)(Qw + (size_t)r32 * 512 + d0 * 16 + hi * 8);
    if (tid < 2) ((LAS unsigned*)(lds + L_TL + 128))[tid] = 0u;
    if (lane < 32) { const float* gp = (const float*)(F.ws + WS_GATE) + (row0 + lane) * 24 + head * 3;
        wsf[64 + lane] = gp[0]; wsf[96 + lane] = gp[1]; wsf[128 + lane] = gp[2]; }
    LDS_WAIT();
    {
        const bf16* Kc = (const bf16*)(F.ws + WS_KCMP) + (size_t)bg * 256 * 64;
        const bf16* Vc = (const bf16*)(F.ws + WS_VCMP) + (size_t)bg * 256 * 64;
        const int ntl = (4 * cur + 66) >> 6;
#pragma unroll
        for (int tl = 0; tl < 4; ++tl) if (tl < ntl) dma_kv<64>(Kc, Vc, 64 * tl, lds0 + L_K + tl * SLOTB, lds0 + L_V + tl * SLOTB, wid, lane);
        WAIT_BAR(0);
        f32x16 zero;
#pragma unroll
        for (int r = 0; r < 16; ++r) zero[r] = 0.f;
        float mrun = -1e30f;
#pragma unroll 1
        for (int tl = 0; tl < ntl; ++tl) {
            f32x16 p0, p1;
            qkt(p0, p1, lds + L_K + tl * SLOTB, qr, zero, r32, hi);
#pragma unroll
            for (int r = 0; r < 16; ++r) { const int c = 64 * tl + crow(r, hi); if (16 * c + 31 > qpos) p0[r] = NEGM; if (16 * (c + 32) + 31 > qpos) p1[r] = NEGM; }
            mrun = fmaxf(mrun, rowmax32(p0, p1));
            asm volatile("" ::: "memory");
        }
        f32x16 o[2];
#pragma unroll
        for (int r = 0; r < 16; ++r) { o[0][r] = 0.f; o[1][r] = 0.f; }
        float impv[4][8]; float prevY3 = 0.f, lsum = 0.f;
        const int vlane = ((lane >> 4) & 1) * 32 + (lane & 3) * 8 + (4 * hi + ((lane & 15) >> 2)) * 64;
#pragma unroll
        for (int tl = 0; tl < 4; ++tl) {
            if (tl < ntl) {
                f32x16 p0, p1;
                qkt(p0, p1, lds + L_K + tl * SLOTB, qr, zero, r32, hi);
#pragma unroll
                for (int r = 0; r < 16; ++r) { const int c = 64 * tl + crow(r, hi);
                    p0[r] = (16 * c + 31 > qpos) ? 0.f : __builtin_amdgcn_exp2f(p0[r] - mrun);
                    p1[r] = (16 * (c + 32) + 31 > qpos) ? 0.f : __builtin_amdgcn_exp2f(p1[r] - mrun); }
                lsum += rowsum32(p0, p1);
                float rX[4], rY[4];
#pragma unroll
                for (int g4 = 0; g4 < 4; ++g4) { rX[g4] = xh_other(p0[4 * g4 + 3], hi); rY[g4] = xh_other(p1[4 * g4 + 3], hi); }
#pragma unroll
                for (int g4 = 0; g4 < 4; ++g4) {
                    const float qs0 = (p0[4 * g4] + p0[4 * g4 + 1]) + (p0[4 * g4 + 2] + p0[4 * g4 + 3]);
                    const float qs1 = (p1[4 * g4] + p1[4 * g4 + 1]) + (p1[4 * g4 + 2] + p1[4 * g4 + 3]);
                    const float lo0 = (g4 > 0) ? rX[g4 > 0 ? g4 - 1 : 0] : prevY3;
                    const float lo1 = (g4 > 0) ? rY[g4 > 0 ? g4 - 1 : 0] : rX[3];
                    impv[tl][g4] = qs0 + (hi ? rX[g4] : lo0);
                    impv[tl][4 + g4] = qs1 + (hi ? rY[g4] : lo1);
                }
                prevY3 = rY[3];
                pv(o, lds + L_V + tl * SLOTB + vlane, p0, p1);
                asm volatile("" ::: "memory");
            } else {
#pragma unroll
                for (int e = 0; e < 8; ++e) impv[tl][e] = 0.f;
            }
        }
        const float ltot = xh_sum(lsum);
        const float invl = ltot > 0.f ? 1.f / ltot : 0.f;
        LAS float* imp = (LAS float*)(lds + L_IMP);
#pragma unroll
        for (int hd = 0; hd < 4; ++hd) {
            if (hh == hd) {
#pragma unroll
                for (int tl = 0; tl < 4; ++tl)
#pragma unroll
                    for (int e = 0; e < 8; ++e) { const int jj = 16 * tl + 8 * (e >> 2) + 2 * (e & 3) + hi; LAS float* p = imp + qq * 65 + jj;
                        if (hd == 0) *p = impv[tl][e] * invl; else *p += impv[tl][e] * invl; }
            }
            LDS_WAIT(); __syncthreads();
        }
        if (hi == 0) wsf[32 + r32] = invl;
        LDS_WAIT();
        float gc[16], il[16]; load_rowvec(gc, wsf + 64, hi); load_rowvec(il, wsf + 32, hi);
#pragma unroll
        for (int d0 = 0; d0 < 2; ++d0)
#pragma unroll
            for (int r = 0; r < 16; ++r) accw[(d0 * 16 + r) * 64 + lane] = o[d0][r] * (gc[r] * il[r]);
        LDS_WAIT();
    }
    if (cur >= 16) {
        LAS float* imp = (LAS float*)(lds + L_IMP);
        const int q = tid >> 3, part = tid & 7;
        if (part == 0) { imp[q * 65] += 1e4f; imp[q * 65 + cur] += 1e4f; imp[q * 65 + cur - 1] += 1e4f; }
        LDS_WAIT(); __syncthreads();
        const LAS float* irow = imp + q * 65;
        float sc[8];
#pragma unroll
        for (int i = 0; i < 8; ++i) { const int jj = part * 8 + i; sc[i] = (jj <= cur) ? irow[jj] : -1.f; }
        int rank[8];
#pragma unroll
        for (int i = 0; i < 8; ++i) rank[i] = 0;
        const int nv = cur + 1, e0 = (8 * part < nv) ? 8 * part : nv, e1 = (8 * part + 8 < nv) ? 8 * part + 8 : nv;
        for (int jp = 0; jp < e0; ++jp) { const float v = irow[jp];
#pragma unroll
            for (int i = 0; i < 8; ++i) rank[i] += (v >= sc[i]) ? 1 : 0; }
        for (int jp = e0; jp < e1; ++jp) { const float v = irow[jp];
#pragma unroll
            for (int i = 0; i < 8; ++i) { const int jj = part * 8 + i; rank[i] += (v > sc[i] || (v == sc[i] && jp < jj)) ? 1 : 0; } }
        for (int jp = e1; jp < nv; ++jp) { const float v = irow[jp];
#pragma unroll
            for (int i = 0; i < 8; ++i) rank[i] += (v > sc[i]) ? 1 : 0; }
        unsigned bits = 0;
#pragma unroll
        for (int i = 0; i < 8; ++i) bits |= (rank[i] < 16 ? 1u : 0u) << i;
        ((LAS unsigned char*)(lds + L_SEL))[q * 8 + part] = (unsigned char)bits;
        __hip_atomic_fetch_or((LAS unsigned*)(lds + L_TL + 128) + (part >> 2), bits << (8 * (part & 3)), __ATOMIC_RELAXED, __HIP_MEMORY_SCOPE_WORKGROUP);
        LDS_WAIT(); __syncthreads();
    } else {
        if (tid < 128) ((LAS unsigned*)(lds + L_SEL))[tid] = (tid & 1) ? 0u : ((1u << (cur + 1)) - 1u);
        if (tid == 0) ((LAS unsigned*)(lds + L_TL + 128))[0] = (1u << (cur + 1)) - 1u;
        LDS_WAIT(); __syncthreads();
    }
    const LAS unsigned* selw = (const LAS unsigned*)(lds + L_SEL);
    const unsigned sel_lo = selw[qq * 2], sel_hi = selw[qq * 2 + 1];
    const unsigned ulo = ((const LAS unsigned*)(lds + L_TL + 128))[0], uhi = ((const LAS unsigned*)(lds + L_TL + 128))[1];
    unsigned long long umask = ((unsigned long long)uhi << 32) | ulo;
    umask &= (cur >= 63) ? ~0ull : ((1ull << (cur + 1)) - 1ull);
    const int jlo = cur >= 8 ? cur - 8 : 0;
    LAS unsigned char* tls = (LAS unsigned char*)(lds + L_TL);
    LAS unsigned char* tlw = tls + 64;
    if (tid < 64) {
        if ((umask >> tid) & 1ull) tls[__builtin_popcountll(umask & ((1ull << tid) - 1ull))] = (unsigned char)tid;
        if (tid <= cur - jlo) tlw[tid] = (unsigned char)(jlo + tid);
    }
    LDS_WAIT(); __syncthreads();
    const int NTs = __builtin_amdgcn_readfirstlane(__builtin_popcountll(umask)), NTw = cur - jlo + 1;
    {
        const bf16* Kh = (const bf16*)(F.ws + WS_KS) + (size_t)bg * SEQ * 64;
        const bf16* Vh = (const bf16*)(F.ws + WS_VS) + (size_t)bg * SEQ * 64;
        f32x16 o[2]; float l;
        attn_fast<1, 64, 8>(lds, Kh, Vh, tls, NTs, qr, qpos, 0, cur, sel_lo, sel_hi, nullptr, 0.f, o, l, wid, lane);
        if (hi == 0) wsf[32 + r32] = 1.f / l;
        LDS_WAIT();
        float fl[16], gs[16]; load_rowvec(fl, wsf + 32, hi); load_rowvec(gs, wsf + 96, hi);
#pragma unroll
        for (int d0 = 0; d0 < 2; ++d0)
#pragma unroll
            for (int r = 0; r < 16; ++r) accw[(d0 * 16 + r) * 64 + lane] += o[d0][r] * (fl[r] * gs[r]);
        LDS_WAIT();
    }
    {
        const bf16* Kh = (const bf16*)(F.ws + WS_KW) + (size_t)bg * SEQ * 64;
        const bf16* Vh = (const bf16*)(F.ws + WS_VW) + (size_t)bg * SEQ * 64;
        f32x16 o[2]; float l;
        attn_fast<2, 64, 8>(lds, Kh, Vh, tlw, NTw, qr, qpos, 0, cur, 0u, 0u, nullptr, 0.f, o, l, wid, lane);
        if (hi == 0) wsf[32 + r32] = 1.f / l;
        LDS_WAIT();
        float fl[16], gate_win[16]; load_rowvec(fl, wsf + 32, hi); load_rowvec(gate_win, wsf + 128, hi);
#pragma unroll
        for (int d0 = 0; d0 < 2; ++d0)
#pragma unroll
            for (int r = 0; r < 16; ++r) o[d0][r] = accw[(d0 * 16 + r) * 64 + lane] + o[d0][r] * (fl[r] * gate_win[r]);
        LDS_WAIT();
        bf16* Ow = (bf16*)(F.ws + WS_Y) + row0 * 1024 + 512 + head * 64;
        store_o_tile<1024>((LDSB*)accw, o, Ow, (float*)(F.ws + WS_SSQY) + row0 * 16 + 8 + head, lane);
    }
    __syncthreads();
}

__device__ __forceinline__ void dep_publish(Frame& F, gu32* w0, gu32* w1) {
    asm volatile("s_waitcnt vmcnt(0)" ::: "memory"); __syncthreads();
    if (F.tid == 0) { __builtin_amdgcn_fence(__ATOMIC_RELEASE, "agent"); asm volatile("s_waitcnt vmcnt(0)" ::: "memory");
        __hip_atomic_fetch_add(w0, 1u, RLX_AGENT); if (w1) __hip_atomic_fetch_add(w1, 1u, RLX_AGENT); }
}
__device__ __forceinline__ void dep_wait(Frame& F, gu32* w, unsigned need, gu32* wall, unsigned needall, int flagword) {
    if (F.wave == 0) {
        unsigned sp = 0;
        while ((unsigned)__builtin_amdgcn_readfirstlane((int)__hip_atomic_load(w, RLX_AGENT)) < need) { __builtin_amdgcn_s_sleep(4); if (++sp > (1u << 22)) break; }
        const unsigned tot = wall ? (unsigned)__builtin_amdgcn_readfirstlane((int)__hip_atomic_load(wall, RLX_AGENT)) : 0u;
        __builtin_amdgcn_fence(__ATOMIC_ACQUIRE, "agent");
        asm volatile("s_waitcnt vmcnt(0)" ::: "memory");
        if (F.lane == 0 && (!wall || tot >= needall)) F.MISC[flagword] = 1u;
    }
    LDS_WAIT(); __syncthreads();
}

constexpr int NSA_COST0 = 24;
__device__ __forceinline__ void p3_attention(Frame& F, kptr_t kp) {
    LAS unsigned short* order = (LAS unsigned short*)(F.lds + L_ORD);
    for (int id = F.tid; id < 2048; id += NTHR) {
        int pos;
        if (id >= 1024 && ((id - 1024) >> 6) < 2) pos = id - 1024;
        else {
            const int c = id < 1024 ? (63 - (id >> 4)) + NSA_COST0 : 4 * (15 - ((id - 1024) >> 6)) + 4;
            pos = 128;
            { int lo = c - NSA_COST0 + 1; if (lo < 0) lo = 0; int cnt = 64 - lo; if (cnt < 0) cnt = 0; pos += 16 * cnt; }
            { int cnt = 0; for (int qb = 0; qb < 14; ++qb) cnt += (4 * qb + 4 > c) ? 1 : 0; pos += 64 * cnt; }
            if (id < 1024) pos += (id & 15);
            else { const int cn = c - NSA_COST0; if (cn >= 0 && cn <= 63) pos += 16; pos += (id & 63); }
        }
        order[pos] = (unsigned short)id;
    }
    if (F.vcu < 8) { p2_cumsum_item(F, F.vcu * NWAVES + F.wave); dep_publish(F, F.ctl + CW_CS, nullptr); }
    LDS_WAIT(); __syncthreads();
    if (F.vcu >= F.G - 128 || F.G < 136) {
        for (int it = (F.G < 136) ? F.vcu : F.vcu - (F.G - 128); it < 128; it += (F.G < 136) ? F.G : 128) {
            p2_compress_item(F, kp, it);
            dep_publish(F, F.ctl + CW_CMP + 64 * ((it >> 2) & 15), F.ctl + CW_CMPT);
        }
    }
    gu32* qhead = F.ctl + CW_Q_ATT;
    for (;;) {
        if (F.tid == 0) F.MISC[0] = __hip_atomic_fetch_add(qhead, 1u, RLX_AGENT);
        LDS_WAIT(); __syncthreads();
        const unsigned k = F.MISC[0];
        if (k >= 2048u) break;
        const int id = (int)order[k];
        __syncthreads();
        if (id < 1024) {
            if (F.MISC[17] == 0u) dep_wait(F, F.ctl + CW_CMP + 64 * (id & 15), 8u, F.ctl + CW_CMPT, 128u, 17);
            nsa_unit(F, (id & 15) >> 1, id & 1, 63 - (id >> 4));
        } else {
            if (F.MISC[16] == 0u) dep_wait(F, F.ctl + CW_CS, 8u, nullptr, 0u, 16);
            fox_unit(F, (id & 63) >> 3, id & 7, 15 - ((id - 1024) >> 6));
        }
    }
}

__device__ __forceinline__ void p4_ynorm(Frame& F) {
    const int gw = F.vcu * NWAVES + F.wave, NGW = F.G * NWAVES;
    for (int m = gw; m < T; m += NGW) {
        bf16* row = (bf16*)(F.ws + WS_Y) + (size_t)m * 1024 + F.lane * 16;
        v4u a = *(const v4u*)row, b = *(const v4u*)(row + 8);
        float v[16];
        const unsigned w[8] = {a.x, a.y, a.z, a.w, b.x, b.y, b.z, b.w};
#pragma unroll
        for (int i = 0; i < 8; ++i) { v[2 * i] = __builtin_bit_cast(float, w[i] << 16); v[2 * i + 1] = __builtin_bit_cast(float, w[i] & 0xffff0000u); }
        float s = 0.f;
#pragma unroll
        for (int i = 0; i < 16; ++i) s += v[i] * v[i];
#pragma unroll
        for (int o = 1; o < 32; o <<= 1) s += __shfl_xor(s, o);
        const float r = 1.f / sqrtf(s * (1.f / 512.f) + EPS);
        v4u oa, ob;
        oa.x = pk2(v[0] * r, v[1] * r); oa.y = pk2(v[2] * r, v[3] * r); oa.z = pk2(v[4] * r, v[5] * r); oa.w = pk2(v[6] * r, v[7] * r);
        ob.x = pk2(v[8] * r, v[9] * r); ob.y = pk2(v[10] * r, v[11] * r); ob.z = pk2(v[12] * r, v[13] * r); ob.w = pk2(v[14] * r, v[15] * r);
        *(v4u*)row = oa; *(v4u*)(row + 8) = ob;
    }
}
__device__ __forceinline__ void p6_hnorm(Frame& F, const float* h1) {
    const int gw = F.vcu * NWAVES + F.wave, NGW = F.G * NWAVES;
    for (int m = gw; m < T; m += NGW) rms_row_to_bf16(F.lane, h1 + (size_t)m * DM, (bf16*)(F.ws + WS_XN) + (size_t)m * DM);
}
__device__ __forceinline__ void p9_final(Frame& F, float* out, const float* g_final) {
    const int gw = F.vcu * NWAVES + F.wave, NGW = F.G * NWAVES;
    for (int m = gw; m < T; m += NGW) {
        GAS f32x4* xr = (GAS f32x4*)(out + (size_t)m * DM) + F.lane;
        f32x4 v[4]; float s = 0.f;
#pragma unroll
        for (int j = 0; j < 4; ++j) { v[j] = xr[64 * j]; s += (v[j].x * v[j].x + v[j].y * v[j].y) + (v[j].z * v[j].z + v[j].w * v[j].w); }
        const float r = 1.f / sqrtf(wave_sum(s) * (1.f / DM) + EPS);
#pragma unroll
        for (int j = 0; j < 4; ++j) { const f32x4 gg = *((const f32x4*)g_final + F.lane + 64 * j); xr[64 * j] = v[j] * r * gg; }
    }
}

constexpr int N_PHASES = 10;
__global__ void __launch_bounds__(NTHR, 2) hymba_fwd(Args args) {
    extern __shared__ __attribute__((aligned(16))) unsigned char lds_raw[];
    Frame F;
    F.lds = (LDSB*)lds_raw;
    F.MISC = (volatile LAS unsigned*)(F.lds + L_MISC);
    F.tid = threadIdx.x; F.lane = F.tid & 63; F.wave = __builtin_amdgcn_readfirstlane(F.tid >> 6);
    F.G = gridDim.x; { const int bx = blockIdx.x; F.vcu = (F.G % 8 == 0) ? (bx % 8) * (F.G / 8) + bx / 8 : bx; }
    kptr_t kp0 = (kptr_t)__builtin_amdgcn_kernarg_segment_ptr();
#define KP() ({ kptr_t k_ = kp0; asm volatile("" : "+s"(k_)); k_; })
    { kptr_t kp = KP(); F.ws = *(unsigned char* const __attribute__((address_space(4)))*)(kp + 8 * 23); }
    F.ctl = (gu32*)(F.ws + WS_CTL);
    if (F.tid < 64) F.MISC[F.tid] = 0u;
    __syncthreads();
    int lo, hi; { kptr_t kp = KP(); lo = *(const int __attribute__((address_space(4)))*)(kp + 192); hi = *(const int __attribute__((address_space(4)))*)(kp + 196); }
    const bool one_launch = (hi - lo) > 1;
    XcdBarrier bar; bar.bar = (unsigned*)(F.ctl + CW_BAR); bar.x = 0; bar.st = nullptr; bar.wave = F.wave;
    if (one_launch) { bar = xcd_barrier_post((unsigned*)(F.ctl + CW_BAR), F.MISC + 8); bar.wave = F.wave; }
#ifdef PHASE_MASK
#define IN(k) (((PHASE_MASK >> (k)) & 1) && lo <= (k) && (k) < hi)
#else
#define IN(k) (lo <= (k) && (k) < hi)
#endif
#define SEAM(k) do { if (IN(k) && IN((k) + 1)) xcd_barrier(bar); } while (0)
#define RELANE() do { F.lane = lane_id(); F.tid = F.wave * 64 + F.lane; } while (0)

    if (IN(0)) { RELANE(); p0_prologue(F, KP()); SEAM(0); }

    if (IN(1)) { RELANE();
        pg8::Gemm g{(const bf16*)(F.ws + WS_XN), (const bf16*)(F.ws + WS_WIN), T, NPROJ, DM}; pg8::StaticOrder S; S.init(T, NPROJ, F.G, (int)blockIdx.x);
        kptr_t kp = KP(); EpiProj E{F.ws, AIN(kp, 3), AIN(kp, 4)};
        pg8::gemm_phase<EpiProj, pg8::StaticOrder, true, true>(F.lds, g, S, E, F.wave);
        if (IN(1) && IN(3)) xcd_barrier(bar);
    }

    if (IN(3)) { RELANE(); p3_attention(F, KP()); if (IN(3) && IN(5)) xcd_barrier(bar); }


    if (IN(5)) { RELANE();
        pg8::Gemm g{(const bf16*)(F.ws + WS_Y), (const bf16*)(F.ws + WS_WOUT), T, DM, DM}; pg8::StaticOrder S; S.init(T, DM, F.G, (int)blockIdx.x);
        pg8::Unit u0, u1; const bool hv0 = S.next(0, u0), hv1 = S.next(1, u1);
        {
            const int i = F.tid >> 8, rl = F.tid & 255; const bool hv = i ? hv1 : hv0; const int pm = i ? u1.pm : u0.pm;
            if (hv) { const f32x4* sp = (const f32x4*)((const float*)(F.ws + WS_SSQY) + (size_t)(pm * 256 + rl) * 16); const f32x4 a = sp[0], b = sp[1], c = sp[2], d = sp[3];
                const float rf = 1.f / sqrtf((((a[0] + a[1]) + (a[2] + a[3])) + ((b[0] + b[1]) + (b[2] + b[3]))) * (1.f / 512.f) + EPS);
                const float rn = 1.f / sqrtf((((c[0] + c[1]) + (c[2] + c[3])) + ((d[0] + d[1]) + (d[2] + d[3]))) * (1.f / 512.f) + EPS);
                LAS float* tab = (LAS float*)(F.lds + L_IMP + 8192) + F.tid * 2; tab[0] = rf / rn; tab[1] = rn; }
            LDS_WAIT(); __syncthreads();
        }
        kptr_t kp = KP(); EpiOutRes E{AIN(kp, 0), *(float* const __attribute__((address_space(4)))*)(kp + 8 * 22), (bf16*)(F.ws + WS_XN), (float*)(F.ws + WS_SSQ1), F.lds, u0.pm};
        pg8::gemm_phase<EpiOutRes, pg8::StaticOrder, true, true>(F.lds, g, S, E, F.wave);
        if (IN(5) && IN(7)) xcd_barrier(bar);
    }


    if (IN(7)) { RELANE();
        pg8::Gemm g{(const bf16*)(F.ws + WS_XN), (const bf16*)(F.ws + WS_WUP), T, FF, DM}; pg8::StaticOrder S; S.init(T, FF, F.G, (int)blockIdx.x);
        EpiUp E{(bf16*)(F.ws + WS_U), (const float*)(F.ws + WS_SSQ1)};
        pg8::gemm_phase<EpiUp, pg8::StaticOrder, true, true>(F.lds, g, S, E, F.wave);
        SEAM(7);
    }

    if (IN(8)) { RELANE();
        pg8::Gemm g{(const bf16*)(F.ws + WS_U), (const bf16*)(F.ws + WS_WDN), T, DM, FF}; pg8::StaticOrder S; S.init(T, DM, F.G, (int)blockIdx.x);
        kptr_t kp = KP(); EpiDownNorm E{*(float* const __attribute__((address_space(4)))*)(kp + 8 * 22), AIN(kp, 21), (float*)(F.ws + WS_XS), F.ctl + CW_PANEL, F.lds};
        pg8::gemm_phase<EpiDownNorm, pg8::StaticOrder, true, true>(F.lds, g, S, E, F.wave);
    }

#undef IN
#undef SEAM
}

extern "C" void kernel_launch(void* const* d_in, const int* in_sizes, int n_in, void* d_out, int out_size, void* d_ws, size_t ws_size, hipStream_t stream) {
    static int grid = 0;
    if (grid == 0) {
        if (n_in != 22 || out_size != T * DM || ws_size < WS_END) { fprintf(stderr, "kernel_launch: unexpected shapes (n_in %d out %d ws %zu)\n", n_in, out_size, ws_size); grid = -1; return; }
        int dev = 0, cus = 0, per_cu = 0;
        if (hipGetDevice(&dev) != hipSuccess || hipDeviceGetAttribute(&cus, hipDeviceAttributeMultiprocessorCount, dev) != hipSuccess) { grid = -1; return; }
        if (hipFuncSetAttribute((const void*)hymba_fwd, hipFuncAttributeMaxDynamicSharedMemorySize, LDS_BYTES) != hipSuccess) { fprintf(stderr, "kernel_launch: hipFuncSetAttribute failed\n"); grid = -1; return; }
        if (hipOccupancyMaxActiveBlocksPerMultiprocessor(&per_cu, (const void*)hymba_fwd, NTHR, LDS_BYTES) != hipSuccess || per_cu < 1) { fprintf(stderr, "kernel_launch: occupancy query says %d\n", per_cu); per_cu = 1; }
        (void)hipGetLastError();
        grid = cus;
    }
    if (grid < 0) return;
    (void)hipMemsetAsync((char*)d_ws + WS_CTL, 0, CTL_ZERO_BYTES, stream);
    Args a{};
    for (int i = 0; i < 22; ++i) a.in[i] = (const float*)d_in[i];
    a.out = (float*)d_out; a.ws = (unsigned char*)d_ws;
#if MK_N_LAUNCHES == 1
    a.ph_lo = 0; a.ph_hi = N_PHASES;
    void* kargs[] = {&a};
    hipError_t e = hipLaunchCooperativeKernel((const void*)hymba_fwd, dim3(grid), dim3(NTHR), kargs, LDS_BYTES, stream);
    if (e != hipSuccess) fprintf(stderr, "kernel_launch: cooperative launch failed: %s (grid %d)\n", hipGetErrorString(e), grid);
#else
    for (int p = 0; p < N_PHASES; ++p) { a.ph_lo = p; a.ph_hi = p + 1; hipLaunchKernelGGL(hymba_fwd, dim3(grid), dim3(NTHR), LDS_BYTES, stream, a); }
#endif
}
```

```cpp
#include <hip/hip_runtime.h>
#include <hip/hip_bf16.h>
#include <cstdio>
#include <cstdint>

#ifndef MK_N_LAUNCHES
#define MK_N_LAUNCHES 1
#endif

__device__ __forceinline__ int lane_id() { return (int)__builtin_amdgcn_mbcnt_hi(~0u, __builtin_amdgcn_mbcnt_lo(~0u, 0u)); }
namespace pg8 {
#define PG8_LAS __attribute__((address_space(3)))
typedef unsigned short bf16_t;
typedef short bf16x8 __attribute__((ext_vector_type(8)));
typedef float f32x4 __attribute__((ext_vector_type(4)));
typedef unsigned u32x4 __attribute__((ext_vector_type(4)));
constexpr int BM = 256, BK = 64, HALF = 128, HTB = HALF * BK * 2, STAGE_BYTES = 8 * HTB, NXCD = 8, WGM = 8;

__host__ __device__ __forceinline__ int lds_byte(int r, int c) { const int st = (r >> 4) * 2 + (c >> 5), rr = r & 15, cc = c & 31, ob = rr * 64 + cc * 2; return st * 1024 + (ob ^ (((ob >> 9) & 1) << 5)); }
__host__ __device__ __forceinline__ void stage_rc(int b, int& R, int& C) { const int st = b / 1024, sb = b % 1024, swz = sb ^ (((sb >> 9) & 1) << 5); R = (st >> 1) * 16 + swz / 64; C = (st & 1) * 32 + (swz % 64) / 2; }
__host__ __device__ __forceinline__ int perm32(int rho) { const int n = rho >> 4, i = rho & 15; return 8 * (i >> 2) + 4 * n + (i & 3); }

struct Unit { int pm, pn; };
struct Gemm { const bf16_t* A; const bf16_t* Bt; int M, N, K; };

struct StaticOrder {
    int nM, nN, nwg, G, c;
    __host__ __device__ void init(int M, int N, int G_, int c_) { nM = M / BM; nN = N / BM; nwg = nM * nN; G = G_; c = c_; }
    __host__ __device__ bool next(int i, Unit& u) const {
        const long L = (long)i * G + c; if (L >= nwg) return false;
        int wgid = (int)L; { const int q = nwg / NXCD, r = nwg % NXCD, xcd = wgid % NXCD, off = wgid / NXCD; wgid = (xcd < r ? xcd * (q + 1) : r * (q + 1) + (xcd - r) * q) + off; }
        const int nig = WGM * nN, gid = wgid / nig, fm = gid * WGM, gsz = (nM - fm) < WGM ? (nM - fm) : WGM;
        u.pm = fm + ((wgid % nig) % gsz); u.pn = (wgid % nig) / gsz; return true;
    }
    __device__ __forceinline__ void a_ready(const Unit&) const {}
    __device__ __forceinline__ void done(const Unit&) const {}
};

__device__ __forceinline__ unsigned cvt_pk_bf16(float lo, float hi) { unsigned r; asm volatile("v_cvt_pk_bf16_f32 %0, %1, %2" : "=v"(r) : "v"(lo), "v"(hi)); return r; }

template <class Epi, class Sched, bool ALIGN_EPI = false, bool SP2 = false>
__device__ __forceinline__ void gemm_phase(PG8_LAS unsigned char* lds, const Gemm g, const Sched& S, const Epi& E, int wave_id) {
    const int wid = wave_id, lane = lane_id(), tid = wid * 64 + lane, wr = wid >> 2, wc = wid & 3, fr = lane & 15, fq = lane >> 4;
    const int K = g.K, nt = K / BK;
    unsigned voffA[2], voffB[2];
#pragma unroll
    for (int i = 0; i < 2; ++i) { int R, C; stage_rc(tid * 16 + i * 8192, R, C); const int Rb = Epi::PERM ? ((R & ~31) + perm32(R & 31)) : R;
        voffA[i] = (unsigned)(R * K + C) * 2u; voffB[i] = (unsigned)(Rb * K + C) * 2u; }
    const size_t kstep = (size_t)(BK * 2);
    const size_t hstep = (size_t)HALF * K * 2;
    const size_t tstep = 2 * hstep;
    const unsigned ldsw = (unsigned)wid * 1024u;
    const int aoff = lds_byte(wr * 64 + fr, fq * 8), boff = lds_byte(wc * 32 + fr, fq * 8);
#define PG8_SA(b, h) (((b) * 2 + (h)) * HTB)
#define PG8_SB(b, h) ((4 + (b) * 2 + (h)) * HTB)
#define PG8_STAGE(bufoff, gbase, voff) do { _Pragma("unroll") for (int _i = 0; _i < 2; ++_i) \
        __builtin_amdgcn_global_load_lds((const unsigned*)((const char*)(gbase) + (voff)[_i]), (PG8_LAS unsigned*)(lds + (bufoff) + ldsw + _i * 8192), 16, 0, 0); } while (0)
#define PG8_LDA(dst, b, h) do { _Pragma("unroll") for (int m = 0; m < 4; ++m) _Pragma("unroll") for (int k = 0; k < 2; ++k) dst[m][k] = *(const PG8_LAS bf16x8*)(lds + PG8_SA(b, h) + aoff + m * 2048 + k * 1024); } while (0)
#define PG8_LDB(dst, b, h) do { _Pragma("unroll") for (int n = 0; n < 2; ++n) _Pragma("unroll") for (int k = 0; k < 2; ++k) dst[n][k] = *(const PG8_LAS bf16x8*)(lds + PG8_SB(b, h) + boff + n * 2048 + k * 1024); } while (0)
#define PG8_MMA(ai, bj, At, Bt) do { __builtin_amdgcn_s_setprio(1); _Pragma("unroll") for (int m = 0; m < 4; ++m) _Pragma("unroll") for (int n = 0; n < 2; ++n) _Pragma("unroll") for (int k = 0; k < 2; ++k) \
        acc[ai][bj][m][n] = __builtin_amdgcn_mfma_f32_16x16x32_bf16(Bt[n][k], At[m][k], acc[ai][bj][m][n], 0, 0, 0); __builtin_amdgcn_s_setprio(0); } while (0)
#define PG8_WAIT_V(n) asm volatile("s_waitcnt vmcnt(" #n ")" ::: "memory")
#define PG8_WAIT_L(n) asm volatile("s_waitcnt lgkmcnt(" #n ")" ::: "memory")
#define PG8_BAR __builtin_amdgcn_s_barrier()
#define PG8_SCHED __builtin_amdgcn_sched_barrier(0)
    Unit cur, nxt; int ui = 0;
    if (!S.next(0, cur)) return;
    f32x4 acc[2][2][4][2];
#pragma unroll
    for (int a = 0; a < 2; ++a)
#pragma unroll
        for (int b = 0; b < 2; ++b)
#pragma unroll
            for (int m = 0; m < 4; ++m)
#pragma unroll
                for (int n = 0; n < 2; ++n) acc[a][b][m][n] = (f32x4){0.f, 0.f, 0.f, 0.f};
    bf16x8 At[4][2], B0[2][2], B1[2][2];
    const char* cA = (const char*)g.A + (size_t)cur.pm * tstep; const char* cB = (const char*)g.Bt + (size_t)cur.pn * tstep;
    S.a_ready(cur);
    if constexpr (SP2) {
        PG8_STAGE(PG8_SB(0, 0), cB, voffB); PG8_STAGE(PG8_SB(0, 1), cB + hstep, voffB); PG8_STAGE(PG8_SA(0, 0), cA, voffA); PG8_STAGE(PG8_SA(0, 1), cA + hstep, voffA);
        if (wr == 1) PG8_BAR;
        PG8_WAIT_V(2); PG8_BAR;
        PG8_STAGE(PG8_SB(1, 0), cB + kstep, voffB); PG8_STAGE(PG8_SA(1, 0), cA + kstep, voffA); PG8_STAGE(PG8_SB(1, 1), cB + hstep + kstep, voffB);
        PG8_WAIT_V(6); PG8_BAR;
    } else {
        PG8_STAGE(PG8_SB(0, 0), cB, voffB); PG8_STAGE(PG8_SA(0, 0), cA, voffA); PG8_STAGE(PG8_SB(0, 1), cB + hstep, voffB); PG8_STAGE(PG8_SA(0, 1), cA + hstep, voffA);
        if (wr == 1) PG8_BAR;
        PG8_WAIT_V(4); PG8_BAR;
        PG8_STAGE(PG8_SB(1, 0), cB + kstep, voffB); PG8_STAGE(PG8_SA(1, 0), cA + kstep, voffA); PG8_STAGE(PG8_SB(1, 1), cB + hstep + kstep, voffB);
        PG8_WAIT_V(6); PG8_BAR;
    }
    for (;;) {
        const bool has_next = S.next(ui + 1, nxt);
        const char* nA = has_next ? (const char*)g.A + (size_t)nxt.pm * tstep : cA; const char* nB = has_next ? (const char*)g.Bt + (size_t)nxt.pn * tstep : cB;
        for (int t = 0; t < nt; t += 2) {
            const bool last = (t == nt - 2);
            const char* a1 = cA + (size_t)(t + 1) * kstep;
            const char* a2 = last ? nA : cA + (size_t)(t + 2) * kstep; const char* b2 = last ? nB : cB + (size_t)(t + 2) * kstep;
            const char* a3 = a2 + kstep; const char* b3 = b2 + kstep;
            if (last && has_next) S.a_ready(nxt);
            if constexpr (Epi::MID) { if (t == nt / 2) E.mid(acc, cur, wr, wc, fr, fq); }
            if constexpr (SP2) {
            PG8_LDB(B0, 0, 0); PG8_LDB(B1, 0, 1); PG8_SCHED; PG8_LDA(At, 0, 0); PG8_STAGE(PG8_SA(1, 1), a1 + hstep, voffA);
            PG8_WAIT_V(8); PG8_WAIT_L(0); PG8_BAR; PG8_MMA(0, 0, At, B0); PG8_MMA(0, 1, At, B1); PG8_BAR; PG8_SCHED;
            PG8_LDA(At, 0, 1); PG8_STAGE(PG8_SB(0, 0), b2, voffB); PG8_STAGE(PG8_SB(0, 1), b2 + hstep, voffB); PG8_STAGE(PG8_SA(0, 0), a2, voffA);
            PG8_WAIT_V(8); PG8_WAIT_L(0); PG8_BAR; PG8_MMA(1, 0, At, B0); PG8_MMA(1, 1, At, B1); PG8_BAR; PG8_SCHED;
            PG8_LDB(B0, 1, 0); PG8_LDB(B1, 1, 1); PG8_SCHED; PG8_LDA(At, 1, 0); PG8_STAGE(PG8_SA(0, 1), a2 + hstep, voffA);
            PG8_WAIT_V(8); PG8_WAIT_L(0); PG8_BAR; PG8_MMA(0, 0, At, B0); PG8_MMA(0, 1, At, B1); PG8_BAR; PG8_SCHED;
            PG8_LDA(At, 1, 1); PG8_STAGE(PG8_SB(1, 0), b3, voffB); PG8_STAGE(PG8_SB(1, 1), b3 + hstep, voffB); PG8_STAGE(PG8_SA(1, 0), a3, voffA);
            PG8_WAIT_V(8); PG8_WAIT_L(0); PG8_BAR; PG8_MMA(1, 0, At, B0); PG8_MMA(1, 1, At, B1); PG8_BAR; PG8_SCHED;
            } else {
            PG8_LDB(B0, 0, 0); PG8_SCHED; PG8_LDA(At, 0, 0); PG8_STAGE(PG8_SA(1, 1), a1 + hstep, voffA);
            PG8_WAIT_L(8); PG8_BAR; PG8_WAIT_L(0); PG8_MMA(0, 0, At, B0); PG8_BAR; PG8_SCHED;
            PG8_LDB(B1, 0, 1); PG8_STAGE(PG8_SB(0, 0), b2, voffB);
            PG8_BAR; PG8_WAIT_L(0); PG8_MMA(0, 1, At, B1); PG8_BAR;
            PG8_LDA(At, 0, 1); PG8_STAGE(PG8_SA(0, 0), a2, voffA);
            PG8_BAR; PG8_WAIT_L(0); PG8_MMA(1, 0, At, B0); PG8_BAR; PG8_SCHED;
            PG8_STAGE(PG8_SB(0, 1), b2 + hstep, voffB);
            PG8_WAIT_V(6); PG8_BAR; PG8_MMA(1, 1, At, B1); PG8_BAR;
            PG8_LDB(B0, 1, 0); PG8_SCHED; PG8_LDA(At, 1, 0); PG8_STAGE(PG8_SA(0, 1), a2 + hstep, voffA);
            PG8_WAIT_L(8); PG8_BAR; PG8_WAIT_L(0); PG8_MMA(0, 0, At, B0); PG8_BAR; PG8_SCHED;
            PG8_LDB(B1, 1, 1); PG8_STAGE(PG8_SB(1, 0), b3, voffB);
            PG8_BAR; PG8_WAIT_L(0); PG8_MMA(0, 1, At, B1); PG8_BAR;
            PG8_LDA(At, 1, 1); PG8_STAGE(PG8_SA(1, 0), a3, voffA);
            PG8_BAR; PG8_WAIT_L(0); PG8_MMA(1, 0, At, B0); PG8_BAR; PG8_SCHED;
            PG8_STAGE(PG8_SB(1, 1), b3 + hstep, voffB);
            PG8_WAIT_V(6); PG8_BAR; PG8_MMA(1, 1, At, B1); PG8_BAR;
            }
        }
        if constexpr (ALIGN_EPI) { if (wr == 0) PG8_BAR; }
        E(acc, cur, wr, wc, fr, fq); S.done(cur);
        if (!has_next) break;
#pragma unroll
        for (int a = 0; a < 2; ++a)
#pragma unroll
            for (int b = 0; b < 2; ++b)
#pragma unroll
                for (int m = 0; m < 4; ++m)
#pragma unroll
                    for (int n = 0; n < 2; ++n) acc[a][b][m][n] = (f32x4){0.f, 0.f, 0.f, 0.f};
        cur = nxt; cA = nA; cB = nB; ++ui;
        if constexpr (ALIGN_EPI) { if (wr == 1) PG8_BAR; }
    }
    PG8_WAIT_V(0);
    if constexpr (!ALIGN_EPI) { if (wr == 0) PG8_BAR; }
    PG8_BAR;
#undef PG8_SA
#undef PG8_SB
#undef PG8_STAGE
#undef PG8_LDA
#undef PG8_LDB
#undef PG8_MMA
#undef PG8_WAIT_V
#undef PG8_WAIT_L
#undef PG8_BAR
#undef PG8_SCHED
}
}

#define GAS __attribute__((address_space(1)))
#define LAS __attribute__((address_space(3)))
typedef unsigned short bf16;
typedef unsigned v4u __attribute__((ext_vector_type(4)));
typedef float f32x4 __attribute__((ext_vector_type(4)));
typedef float f32x16 __attribute__((ext_vector_type(16)));
typedef short bf16x8 __attribute__((ext_vector_type(8)));
typedef short s16x4 __attribute__((ext_vector_type(4)));
typedef short v4i16_t __attribute__((ext_vector_type(4)));
typedef LAS unsigned char LDSB;
typedef GAS unsigned gu32;

constexpr int NWAVES = 8, NTHR = 512;
constexpr int BATCH = 8, SEQ = 4096, DM = 1024, T = BATCH * SEQ;
constexpr int NPROJ = 3072;
constexpr int N_IN = 2848, FF = 4096;
constexpr float EPS = 1e-6f;
constexpr float C2 = 0.125f * 1.4426950408889634f;
constexpr float LOG2E = 1.4426950408889634f;
constexpr float NEGM = -1000.0f;

constexpr size_t MiB = 1u << 20;
constexpr size_t WS_CTL = 0, CTL_ZERO_BYTES = 1 * MiB;
constexpr size_t WS_WIN = 2 * MiB;
constexpr size_t WS_WOUT = 8 * MiB;
constexpr size_t WS_WUP = 10 * MiB;
constexpr size_t WS_WDN = 18 * MiB;
constexpr size_t WS_W1K = 26 * MiB;
constexpr size_t WS_W1V = 27 * MiB;
constexpr size_t WS_W2K = 28 * MiB;
constexpr size_t WS_W2V = 28 * MiB + 65536;
constexpr size_t WS_B1K = 28 * MiB + 131072;
constexpr size_t WS_B1V = 28 * MiB + 131072 + 65536;
constexpr size_t WS_ROPEC = 29 * MiB;
constexpr size_t WS_ROPES = 29 * MiB + 524288;
constexpr size_t WS_FL = 30 * MiB;
constexpr size_t WS_CB = 31 * MiB;
constexpr size_t WS_XN = 32 * MiB;
constexpr size_t WS_U = 96 * MiB;
constexpr size_t WS_QF = 96 * MiB;
constexpr size_t WS_KF = 128 * MiB;
constexpr size_t WS_VF = 160 * MiB;
constexpr size_t WS_QN = 192 * MiB;
constexpr size_t WS_KC = 224 * MiB;
constexpr size_t WS_VC = 233 * MiB;
constexpr size_t WS_KS = 242 * MiB;
constexpr size_t WS_VS = 250 * MiB;
constexpr size_t WS_KW = 258 * MiB;
constexpr size_t WS_VW = 266 * MiB;
constexpr size_t WS_GATE = 274 * MiB;
constexpr size_t WS_KCMP = 277 * MiB;
constexpr size_t WS_VCMP = 277 * MiB + 524288;
constexpr size_t WS_Y = 280 * MiB;
constexpr size_t WS_SSQ1 = 352 * MiB;
constexpr size_t WS_XS = 353 * MiB;
constexpr size_t WS_SSQY = 354 * MiB;
constexpr size_t WS_END = 356 * MiB;

constexpr int CW_Q_ATT = 64;
constexpr int CW_CS = 128;
constexpr int CW_CMPT = 192;
constexpr int CW_CMP = 256;
constexpr int CW_BAR = 4096;
constexpr int CW_KMAX = 2048;
constexpr int CW_PANEL = 8192;

constexpr int L_K = 0;
constexpr int L_V = 32768;
constexpr int L_ACC = 65536;
constexpr int L_IMP = 131072;
constexpr int L_WS = 131072 + 17408;
constexpr int L_SEL = L_WS + 8192;
constexpr int L_ORD = L_SEL + 512;
constexpr int L_MISC = L_ORD + 4096;
constexpr int L_TL = L_MISC + 256;
constexpr int LDS_BYTES = L_TL + 256;
constexpr int SLOTB = 8192;

#define RLX_AGENT __ATOMIC_RELAXED, __HIP_MEMORY_SCOPE_AGENT
#define LDS_WAIT() asm volatile("s_waitcnt lgkmcnt(0)" ::: "memory")
#define VM_WAIT() asm volatile("s_waitcnt vmcnt(0)" ::: "memory")
__device__ __forceinline__ unsigned f2bf(float f) { unsigned u = __builtin_bit_cast(unsigned, f); return (u + 0x7fffu + ((u >> 16) & 1u)) >> 16; }
__device__ __forceinline__ unsigned pk2(float lo, float hi) { return f2bf(lo) | (f2bf(hi) << 16); }
__device__ __forceinline__ float bf2f(unsigned short b) { return __builtin_bit_cast(float, (unsigned)b << 16); }

#define XB_TMO      128
#define XB_XCNT(j)  (256  + 64 * (j))
#define XB_XSUB(j)  (1280 + 64 * (j))
#define XB_XGEN(j)  (2304 + 64 * (j))
#define XB_TOP      3328
#define XB_TOPGEN   3392
#define XCD_BAR_WORDS 3456
#define XB_SPIN_CAP (1u << 22)
__device__ __forceinline__ unsigned xb_ld(unsigned* p)              { return __hip_atomic_load(p, __ATOMIC_RELAXED, __HIP_MEMORY_SCOPE_AGENT); }
__device__ __forceinline__ unsigned xb_add(unsigned* p, unsigned v) { return __hip_atomic_fetch_add(p, v, __ATOMIC_RELAXED, __HIP_MEMORY_SCOPE_AGENT); }
__device__ __forceinline__ unsigned xb_xcc_id() { return (unsigned)__builtin_amdgcn_s_getreg((3 << 11) | 20) & 0xFu; }
#define XB_SPIN(cond, bar) do { unsigned _sp = 0; while (cond) { __builtin_amdgcn_s_sleep(1); \
    if ((++_sp & 255u) == 0u) { if (xb_ld(&(bar)[XB_TMO])) break; if (_sp > XB_SPIN_CAP) { atomicAdd(&(bar)[XB_TMO], 1u); break; } } } } while (0)
struct XcdBarrier { unsigned* bar; unsigned x; volatile LAS unsigned* st; int wave; };
__device__ __forceinline__ XcdBarrier xcd_barrier_post(unsigned* bar, volatile LAS unsigned* st) {
    XcdBarrier b; b.bar = bar; b.x = xb_xcc_id(); b.st = st; b.wave = 0;
    if (threadIdx.x == 0) (void)xb_add(&bar[XB_XCNT(b.x)], 1u);
    return b;
}
__device__ __forceinline__ void xcd_barrier_complete(unsigned* bar, unsigned x, unsigned& nloc, unsigned& nx) {
    const unsigned G = gridDim.x * gridDim.y * gridDim.z;
    unsigned sum, cnt, mine, sp = 0u;
    for (;;) {
        sum = 0u; cnt = 0u; mine = 0u;
#pragma unroll
        for (unsigned j = 0; j < 16; ++j) { const unsigned c = xb_ld(&bar[XB_XCNT(j)]); sum += c; cnt += (c > 0u) ? 1u : 0u; mine = (j == x) ? c : mine; }
        if (sum == G) break;
        __builtin_amdgcn_s_sleep(1);
        if ((++sp & 255u) == 0u) { if (xb_ld(&bar[XB_TMO])) break; if (sp > XB_SPIN_CAP) { atomicAdd(&bar[XB_TMO], 1u); break; } }
    }
    nloc = mine > 0u ? mine : 1u; nx = cnt > 0u ? cnt : 1u;
}
__device__ __forceinline__ void xcd_barrier(const XcdBarrier& b) {
    asm volatile("s_waitcnt vmcnt(0)" ::: "memory");
    __syncthreads();
    if (b.wave == 0 && lane_id() == 0) {
        unsigned* bar = b.bar;
        __builtin_amdgcn_s_waitcnt(0);
        unsigned nloc = b.st[0], nx = b.st[1];
        if (nloc == 0u) { xcd_barrier_complete(bar, b.x, nloc, nx); b.st[0] = nloc; b.st[1] = nx; }
        const unsigned old = xb_add(&bar[XB_XSUB(b.x)], 1u);
        const unsigned gen = old / nloc;
        if (old + 1u == (gen + 1u) * nloc) {
            __builtin_amdgcn_fence(__ATOMIC_RELEASE, "agent");
            asm volatile("s_waitcnt vmcnt(0)" ::: "memory");
            const unsigned og = xb_add(&bar[XB_TOP], 1u);
            const unsigned tg = og / nx;
            if (og + 1u == (tg + 1u) * nx) xb_add(&bar[XB_TOPGEN], 1u);
            else XB_SPIN(xb_ld(&bar[XB_TOPGEN]) == tg, bar);
            __builtin_amdgcn_fence(__ATOMIC_ACQUIRE, "agent");
            xb_add(&bar[XB_XGEN(b.x)], 1u);
            asm volatile("s_waitcnt vmcnt(0)" ::: "memory");
        } else {
            XB_SPIN(xb_ld(&bar[XB_XGEN(b.x)]) == gen, bar);
            __builtin_amdgcn_fence(__ATOMIC_ACQUIRE, "agent");
            asm volatile("s_waitcnt vmcnt(0)" ::: "memory");
        }
    }
    __syncthreads();
}

struct Args { const float* in[22]; float* out; unsigned char* ws; int ph_lo, ph_hi; };

struct Frame {
    LDSB* lds;
    volatile LAS unsigned* MISC;
    gu32* ctl;
    int tid, lane, wave, vcu, G;
    unsigned char* ws;
};

__device__ __forceinline__ float wave_sum(float v) {
#pragma unroll
    for (int o = 1; o < 64; o <<= 1) v += __shfl_xor(v, o);
    return v;
}

__device__ __forceinline__ int win_src_col(int n) {
    const int pn = n >> 8, c = n & 255, half = c >> 7, slot = (c >> 5) & 3, d = c & 31;
    if (pn < 8) {
        const int tsr = pn >> 1, j = pn & 1;
        const int tb = (tsr == 0) ? 0 : (tsr == 1) ? 512 : (tsr == 2) ? 1024 : 1544;
        return tb + 64 * (4 * j + slot) + 32 * half + d;
    }
    if (pn < 11) {
        const int base = 2056 + (pn - 8) * 256;
        return base + (slot >> 1) * 128 + (slot & 1) * 64 + 32 * half + d;
    }
    if (c < 8) return 1536 + c;
    if (c < 32) return 2824 + (c - 8);
    return -1;
}

template <bool MAPPED>
__device__ __forceinline__ void p0_transpose_item(const float* W, int K, int N, bf16* WT, LAS float* scr, int item, int lane, const float* kscale, int nblk) {
    const int kb = item / nblk, nb = item % nblk, k0 = 64 * kb, n0 = 32 * nb;
    int src = n0 + 4 * (lane & 7);
    if (MAPPED) src = win_src_col(src);
    f32x4 v[8];
#pragma unroll
    for (int i = 0; i < 8; ++i) { const int kk = 8 * i + (lane >> 3);
        v[i] = (src >= 0) ? *(const f32x4*)(W + (size_t)(k0 + kk) * N + src) : (f32x4){0.f, 0.f, 0.f, 0.f}; }
#pragma unroll
    for (int i = 0; i < 8; ++i) { const int kk = 8 * i + (lane >> 3); const float sc = kscale ? kscale[k0 + kk] : 1.f;
        LAS float* p = scr + kk * 33 + 4 * (lane & 7); p[0] = v[i][0] * sc; p[1] = v[i][1] * sc; p[2] = v[i][2] * sc; p[3] = v[i][3] * sc; }
    LDS_WAIT(); asm volatile("" ::: "memory");
    const int c = lane & 7;
#pragma unroll
    for (int j = 0; j < 4; ++j) { const int n = (lane >> 3) + 8 * j; const LAS float* sp = scr + (8 * c) * 33 + n;
        v4u o; o.x = pk2(sp[0 * 33], sp[1 * 33]); o.y = pk2(sp[2 * 33], sp[3 * 33]); o.z = pk2(sp[4 * 33], sp[5 * 33]); o.w = pk2(sp[6 * 33], sp[7 * 33]);
        *(GAS v4u*)(WT + (size_t)(n0 + n) * K + k0 + 8 * c) = o; }
    LDS_WAIT(); asm volatile("" ::: "memory");
}

__device__ __forceinline__ void rms_row_to_bf16(int lane, const float* xrow, bf16* orow) {
    const GAS f32x4* xr = (const GAS f32x4*)xrow + lane;
    f32x4 v[4]; float s = 0.f;
#pragma unroll
    for (int j = 0; j < 4; ++j) { v[j] = xr[64 * j]; s += (v[j].x * v[j].x + v[j].y * v[j].y) + (v[j].z * v[j].z + v[j].w * v[j].w); }
    const float r = 1.f / sqrtf(wave_sum(s) * (1.f / DM) + EPS);
    GAS unsigned long long* o8 = (GAS unsigned long long*)orow + lane;
#pragma unroll
    for (int j = 0; j < 4; ++j) o8[64 * j] = (unsigned long long)pk2(v[j].x * r, v[j].y * r) | ((unsigned long long)pk2(v[j].z * r, v[j].w * r) << 32);
}

typedef __attribute__((address_space(4))) const char* kptr_t;
#define AIN(kp_, i) (*(const float* const __attribute__((address_space(4)))*)((kp_) + 8 * (i)))
__device__ __forceinline__ void p0_prologue(Frame& F, kptr_t kp) {
    const float* x = AIN(kp, 0); const float* g_attn = AIN(kp, 1); const float* w_in = AIN(kp, 2);
    const float* cmpk_pe = AIN(kp, 5); const float* cmpk_w1 = AIN(kp, 6); const float* cmpk_w2 = AIN(kp, 8);
    const float* cmpv_pe = AIN(kp, 10); const float* cmpv_w1 = AIN(kp, 11); const float* cmpv_w2 = AIN(kp, 13);
    const float* g_fox = AIN(kp, 15); const float* g_nsa = AIN(kp, 16); const float* w_out = AIN(kp, 17);
    const float* g_mlp = AIN(kp, 18); const float* w_up = AIN(kp, 19); const float* w_down = AIN(kp, 20);
    LAS float* scr = (LAS float*)(F.lds + F.wave * 16384);
    const int gw = F.vcu * NWAVES + F.wave, NGW = F.G * NWAVES;
    for (int it = gw; it < 128; it += NGW) {
        const int kv = it >> 6, kc = it & 63;
        const float* pe = kv ? cmpv_pe : cmpk_pe; const float* w1 = kv ? cmpv_w1 : cmpk_w1;
        f32x4 a = (f32x4){0.f, 0.f, 0.f, 0.f};
#pragma unroll 8
        for (int k = 32 * kc; k < 32 * kc + 32; ++k) { const f32x4 wv = *((const f32x4*)(w1 + (size_t)k * 256) + F.lane); a = a + wv * pe[k]; }
        *((f32x4*)(F.ws + (kv ? WS_B1V : WS_B1K)) + kc * 64 + F.lane) = a;
    }
    constexpr int I_IN = (DM / 64) * (NPROJ / 32), I_OUT = (DM / 64) * (DM / 32), I_UP = (DM / 64) * (FF / 32), I_DN = (FF / 64) * (DM / 32);
    constexpr int I_W1 = (2048 / 64) * (256 / 32), I_W2 = (256 / 64) * (64 / 32);
    constexpr int NITEMS = I_IN + I_OUT + I_UP + I_DN + 2 * I_W1 + 2 * I_W2;
    for (int it = gw; it < NITEMS; it += NGW) {
        int r = it;
        if (r < I_IN) { p0_transpose_item<true>(w_in, DM, N_IN, (bf16*)(F.ws + WS_WIN), scr, r, F.lane, g_attn, NPROJ / 32); continue; } r -= I_IN;
        if (r < I_OUT) {
            const int kb = r / (DM / 32);
            const float* ks = (kb < 8) ? g_fox : (g_nsa - 512);
            p0_transpose_item<false>(w_out, DM, DM, (bf16*)(F.ws + WS_WOUT), scr, r, F.lane, ks, DM / 32); continue; } r -= I_OUT;
        if (r < I_UP) { p0_transpose_item<false>(w_up, DM, FF, (bf16*)(F.ws + WS_WUP), scr, r, F.lane, g_mlp, FF / 32); continue; } r -= I_UP;
        if (r < I_DN) { p0_transpose_item<false>(w_down, FF, DM, (bf16*)(F.ws + WS_WDN), scr, r, F.lane, nullptr, DM / 32); continue; } r -= I_DN;
        if (r < I_W1) { p0_transpose_item<false>(cmpk_w1, 2048, 256, (bf16*)(F.ws + WS_W1K), scr, r, F.lane, nullptr, 8); continue; } r -= I_W1;
        if (r < I_W1) { p0_transpose_item<false>(cmpv_w1, 2048, 256, (bf16*)(F.ws + WS_W1V), scr, r, F.lane, nullptr, 8); continue; } r -= I_W1;
        if (r < I_W2) { p0_transpose_item<false>(cmpk_w2, 256, 64, (bf16*)(F.ws + WS_W2K), scr, r, F.lane, nullptr, 2); continue; } r -= I_W2;
        p0_transpose_item<false>(cmpv_w2, 256, 64, (bf16*)(F.ws + WS_W2V), scr, r, F.lane, nullptr, 2);
    }
    {
        float* rc = (float*)(F.ws + WS_ROPEC); float* rs = (float*)(F.ws + WS_ROPES);
        for (int i = F.vcu * NTHR + F.tid; i < SEQ * 32; i += F.G * NTHR) {
            const int pos = i >> 5, d = i & 31;
            const float inv = exp2f(-(float)d * (13.287712379549449f / 32.0f));
            const float ang = (float)pos * inv;
            const double a = (double)ang;
            const double k = __builtin_rint(a * 0.15915494309189535);
            const float red = (float)(a - k * 6.283185307179586);
            rc[i] = cosf(red); rs[i] = sinf(red);
        }
    }
    for (int m = gw; m < T; m += 4 * NGW) {
        f32x4 v[4][4]; float ss[4];
#pragma unroll
        for (int r = 0; r < 4; ++r) { const int mr = (m + r * NGW < T) ? m + r * NGW : m; const GAS f32x4* xr = (const GAS f32x4*)(x + (size_t)mr * DM) + F.lane;
#pragma unroll
            for (int j = 0; j < 4; ++j) v[r][j] = xr[64 * j]; }
#pragma unroll
        for (int r = 0; r < 4; ++r) { float a = 0.f;
#pragma unroll
            for (int j = 0; j < 4; ++j) a += (v[r][j].x * v[r][j].x + v[r][j].y * v[r][j].y) + (v[r][j].z * v[r][j].z + v[r][j].w * v[r][j].w);
            ss[r] = a; }
#pragma unroll
        for (int o = 1; o < 64; o <<= 1) {
#pragma unroll
            for (int r = 0; r < 4; ++r) ss[r] += __shfl_xor(ss[r], o); }
#pragma unroll
        for (int r = 0; r < 4; ++r) { const float rs = 1.f / sqrtf(ss[r] * (1.f / DM) + EPS);
            const int mr = (m + r * NGW < T) ? m + r * NGW : m;
            GAS unsigned long long* o8 = (GAS unsigned long long*)((bf16*)(F.ws + WS_XN) + (size_t)mr * DM) + F.lane;
#pragma unroll
            for (int j = 0; j < 4; ++j) o8[64 * j] = (unsigned long long)pk2(v[r][j].x * rs, v[r][j].y * rs) | ((unsigned long long)pk2(v[r][j].z * rs, v[r][j].w * rs) << 32); }
    }
}

typedef pg8::f32x4 pf4;
__device__ __forceinline__ float log_sigmoidf(float v) { const float t = __builtin_amdgcn_exp2f(-fabsf(v) * LOG2E); return fminf(v, 0.f) - __builtin_amdgcn_logf(1.f + t) * 0.6931471805599453f; }
__device__ __forceinline__ float sigmoid_fast(float z) { return __builtin_amdgcn_rcpf(1.f + __builtin_amdgcn_exp2f(-z * LOG2E)); }

struct EpiProj { static constexpr bool MID = false;
    static constexpr bool PERM = true;
    unsigned char* ws; const float* b_f; const float* b_gate;
    __device__ __forceinline__ void operator()(const pf4 (&acc)[2][2][4][2], const pg8::Unit& u, int wr, int wc, int fr, int fq) const {
        const int pn = u.pn; const int rbase = u.pm * 256 + wr * 64 + fr;
        if (pn == 11) {
            if (wc != 0) return;
            float* FL = (float*)(ws + WS_FL); float* GT = (float*)(ws + WS_GATE);
#pragma unroll
            for (int ai = 0; ai < 2; ++ai)
#pragma unroll
                for (int m = 0; m < 4; ++m) { const int row = rbase + ai * 128 + m * 16; const int b = row >> 12, s = row & 4095;
#pragma unroll
                    for (int n = 0; n < 2; ++n) { const pf4 v = acc[ai][0][m][n];
                        if (fq == 0) {
#pragma unroll
                            for (int i = 0; i < 4; ++i) { const int h = 4 * n + i; FL[(size_t)(b * 8 + h) * SEQ + s] = log_sigmoidf(v[i] + b_f[h]); }
                        } else { const int j0 = 8 * fq - 8 + 4 * n; pf4 o;
#pragma unroll
                            for (int i = 0; i < 4; ++i) { const float z = v[i] + b_gate[j0 + i]; o[i] = sigmoid_fast(z); }
                            *(pf4*)(GT + (size_t)row * 24 + j0) = o; } } }
            return;
        }
        const bool rope = (pn == 6) || (pn == 7) || ((pn == 9 || pn == 10) && wc < 2);
        const float sc = (pn < 2 || pn == 6 || pn == 7) ? C2 : 1.f;
        const float* RC = (const float*)(ws + WS_ROPEC); const float* RS = (const float*)(ws + WS_ROPES);
        size_t tb;
        if (pn < 8) { const int tsr = pn >> 1; tb = (tsr == 0) ? WS_QF : (tsr == 1) ? WS_KF : (tsr == 2) ? WS_VF : WS_QN; }
        else { const int vt = wc >> 1; tb = (pn == 8) ? (vt ? WS_VC : WS_KC) : (pn == 9) ? (vt ? WS_VS : WS_KS) : (vt ? WS_VW : WS_KW); }
        bf16* TB = (bf16*)(ws + tb);
        float kmx = 0.f;
#pragma unroll
        for (int ai = 0; ai < 2; ++ai)
#pragma unroll
            for (int m = 0; m < 4; ++m) { const int row = rbase + ai * 128 + m * 16;
                pf4 a0 = acc[ai][0][m][0], a1 = acc[ai][0][m][1], b0 = acc[ai][1][m][0], b1 = acc[ai][1][m][1];
                if (rope) { const int pos = row & 4095;
                    const pf4 c0 = *(const pf4*)(RC + pos * 32 + 8 * fq), c1 = *(const pf4*)(RC + pos * 32 + 8 * fq + 4);
                    const pf4 s0 = *(const pf4*)(RS + pos * 32 + 8 * fq), s1 = *(const pf4*)(RS + pos * 32 + 8 * fq + 4);
                    const pf4 x0 = a0 * c0 - b0 * s0, x1 = a1 * c1 - b1 * s1, y0 = a0 * s0 + b0 * c0, y1 = a1 * s1 + b1 * c1;
                    a0 = x0; a1 = x1; b0 = y0; b1 = y1; }
                a0 = a0 * sc; a1 = a1 * sc; b0 = b0 * sc; b1 = b1 * sc;
                v4u w0, w1; w0.x = pk2(a0[0], a0[1]); w0.y = pk2(a0[2], a0[3]); w0.z = pk2(a1[0], a1[1]); w0.w = pk2(a1[2], a1[3]);
                w1.x = pk2(b0[0], b0[1]); w1.y = pk2(b0[2], b0[3]); w1.z = pk2(b1[0], b1[1]); w1.w = pk2(b1[2], b1[3]);
                if (pn == 2 || pn == 3) { float q2 = 0.f;
#pragma unroll
                    for (int i = 0; i < 4; ++i) q2 += (a0[i] * a0[i] + a1[i] * a1[i]) + (b0[i] * b0[i] + b1[i] * b1[i]);
                    q2 += __shfl_xor(q2, 16); q2 += __shfl_xor(q2, 32); kmx = fmaxf(kmx, q2); }
                bf16* p;
                if (pn < 8) p = TB + (size_t)row * 512 + 64 * (4 * (pn & 1) + wc) + 8 * fq;
                else { const int b = row >> 12, s = row & 4095, g = wc & 1; p = TB + ((size_t)(b * 2 + g) * SEQ + s) * 64 + 8 * fq; }
                *(v4u*)p = w0; *(v4u*)(p + 32) = w1; }
        if (pn == 2 || pn == 3) {
#pragma unroll
            for (int o = 1; o < 16; o <<= 1) kmx = fmaxf(kmx, __shfl_xor(kmx, o));
            if (fr == 0 && fq == 0) atomicMax((unsigned*)(ws + WS_CTL) + CW_KMAX + (rbase >> 12) * 8 + 4 * (pn & 1) + wc, __float_as_uint(kmx));
        }
    }
};

struct EpiOutRes {
    static constexpr bool PERM = true, MID = true;
    const float* x; float* out; bf16* xn; float* ssq; LDSB* lds; int pm0;
    __device__ __forceinline__ const LAS float* tabrow(const pg8::Unit& u, int rl) const { return (const LAS float*)(lds + L_IMP + 8192) + (((u.pm == pm0) ? 0 : 256) + rl) * 2; }
    __device__ __forceinline__ void mid(pf4 (&acc)[2][2][4][2], const pg8::Unit& u, int wr, int wc, int fr, int fq) const {
#pragma unroll
        for (int ai = 0; ai < 2; ++ai)
#pragma unroll
            for (int m = 0; m < 4; ++m) { const float q = tabrow(u, ai * 128 + wr * 64 + m * 16 + fr)[0];
#pragma unroll
                for (int bj = 0; bj < 2; ++bj) { acc[ai][bj][m][0] = acc[ai][bj][m][0] * q; acc[ai][bj][m][1] = acc[ai][bj][m][1] * q; } }
    }
    __device__ __forceinline__ void operator()(const pf4 (&acc)[2][2][4][2], const pg8::Unit& u, int wr, int wc, int fr, int fq) const {
        const int col0 = u.pn * 256 + wc * 32 + 8 * fq;
        LAS float* P = (LAS float*)(lds + L_IMP);
#pragma unroll
        for (int ai = 0; ai < 2; ++ai)
#pragma unroll
            for (int m = 0; m < 4; ++m) { const int rl = ai * 128 + wr * 64 + m * 16 + fr; const size_t off = (size_t)(u.pm * 256 + rl) * DM + col0; float sq = 0.f;
                const float rn = tabrow(u, rl)[1];
#pragma unroll
                for (int bj = 0; bj < 2; ++bj) {
                    const pf4 h0 = *(const pf4*)(x + off + bj * 128) + acc[ai][bj][m][0] * rn, h1 = *(const pf4*)(x + off + bj * 128 + 4) + acc[ai][bj][m][1] * rn;
                    *(pf4*)(out + off + bj * 128) = h0; *(pf4*)(out + off + bj * 128 + 4) = h1;
                    sq += ((h0[0] * h0[0] + h0[1] * h0[1]) + (h0[2] * h0[2] + h0[3] * h0[3])) + ((h1[0] * h1[0] + h1[1] * h1[1]) + (h1[2] * h1[2] + h1[3] * h1[3]));
                    v4u w; w.x = pk2(h0[0], h0[1]); w.y = pk2(h0[2], h0[3]); w.z = pk2(h1[0], h1[1]); w.w = pk2(h1[2], h1[3]);
                    *(v4u*)(xn + off + bj * 128) = w; }
                sq += __shfl_xor(sq, 16); sq += __shfl_xor(sq, 32);
                if (fq == 0) P[rl * 4 + wc] = sq; }
        asm volatile("s_waitcnt lgkmcnt(0)\n\ts_barrier" ::: "memory");
        const int t = (wr * 4 + wc) * 64 + (fq * 16 + fr);
        if (t < 256) { const f32x4 p = *(const LAS f32x4*)(P + t * 4); ssq[(size_t)(u.pm * 256 + t) * 4 + u.pn] = (p[0] + p[1]) + (p[2] + p[3]); }
    }
};

struct EpiUp { static constexpr bool MID = false;
    static constexpr bool PERM = true;
    bf16* O; const float* ssq;
    __device__ __forceinline__ void operator()(const pf4 (&acc)[2][2][4][2], const pg8::Unit& u, int wr, int wc, int fr, int fq) const {
        const int row0 = u.pm * 256 + wr * 64 + fr, col0 = u.pn * 256 + wc * 32 + 8 * fq;
#pragma unroll
        for (int ai = 0; ai < 2; ++ai)
#pragma unroll
            for (int m = 0; m < 4; ++m) { const int row = row0 + ai * 128 + m * 16; bf16* rowp = O + (size_t)row * FF + col0;
                const pf4 s0 = *(const pf4*)(ssq + (size_t)row * 4);
                const float tot = (s0[0] + s0[1]) + (s0[2] + s0[3]);
                const float r2 = 1.f / (tot * (1.f / DM) + EPS);
#pragma unroll
                for (int bj = 0; bj < 2; ++bj) { pf4 v0 = acc[ai][bj][m][0], v1 = acc[ai][bj][m][1];
#pragma unroll
                    for (int i = 0; i < 4; ++i) { const float a = fmaxf(v0[i], 0.f), b = fmaxf(v1[i], 0.f); v0[i] = a * a * r2; v1[i] = b * b * r2; }
                    v4u w; w.x = pk2(v0[0], v0[1]); w.y = pk2(v0[2], v0[3]); w.z = pk2(v1[0], v1[1]); w.w = pk2(v1[2], v1[3]);
                    *(v4u*)(rowp + bj * 128) = w; } }
    }
};

struct EpiDownNorm { static constexpr bool MID = false;
    static constexpr bool PERM = true;
    float* out; const float* g; float* xs; gu32* cnt; LDSB* lds;
    __device__ __forceinline__ void operator()(pf4 (&acc)[2][2][4][2], const pg8::Unit& u, int wr, int wc, int fr, int fq) const {
        const int col0 = u.pn * 256 + wc * 32 + 8 * fq;
        LAS float* P = (LAS float*)(lds + L_IMP);
        LAS float* S = P + 1024;
#pragma unroll
        for (int ai = 0; ai < 2; ++ai)
#pragma unroll
            for (int m = 0; m < 4; ++m) { const int rl = ai * 128 + wr * 64 + m * 16 + fr; const size_t off = (size_t)(u.pm * 256 + rl) * DM + col0; float sq = 0.f;
#pragma unroll
                for (int bj = 0; bj < 2; ++bj) { const float* p = out + off + bj * 128;
                    const pf4 h0 = *(const pf4*)p + acc[ai][bj][m][0], h1 = *(const pf4*)(p + 4) + acc[ai][bj][m][1];
                    acc[ai][bj][m][0] = h0; acc[ai][bj][m][1] = h1;
                    sq += ((h0[0] * h0[0] + h0[1] * h0[1]) + (h0[2] * h0[2] + h0[3] * h0[3])) + ((h1[0] * h1[0] + h1[1] * h1[1]) + (h1[2] * h1[2] + h1[3] * h1[3])); }
                sq += __shfl_xor(sq, 16); sq += __shfl_xor(sq, 32);
                if (fq == 0) P[rl * 4 + wc] = sq; }
        asm volatile("s_waitcnt lgkmcnt(0)\n\ts_barrier" ::: "memory");
        const int wid = wr * 4 + wc, lane = fq * 16 + fr, t = wid * 64 + lane;
        if (t < 256) { const f32x4 p = *(const LAS f32x4*)(P + t * 4);
            __hip_atomic_store(xs + (size_t)(u.pm * 256 + t) * 4 + u.pn, (p[0] + p[1]) + (p[2] + p[3]), __ATOMIC_RELAXED, __HIP_MEMORY_SCOPE_AGENT); }
        asm volatile("s_waitcnt vmcnt(0)" ::: "memory");
        if (t < 256 && lane == 0) __hip_atomic_fetch_add(cnt + 64 * u.pm, 1u, RLX_AGENT);
        if (wid == 0) {
            unsigned sp = 0;
            while ((unsigned)__builtin_amdgcn_readfirstlane((int)__hip_atomic_load(cnt + 64 * u.pm, RLX_AGENT)) < 16u) { __builtin_amdgcn_s_sleep(2); if (++sp > (1u << 22)) break; }
            __builtin_amdgcn_fence(__ATOMIC_ACQUIRE, "agent");
            asm volatile("s_waitcnt vmcnt(0)" ::: "memory");
        }
        asm volatile("s_waitcnt lgkmcnt(0)\n\ts_barrier" ::: "memory");
        if (t < 256) { const float* sl = xs + (size_t)(u.pm * 256 + t) * 4;
            const float a0 = __hip_atomic_load(sl, RLX_AGENT), a1 = __hip_atomic_load(sl + 1, RLX_AGENT), a2 = __hip_atomic_load(sl + 2, RLX_AGENT), a3 = __hip_atomic_load(sl + 3, RLX_AGENT);
            S[t] = 1.f / sqrtf(((a0 + a1) + (a2 + a3)) * (1.f / DM) + EPS); }
        asm volatile("s_waitcnt lgkmcnt(0)\n\ts_barrier" ::: "memory");
#pragma unroll
        for (int bj = 0; bj < 2; ++bj) { const pf4 g0 = *(const pf4*)(g + col0 + bj * 128), g1 = *(const pf4*)(g + col0 + bj * 128 + 4);
#pragma unroll
            for (int ai = 0; ai < 2; ++ai)
#pragma unroll
                for (int m = 0; m < 4; ++m) { const int rl = ai * 128 + wr * 64 + m * 16 + fr; const float r = S[rl]; float* p = out + (size_t)(u.pm * 256 + rl) * DM + col0 + bj * 128;
                    *(pf4*)p = acc[ai][bj][m][0] * r * g0; *(pf4*)(p + 4) = acc[ai][bj][m][1] * r * g1; } }
    }
};

__device__ __forceinline__ void p2_cumsum_item(Frame& F, int item) {
    const float* fl = (const float*)(F.ws + WS_FL) + (size_t)item * SEQ; float* cb = (float*)(F.ws + WS_CB) + (size_t)item * SEQ;
    const int lane = F.lane;
    float v[64]; float run = 0.f;
#pragma unroll
    for (int i = 0; i < 16; ++i) { const f32x4 t = *(const f32x4*)(fl + lane * 64 + 4 * i); v[4 * i] = t[0]; v[4 * i + 1] = t[1]; v[4 * i + 2] = t[2]; v[4 * i + 3] = t[3]; }
#pragma unroll
    for (int i = 0; i < 64; ++i) { run += v[i]; v[i] = run; }
    float incl = run;
#pragma unroll
    for (int o = 1; o < 64; o <<= 1) { const float t = __shfl_up(incl, o); if (lane >= o) incl += t; }
    const float base = incl - run;
#pragma unroll
    for (int i = 0; i < 16; ++i) { f32x4 t; t[0] = -(v[4 * i] + base) * LOG2E; t[1] = -(v[4 * i + 1] + base) * LOG2E; t[2] = -(v[4 * i + 2] + base) * LOG2E; t[3] = -(v[4 * i + 3] + base) * LOG2E;
        *(f32x4*)(cb + lane * 64 + 4 * i) = t; }
}

__device__ __forceinline__ float gelu_tanh(float x) {
    const float u = 0.7978845608028654f * (x + 0.044715f * x * x * x);
    const float e = __expf(2.f * u);
    const float th = 1.f - 2.f / (e + 1.f);
    return 0.5f * x * (1.f + th);
}

__device__ __forceinline__ void p2_compress_item(Frame& F0, kptr_t kp, int item) {
    typedef float f4 __attribute__((ext_vector_type(4)));
    struct { unsigned char* ws; LDSB* lds; int tid, lane, wave; } F; F.ws = F0.ws; F.lds = F0.lds; F.wave = F0.wave;
    { int t_ = F0.tid; asm volatile("" : "+v"(t_)); F.tid = t_; F.lane = t_ & 63; }
    asm volatile("" : "+s"(F.ws));
    const int kv = item >> 6, bg = (item >> 2) & 15, cblk = item & 3, c0 = 64 * cblk;
    const int lane = F.lane, w = F.wave, fr = lane & 15, fq = lane >> 4;
    const bf16* Ab = (const bf16*)(F.ws + (kv ? WS_VC : WS_KC)) + (size_t)bg * SEQ * 64 + (size_t)c0 * 1024;
    const bf16* W1 = (const bf16*)(F.ws + (kv ? WS_W1V : WS_W1K));
    const bf16* W2 = (const bf16*)(F.ws + (kv ? WS_W2V : WS_W2K));
    const float* B1 = (const float*)(F.ws + (kv ? WS_B1V : WS_B1K));
    const float* b1 = AIN(kp, kv ? 12 : 7);
    const float* b2 = AIN(kp, kv ? 14 : 9);
    LDSB* lds = F.lds;
    LAS bf16* Hs = (LAS bf16*)(lds + 92160);
    f4 acc[4][2];
#pragma unroll
    for (int m = 0; m < 4; ++m) { acc[m][0] = (f4){0.f, 0.f, 0.f, 0.f}; acc[m][1] = (f4){0.f, 0.f, 0.f, 0.f}; }
    const int tid = F.tid, lrow = tid >> 3, lch = tid & 7;
    const bf16* ag = Ab + (size_t)lrow * 1024 + lch * 8;
    const bf16* bg_ = W1 + (size_t)lrow * 2048 + lch * 8;
    const int sto = (lrow * 72 + lch * 8) * 2;
    v4u ra = *(const v4u*)ag, rb[4];
#pragma unroll
    for (int i = 0; i < 4; ++i) rb[i] = *(const v4u*)(bg_ + (size_t)i * 64 * 2048);
    *(LAS v4u*)(lds + sto) = ra;
#pragma unroll
    for (int i = 0; i < 4; ++i) *(LAS v4u*)(lds + 18432 + sto + i * 64 * 144) = rb[i];
    __syncthreads();
    for (int ks = 0; ks < 32; ++ks) {
        const int cb = ks & 1;
        if (ks + 1 < 32) { ra = *(const v4u*)(ag + (ks + 1) * 64);
#pragma unroll
            for (int i = 0; i < 4; ++i) rb[i] = *(const v4u*)(bg_ + (size_t)i * 64 * 2048 + (ks + 1) * 64); }
        const LDSB* As = lds + cb * 9216; const LDSB* Bs = lds + 18432 + cb * 36864;
#pragma unroll
        for (int kh = 0; kh < 2; ++kh) {
            bf16x8 a[4], b[2];
#pragma unroll
            for (int m = 0; m < 4; ++m) a[m] = *(const LAS bf16x8*)(As + ((16 * m + fr) * 72 + 32 * kh + 8 * fq) * 2);
#pragma unroll
            for (int n = 0; n < 2; ++n) b[n] = *(const LAS bf16x8*)(Bs + ((32 * w + 16 * n + fr) * 72 + 32 * kh + 8 * fq) * 2);
#pragma unroll
            for (int m = 0; m < 4; ++m)
#pragma unroll
                for (int n = 0; n < 2; ++n) acc[m][n] = __builtin_amdgcn_mfma_f32_16x16x32_bf16(a[m], b[n], acc[m][n], 0, 0, 0);
        }
        if (ks + 1 < 32) {
            *(LAS v4u*)(lds + (cb ^ 1) * 9216 + sto) = ra;
#pragma unroll
            for (int i = 0; i < 4; ++i) *(LAS v4u*)(lds + 18432 + (cb ^ 1) * 36864 + sto + i * 64 * 144) = rb[i];
        }
        __syncthreads();
    }
    float bbv[2];
#pragma unroll
    for (int n = 0; n < 2; ++n) { const int col = 32 * w + 16 * n + fr; float bb = b1[col];
#pragma unroll 8
        for (int kc = 0; kc < 64; ++kc) bb += B1[kc * 256 + col];
        bbv[n] = bb; }
#pragma unroll
    for (int m = 0; m < 4; ++m)
#pragma unroll
        for (int n = 0; n < 2; ++n) { const int col = 32 * w + 16 * n + fr;
#pragma unroll
            for (int r = 0; r < 4; ++r) Hs[(16 * m + 4 * fq + r) * 264 + col] = (bf16)f2bf(gelu_tanh(acc[m][n][r] + bbv[n])); }
    __syncthreads();
    const int mt = w >> 1, ntA = (w & 1), ntB = (w & 1) + 2;
    f4 oa = (f4){0.f, 0.f, 0.f, 0.f}, ob = (f4){0.f, 0.f, 0.f, 0.f};
#pragma unroll
    for (int k0 = 0; k0 < 256; k0 += 32) {
        const bf16x8 a = *(const LAS bf16x8*)(Hs + (16 * mt + fr) * 264 + k0 + 8 * fq);
        const bf16x8 bA = *(const bf16x8*)(W2 + (size_t)(16 * ntA + fr) * 256 + k0 + 8 * fq);
        const bf16x8 bB = *(const bf16x8*)(W2 + (size_t)(16 * ntB + fr) * 256 + k0 + 8 * fq);
        oa = __builtin_amdgcn_mfma_f32_16x16x32_bf16(a, bA, oa, 0, 0, 0);
        ob = __builtin_amdgcn_mfma_f32_16x16x32_bf16(a, bB, ob, 0, 0, 0);
    }
    const int d1 = 16 * (w & 1) + fr;
    const float bb1 = b2[d1], bb2 = b2[d1 + 32];
    const float* RC = (const float*)(F.ws + WS_ROPEC); const float* RS = (const float*)(F.ws + WS_ROPES);
    bf16* O = (bf16*)(F.ws + (kv ? WS_VCMP : WS_KCMP)) + (size_t)bg * 256 * 64;
#pragma unroll
    for (int r = 0; r < 4; ++r) { const int c = c0 + 16 * mt + 4 * fq + r;
        float x1 = oa[r] + bb1, x2 = ob[r] + bb2;
        if (kv == 0) { int pos = 16 * c + 31; pos = pos > 4095 ? 4095 : pos; const float cs = RC[pos * 32 + d1], sn = RS[pos * 32 + d1];
            const float y1 = x1 * cs - x2 * sn, y2 = x1 * sn + x2 * cs; x1 = y1; x2 = y2; }
        O[(size_t)c * 64 + d1] = (bf16)f2bf(x1); O[(size_t)c * 64 + d1 + 32] = (bf16)f2bf(x2); }
    __syncthreads();
}

__device__ __forceinline__ int crow(int r, int hi) { return (r & 3) + 8 * (r >> 2) + 4 * hi; }
__device__ __forceinline__ void glds16(const void* gsrc, unsigned lds_dst) { unsigned keep;
    asm volatile("s_mov_b32 %0, m0\n\ts_mov_b32 m0, %2\n\ts_nop 0\n\tglobal_load_lds_dwordx4 %1, off\n\ts_mov_b32 m0, %0" : "=&s"(keep) : "v"(gsrc), "s"(lds_dst) : "memory"); }
#define WAIT_BAR(N) asm volatile("s_waitcnt vmcnt(" #N ") lgkmcnt(0)\n\ts_barrier" ::: "memory")
__device__ __forceinline__ unsigned cvtpk_s(float lo, float hi) { typedef float f2 __attribute__((ext_vector_type(2))); typedef __bf16 b2 __attribute__((ext_vector_type(2)));
    f2 v = {lo, hi}; b2 b = __builtin_convertvector(v, b2); return __builtin_bit_cast(unsigned, b); }
__device__ __forceinline__ s16x4 vtr(const LDSB* p) { return __builtin_bit_cast(s16x4, __builtin_amdgcn_ds_read_tr16_b64_v4i16((LAS v4i16_t*)p)); }

__device__ __forceinline__ float xh_max(float a) { auto r = __builtin_amdgcn_permlane32_swap(__float_as_uint(a), __float_as_uint(a), false, false); return fmaxf(__uint_as_float(r[0]), __uint_as_float(r[1])); }
__device__ __forceinline__ float xh_sum(float a) { auto r = __builtin_amdgcn_permlane32_swap(__float_as_uint(a), __float_as_uint(a), false, false); return __uint_as_float(r[0]) + __uint_as_float(r[1]); }
__device__ __forceinline__ float xh_other(float a, int hi) { auto r = __builtin_amdgcn_permlane32_swap(__float_as_uint(a), __float_as_uint(a), false, false); return hi ? __uint_as_float(r[0]) : __uint_as_float(r[1]); }
__device__ __forceinline__ float wave_max_u(float v) {
#define DPPMAX_(ctrl) v = fmaxf(v, __builtin_bit_cast(float, __builtin_amdgcn_update_dpp(__builtin_bit_cast(int, v), __builtin_bit_cast(int, v), ctrl, 0xF, 0xF, false)))
    DPPMAX_(0x111); DPPMAX_(0x112); DPPMAX_(0x114); DPPMAX_(0x118);
#undef DPPMAX_
    const float a = __builtin_bit_cast(float, __builtin_amdgcn_readlane(__builtin_bit_cast(int, v), 15)), b = __builtin_bit_cast(float, __builtin_amdgcn_readlane(__builtin_bit_cast(int, v), 31));
    const float c = __builtin_bit_cast(float, __builtin_amdgcn_readlane(__builtin_bit_cast(int, v), 47)), d = __builtin_bit_cast(float, __builtin_amdgcn_readlane(__builtin_bit_cast(int, v), 63));
    return fmaxf(fmaxf(a, b), fmaxf(c, d));
}
__device__ __forceinline__ void qkt(f32x16& p0, f32x16& p1, const LDSB* kslot, const bf16x8 (&qr)[4], const f32x16& cinit, int r32, int hi) {
    const LDSB* kb = kslot + hi * 1024 + r32 * 16;
#pragma unroll
    for (int d0 = 0; d0 < 4; ++d0) {
        const bf16x8 b0 = *(const LAS bf16x8*)(kb + d0 * 2048);
        const bf16x8 b1 = *(const LAS bf16x8*)(kb + d0 * 2048 + 512);
        if (d0 == 0) { p0 = __builtin_amdgcn_mfma_f32_32x32x16_bf16(b0, qr[0], cinit, 0, 0, 0); p1 = __builtin_amdgcn_mfma_f32_32x32x16_bf16(b1, qr[0], cinit, 0, 0, 0); }
        else { p0 = __builtin_amdgcn_mfma_f32_32x32x16_bf16(b0, qr[d0], p0, 0, 0, 0); p1 = __builtin_amdgcn_mfma_f32_32x32x16_bf16(b1, qr[d0], p1, 0, 0, 0); }
    }
}
__device__ __forceinline__ void pv(f32x16 (&o)[2], const LDSB* vp, const f32x16& p0, const f32x16& p1) {
    v4u pw[4];
    pw[0] = (v4u){cvtpk_s(p0[0], p0[1]), cvtpk_s(p0[2], p0[3]), cvtpk_s(p0[4], p0[5]), cvtpk_s(p0[6], p0[7])};
    pw[1] = (v4u){cvtpk_s(p0[8], p0[9]), cvtpk_s(p0[10], p0[11]), cvtpk_s(p0[12], p0[13]), cvtpk_s(p0[14], p0[15])};
    pw[2] = (v4u){cvtpk_s(p1[0], p1[1]), cvtpk_s(p1[2], p1[3]), cvtpk_s(p1[4], p1[5]), cvtpk_s(p1[6], p1[7])};
    pw[3] = (v4u){cvtpk_s(p1[8], p1[9]), cvtpk_s(p1[10], p1[11]), cvtpk_s(p1[12], p1[13]), cvtpk_s(p1[14], p1[15])};
#pragma unroll
    for (int d0 = 0; d0 < 2; ++d0)
#pragma unroll
        for (int ks = 0; ks < 4; ++ks) {
            const s16x4 lo = vtr(vp + d0 * 4096 + ks * 1024), hi = vtr(vp + d0 * 4096 + ks * 1024 + 512);
            const bf16x8 vf = (bf16x8){lo[0], lo[1], lo[2], lo[3], hi[0], hi[1], hi[2], hi[3]};
            o[d0] = __builtin_amdgcn_mfma_f32_32x32x16_bf16(__builtin_bit_cast(bf16x8, pw[ks]), vf, o[d0], 0, 0, 0);
        }
}
__device__ __forceinline__ float rowmax32(const f32x16& p0, const f32x16& p1) {
    float a = fmaxf(p0[0], p1[0]);
#pragma unroll
    for (int r = 1; r < 16; ++r) a = fmaxf(a, fmaxf(p0[r], p1[r]));
    return xh_max(a);
}
__device__ __forceinline__ float rowsum32(const f32x16& p0, const f32x16& p1) {
    float a = 0.f, b = 0.f;
#pragma unroll
    for (int r = 0; r < 16; ++r) { a += p0[r]; b += p1[r]; }
    return a + b;
}

template <int PITCH>
__device__ __forceinline__ void dma_kv(const bf16* Kh, const bf16* Vh, int key0, unsigned kdst, unsigned vdst, int wid, int lane) {
    const bf16* ksrc = Kh + (size_t)(key0 + lane) * PITCH + wid * 8;
    const bf16* vsrc = Vh + (size_t)(key0 + 16 * (wid & 3) + (lane >> 2)) * PITCH + (wid >> 2) * 32 + (lane & 3) * 8;
    glds16(ksrc, (unsigned)__builtin_amdgcn_readfirstlane(kdst + wid * 1024));
    glds16(vsrc, (unsigned)__builtin_amdgcn_readfirstlane(vdst + wid * 1024));
}


#define SBAR() __builtin_amdgcn_sched_barrier(0)
__device__ __forceinline__ void kload8(bf16x8* kf, const LDSB* kp) {
    kf[0] = *(const LAS bf16x8*)(kp);        kf[1] = *(const LAS bf16x8*)(kp + 512);
    kf[2] = *(const LAS bf16x8*)(kp + 2048); kf[3] = *(const LAS bf16x8*)(kp + 2560);
    kf[4] = *(const LAS bf16x8*)(kp + 4096); kf[5] = *(const LAS bf16x8*)(kp + 4608);
    kf[6] = *(const LAS bf16x8*)(kp + 6144); kf[7] = *(const LAS bf16x8*)(kp + 6656);
}
__device__ __forceinline__ void kload2(bf16x8* kf, const LDSB* kp, int j) { kf[2 * j] = *(const LAS bf16x8*)(kp + j * 2048); kf[2 * j + 1] = *(const LAS bf16x8*)(kp + j * 2048 + 512); }

template <int MODE>
__device__ __forceinline__ void att_mod(f32x16& C0, f32x16& C1, int j, int qabs, int qw0, int cur, unsigned sel_lo, unsigned sel_hi, const LAS float* kbias, int hi) {
    if (MODE == 0) {
        const LAS float* kb = kbias + 64 * j + 4 * hi;
#pragma unroll
        for (int g4 = 0; g4 < 4; ++g4) { const f32x4 b0 = *(const LAS f32x4*)(kb + 8 * g4), b1 = *(const LAS f32x4*)(kb + 32 + 8 * g4);
#pragma unroll
            for (int i = 0; i < 4; ++i) { C0[4 * g4 + i] += b0[i]; C1[4 * g4 + i] += b1[i]; } }
        if (64 * j + 63 > qw0) {
#pragma unroll
            for (int r = 0; r < 16; ++r) { const int kv = 64 * j + crow(r, hi); if (kv > qabs) C0[r] = NEGM; if (kv + 32 > qabs) C1[r] = NEGM; }
        }
    } else if (MODE == 1) {
        const bool sel = ((j < 32 ? (sel_lo >> j) : (sel_hi >> (j - 32))) & 1u) != 0u;
        if (j == cur) {
#pragma unroll
            for (int r = 0; r < 16; ++r) { const int kv = 64 * j + crow(r, hi); if (kv > qabs || !sel) C0[r] = NEGM; if (kv + 32 > qabs || !sel) C1[r] = NEGM; }
        } else {
#pragma unroll
            for (int r = 0; r < 16; ++r) { if (!sel) { C0[r] = NEGM; C1[r] = NEGM; } }
        }
    } else {
        if (j == cur || j + 8 <= cur) {
#pragma unroll
            for (int r = 0; r < 16; ++r) { const int kv = 64 * j + crow(r, hi);
                if (kv > qabs || kv < qabs - 511) C0[r] = NEGM; if (kv + 32 > qabs || kv + 32 < qabs - 511) C1[r] = NEGM; }
        }
    }
}

template <int MODE, int PITCH, int THRL>
__device__ __forceinline__ void attn_fast(LDSB* lds, const bf16* Kh, const bf16* Vh, const LAS unsigned char* tl, int NT_in, const bf16x8 (&qr)[4], int qabs, int qw0, int cur,
                                          unsigned sel_lo, unsigned sel_hi, const LAS float* kbias, float skipb, f32x16 (&o)[2], float& l_out, int wid, int lane) {
    int NT = NT_in;
    const int r32 = lane & 31, hi = lane >> 5;
    const unsigned lds0 = (unsigned)(uintptr_t)lds;
    LAS float* wsf = (LAS float*)(lds + L_WS) + wid * 256;
    const bf16* ksrc = Kh + (size_t)lane * PITCH + wid * 8;
    const bf16* vsrc = Vh + (size_t)(16 * (wid & 3) + (lane >> 2)) * PITCH + (wid >> 2) * 32 + (lane & 3) * 8;
    const unsigned kdst = lds0 + L_K + wid * 1024, vdst = lds0 + L_V + wid * 1024;
#define TILE(t) __builtin_amdgcn_readfirstlane((int)tl[t])
#define DMA_K(t, slot) glds16(ksrc + (size_t)TILE(t) * (64 * PITCH), (unsigned)__builtin_amdgcn_readfirstlane(kdst + (slot)))
#define DMA_V(t, slot) glds16(vsrc + (size_t)TILE(t) * (64 * PITCH), (unsigned)__builtin_amdgcn_readfirstlane(vdst + (slot)))
    const LDSB* kp0 = lds + L_K + hi * 1024 + r32 * 16;
    const LDSB* vp0 = lds + L_V + ((lane >> 4) & 1) * 32 + (lane & 3) * 8 + (4 * hi + ((lane & 15) >> 2)) * 64;
    bf16x8 kf[8];
    float mhat = 0.f, l_reg = 0.f;
    f32x16 negm;
#pragma unroll
    for (int r = 0; r < 16; ++r) { negm[r] = 0.f; o[0][r] = 0.f; o[1][r] = 0.f; }
    asm volatile("" : "+v"(negm));
    bool resc = false;
    f32x16 pA0, pA1, pB0, pB1;
    int sl_prev = 0, sl_cur = 0, sl_next = SLOTB, sl_last = 0;
#define ROT() do { sl_prev = sl_cur; sl_cur = sl_next; sl_next = (sl_next == 2 * SLOTB) ? 0 : sl_next + SLOTB; } while (0)
#define RESC() do { if (resc) { LDS_WAIT(); \
        _Pragma("unroll") for (int d_ = 0; d_ < 2; ++d_) _Pragma("unroll") for (int r = 0; r < 16; ++r) o[d_][r] *= wsf[crow(r, hi)]; } } while (0)
#define ENDW(tt) do { if ((tt) + 3 < NT) { WAIT_BAR(2); } else if ((tt) + 2 < NT) { WAIT_BAR(1); } else { WAIT_BAR(0); } } while (0)
    DMA_K(0, 0); DMA_V(0, 0); if (NT > 1) DMA_K(1, SLOTB); if (NT > 2) DMA_K(2, 2 * SLOTB);
    if (NT > 2) { WAIT_BAR(3); } else if (NT > 1) { WAIT_BAR(2); } else { WAIT_BAR(1); }
    {
        const int j0 = TILE(0);
        qkt(pA0, pA1, lds + L_K, qr, negm, r32, hi);
        att_mod<MODE>(pA0, pA1, j0, qabs, qw0, cur, sel_lo, sel_hi, kbias, hi);
        const float rm = rowmax32(pA0, pA1);
        mhat += rm;
#pragma unroll
        for (int r = 0; r < 16; ++r) { pA0[r] -= rm; pA1[r] -= rm; negm[r] = -mhat; }
        asm volatile("" : "+v"(negm));
#pragma unroll
        for (int r = 0; r < 16; ++r) { pA0[r] = __builtin_amdgcn_exp2f(pA0[r]); pA1[r] = __builtin_amdgcn_exp2f(pA1[r]); }
    }
    WAIT_BAR(0);
    if (NT > 3) DMA_K(3, 0);
    if (NT > 1) DMA_V(1, SLOTB);
    ROT();
    if (NT > 1) kload8(kf, kp0 + sl_cur);
    ENDW(0);
    s16x4 vlo[8], vhi[8]; v4u pw0, pw1, pw2, pw3;
#define PKW(P, B) cvtpk_s(P[B], P[B + 1])
#define PAF(k) __builtin_bit_cast(bf16x8, pw##k)
#define VFR(i) (bf16x8){vlo[i][0], vlo[i][1], vlo[i][2], vlo[i][3], vhi[i][0], vhi[i][1], vhi[i][2], vhi[i][3]}
#define PIN(x) asm volatile("" : "+v"(x))
#define MX3(a, b, c) __builtin_fmaxf(__builtin_fmaxf((a), (b)), (c))
#define GAPA(MF, A0, A1, A2, A3, W0, W1, PW) do { MF; sacc += A0; sacc += A1; sacc += A2; sacc += A3; PIN(sacc); W0; W1; PIN(PW); SBAR(); } while (0)
#define EX(v) __builtin_amdgcn_exp2f(v)
#define GAPB(MF, X, B) do { MF; X[B] = EX(X[B]); X[B + 1] = EX(X[B + 1]); X[B + 2] = EX(X[B + 2]); X[B + 3] = EX(X[B + 3]); PIN(X); SBAR(); } while (0)
#define VRD(i) do { vlo[i] = vtr(vp_ + (((i) >> 2) * 4096 + ((i) & 3) * 1024)); vhi[i] = vtr(vp_ + (((i) >> 2) * 4096 + ((i) & 3) * 1024 + 512)); } while (0)
#define KRD(G, j) do { if (G) { kload2(kf, kp0 + sl_next, j); SBAR(); } } while (0)
#define MFMA32 __builtin_amdgcn_mfma_f32_32x32x16_bf16
#define STEP(C0, C1, P0, P1, t) do { const int jt_ = TILE(t); const bool GK_ = (t) + 3 < NT, GV_ = (t) + 1 < NT; sl_last = sl_cur; SBAR(); \
    const LDSB* vp_ = vp0 + sl_prev; \
    VRD(0); SBAR(); float sacc = (P0[0] + P0[1]); \
    GAPA(C0 = MFMA32(kf[0], qr[0], negm, 0, 0, 0), P0[2], P0[3], P0[4], P0[5],     pw0[0] = PKW(P0, 0), pw0[1] = PKW(P0, 2), pw0); \
    VRD(4); SBAR(); GAPA(C1 = MFMA32(kf[1], qr[0], negm, 0, 0, 0), P0[6], P0[7], P0[8], P0[9],     pw0[2] = PKW(P0, 4), pw0[3] = PKW(P0, 6), pw0); \
    VRD(1); SBAR(); GAPA(C0 = MFMA32(kf[2], qr[1], C0, 0, 0, 0),   P0[10], P0[11], P0[12], P0[13], pw1[0] = PKW(P0, 8), pw1[1] = PKW(P0, 10), pw1); \
    VRD(5); SBAR(); GAPA(C1 = MFMA32(kf[3], qr[1], C1, 0, 0, 0),   P0[14], P0[15], P1[0], P1[1],   pw1[2] = PKW(P0, 12), pw1[3] = PKW(P0, 14), pw1); \
    VRD(2); SBAR(); GAPA(C0 = MFMA32(kf[4], qr[2], C0, 0, 0, 0),   P1[2], P1[3], P1[4], P1[5],     pw2[0] = PKW(P1, 0), pw2[1] = PKW(P1, 2), pw2); \
    VRD(6); SBAR(); GAPA(C1 = MFMA32(kf[5], qr[2], C1, 0, 0, 0),   P1[6], P1[7], P1[8], P1[9],     pw2[2] = PKW(P1, 4), pw2[3] = PKW(P1, 6), pw2); \
    VRD(3); SBAR(); GAPA(C0 = MFMA32(kf[6], qr[3], C0, 0, 0, 0),   P1[10], P1[11], P1[12], P1[13], pw3[0] = PKW(P1, 8), pw3[1] = PKW(P1, 10), pw3); \
    VRD(7); SBAR(); GAPA(C1 = MFMA32(kf[7], qr[3], C1, 0, 0, 0),   P1[14], P1[15], 0.f, 0.f,       pw3[2] = PKW(P1, 12), pw3[3] = PKW(P1, 14), pw3); \
    l_reg += sacc; \
    if (GK_) { DMA_K((t) + 3, sl_cur); } if (GV_) { DMA_V((t) + 1, sl_next); } \
    att_mod<MODE>(C0, C1, jt_, qabs, qw0, cur, sel_lo, sel_hi, kbias, hi); \
    { float a = MX3(C0[0], C0[1], C1[0]), b = MX3(C0[2], C0[3], C1[1]); a = MX3(a, C1[2], C1[3]); \
      _Pragma("unroll") for (int r = 4; r < 16; r += 4) { a = MX3(a, C0[r], C0[r + 1]); b = MX3(b, C0[r + 2], C0[r + 3]); a = MX3(a, C1[r], C1[r + 1]); b = MX3(b, C1[r + 2], C1[r + 3]); } \
      float rm = xh_max(__builtin_fmaxf(a, b)); \
      resc = false; \
      if (__builtin_expect(__any(rm > (float)THRL), 0)) { const float dl = __builtin_fmaxf(rm, 0.f); mhat += dl; \
        _Pragma("unroll") for (int r = 0; r < 16; ++r) { C0[r] -= dl; C1[r] -= dl; } \
        _Pragma("unroll") for (int r = 0; r < 16; ++r) negm[r] = -mhat; asm volatile("" : "+v"(negm)); \
        const float f = __builtin_amdgcn_exp2f(-dl); l_reg *= f; if (hi == 0) wsf[r32] = f; resc = true; } } \
    SBAR(); \
    GAPB(o[0] = MFMA32(PAF(0), VFR(0), o[0], 0, 0, 0), C0, 0); \
    GAPB(o[1] = MFMA32(PAF(0), VFR(4), o[1], 0, 0, 0), C0, 4); \
    KRD(GV_, 0); GAPB(o[0] = MFMA32(PAF(1), VFR(1), o[0], 0, 0, 0), C0, 8); \
    KRD(GV_, 1); GAPB(o[1] = MFMA32(PAF(1), VFR(5), o[1], 0, 0, 0), C0, 12); \
    KRD(GV_, 2); GAPB(o[0] = MFMA32(PAF(2), VFR(2), o[0], 0, 0, 0), C1, 0); \
    KRD(GV_, 3); GAPB(o[1] = MFMA32(PAF(2), VFR(6), o[1], 0, 0, 0), C1, 4); \
    GAPB(o[0] = MFMA32(PAF(3), VFR(3), o[0], 0, 0, 0), C1, 8); \
    GAPB(o[1] = MFMA32(PAF(3), VFR(7), o[1], 0, 0, 0), C1, 12); \
    } while (0)
    int t = 1;
    for (; t + 1 < NT; t += 2) {
        STEP(pB0, pB1, pA0, pA1, t);
        if (MODE == 0 && t == 3 && NT_in > 8) { const float wm = -wave_max_u(-mhat); if (lane == 0) wsf[192] = wm; }
        ENDW(t);     RESC(); ROT();
        if (MODE == 0 && t == 3 && NT_in > 8) {
            const LAS float* wsall = (const LAS float*)(lds + L_WS);
            float mn = wsall[192];
#pragma unroll
            for (int w = 1; w < 8; ++w) mn = fminf(mn, wsall[w * 256 + 192]);
            const float thr = mn - skipb;
            const bool keep = (lane < NT_in) && (kbias[64 * lane + 63] >= thr);
            const unsigned long long bal = __ballot(keep);
            const int jkeep = bal ? __builtin_ctzll(bal) : 0;
            int ntn = NT_in - jkeep; if (ntn < 8) ntn = 8;
            NT = __builtin_amdgcn_readfirstlane(ntn < NT ? ntn : NT);
        }
        STEP(pA0, pA1, pB0, pB1, t + 1); ENDW(t + 1); RESC(); ROT();
    }
    const LDSB* vlane_p = lds + L_V + ((lane >> 4) & 1) * 32 + (lane & 3) * 8 + (4 * hi + ((lane & 15) >> 2)) * 64;
    if (t < NT) {
        STEP(pB0, pB1, pA0, pA1, t); ENDW(t); RESC();
        l_reg += rowsum32(pB0, pB1);
        pv(o, vlane_p + sl_last, pB0, pB1);
    } else {
        l_reg += rowsum32(pA0, pA1);
        pv(o, vlane_p + sl_last, pA0, pA1);
    }
    l_out = xh_sum(l_reg);
    asm volatile("s_waitcnt lgkmcnt(0)\n\ts_barrier" ::: "memory");
#undef TILE
#undef DMA_K
#undef DMA_V
#undef ROT
#undef RESC
#undef ENDW
#undef PKW
#undef PAF
#undef VFR
#undef PIN
#undef MX3
#undef GAPA
#undef EX
#undef GAPB
#undef VRD
#undef KRD
#undef MFMA32
#undef STEP
}

__device__ __forceinline__ void load_rowvec(float (&fac)[16], const LAS float* tab, int hi) {
#pragma unroll
    for (int g4 = 0; g4 < 4; ++g4) { const f32x4 ff = *(const LAS f32x4*)(tab + 8 * g4 + 4 * hi);
#pragma unroll
        for (int i = 0; i < 4; ++i) fac[4 * g4 + i] = ff[i]; }
}

template <int PITCHO>
__device__ __forceinline__ void store_o_tile(LDSB* stage, const f32x16 (&o)[2], bf16* Ow, float* ssq, int lane) {
    const int r32 = lane & 31, hi = lane >> 5;
    LAS bf16* stg = (LAS bf16*)stage;
#pragma unroll
    for (int r = 0; r < 16; ++r) { const int orow = crow(r, hi);
#pragma unroll
        for (int d0 = 0; d0 < 2; ++d0) stg[orow * 64 + d0 * 32 + r32] = (bf16)f2bf(o[d0][r]); }
    LDS_WAIT();
#pragma unroll
    for (int i = 0; i < 4; ++i) { const int row = i * 8 + (lane >> 3), ch = lane & 7; const v4u v = *(const LAS v4u*)(stg + row * 64 + ch * 8); *(v4u*)(Ow + (size_t)row * PITCHO + ch * 8) = v;
        const unsigned w[4] = {v.x, v.y, v.z, v.w}; float sq = 0.f;
#pragma unroll
        for (int k = 0; k < 4; ++k) { const float a = __builtin_bit_cast(float, w[k] << 16), b = __builtin_bit_cast(float, w[k] & 0xffff0000u); sq += a * a + b * b; }
        sq += __builtin_bit_cast(float, __builtin_amdgcn_update_dpp(0, __builtin_bit_cast(int, sq), 0xB1, 0xF, 0xF, true));
        sq += __builtin_bit_cast(float, __builtin_amdgcn_update_dpp(0, __builtin_bit_cast(int, sq), 0x4E, 0xF, 0xF, true));
        sq += __builtin_bit_cast(float, __builtin_amdgcn_update_dpp(0, __builtin_bit_cast(int, sq), 0x141, 0xF, 0xF, true));
        if (ch == 0) ssq[(size_t)row * 16] = sq; }
    LDS_WAIT();
}

__device__ __forceinline__ void fox_unit(Frame& F0, int b, int h, int qb) {
    struct { unsigned char* ws; LDSB* lds; int tid, wave; } F; F.ws = F0.ws; F.lds = F0.lds; F.tid = F0.tid; F.wave = F0.wave;
    asm volatile("" : "+s"(F.ws));
    LDSB* lds = F.lds; int tid_ = F.tid; asm volatile("" : "+v"(tid_));
    const int tid = tid_, lane = tid & 63, wid = F.wave, r32 = lane & 31, hi = lane >> 5;
    const int q0 = 256 * qb, NT = 4 * qb + 4;
    const float* cb = (const float*)(F.ws + WS_CB) + (size_t)(b * 8 + h) * SEQ;
    LAS float* kb = (LAS float*)(lds + L_ACC);
    for (int i = tid; i < q0 + 256; i += NTHR) kb[i] = cb[i];
    LAS unsigned char* tl = (LAS unsigned char*)(lds + L_TL);
    if (tid < NT) tl[tid] = (unsigned char)(NT - 1 - tid);
    const bf16* Qw = (const bf16*)(F.ws + WS_QF) + ((size_t)b * SEQ + q0 + 32 * wid) * 512 + h * 64;
    bf16x8 qr[4];
#pragma unroll
    for (int d0 = 0; d0 < 4; ++d0) qr[d0] = *(const bf16x8*)(Qw + (size_t)r32 * 512 + d0 * 16 + hi * 8);
    {
        float q2 = 0.f;
#pragma unroll
        for (int d0 = 0; d0 < 4; ++d0)
#pragma unroll
            for (int e = 0; e < 8; ++e) { const float v = bf2f((unsigned short)qr[d0][e]); q2 += v * v; }
        q2 = xh_sum(q2);
        const float wq = wave_max_u(q2);
        if (lane == 0) ((LAS float*)(lds + L_WS))[wid * 256 + 193] = wq;
    }
    LDS_WAIT(); __syncthreads();
    float skipb;
    {   const LAS float* wsall = (const LAS float*)(lds + L_WS); float qm = wsall[193];
#pragma unroll
        for (int w = 1; w < 8; ++w) qm = fmaxf(qm, wsall[w * 256 + 193]);
        const float km = __uint_as_float(((const unsigned*)(F.ws + WS_CTL))[CW_KMAX + b * 8 + h]);
        skipb = 161.f + 1.02f * sqrtf(qm * km); }
    const bf16* Kh = (const bf16*)(F.ws + WS_KF) + (size_t)b * SEQ * 512 + h * 64;
    const bf16* Vh = (const bf16*)(F.ws + WS_VF) + (size_t)b * SEQ * 512 + h * 64;
    f32x16 o[2]; float l;
    attn_fast<0, 512, 8>(lds, Kh, Vh, tl, NT, qr, q0 + 32 * wid + r32, q0 + 32 * wid, 0, 0u, 0u, kb, skipb, o, l, wid, lane);
    LAS float* wsf = (LAS float*)(lds + L_WS) + wid * 256;
    if (hi == 0) wsf[32 + r32] = 1.f / l;
    LDS_WAIT();
    float fac[16]; load_rowvec(fac, wsf + 32, hi);
#pragma unroll
    for (int r = 0; r < 16; ++r) { o[0][r] *= fac[r]; o[1][r] *= fac[r]; }
    bf16* Ow = (bf16*)(F.ws + WS_Y) + ((size_t)b * SEQ + q0 + 32 * wid) * 1024 + h * 64;
    store_o_tile<1024>(lds + L_ACC + 16384 + wid * 4096, o, Ow, (float*)(F.ws + WS_SSQY) + ((size_t)b * SEQ + q0 + 32 * wid) * 16 + h, lane);
    __syncthreads();
}

__device__ __forceinline__ void nsa_unit(Frame& F0, int b, int g, int cur) {
    struct { unsigned char* ws; LDSB* lds; int tid, wave; } F; F.ws = F0.ws; F.lds = F0.lds; F.tid = F0.tid; F.wave = F0.wave;
    asm volatile("" : "+s"(F.ws));
    LDSB* lds = F.lds; int tid_ = F.tid; asm volatile("" : "+v"(tid_));
    const int tid = tid_, lane = tid & 63, wid = F.wave, r32 = lane & 31, hi = lane >> 5;
    const int bg = b * 2 + g, hh = wid >> 1, head = 4 * g + hh, qh = wid & 1, qq = 32 * qh + r32, qpos = 64 * cur + qq;
    const unsigned lds0 = (unsigned)(uintptr_t)lds;
    LAS float* wsf = (LAS float*)(lds + L_WS) + wid * 256;
    LAS float* accw = (LAS float*)(lds + L_ACC) + wid * 2048;
    const size_t row0 = (size_t)b * SEQ + 64 * cur + 32 * qh;
    const bf16* Qw = (const bf16*)(F.ws + WS_QN) + row0 * 512 + head * 64;
    bf16x8 qr[4];
#pragma unroll
    for (int d0 = 0; d0 < 4; ++d0) qr[d0] = *(const bf16x8*)(Qw + (size_t)r32 * 512 + d0 * 16 + hi * 8);
    if (tid < 2) ((LAS unsigned*)(lds + L_TL + 128))[tid] = 0u;
    if (lane < 32) { const float* gp = (const float*)(F.ws + WS_GATE) + (row0 + lane) * 24 + head * 3;
        wsf[64 + lane] = gp[0]; wsf[96 + lane] = gp[1]; wsf[128 + lane] = gp[2]; }
    LDS_WAIT();
    {
        const bf16* Kc = (const bf16*)(F.ws + WS_KCMP) + (size_t)bg * 256 * 64;
        const bf16* Vc = (const bf16*)(F.ws + WS_VCMP) + (size_t)bg * 256 * 64;
        const int ntl = (4 * cur + 66) >> 6;
#pragma unroll
        for (int tl = 0; tl < 4; ++tl) if (tl < ntl) dma_kv<64>(Kc, Vc, 64 * tl, lds0 + L_K + tl * SLOTB, lds0 + L_V + tl * SLOTB, wid, lane);
        WAIT_BAR(0);
        f32x16 zero;
#pragma unroll
        for (int r = 0; r < 16; ++r) zero[r] = 0.f;
        float mrun = -1e30f;
#pragma unroll 1
        for (int tl = 0; tl < ntl; ++tl) {
            f32x16 p0, p1;
            qkt(p0, p1, lds + L_K + tl * SLOTB, qr, zero, r32, hi);
#pragma unroll
            for (int r = 0; r < 16; ++r) { const int c = 64 * tl + crow(r, hi); if (16 * c + 31 > qpos) p0[r] = NEGM; if (16 * (c + 32) + 31 > qpos) p1[r] = NEGM; }
            mrun = fmaxf(mrun, rowmax32(p0, p1));
            asm volatile("" ::: "memory");
        }
        f32x16 o[2];
#pragma unroll
        for (int r = 0; r < 16; ++r) { o[0][r] = 0.f; o[1][r] = 0.f; }
        float impv[4][8]; float prevY3 = 0.f, lsum = 0.f;
        const int vlane = ((lane >> 4) & 1) * 32 + (lane & 3) * 8 + (4 * hi + ((lane & 15) >> 2)) * 64;
#pragma unroll
        for (int tl = 0; tl < 4; ++tl) {
            if (tl < ntl) {
                f32x16 p0, p1;
                qkt(p0, p1, lds + L_K + tl * SLOTB, qr, zero, r32, hi);
#pragma unroll
                for (int r = 0; r < 16; ++r) { const int c = 64 * tl + crow(r, hi);
                    p0[r] = (16 * c + 31 > qpos) ? 0.f : __builtin_amdgcn_exp2f(p0[r] - mrun);
                    p1[r] = (16 * (c + 32) + 31 > qpos) ? 0.f : __builtin_amdgcn_exp2f(p1[r] - mrun); }
                lsum += rowsum32(p0, p1);
                float rX[4], rY[4];
#pragma unroll
                for (int g4 = 0; g4 < 4; ++g4) { rX[g4] = xh_other(p0[4 * g4 + 3], hi); rY[g4] = xh_other(p1[4 * g4 + 3], hi); }
#pragma unroll
                for (int g4 = 0; g4 < 4; ++g4) {
                    const float qs0 = (p0[4 * g4] + p0[4 * g4 + 1]) + (p0[4 * g4 + 2] + p0[4 * g4 + 3]);
                    const float qs1 = (p1[4 * g4] + p1[4 * g4 + 1]) + (p1[4 * g4 + 2] + p1[4 * g4 + 3]);
                    const float lo0 = (g4 > 0) ? rX[g4 > 0 ? g4 - 1 : 0] : prevY3;
                    const float lo1 = (g4 > 0) ? rY[g4 > 0 ? g4 - 1 : 0] : rX[3];
                    impv[tl][g4] = qs0 + (hi ? rX[g4] : lo0);
                    impv[tl][4 + g4] = qs1 + (hi ? rY[g4] : lo1);
                }
                prevY3 = rY[3];
                pv(o, lds + L_V + tl * SLOTB + vlane, p0, p1);
                asm volatile("" ::: "memory");
            } else {
#pragma unroll
                for (int e = 0; e < 8; ++e) impv[tl][e] = 0.f;
            }
        }
        const float ltot = xh_sum(lsum);
        const float invl = ltot > 0.f ? 1.f / ltot : 0.f;
        LAS float* imp = (LAS float*)(lds + L_IMP);
#pragma unroll
        for (int hd = 0; hd < 4; ++hd) {
            if (hh == hd) {
#pragma unroll
                for (int tl = 0; tl < 4; ++tl)
#pragma unroll
                    for (int e = 0; e < 8; ++e) { const int jj = 16 * tl + 8 * (e >> 2) + 2 * (e & 3) + hi; LAS float* p = imp + qq * 65 + jj;
                        if (hd == 0) *p = impv[tl][e] * invl; else *p += impv[tl][e] * invl; }
            }
            LDS_WAIT(); __syncthreads();
        }
        if (hi == 0) wsf[32 + r32] = invl;
        LDS_WAIT();
        float gc[16], il[16]; load_rowvec(gc, wsf + 64, hi); load_rowvec(il, wsf + 32, hi);
#pragma unroll
        for (int d0 = 0; d0 < 2; ++d0)
#pragma unroll
            for (int r = 0; r < 16; ++r) accw[(d0 * 16 + r) * 64 + lane] = o[d0][r] * (gc[r] * il[r]);
        LDS_WAIT();
    }
    if (cur >= 16) {
        LAS float* imp = (LAS float*)(lds + L_IMP);
        const int q = tid >> 3, part = tid & 7;
        if (part == 0) { imp[q * 65] += 1e4f; imp[q * 65 + cur] += 1e4f; imp[q * 65 + cur - 1] += 1e4f; }
        LDS_WAIT(); __syncthreads();
        const LAS float* irow = imp + q * 65;
        float sc[8];
#pragma unroll
        for (int i = 0; i < 8; ++i) { const int jj = part * 8 + i; sc[i] = (jj <= cur) ? irow[jj] : -1.f; }
        int rank[8];
#pragma unroll
        for (int i = 0; i < 8; ++i) rank[i] = 0;
        const int nv = cur + 1, e0 = (8 * part < nv) ? 8 * part : nv, e1 = (8 * part + 8 < nv) ? 8 * part + 8 : nv;
        for (int jp = 0; jp < e0; ++jp) { const float v = irow[jp];
#pragma unroll
            for (int i = 0; i < 8; ++i) rank[i] += (v >= sc[i]) ? 1 : 0; }
        for (int jp = e0; jp < e1; ++jp) { const float v = irow[jp];
#pragma unroll
            for (int i = 0; i < 8; ++i) { const int jj = part * 8 + i; rank[i] += (v > sc[i] || (v == sc[i] && jp < jj)) ? 1 : 0; } }
        for (int jp = e1; jp < nv; ++jp) { const float v = irow[jp];
#pragma unroll
            for (int i = 0; i < 8; ++i) rank[i] += (v > sc[i]) ? 1 : 0; }
        unsigned bits = 0;
#pragma unroll
        for (int i = 0; i < 8; ++i) bits |= (rank[i] < 16 ? 1u : 0u) << i;
        ((LAS unsigned char*)(lds + L_SEL))[q * 8 + part] = (unsigned char)bits;
        __hip_atomic_fetch_or((LAS unsigned*)(lds + L_TL + 128) + (part >> 2), bits << (8 * (part & 3)), __ATOMIC_RELAXED, __HIP_MEMORY_SCOPE_WORKGROUP);
        LDS_WAIT(); __syncthreads();
    } else {
        if (tid < 128) ((LAS unsigned*)(lds + L_SEL))[tid] = (tid & 1) ? 0u : ((1u << (cur + 1)) - 1u);
        if (tid == 0) ((LAS unsigned*)(lds + L_TL + 128))[0] = (1u << (cur + 1)) - 1u;
        LDS_WAIT(); __syncthreads();
    }
    const LAS unsigned* selw = (const LAS unsigned*)(lds + L_SEL);
    const unsigned sel_lo = selw[qq * 2], sel_hi = selw[qq * 2 + 1];
    const unsigned ulo = ((const LAS unsigned*)(lds + L_TL + 128))[0], uhi = ((const LAS unsigned*)(lds + L_TL + 128))[1];
    unsigned long long umask = ((unsigned long long)uhi << 32) | ulo;
    umask &= (cur >= 63) ? ~0ull : ((1ull << (cur + 1)) - 1ull);
    const int jlo = cur >= 8 ? cur - 8 : 0;
    LAS unsigned char* tls = (LAS unsigned char*)(lds + L_TL);
    LAS unsigned char* tlw = tls + 64;
    if (tid < 64) {
        if ((umask >> tid) & 1ull) tls[__builtin_popcountll(umask & ((1ull << tid) - 1ull))] = (unsigned char)tid;
        if (tid <= cur - jlo) tlw[tid] = (unsigned char)(jlo + tid);
    }
    LDS_WAIT(); __syncthreads();
    const int NTs = __builtin_amdgcn_readfirstlane(__builtin_popcountll(umask)), NTw = cur - jlo + 1;
    {
        const bf16* Kh = (const bf16*)(F.ws + WS_KS) + (size_t)bg * SEQ * 64;
        const bf16* Vh = (const bf16*)(F.ws + WS_VS) + (size_t)bg * SEQ * 64;
        f32x16 o[2]; float l;
        attn_fast<1, 64, 8>(lds, Kh, Vh, tls, NTs, qr, qpos, 0, cur, sel_lo, sel_hi, nullptr, 0.f, o, l, wid, lane);
        if (hi == 0) wsf[32 + r32] = 1.f / l;
        LDS_WAIT();
        float fl[16], gs[16]; load_rowvec(fl, wsf + 32, hi); load_rowvec(gs, wsf + 96, hi);
#pragma unroll
        for (int d0 = 0; d0 < 2; ++d0)
#pragma unroll
            for (int r = 0; r < 16; ++r) accw[(d0 * 16 + r) * 64 + lane] += o[d0][r] * (fl[r] * gs[r]);
        LDS_WAIT();
    }
    {
        const bf16* Kh = (const bf16*)(F.ws + WS_KW) + (size_t)bg * SEQ * 64;
        const bf16* Vh = (const bf16*)(F.ws + WS_VW) + (size_t)bg * SEQ * 64;
        f32x16 o[2]; float l;
        attn_fast<2, 64, 8>(lds, Kh, Vh, tlw, NTw, qr, qpos, 0, cur, 0u, 0u, nullptr, 0.f, o, l, wid, lane);
        if (hi == 0) wsf[32 + r32] = 1.f / l;
        LDS_WAIT();
        float fl[16], gate_win[16]; load_rowvec(fl, wsf + 32, hi); load_rowvec(gate_win, wsf + 128, hi);
#pragma unroll
        for (int d0 = 0; d0 < 2; ++d0)
#pragma unroll
            for (int r = 0; r < 16; ++r) o[d0][r] = accw[(d0 * 16 + r) * 64 + lane] + o[d0][r] * (fl[r] * gate_win[r]);
        LDS_WAIT();
        bf16* Ow = (bf16*)(F.ws + WS_Y) + row0 * 1024 + 512 + head * 64;
        store_o_tile<1024>((LDSB*)accw, o, Ow, (float*)(F.ws + WS_SSQY) + row0 * 16 + 8 + head, lane);
    }
    __syncthreads();
}

__device__ __forceinline__ void dep_publish(Frame& F, gu32* w0, gu32* w1) {
    asm volatile("s_waitcnt vmcnt(0)" ::: "memory"); __syncthreads();
    if (F.tid == 0) { __builtin_amdgcn_fence(__ATOMIC_RELEASE, "agent"); asm volatile("s_waitcnt vmcnt(0)" ::: "memory");
        __hip_atomic_fetch_add(w0, 1u, RLX_AGENT); if (w1) __hip_atomic_fetch_add(w1, 1u, RLX_AGENT); }
}
__device__ __forceinline__ void dep_wait(Frame& F, gu32* w, unsigned need, gu32* wall, unsigned needall, int flagword) {
    if (F.wave == 0) {
        unsigned sp = 0;
        while ((unsigned)__builtin_amdgcn_readfirstlane((int)__hip_atomic_load(w, RLX_AGENT)) < need) { __builtin_amdgcn_s_sleep(4); if (++sp > (1u << 22)) break; }
        const unsigned tot = wall ? (unsigned)__builtin_amdgcn_readfirstlane((int)__hip_atomic_load(wall, RLX_AGENT)) : 0u;
        __builtin_amdgcn_fence(__ATOMIC_ACQUIRE, "agent");
        asm volatile("s_waitcnt vmcnt(0)" ::: "memory");
        if (F.lane == 0 && (!wall || tot >= needall)) F.MISC[flagword] = 1u;
    }
    LDS_WAIT(); __syncthreads();
}

constexpr int NSA_COST0 = 24;
__device__ __forceinline__ void p3_attention(Frame& F, kptr_t kp) {
    LAS unsigned short* order = (LAS unsigned short*)(F.lds + L_ORD);
    for (int id = F.tid; id < 2048; id += NTHR) {
        int pos;
        if (id >= 1024 && ((id - 1024) >> 6) < 2) pos = id - 1024;
        else {
            const int c = id < 1024 ? (63 - (id >> 4)) + NSA_COST0 : 4 * (15 - ((id - 1024) >> 6)) + 4;
            pos = 128;
            { int lo = c - NSA_COST0 + 1; if (lo < 0) lo = 0; int cnt = 64 - lo; if (cnt < 0) cnt = 0; pos += 16 * cnt; }
            { int cnt = 0; for (int qb = 0; qb < 14; ++qb) cnt += (4 * qb + 4 > c) ? 1 : 0; pos += 64 * cnt; }
            if (id < 1024) pos += (id & 15);
            else { const int cn = c - NSA_COST0; if (cn >= 0 && cn <= 63) pos += 16; pos += (id & 63); }
        }
        order[pos] = (unsigned short)id;
    }
    if (F.vcu < 8) { p2_cumsum_item(F, F.vcu * NWAVES + F.wave); dep_publish(F, F.ctl + CW_CS, nullptr); }
    LDS_WAIT(); __syncthreads();
    if (F.vcu >= F.G - 128 || F.G < 136) {
        for (int it = (F.G < 136) ? F.vcu : F.vcu - (F.G - 128); it < 128; it += (F.G < 136) ? F.G : 128) {
            p2_compress_item(F, kp, it);
            dep_publish(F, F.ctl + CW_CMP + 64 * ((it >> 2) & 15), F.ctl + CW_CMPT);
        }
    }
    gu32* qhead = F.ctl + CW_Q_ATT;
    for (;;) {
        if (F.tid == 0) F.MISC[0] = __hip_atomic_fetch_add(qhead, 1u, RLX_AGENT);
        LDS_WAIT(); __syncthreads();
        const unsigned k = F.MISC[0];
        if (k >= 2048u) break;
        const int id = (int)order[k];
        __syncthreads();
        if (id < 1024) {
            if (F.MISC[17] == 0u) dep_wait(F, F.ctl + CW_CMP + 64 * (id & 15), 8u, F.ctl + CW_CMPT, 128u, 17);
            nsa_unit(F, (id & 15) >> 1, id & 1, 63 - (id >> 4));
        } else {
            if (F.MISC[16] == 0u) dep_wait(F, F.ctl + CW_CS, 8u, nullptr, 0u, 16);
            fox_unit(F, (id & 63) >> 3, id & 7, 15 - ((id - 1024) >> 6));
        }
    }
}

__device__ __forceinline__ void p4_ynorm(Frame& F) {
    const int gw = F.vcu * NWAVES + F.wave, NGW = F.G * NWAVES;
    for (int m = gw; m < T; m += NGW) {
        bf16* row = (bf16*)(F.ws + WS_Y) + (size_t)m * 1024 + F.lane * 16;
        v4u a = *(const v4u*)row, b = *(const v4u*)(row + 8);
        float v[16];
        const unsigned w[8] = {a.x, a.y, a.z, a.w, b.x, b.y, b.z, b.w};
#pragma unroll
        for (int i = 0; i < 8; ++i) { v[2 * i] = __builtin_bit_cast(float, w[i] << 16); v[2 * i + 1] = __builtin_bit_cast(float, w[i] & 0xffff0000u); }
        float s = 0.f;
#pragma unroll
        for (int i = 0; i < 16; ++i) s += v[i] * v[i];
#pragma unroll
        for (int o = 1; o < 32; o <<= 1) s += __shfl_xor(s, o);
        const float r = 1.f / sqrtf(s * (1.f / 512.f) + EPS);
        v4u oa, ob;
        oa.x = pk2(v[0] * r, v[1] * r); oa.y = pk2(v[2] * r, v[3] * r); oa.z = pk2(v[4] * r, v[5] * r); oa.w = pk2(v[6] * r, v[7] * r);
        ob.x = pk2(v[8] * r, v[9] * r); ob.y = pk2(v[10] * r, v[11] * r); ob.z = pk2(v[12] * r, v[13] * r); ob.w = pk2(v[14] * r, v[15] * r);
        *(v4u*)row = oa; *(v4u*)(row + 8) = ob;
    }
}
__device__ __forceinline__ void p6_hnorm(Frame& F, const float* h1) {
    const int gw = F.vcu * NWAVES + F.wave, NGW = F.G * NWAVES;
    for (int m = gw; m < T; m += NGW) rms_row_to_bf16(F.lane, h1 + (size_t)m * DM, (bf16*)(F.ws + WS_XN) + (size_t)m * DM);
}
__device__ __forceinline__ void p9_final(Frame& F, float* out, const float* g_final) {
    const int gw = F.vcu * NWAVES + F.wave, NGW = F.G * NWAVES;
    for (int m = gw; m < T; m += NGW) {
        GAS f32x4* xr = (GAS f32x4*)(out + (size_t)m * DM) + F.lane;
        f32x4 v[4]; float s = 0.f;
#pragma unroll
        for (int j = 0; j < 4; ++j) { v[j] = xr[64 * j]; s += (v[j].x * v[j].x + v[j].y * v[j].y) + (v[j].z * v[j].z + v[j].w * v[j].w); }
        const float r = 1.f / sqrtf(wave_sum(s) * (1.f / DM) + EPS);
#pragma unroll
        for (int j = 0; j < 4; ++j) { const f32x4 gg = *((const f32x4*)g_final + F.lane + 64 * j); xr[64 * j] = v[j] * r * gg; }
    }
}

constexpr int N_PHASES = 10;
__global__ void __launch_bounds__(NTHR, 2) hymba_fwd(Args args) {
    extern __shared__ __attribute__((aligned(16))) unsigned char lds_raw[];
    Frame F;
    F.lds = (LDSB*)lds_raw;
    F.MISC = (volatile LAS unsigned*)(F.lds + L_MISC);
    F.tid = threadIdx.x; F.lane = F.tid & 63; F.wave = __builtin_amdgcn_readfirstlane(F.tid >> 6);
    F.G = gridDim.x; { const int bx = blockIdx.x; F.vcu = (F.G % 8 == 0) ? (bx % 8) * (F.G / 8) + bx / 8 : bx; }
    kptr_t kp0 = (kptr_t)__builtin_amdgcn_kernarg_segment_ptr();
#define KP() ({ kptr_t k_ = kp0; asm volatile("" : "+s"(k_)); k_; })
    { kptr_t kp = KP(); F.ws = *(unsigned char* const __attribute__((address_space(4)))*)(kp + 8 * 23); }
    F.ctl = (gu32*)(F.ws + WS_CTL);
    if (F.tid < 64) F.MISC[F.tid] = 0u;
    __syncthreads();
    int lo, hi; { kptr_t kp = KP(); lo = *(const int __attribute__((address_space(4)))*)(kp + 192); hi = *(const int __attribute__((address_space(4)))*)(kp + 196); }
    const bool one_launch = (hi - lo) > 1;
    XcdBarrier bar; bar.bar = (unsigned*)(F.ctl + CW_BAR); bar.x = 0; bar.st = nullptr; bar.wave = F.wave;
    if (one_launch) { bar = xcd_barrier_post((unsigned*)(F.ctl + CW_BAR), F.MISC + 8); bar.wave = F.wave; }
#ifdef PHASE_MASK
#define IN(k) (((PHASE_MASK >> (k)) & 1) && lo <= (k) && (k) < hi)
#else
#define IN(k) (lo <= (k) && (k) < hi)
#endif
#define SEAM(k) do { if (IN(k) && IN((k) + 1)) xcd_barrier(bar); } while (0)
#define RELANE() do { F.lane = lane_id(); F.tid = F.wave * 64 + F.lane; } while (0)

    if (IN(0)) { RELANE(); p0_prologue(F, KP()); SEAM(0); }

    if (IN(1)) { RELANE();
        pg8::Gemm g{(const bf16*)(F.ws + WS_XN), (const bf16*)(F.ws + WS_WIN), T, NPROJ, DM}; pg8::StaticOrder S; S.init(T, NPROJ, F.G, (int)blockIdx.x);
        kptr_t kp = KP(); EpiProj E{F.ws, AIN(kp, 3), AIN(kp, 4)};
        pg8::gemm_phase<EpiProj, pg8::StaticOrder, true, true>(F.lds, g, S, E, F.wave);
        if (IN(1) && IN(3)) xcd_barrier(bar);
    }

    if (IN(3)) { RELANE(); p3_attention(F, KP()); if (IN(3) && IN(5)) xcd_barrier(bar); }


    if (IN(5)) { RELANE();
        pg8::Gemm g{(const bf16*)(F.ws + WS_Y), (const bf16*)(F.ws + WS_WOUT), T, DM, DM}; pg8::StaticOrder S; S.init(T, DM, F.G, (int)blockIdx.x);
        pg8::Unit u0, u1; const bool hv0 = S.next(0, u0), hv1 = S.next(1, u1);
        {
            const int i = F.tid >> 8, rl = F.tid & 255; const bool hv = i ? hv1 : hv0; const int pm = i ? u1.pm : u0.pm;
            if (hv) { const f32x4* sp = (const f32x4*)((const float*)(F.ws + WS_SSQY) + (size_t)(pm * 256 + rl) * 16); const f32x4 a = sp[0], b = sp[1], c = sp[2], d = sp[3];
                const float rf = 1.f / sqrtf((((a[0] + a[1]) + (a[2] + a[3])) + ((b[0] + b[1]) + (b[2] + b[3]))) * (1.f / 512.f) + EPS);
                const float rn = 1.f / sqrtf((((c[0] + c[1]) + (c[2] + c[3])) + ((d[0] + d[1]) + (d[2] + d[3]))) * (1.f / 512.f) + EPS);
                LAS float* tab = (LAS float*)(F.lds + L_IMP + 8192) + F.tid * 2; tab[0] = rf / rn; tab[1] = rn; }
            LDS_WAIT(); __syncthreads();
        }
        kptr_t kp = KP(); EpiOutRes E{AIN(kp, 0), *(float* const __attribute__((address_space(4)))*)(kp + 8 * 22), (bf16*)(F.ws + WS_XN), (float*)(F.ws + WS_SSQ1), F.lds, u0.pm};
        pg8::gemm_phase<EpiOutRes, pg8::StaticOrder, true, true>(F.lds, g, S, E, F.wave);
        if (IN(5) && IN(7)) xcd_barrier(bar);
    }


    if (IN(7)) { RELANE();
        pg8::Gemm g{(const bf16*)(F.ws + WS_XN), (const bf16*)(F.ws + WS_WUP), T, FF, DM}; pg8::StaticOrder S; S.init(T, FF, F.G, (int)blockIdx.x);
        EpiUp E{(bf16*)(F.ws + WS_U), (const float*)(F.ws + WS_SSQ1)};
        pg8::gemm_phase<EpiUp, pg8::StaticOrder, true, true>(F.lds, g, S, E, F.wave);
        SEAM(7);
    }

    if (IN(8)) { RELANE();
        pg8::Gemm g{(const bf16*)(F.ws + WS_U), (const bf16*)(F.ws + WS_WDN), T, DM, FF}; pg8::StaticOrder S; S.init(T, DM, F.G, (int)blockIdx.x);
        kptr_t kp = KP(); EpiDownNorm E{*(float* const __attribute__((address_space(4)))*)(kp + 8 * 22), AIN(kp, 21), (float*)(F.ws + WS_XS), F.ctl + CW_PANEL, F.lds};
        pg8::gemm_phase<EpiDownNorm, pg8::StaticOrder, true, true>(F.lds, g, S, E, F.wave);
    }

#undef IN
#undef SEAM
}

extern "C" void kernel_launch(void* const* d_in, const int* in_sizes, int n_in, void* d_out, int out_size, void* d_ws, size_t ws_size, hipStream_t stream) {
    static int grid = 0;
    if (grid == 0) {
        if (n_in != 22 || out_size != T * DM || ws_size < WS_END) { fprintf(stderr, "kernel_launch: unexpected shapes (n_in %d out %d ws %zu)\n", n_in, out_size, ws_size); grid = -1; return; }
        int dev = 0, cus = 0, per_cu = 0;
        if (hipGetDevice(&dev) != hipSuccess || hipDeviceGetAttribute(&cus, hipDeviceAttributeMultiprocessorCount, dev) != hipSuccess) { grid = -1; return; }
        if (hipFuncSetAttribute((const void*)hymba_fwd, hipFuncAttributeMaxDynamicSharedMemorySize, LDS_BYTES) != hipSuccess) { fprintf(stderr, "kernel_launch: hipFuncSetAttribute failed\n"); grid = -1; return; }
        if (hipOccupancyMaxActiveBlocksPerMultiprocessor(&per_cu, (const void*)hymba_fwd, NTHR, LDS_BYTES) != hipSuccess || per_cu < 1) { fprintf(stderr, "kernel_launch: occupancy query says %d\n", per_cu); per_cu = 1; }
        (void)hipGetLastError();
        grid = cus;
    }
    if (grid < 0) return;
    (void)hipMemsetAsync((char*)d_ws + WS_CTL, 0, CTL_ZERO_BYTES, stream);
    Args a{};
    for (int i = 0; i < 22; ++i) a.in[i] = (const float*)d_in[i];
    a.out = (float*)d_out; a.ws = (unsigned char*)d_ws;
#if MK_N_LAUNCHES == 1
    a.ph_lo = 0; a.ph_hi = N_PHASES;
    void* kargs[] = {&a};
    hipError_t e = hipLaunchCooperativeKernel((const void*)hymba_fwd, dim3(grid), dim3(NTHR), kargs, LDS_BYTES, stream);
    if (e != hipSuccess) fprintf(stderr, "kernel_launch: cooperative launch failed: %s (grid %d)\n", hipGetErrorString(e), grid);
#else
    for (int p = 0; p < N_PHASES; ++p) { a.ph_lo = p; a.ph_hi = p + 1; hipLaunchKernelGGL(hymba_fwd, dim3(grid), dim3(NTHR), LDS_BYTES, stream, a); }
#endif
}
```
